# Optimizing an MI355X kernel written in HIP

```python
import math
import jax
import jax.numpy as jnp
from jax import lax
import numpy as np

D_MODEL = 1024
BATCH = 1
SEQ = 16384
DEPTH = 4

CTX_LEN = 256
GRID_W = 64
EPS = 1e-6

DA_HEADS = 4
DA_DH = 64
DA_DV = 2 * DA_DH
DA_QK_W = DA_HEADS * 2 * DA_DH
DA_W = DA_HEADS * DA_DV
DA_SCALE = DA_DH ** -0.5
Q_BLOCK = 128
ROPE_PAIRS = DA_DH // 4
ROPE_BASE = 10000.0

HG_HEADS = 4
HG_DK = 128
HG_DV = 128
HG_KW = HG_HEADS * HG_DK
HG_W = HG_HEADS * HG_DV
HG_CHUNK = 64

N_EXPERTS = 32
TOP_K = 4
D_FF = 1024
SWIGLU_ALPHA = 1.702
SWIGLU_LIMIT = 7.0
MOE_BLOCK = 256

IN_WIDTHS = (DA_QK_W, DA_QK_W, DA_W, HG_KW, HG_KW, HG_KW, HG_W, HG_W, D_MODEL, D_MODEL)
IN_COLS = 2 * DA_QK_W + DA_W + 3 * HG_KW + 2 * HG_W + 2 * D_MODEL

kernel_name = 'hybrid_diffattn_hgrn2_moe_dit'


def _rmsnorm(x, g):
    x32 = x.astype(jnp.float32)
    y = x32 * lax.rsqrt(jnp.mean(x32 * x32, axis=-1, keepdims=True) + EPS)
    return y.astype(x.dtype) * g


def _split_in(p):
    parts, o = [], 0
    for w in IN_WIDTHS:
        parts.append(p[..., o:o + w])
        o += w
    return parts


def _rotate_half(x, ang):
    x1, x2 = jnp.split(x, 2, axis=-1)
    cos, sin = jnp.cos(ang), jnp.sin(ang)
    return jnp.concatenate([x1 * cos - x2 * sin, x2 * cos + x1 * sin], axis=-1)


def _rope_2d(x, row_ang, col_ang):
    x32 = x.astype(jnp.float32)
    xr, xc = jnp.split(x32, 2, axis=-1)
    out = jnp.concatenate([_rotate_half(xr, row_ang), _rotate_half(xc, col_ang)], axis=-1)
    return out.astype(x.dtype)


def _diff_attn(qb, k, v, lam):
    s = jnp.einsum('bqhmd,bkhmd->bhmqk', qb, k).astype(jnp.float32) * DA_SCALE
    p = jax.nn.softmax(s, axis=-1)
    pd = p[:, :, 0] - lam * p[:, :, 1]
    return jnp.einsum('bhqk,bkhv->bqhv', pd.astype(v.dtype), v)


def _forget(z, lb):
    z32 = z.astype(jnp.float32)
    lb = lb.reshape(HG_HEADS, HG_DK)
    log_f = jnp.logaddexp(jnp.log(lb), jnp.log1p(-lb) + jax.nn.log_sigmoid(z32))
    k = (1.0 - lb) * jax.nn.sigmoid(-z32)
    return log_f, k


def _chunk_scan(q, k, v, log_f, s0):
    B, L = q.shape[:2]
    n = L // HG_CHUNK
    def chunks(t):
        return jnp.moveaxis(t.astype(jnp.float32).reshape(B, n, HG_CHUNK, HG_HEADS, t.shape[-1]), 1, 0)
    mask = jnp.tril(jnp.ones((HG_CHUNK, HG_CHUNK), bool))[None, :, :, None, None]
    def step(S, inp):
        qc, kc, vc, gc = inp
        b = jnp.cumsum(gc, axis=1)
        o_inter = jnp.einsum('bthd,bhdv->bthv', qc * jnp.exp(b), S)
        diff = b[:, :, None] - b[:, None, :]
        decay = jnp.exp(jnp.where(mask, diff, -jnp.inf))
        A = jnp.einsum('bthd,btshd,bshd->bhts', qc, decay, kc)
        o_intra = jnp.einsum('bhts,bshv->bthv', A, vc)
        b_last = b[:, -1]
        S_new = jnp.exp(b_last)[..., None] * S + jnp.einsum('bshd,bshv->bhdv', kc * jnp.exp(b_last[:, None] - b), vc)
        return S_new, o_inter + o_intra
    S_fin, o = lax.scan(step, s0, (chunks(q), chunks(k), chunks(v), chunks(log_f)))
    o = jnp.moveaxis(o, 0, 1).reshape(B, L, HG_HEADS, HG_DV)
    return o.astype(v.dtype), S_fin


def _hgrn2_direction(q, z, v, lb, s0, reverse):
    log_f, k = _forget(z, lb)
    if reverse:
        q, k, v, log_f = (jnp.flip(t, axis=1) for t in (q, k, v, log_f))
    o, s = _chunk_scan(q, k, v, log_f, s0)
    if reverse:
        o = jnp.flip(o, axis=1)
    return o, s


def _token_mixer(h, hc, row_ang, col_ang, w_in, qn_g, kn_g, lam_qk, subln_g,
                 lb_f, lb_b, hg_norm_g, w_branch_a, w_branch_b, w_out, layer, with_ctx):
    B, S, _ = h.shape
    Lc = hc.shape[1]
    qa, ka, va, qh, zf, zb, vh, gh, ga, gb = _split_in(h @ w_in)
    qac, kac, vac, qhc, zfc, zbc, vhc, ghc, gac, gbc = _split_in(hc @ w_in)

    lam_init = 0.8 - 0.6 * math.exp(-0.3 * layer)
    lq1, lk1, lq2, lk2 = (lam_qk[i].astype(jnp.float32) for i in range(4))
    lam = jnp.exp(jnp.sum(lq1 * lk1)) - jnp.exp(jnp.sum(lq2 * lk2)) + lam_init
    def qk(t, L, g):
        return _rmsnorm(t.reshape(B, L, DA_HEADS, 2, DA_DH), g)
    q = _rope_2d(qk(qa, S, qn_g), row_ang, col_ang)
    k = _rope_2d(qk(ka, S, kn_g), row_ang, col_ang)
    kc = qk(kac, Lc, kn_g)
    vc = vac.reshape(B, Lc, DA_HEADS, DA_DV)
    k_all = jnp.concatenate([kc, k], axis=1)
    v_all = jnp.concatenate([vc, va.reshape(B, S, DA_HEADS, DA_DV)], axis=1)
    nb = S // Q_BLOCK
    q_blocks = jnp.moveaxis(q.reshape(B, nb, Q_BLOCK, DA_HEADS, 2, DA_DH), 1, 0)
    oa = lax.map(lambda qb: _diff_attn(qb, k_all, v_all, lam), q_blocks)
    oa = jnp.moveaxis(oa, 0, 1).reshape(B, S, DA_HEADS, DA_DV)
    oa = (_rmsnorm(oa, subln_g) * (1.0 - lam_init)).reshape(B, S, DA_W)

    def hd(t, L, d):
        return t.reshape(B, L, HG_HEADS, d)
    s0 = jnp.zeros((B, HG_HEADS, HG_DK, HG_DV), jnp.float32)
    ob, obc = 0.0, 0.0
    for z, zc, lb, rev in ((zf, zfc, lb_f, False), (zb, zbc, lb_b, True)):
        oc_d, sc_d = _hgrn2_direction(hd(qhc, Lc, HG_DK), hd(zc, Lc, HG_DK), hd(vhc, Lc, HG_DV), lb, s0, rev)
        o_d, _ = _hgrn2_direction(hd(qh, S, HG_DK), hd(z, S, HG_DK), hd(vh, S, HG_DV), lb, sc_d, rev)
        ob = ob + o_d
        obc = obc + oc_d
    ob = (_rmsnorm(ob, hg_norm_g) * jax.nn.silu(hd(gh, S, HG_DV))).reshape(B, S, HG_W)

    y = (jax.nn.sigmoid(ga) * (oa @ w_branch_a) + jax.nn.sigmoid(gb) * (ob @ w_branch_b)) @ w_out
    if not with_ctx:
        return y, None
    qc = qk(qac, Lc, qn_g)
    oac = _diff_attn(qc, kc, vc, lam)
    oac = (_rmsnorm(oac, subln_g) * (1.0 - lam_init)).reshape(B, Lc, DA_W)
    obc = (_rmsnorm(obc, hg_norm_g) * jax.nn.silu(hd(ghc, Lc, HG_DV))).reshape(B, Lc, HG_W)
    yc = (jax.nn.sigmoid(gac) * (oac @ w_branch_a) + jax.nn.sigmoid(gbc) * (obc @ w_branch_b)) @ w_out
    return y, yc


def _moe(tok, router_w, router_b, w_gu, b_gu, w_down, b_down):
    T, D = tok.shape
    logits = (tok @ router_w + router_b).astype(jnp.float32)
    top_v, top_i = lax.top_k(logits, TOP_K)
    top_w = jax.nn.softmax(top_v, axis=-1)
    n_assign = T * TOP_K
    flat_e = top_i.reshape(-1)
    flat_t = jnp.repeat(jnp.arange(T, dtype=jnp.int32), TOP_K)
    flat_w = top_w.reshape(-1)
    order = jnp.argsort(flat_e, stable=True)
    e_s, t_s, w_s = flat_e[order], flat_t[order], flat_w[order]
    counts = jnp.bincount(flat_e, length=N_EXPERTS)
    starts = jnp.cumsum(counts) - counts
    padded = (counts + MOE_BLOCK - 1) // MOE_BLOCK * MOE_BLOCK
    pad_ends = jnp.cumsum(padded)
    pad_starts = pad_ends - padded
    dest = pad_starts[e_s] + (jnp.arange(n_assign) - starts[e_s])
    n_rows = -(-n_assign // MOE_BLOCK) * MOE_BLOCK + N_EXPERTS * MOE_BLOCK
    n_blocks = n_rows // MOE_BLOCK
    row_tok = jnp.full((n_rows,), T, jnp.int32).at[dest].set(t_s)
    row_w = jnp.zeros((n_rows,), tok.dtype).at[dest].set(w_s.astype(tok.dtype))
    blk_start = jnp.arange(n_blocks) * MOE_BLOCK
    blk_e = jnp.minimum(jnp.sum(blk_start[:, None] >= pad_ends[None, :], axis=1), N_EXPERTS - 1)
    xs = jnp.concatenate([tok, jnp.zeros((1, D), tok.dtype)], axis=0)[row_tok].reshape(n_blocks, MOE_BLOCK, D)
    def expert_block(args):
        xb, e = args
        gate, up = jnp.split(xb @ w_gu[e] + b_gu[e], 2, axis=-1)
        gate = jnp.minimum(gate, SWIGLU_LIMIT)
        up = jnp.clip(up, -SWIGLU_LIMIT, SWIGLU_LIMIT)
        hdn = (up + 1.0) * gate * jax.nn.sigmoid(SWIGLU_ALPHA * gate)
        return hdn @ w_down[e] + b_down[e]
    ys = lax.map(expert_block, (xs, blk_e)).reshape(n_rows, D)
    out = jnp.zeros((T + 1, D), tok.dtype).at[row_tok].add(row_w[:, None] * ys)
    return out[:T]


def setup_inputs(seed: int = 0) -> dict:
    key = jax.random.key(seed)
    ks = jax.random.split(key, 24)
    f32 = jnp.float32
    D = D_MODEL
    def nrm(k, shape, scale):
        return jax.random.normal(k, shape, f32) * scale
    return {
        'x': nrm(ks[0], (BATCH, SEQ, D), 1.0),
        'c': nrm(ks[1], (BATCH, D), 1.0),
        'ctx': nrm(ks[2], (BATCH, CTX_LEN, D), 1.0),
        'c_ctx': nrm(ks[3], (D,), 1.0),
        'ada_w': nrm(ks[4], (DEPTH, D, 6 * D), 0.5 * D ** -0.5),
        'ada_b': nrm(ks[5], (DEPTH, 6 * D), 0.02),
        'norm1_g': 1.0 + nrm(ks[6], (DEPTH, D), 0.02),
        'norm2_g': 1.0 + nrm(ks[7], (DEPTH, D), 0.02),
        'w_in': nrm(ks[8], (DEPTH, D, IN_COLS), D ** -0.5),
        'qn_g': 1.0 + nrm(ks[9], (DEPTH, DA_DH), 0.02),
        'kn_g': 1.0 + nrm(ks[10], (DEPTH, DA_DH), 0.02),
        'lam_qk': nrm(ks[11], (DEPTH, 4, DA_DH), 0.1),
        'subln_g': 1.0 + nrm(ks[12], (DEPTH, DA_DV), 0.02),
        'hg_lb': nrm(ks[13], (2, DEPTH, HG_KW), 0.1),
        'hg_norm_g': 1.0 + nrm(ks[14], (DEPTH, HG_DV), 0.02),
        'w_branch_a': nrm(ks[15], (DEPTH, DA_W, D), DA_W ** -0.5),
        'w_branch_b': nrm(ks[16], (DEPTH, HG_W, D), HG_W ** -0.5),
        'w_out': nrm(ks[17], (DEPTH, D, D), D ** -0.5),
        'router_w': nrm(ks[18], (DEPTH, D, N_EXPERTS), D ** -0.5),
        'router_b': nrm(ks[19], (DEPTH, N_EXPERTS), 0.01),
        'w_gu': nrm(ks[20], (DEPTH, N_EXPERTS, D, 2 * D_FF), D ** -0.5),
        'b_gu': nrm(ks[21], (DEPTH, N_EXPERTS, 2 * D_FF), 0.01),
        'w_down': nrm(ks[22], (DEPTH, N_EXPERTS, D_FF, D), D_FF ** -0.5),
        'b_down': nrm(ks[23], (DEPTH, N_EXPERTS, D), 0.01),
    }


def reference(x, c, ctx, c_ctx, ada_w, ada_b, norm1_g, norm2_g, w_in, qn_g, kn_g, lam_qk,
              subln_g, hg_lb, hg_norm_g, w_branch_a, w_branch_b, w_out, router_w, router_b,
              w_gu, b_gu, w_down, b_down):
    B, S, D = x.shape
    Lc = ctx.shape[1]
    rows_n = S // GRID_W
    row = jnp.repeat(jnp.arange(rows_n), GRID_W).astype(jnp.float32)
    col = jnp.tile(jnp.arange(GRID_W), rows_n).astype(jnp.float32)
    freq = ROPE_BASE ** (-jnp.arange(ROPE_PAIRS, dtype=jnp.float32) / ROPE_PAIRS)
    row_ang = (row[:, None] * freq)[:, None, None, :]
    col_ang = (col[:, None] * freq)[:, None, None, :]
    cs = jnp.cumsum(jax.nn.softmax(hg_lb.astype(jnp.float32), axis=1), axis=1)
    lb_all = cs - cs[:, :1]
    for l in range(DEPTH):
        last = l == DEPTH - 1
        mod = (jax.nn.silu(c) @ ada_w[l] + ada_b[l])[:, None, :]
        mod_c = jax.nn.silu(c_ctx) @ ada_w[l] + ada_b[l]
        sh1, sc1, g1, sh2, sc2, g2 = jnp.split(mod, 6, axis=-1)
        sh1c, sc1c, g1c, sh2c, sc2c, g2c = jnp.split(mod_c, 6, axis=-1)
        h = _rmsnorm(x, norm1_g[l]) * (1.0 + sc1) + sh1
        hc = _rmsnorm(ctx, norm1_g[l]) * (1.0 + sc1c) + sh1c
        y, yc = _token_mixer(h, hc, row_ang, col_ang, w_in[l], qn_g[l], kn_g[l], lam_qk[l], subln_g[l],
                             lb_all[0, l], lb_all[1, l], hg_norm_g[l], w_branch_a[l], w_branch_b[l],
                             w_out[l], l, not last)
        x = x + g1 * y
        h2 = _rmsnorm(x, norm2_g[l]) * (1.0 + sc2) + sh2
        tok = h2.reshape(B * S, D)
        if not last:
            ctx = ctx + g1c * yc
            h2c = _rmsnorm(ctx, norm2_g[l]) * (1.0 + sc2c) + sh2c
            tok = jnp.concatenate([tok, h2c.reshape(B * Lc, D)], axis=0)
        m = _moe(tok, router_w[l], router_b[l], w_gu[l], b_gu[l], w_down[l], b_down[l])
        x = x + g2 * m[:B * S].reshape(B, S, D)
        if not last:
            ctx = ctx + g2c * m[B * S:].reshape(B, Lc, D)
    return x
```

```cpp
#include <hip/hip_runtime.h>
#include <cstdio>
#include <cstdint>

#ifndef MK_ONE_LAUNCH
#define MK_ONE_LAUNCH 0
#endif

#define GAS __attribute__((address_space(1)))
#define LAS __attribute__((address_space(3)))
typedef unsigned short bf16;
typedef unsigned v4u __attribute__((ext_vector_type(4)));
typedef unsigned v2u __attribute__((ext_vector_type(2)));
typedef float f32x4 __attribute__((ext_vector_type(4)));
typedef float f32x16 __attribute__((ext_vector_type(16)));
typedef short bf16x8 __attribute__((ext_vector_type(8)));
typedef short s16x4 __attribute__((ext_vector_type(4)));
typedef float f32x2_t __attribute__((ext_vector_type(2)));
typedef __bf16 bf16x2_t __attribute__((ext_vector_type(2)));

constexpr int D = 1024, SEQ = 16384, LC = 256, NT = SEQ + LC, DEPTH = 4;
constexpr int INC = 6144, NE = 32, DFF = 1024, TOPK = 4;
constexpr int CAP = NT;
constexpr int PROJW = 4608;
constexpr int PC_QH = 0, PC_ZF = 512, PC_ZB = 1024, PC_VH = 1536, PC_GH = 2048, PC_GA = 2560, PC_GB = 3584;
constexpr int LDV = NT;
constexpr float EPS = 1e-6f;
constexpr int NWAVES = 8, NTHR = 512;
constexpr int NPH_PRO = 2, NPH_LAYER = 10, NPHASES = NPH_PRO + NPH_LAYER * DEPTH;

constexpr size_t MiB = 1u << 20;
constexpr size_t WS_CTL = 0, CTL_ZERO_BYTES = 1 * MiB;
constexpr size_t WS_MODP = 1 * MiB;
constexpr size_t WS_MODV = WS_MODP + 2 * MiB;
constexpr size_t WS_LB = WS_MODV + 1 * MiB;
constexpr size_t WS_ROPE = WS_LB + 1 * MiB;
constexpr size_t WS_WIN = WS_ROPE + 1 * MiB;
constexpr size_t WIN_L = (size_t)5632 * 1024 * 2;
constexpr size_t WS_WV = WS_WIN + 4 * WIN_L;
constexpr size_t WV_L = (size_t)512 * 1024 * 2;
constexpr size_t WS_WAB = WS_WV + 4 * WV_L;
constexpr size_t WAB_L = (size_t)2048 * 512 * 2;
constexpr size_t WS_WO = WS_WAB + 4 * WAB_L;
constexpr size_t WO_L = (size_t)1024 * 1024 * 2;
constexpr size_t WS_WGU = WS_WO + 4 * WO_L;
constexpr size_t WGU_E = (size_t)2048 * 1024 * 2, WGU_L = 32 * WGU_E;
constexpr size_t WS_WD = WS_WGU + 4 * WGU_L;
constexpr size_t WD_E = (size_t)1024 * 1024 * 2, WD_L = 32 * WD_E;
constexpr size_t WS_XRES = WS_WD + 4 * WD_L;
constexpr size_t WS_H = WS_XRES + (size_t)NT * D * 4;
constexpr size_t WS_Q = WS_H + (size_t)NT * D * 2;
constexpr size_t WS_K = WS_Q + (size_t)NT * 512 * 2;
constexpr size_t WS_VT = WS_K + (size_t)NT * 512 * 2;
constexpr size_t WS_PROJ = WS_VT + (size_t)512 * LDV * 2;
constexpr size_t WS_OAB = WS_PROJ + (size_t)NT * PROJW * 2;
constexpr size_t WS_OBF = WS_OAB + (size_t)2 * NT * 512 * 2;
constexpr size_t WS_U = WS_OBF + (size_t)NT * 512 * 4;
constexpr size_t WS_HGU = WS_U + (size_t)NT * D * 2;
constexpr size_t WS_HGD = WS_HGU + (size_t)512 * 16384 * 4;
constexpr size_t WS_HGS = WS_HGD + 1 * MiB;
constexpr size_t WS_TOK = WS_HGS + (size_t)520 * 16384 * 4;
constexpr size_t WS_XS = WS_TOK + (size_t)NT * 64;
constexpr size_t SLAB = (size_t)NE * CAP * D * 2;
constexpr size_t WS_HDN = WS_XS + SLAB;
constexpr size_t WS_END = WS_HDN + SLAB;
constexpr int CW_TMO = 0;
constexpr int CW_BAR = 4096;
constexpr int CW_CNT = 16384;

constexpr int LDS_BYTES = 162816;
constexpr int MISC_OFF = LDS_BYTES - 256;

#define RLX_AGENT __ATOMIC_RELAXED, __HIP_MEMORY_SCOPE_AGENT
__device__ __forceinline__ unsigned pk2(float lo, float hi) { f32x2_t v = {lo, hi}; bf16x2_t b = __builtin_convertvector(v, bf16x2_t); return __builtin_bit_cast(unsigned, b); }
__device__ __forceinline__ float bflo(unsigned w) { return __uint_as_float(w << 16); }
__device__ __forceinline__ float bfhi(unsigned w) { return __uint_as_float(w & 0xffff0000u); }
__device__ __forceinline__ float bf2f(bf16 b) { return __uint_as_float(((unsigned)b) << 16); }
__device__ __forceinline__ float wave_sum(float v) {
#pragma unroll
    for (int o = 1; o < 64; o <<= 1) v += __shfl_xor(v, o);
    return v;
}
__device__ __forceinline__ float fast_exp(float x) { return __builtin_amdgcn_exp2f(x * 1.4426950408889634f); }
__device__ __forceinline__ float fast_log(float x) { return __builtin_amdgcn_logf(x) * 0.6931471805599453f; }
__device__ __forceinline__ float fast_rcp(float x) { return __builtin_amdgcn_rcpf(x); }
__device__ __forceinline__ float sigmoidf_(float x) { return fast_rcp(1.f + fast_exp(-x)); }
__device__ __forceinline__ int perm8(int s) { return (s & ~31) | (((s >> 2) & 1) << 4) | (((s >> 3) & 3) << 2) | (s & 3); }

namespace pg8 {
#define PG8_LAS __attribute__((address_space(3)))
typedef unsigned short bf16_t;
typedef short bf16x8 __attribute__((ext_vector_type(8)));
typedef float f32x4 __attribute__((ext_vector_type(4)));
typedef unsigned u32x4 __attribute__((ext_vector_type(4)));
constexpr int BM = 256, BK = 64, HALF = 128, HTB = HALF * BK * 2  , STAGE_BYTES = 8 * HTB, NXCD = 8, WGM = 8;

__host__ __device__ __forceinline__ int lds_byte(int r, int c) { const int st = (r >> 4) * 2 + (c >> 5), rr = r & 15, cc = c & 31, ob = rr * 64 + cc * 2; return st * 1024 + (ob ^ (((ob >> 9) & 1) << 5)); }
__host__ __device__ __forceinline__ void stage_rc(int b, int& R, int& C) { const int st = b / 1024, sb = b % 1024, swz = sb ^ (((sb >> 9) & 1) << 5); R = (st >> 1) * 16 + swz / 64; C = (st & 1) * 32 + (swz % 64) / 2; }
__host__ __device__ __forceinline__ int perm32(int rho) { const int n = rho >> 4, i = rho & 15; return 8 * (i >> 2) + 4 * n + (i & 3); }

struct Unit { int pm, pn; };
struct Gemm { const bf16_t* A; const bf16_t* Bt; int M, N, K; };
struct StaticOrder {
    int nM, nN, nwg, G, c;
    __host__ __device__ void init(int M, int N, int G_, int c_) { nM = M / BM; nN = N / BM; nwg = nM * nN; G = G_; c = c_; }
    __host__ __device__ bool next(int i, Unit& u) const {
        const long L = (long)i * G + c; if (L >= nwg) return false;
        int wgid = (int)L; { const int q = nwg / NXCD, r = nwg % NXCD, xcd = wgid % NXCD, off = wgid / NXCD; wgid = (xcd < r ? xcd * (q + 1) : r * (q + 1) + (xcd - r) * q) + off; }
        const int nig = WGM * nN, gid = wgid / nig, fm = gid * WGM, gsz = (nM - fm) < WGM ? (nM - fm) : WGM;
        u.pm = fm + ((wgid % nig) % gsz); u.pn = (wgid % nig) / gsz; return true;
    }
    __device__ __forceinline__ void a_ready(const Unit&) const {}
    __device__ __forceinline__ void done(const Unit&) const {}
};
struct MergeOrder {
    int nM, G, c;
    __device__ bool next(int i, Unit& u) const {
        const int L = (i >> 1) * G + c, br = i & 1; if (L >= nM * 4) return false;
        u.pm = 65 * br + (L >> 2); u.pn = 4 * br + (L & 3); return true;
    }
    __device__ __forceinline__ void a_ready(const Unit&) const {}
    __device__ __forceinline__ void done(const Unit&) const {}
};
template <int NPN_LOG> struct MoeOrder {
    const PG8_LAS int* ptab; int G, c;
    __device__ bool next(int i, Unit& u) const {
        const int L = i * G + c, tr = L >> NPN_LOG, pn = L & ((1 << NPN_LOG) - 1);
        const int total = __builtin_amdgcn_readfirstlane(ptab[32]); if (tr >= total) return false;
        int e = 0;
#pragma unroll 1
        for (int j = 1; j < 32; ++j) { const int pj = __builtin_amdgcn_readfirstlane(ptab[j]); e = (tr >= pj) ? j : e; }
        const int pe = __builtin_amdgcn_readfirstlane(ptab[e]);
        u.pm = 65 * e + (tr - pe); u.pn = (e << NPN_LOG) + pn; return true;
    }
    __device__ __forceinline__ void a_ready(const Unit&) const {}
    __device__ __forceinline__ void done(const Unit&) const {}
};

template <class Epi, class Sched, bool ALIGN_EPI = false, bool SP2 = false>
__device__ __forceinline__ void gemm_phase(PG8_LAS unsigned char* lds, const Gemm g, const Sched& S, const Epi& E) {
    int tid_ = threadIdx.x; asm volatile("" : "+v"(tid_));
    const int tid = tid_, wid = __builtin_amdgcn_readfirstlane(tid >> 6), lane = tid & 63, wr = wid >> 2, wc = wid & 3, fr = lane & 15, fq = lane >> 4;
    const int K = g.K, nt = K / BK;
    unsigned voffA[2], voffB[2];
#pragma unroll
    for (int i = 0; i < 2; ++i) { int R, C; stage_rc(tid * 16 + i * 8192, R, C); const int Rb = Epi::PERM ? ((R & ~31) + perm32(R & 31)) : R;
        voffA[i] = (unsigned)(R * K + C) * 2u; voffB[i] = (unsigned)(Rb * K + C) * 2u; }
    const size_t kstep = (size_t)(BK * 2);
    const size_t hstep = (size_t)HALF * K * 2;
    const size_t tstep = 2 * hstep;
    const unsigned ldsw = (unsigned)wid * 1024u;
    const int aoff = lds_byte(wr * 64 + fr, fq * 8), boff = lds_byte(wc * 32 + fr, fq * 8);
#define PG8_SA(b, h) (((b) * 2 + (h)) * HTB)
#define PG8_SB(b, h) ((4 + (b) * 2 + (h)) * HTB)
#define PG8_STAGE(bufoff, gbase, voff) do { _Pragma("unroll") for (int _i = 0; _i < 2; ++_i) \
        __builtin_amdgcn_global_load_lds((const unsigned*)((const char*)(gbase) + (voff)[_i]), (PG8_LAS unsigned*)(lds + (bufoff) + ldsw + _i * 8192), 16, 0, 0); } while (0)
#define PG8_LDA(dst, b, h) do { _Pragma("unroll") for (int m = 0; m < 4; ++m) _Pragma("unroll") for (int k = 0; k < 2; ++k) dst[m][k] = *(const PG8_LAS bf16x8*)(lds + PG8_SA(b, h) + aoff + m * 2048 + k * 1024); } while (0)
#define PG8_LDB(dst, b, h) do { _Pragma("unroll") for (int n = 0; n < 2; ++n) _Pragma("unroll") for (int k = 0; k < 2; ++k) dst[n][k] = *(const PG8_LAS bf16x8*)(lds + PG8_SB(b, h) + boff + n * 2048 + k * 1024); } while (0)
#define PG8_MMA(ai, bj, At, Bt) do { __builtin_amdgcn_s_setprio(1); _Pragma("unroll") for (int m = 0; m < 4; ++m) _Pragma("unroll") for (int n = 0; n < 2; ++n) _Pragma("unroll") for (int k = 0; k < 2; ++k) \
        acc[ai][bj][m][n] = __builtin_amdgcn_mfma_f32_16x16x32_bf16(Bt[n][k], At[m][k], acc[ai][bj][m][n], 0, 0, 0); __builtin_amdgcn_s_setprio(0); } while (0)
#define PG8_WAIT_V(n) asm volatile("s_waitcnt vmcnt(" #n ")" ::: "memory")
#define PG8_WAIT_L(n) asm volatile("s_waitcnt lgkmcnt(" #n ")" ::: "memory")
#define PG8_BAR __builtin_amdgcn_s_barrier()
#define PG8_SCHED __builtin_amdgcn_sched_barrier(0)
    Unit cur, nxt; int ui = 0;
    if (!S.next(0, cur)) return;
    f32x4 acc[2][2][4][2];
#pragma unroll
    for (int a = 0; a < 2; ++a)
#pragma unroll
        for (int b = 0; b < 2; ++b)
#pragma unroll
            for (int m = 0; m < 4; ++m)
#pragma unroll
                for (int n = 0; n < 2; ++n) acc[a][b][m][n] = (f32x4){0.f, 0.f, 0.f, 0.f};
    bf16x8 At[4][2], B0[2][2], B1[2][2];
    const char* cA = (const char*)g.A + (size_t)cur.pm * tstep; const char* cB = (const char*)g.Bt + (size_t)cur.pn * tstep;
    S.a_ready(cur);
    if constexpr (SP2) {
        PG8_STAGE(PG8_SB(0, 0), cB, voffB); PG8_STAGE(PG8_SB(0, 1), cB + hstep, voffB); PG8_STAGE(PG8_SA(0, 0), cA, voffA); PG8_STAGE(PG8_SA(0, 1), cA + hstep, voffA);
        if (wr == 1) PG8_BAR;
        PG8_WAIT_V(2); PG8_BAR;
        PG8_STAGE(PG8_SB(1, 0), cB + kstep, voffB); PG8_STAGE(PG8_SA(1, 0), cA + kstep, voffA); PG8_STAGE(PG8_SB(1, 1), cB + hstep + kstep, voffB);
        PG8_WAIT_V(6); PG8_BAR;
    } else {
        PG8_STAGE(PG8_SB(0, 0), cB, voffB); PG8_STAGE(PG8_SA(0, 0), cA, voffA); PG8_STAGE(PG8_SB(0, 1), cB + hstep, voffB); PG8_STAGE(PG8_SA(0, 1), cA + hstep, voffA);
        if (wr == 1) PG8_BAR;
        PG8_WAIT_V(4); PG8_BAR;
        PG8_STAGE(PG8_SB(1, 0), cB + kstep, voffB); PG8_STAGE(PG8_SA(1, 0), cA + kstep, voffA); PG8_STAGE(PG8_SB(1, 1), cB + hstep + kstep, voffB);
        PG8_WAIT_V(6); PG8_BAR;
    }
    for (;;) {
        const bool has_next = S.next(ui + 1, nxt);
        const char* nA = has_next ? (const char*)g.A + (size_t)nxt.pm * tstep : cA; const char* nB = has_next ? (const char*)g.Bt + (size_t)nxt.pn * tstep : cB;
        for (int t = 0; t < nt; t += 2) {
            const bool last = (t == nt - 2);
            const char* a1 = cA + (size_t)(t + 1) * kstep;
            const char* a2 = last ? nA : cA + (size_t)(t + 2) * kstep; const char* b2 = last ? nB : cB + (size_t)(t + 2) * kstep;
            const char* a3 = a2 + kstep; const char* b3 = b2 + kstep;
            if (last && has_next) S.a_ready(nxt);
            if constexpr (SP2) {
            PG8_LDB(B0, 0, 0); PG8_LDB(B1, 0, 1); PG8_SCHED; PG8_LDA(At, 0, 0); PG8_STAGE(PG8_SA(1, 1), a1 + hstep, voffA);
            PG8_WAIT_V(8); PG8_WAIT_L(0); PG8_BAR; PG8_MMA(0, 0, At, B0); PG8_MMA(0, 1, At, B1); PG8_BAR; PG8_SCHED;
            PG8_LDA(At, 0, 1); PG8_STAGE(PG8_SB(0, 0), b2, voffB); PG8_STAGE(PG8_SB(0, 1), b2 + hstep, voffB); PG8_STAGE(PG8_SA(0, 0), a2, voffA);
            PG8_WAIT_V(8); PG8_WAIT_L(0); PG8_BAR; PG8_MMA(1, 0, At, B0); PG8_MMA(1, 1, At, B1); PG8_BAR; PG8_SCHED;
            PG8_LDB(B0, 1, 0); PG8_LDB(B1, 1, 1); PG8_SCHED; PG8_LDA(At, 1, 0); PG8_STAGE(PG8_SA(0, 1), a2 + hstep, voffA);
            PG8_WAIT_V(8); PG8_WAIT_L(0); PG8_BAR; PG8_MMA(0, 0, At, B0); PG8_MMA(0, 1, At, B1); PG8_BAR; PG8_SCHED;
            PG8_LDA(At, 1, 1); PG8_STAGE(PG8_SB(1, 0), b3, voffB); PG8_STAGE(PG8_SB(1, 1), b3 + hstep, voffB); PG8_STAGE(PG8_SA(1, 0), a3, voffA);
            PG8_WAIT_V(8); PG8_WAIT_L(0); PG8_BAR; PG8_MMA(1, 0, At, B0); PG8_MMA(1, 1, At, B1); PG8_BAR; PG8_SCHED;
            } else {
            PG8_LDB(B0, 0, 0); PG8_SCHED; PG8_LDA(At, 0, 0); PG8_STAGE(PG8_SA(1, 1), a1 + hstep, voffA);
            PG8_WAIT_L(8); PG8_BAR; PG8_WAIT_L(0); PG8_MMA(0, 0, At, B0); PG8_BAR; PG8_SCHED;
            PG8_LDB(B1, 0, 1); PG8_STAGE(PG8_SB(0, 0), b2, voffB);
            PG8_BAR; PG8_WAIT_L(0); PG8_MMA(0, 1, At, B1); PG8_BAR;
            PG8_LDA(At, 0, 1); PG8_STAGE(PG8_SA(0, 0), a2, voffA);
            PG8_BAR; PG8_WAIT_L(0); PG8_MMA(1, 0, At, B0); PG8_BAR; PG8_SCHED;
            PG8_STAGE(PG8_SB(0, 1), b2 + hstep, voffB);
            PG8_WAIT_V(6); PG8_BAR; PG8_MMA(1, 1, At, B1); PG8_BAR;
            PG8_LDB(B0, 1, 0); PG8_SCHED; PG8_LDA(At, 1, 0); PG8_STAGE(PG8_SA(0, 1), a2 + hstep, voffA);
            PG8_WAIT_L(8); PG8_BAR; PG8_WAIT_L(0); PG8_MMA(0, 0, At, B0); PG8_BAR; PG8_SCHED;
            PG8_LDB(B1, 1, 1); PG8_STAGE(PG8_SB(1, 0), b3, voffB);
            PG8_BAR; PG8_WAIT_L(0); PG8_MMA(0, 1, At, B1); PG8_BAR;
            PG8_LDA(At, 1, 1); PG8_STAGE(PG8_SA(1, 0), a3, voffA);
            PG8_BAR; PG8_WAIT_L(0); PG8_MMA(1, 0, At, B0); PG8_BAR; PG8_SCHED;
            PG8_STAGE(PG8_SB(1, 1), b3 + hstep, voffB);
            PG8_WAIT_V(6); PG8_BAR; PG8_MMA(1, 1, At, B1); PG8_BAR;
            }
        }
        if constexpr (ALIGN_EPI) { if (wr == 0) PG8_BAR; }
        if constexpr (!Epi::AFTER_DRAIN) { E(acc, cur, wr, wc, fr, fq); S.done(cur); }
        if (!has_next) break;
#pragma unroll
        for (int a = 0; a < 2; ++a)
#pragma unroll
            for (int b = 0; b < 2; ++b)
#pragma unroll
                for (int m = 0; m < 4; ++m)
#pragma unroll
                    for (int n = 0; n < 2; ++n) acc[a][b][m][n] = (f32x4){0.f, 0.f, 0.f, 0.f};
        cur = nxt; cA = nA; cB = nB; ++ui;
        if constexpr (ALIGN_EPI) { if (wr == 1) PG8_BAR; }
    }
    PG8_WAIT_V(0);
    if constexpr (!ALIGN_EPI) { if (wr == 0) PG8_BAR; }
    PG8_BAR;
    if constexpr (Epi::AFTER_DRAIN) { E.fused(acc, cur, wr, wc, fr, fq, lds, wid, lane); S.done(cur); }
#undef PG8_SA
#undef PG8_SB
#undef PG8_STAGE
#undef PG8_LDA
#undef PG8_LDB
#undef PG8_MMA
#undef PG8_WAIT_V
#undef PG8_WAIT_L
#undef PG8_BAR
#undef PG8_SCHED
}
}


struct Params { const float* in[24]; float* out; unsigned char* ws; int ph_lo, ph_hi; };
enum { I_X = 0, I_C, I_CTX, I_CCTX, I_ADAW, I_ADAB, I_N1G, I_N2G, I_WIN, I_QNG, I_KNG, I_LAMQK, I_SUBLN, I_HGLB, I_HGNG, I_WBA, I_WBB, I_WOUT, I_RW, I_RB, I_WGU, I_BGU, I_WDN, I_BDN };

#define LDS_WAIT() asm volatile("s_waitcnt lgkmcnt(0)" ::: "memory")

template <int KIND>
__device__ __forceinline__ void transpose_item(const float* __restrict__ W, int K, int N, bf16* WT, bf16* WT2, int row_off, int k0, int n0, LAS float* scr, int lane) {
#pragma unroll 4
    for (int it = 0; it < 16; ++it) {
        const int k = 4 * it + (lane >> 4), n4 = (lane & 15) * 4;
        const f32x4 v = *(const f32x4*)(W + (size_t)(k0 + k) * N + n0 + n4);
        *(LAS f32x4*)(scr + k * 64 + (n4 ^ (4 * ((k >> 3) & 7)))) = v;
    }
    LDS_WAIT();
    const int c = lane & 7;
#pragma unroll 2
    for (int j2 = 0; j2 < 8; ++j2) {
        const int nl = (lane >> 3) + 8 * j2, n = n0 + nl;
        const LAS float* s = scr + (8 * c) * 64 + (nl ^ (4 * c));
        v4u o; o.x = pk2(s[0], s[64]); o.y = pk2(s[128], s[192]); o.z = pk2(s[256], s[320]); o.w = pk2(s[384], s[448]);
        bf16* dst;
        if (KIND == 0) dst = WT + (size_t)(row_off + n) * K;
        else if (KIND == 1) dst = WT + (size_t)(row_off + perm8(n)) * K;
        else if (KIND == 2) {
            if (n < 1024) { const int tile = n >> 8, G = (n >> 6) & 3, bj = (n >> 5) & 1, e = n & 31; dst = WT + (size_t)(256 * tile + 128 * bj + 32 * G + e) * K; }
            else if (n < 1536) dst = WT2 + (size_t)(n - 1024) * K;
            else dst = WT + (size_t)(1024 + perm8(n - 1536)) * K;
        } else {
            const int half = n >> 10, nn = n & 1023;
            dst = WT + (size_t)(256 * (nn >> 7) + 128 * half + perm8(nn & 127)) * K;
        }
        *(v4u*)(dst + k0 + 8 * c) = o;
    }
    LDS_WAIT();
}

__device__ __forceinline__ void sincos_d(double x, double& s, double& c) {
    const double k = __builtin_rint(x * 0.63661977236758134308);
    double r = __builtin_fma(-k, 1.57079632679489655800e+00, x); r = __builtin_fma(-k, 6.12323399573676603587e-17, r);
    const double r2 = r * r;
    double sp = -1.0 / 1307674368000.0; sp = sp * r2 + 1.0 / 6227020800.0; sp = sp * r2 - 1.0 / 39916800.0; sp = sp * r2 + 1.0 / 362880.0; sp = sp * r2 - 1.0 / 5040.0; sp = sp * r2 + 1.0 / 120.0; sp = sp * r2 - 1.0 / 6.0; sp = sp * r2 + 1.0;
    const double sr = sp * r;
    double cp = 1.0 / 20922789888000.0; cp = cp * r2 - 1.0 / 87178291200.0; cp = cp * r2 + 1.0 / 479001600.0; cp = cp * r2 - 1.0 / 3628800.0; cp = cp * r2 + 1.0 / 40320.0; cp = cp * r2 - 1.0 / 720.0; cp = cp * r2 + 1.0 / 24.0; cp = cp * r2 - 0.5; cp = cp * r2 + 1.0;
    const int q = ((int)k) & 3;
    s = (q == 0) ? sr : (q == 1) ? cp : (q == 2) ? -sr : -cp;
    c = (q == 0) ? cp : (q == 1) ? -sr : (q == 2) ? -cp : sr;
}

__device__ __forceinline__ void phase_p0a(const Params& P, LAS unsigned char* lds, int G) {
    int tid_ = threadIdx.x; asm volatile("" : "+v"(tid_));
    const int tid = tid_, lane = tid & 63, wave = tid >> 6;
    unsigned char* ws = P.ws;
    LAS float* sil = (LAS float*)(lds + 131072);
    for (int i = tid; i < 2048; i += NTHR) { const float v = (i < 1024) ? P.in[I_C][i] : P.in[I_CCTX][i - 1024]; sil[i] = v * sigmoidf_(v); }
    __syncthreads();
    {
        float* modp = (float*)(ws + WS_MODP);
        for (int t = blockIdx.x * NTHR + tid; t < DEPTH * 8 * 6144; t += G * NTHR) {
            const int j = t % 6144, lp = t / 6144, part = lp & 7, l = lp >> 3;
            const float* w = P.in[I_ADAW] + ((size_t)l * D + part * 128) * 6144 + j;
            float a0 = 0.f, a1 = 0.f;
#pragma unroll 8
            for (int i = 0; i < 128; ++i) { const float wv = w[(size_t)i * 6144]; a0 += sil[part * 128 + i] * wv; a1 += sil[1024 + part * 128 + i] * wv; }
            modp[((size_t)(l * 8 + part) * 2 + 0) * 6144 + j] = a0;
            modp[((size_t)(l * 8 + part) * 2 + 1) * 6144 + j] = a1;
        }
    }
    {
        float* lbo = (float*)(ws + WS_LB);
        for (int t = blockIdx.x * NTHR + tid; t < 2 * 512; t += G * NTHR) {
            const int dir = t >> 9, j = t & 511;
            float v[DEPTH], mx = -1e30f;
#pragma unroll
            for (int l = 0; l < DEPTH; ++l) { v[l] = P.in[I_HGLB][((size_t)dir * DEPTH + l) * 512 + j]; mx = fmaxf(mx, v[l]); }
            float sum = 0.f;
#pragma unroll
            for (int l = 0; l < DEPTH; ++l) { v[l] = expf(v[l] - mx); sum += v[l]; }
            float cs = 0.f, first = 0.f;
#pragma unroll
            for (int l = 0; l < DEPTH; ++l) { cs += v[l] / sum; if (l == 0) first = cs; lbo[((size_t)dir * DEPTH + l) * 512 + j] = cs - first; }
        }
    }
    {
        float* rt = (float*)(ws + WS_ROPE);
        for (int t = blockIdx.x * NTHR + tid; t < 256 * 16; t += G * NTHR) {
            const int pos = t >> 4, fi = t & 15;
            const float freq = (float)exp2(-(double)fi * (13.287712379549449 / 16.0));
            const float ang = (float)pos * freq;
            double s, c; sincos_d((double)ang, s, c);
            rt[2 * t] = (float)c; rt[2 * t + 1] = (float)s;
        }
    }
    {
        LAS float* scr = (LAS float*)(lds + wave * 16384);
        const int gw = blockIdx.x * NWAVES + wave, NGW = G * NWAVES;
        constexpr int I_IN = 16 * 96, I_A = 8 * 16, I_B = 8 * 16, I_O = 16 * 16, I_GU = 16 * 32, I_DN = 16 * 16;
        constexpr int PER_L = I_IN + I_A + I_B + I_O + NE * I_GU + NE * I_DN;
        for (int it = gw; it < DEPTH * PER_L; it += NGW) {
            const int l = it / PER_L; int r = it % PER_L;
            if (r < I_IN) { const int kb = r / 96, nb = r % 96;
                transpose_item<2>(P.in[I_WIN] + (size_t)l * D * INC, D, INC, (bf16*)(ws + WS_WIN + l * WIN_L), (bf16*)(ws + WS_WV + l * WV_L), 0, 64 * kb, 64 * nb, scr, lane); continue; }
            r -= I_IN;
            if (r < I_A) { const int kb = r / 16, nb = r % 16;
                transpose_item<1>(P.in[I_WBA] + (size_t)l * 512 * D, 512, D, (bf16*)(ws + WS_WAB + l * WAB_L), nullptr, 0, 64 * kb, 64 * nb, scr, lane); continue; }
            r -= I_A;
            if (r < I_B) { const int kb = r / 16, nb = r % 16;
                transpose_item<1>(P.in[I_WBB] + (size_t)l * 512 * D, 512, D, (bf16*)(ws + WS_WAB + l * WAB_L), nullptr, 1024, 64 * kb, 64 * nb, scr, lane); continue; }
            r -= I_B;
            if (r < I_O) { const int kb = r / 16, nb = r % 16;
                transpose_item<0>(P.in[I_WOUT] + (size_t)l * D * D, D, D, (bf16*)(ws + WS_WO + l * WO_L), nullptr, 0, 64 * kb, 64 * nb, scr, lane); continue; }
            r -= I_O;
            if (r < NE * I_GU) { const int e = r / I_GU, q = r % I_GU, kb = q / 32, nb = q % 32;
                transpose_item<3>(P.in[I_WGU] + ((size_t)l * NE + e) * D * 2048, D, 2048, (bf16*)(ws + WS_WGU + l * WGU_L + e * WGU_E), nullptr, 0, 64 * kb, 64 * nb, scr, lane); continue; }
            r -= NE * I_GU;
            { const int e = r / I_DN, q = r % I_DN, kb = q / 16, nb = q % 16;
                transpose_item<1>(P.in[I_WDN] + ((size_t)l * NE + e) * DFF * D, DFF, D, (bf16*)(ws + WS_WD + l * WD_L + e * WD_E), nullptr, 0, 64 * kb, 64 * nb, scr, lane); }
        }
    }
}

__device__ __forceinline__ const float* modv_ptr(const Params& P, int l, int w) { return (const float*)(P.ws + WS_MODV) + ((size_t)l * 2 + w) * 6144; }
__device__ __forceinline__ const float* xin_row(const Params& P, int l, int row) {
    if (l == 0) return (row < SEQ) ? P.in[I_X] + (size_t)row * D : P.in[I_CTX] + (size_t)(row - SEQ) * D;
    return (const float*)(P.ws + WS_XRES) + (size_t)row * D;
}
__device__ __forceinline__ void norm_store_row(const f32x4 (&v)[4], const LAS float* A, const LAS float* B, bf16* hrow, int lane) {
    float ss = 0.f;
#pragma unroll
    for (int j = 0; j < 4; ++j) ss += (v[j].x * v[j].x + v[j].y * v[j].y) + (v[j].z * v[j].z + v[j].w * v[j].w);
    const float rstd = __builtin_amdgcn_rsqf(wave_sum(ss) * (1.f / D) + EPS);
#pragma unroll
    for (int j = 0; j < 4; ++j) {
        const f32x4 a = *(const LAS f32x4*)(A + 4 * lane + 256 * j), b = *(const LAS f32x4*)(B + 4 * lane + 256 * j);
        const f32x4 y = v[j] * rstd * a + b;
        v2u o; o.x = pk2(y.x, y.y); o.y = pk2(y.z, y.w);
        *(v2u*)(hrow + 4 * lane + 256 * j) = o;
    }
}

__device__ __forceinline__ void phase_p0b(const Params& P, LAS unsigned char* lds, int G) {
    int tid_ = threadIdx.x; asm volatile("" : "+v"(tid_));
    const int tid = tid_, lane = tid & 63, wave = tid >> 6;
    unsigned char* ws = P.ws;
    const float* modp = (const float*)(ws + WS_MODP);
    float* modv = (float*)(ws + WS_MODV);
    for (int t = blockIdx.x * NTHR + tid; t < DEPTH * 2 * 6144; t += G * NTHR) {
        const int j = t % 6144, lw = t / 6144, w = lw & 1, l = lw >> 1;
        float a = P.in[I_ADAB][(size_t)l * 6144 + j];
#pragma unroll
        for (int p = 0; p < 8; ++p) a += modp[((size_t)(l * 8 + p) * 2 + w) * 6144 + j];
        modv[t] = a;
    }
    LAS float* TA = (LAS float*)lds;
    LAS float* TB = (LAS float*)(lds + 8192);
    for (int i = tid; i < 2048; i += NTHR) {
        const int w = i >> 10, j = i & 1023;
        float sh = P.in[I_ADAB][j], sc = P.in[I_ADAB][1024 + j];
#pragma unroll
        for (int p = 0; p < 8; ++p) { sh += modp[((size_t)p * 2 + w) * 6144 + j]; sc += modp[((size_t)p * 2 + w) * 6144 + 1024 + j]; }
        TA[i] = P.in[I_N1G][j] * (1.f + sc); TB[i] = sh;
    }
    __syncthreads();
    bf16* H = (bf16*)(ws + WS_H);
    for (int row = blockIdx.x * NWAVES + wave; row < NT; row += G * NWAVES) {
        const float* xr = xin_row(P, 0, row); const int w = row >= SEQ;
        f32x4 v[4];
#pragma unroll
        for (int j = 0; j < 4; ++j) v[j] = *(const f32x4*)(xr + 4 * lane + 256 * j);
        norm_store_row(v, TA + 1024 * w, TB + 1024 * w, H + (size_t)row * D, lane);
    }
}

using pg8::Unit;

struct EpiInProj {
    static constexpr bool PERM = false, AFTER_DRAIN = false;
    bf16* Q; bf16* K; bf16* proj; const float* qn_g; const float* kn_g; const float* rope;
    __device__ __forceinline__ void operator()(const f32x4 (&acc)[2][2][4][2], const Unit& u, int wr, int wc, int fr, int fq) const {
        const int row0 = u.pm * 256 + wr * 64 + fr;
        if (u.pn < 4) {
            const bool isq = u.pn < 2; const int gg = 4 * (u.pn & 1) + wc, hh = gg >> 1, mm = gg & 1;
            const float* gv = isq ? qn_g : kn_g; bf16* dstb = (isq ? Q : K) + (size_t)hh * NT * 128 + 64 * mm;
            const float oscale = isq ? 0.125f * 1.4426950408889634f : 1.f;
            f32x4 g[2][2];
#pragma unroll
            for (int bj = 0; bj < 2; ++bj)
#pragma unroll
                for (int n = 0; n < 2; ++n) g[bj][n] = *(const f32x4*)(gv + 32 * bj + 16 * n + 4 * fq);
#pragma unroll
            for (int ai = 0; ai < 2; ++ai)
#pragma unroll
                for (int m = 0; m < 4; ++m) {
                    const int row = row0 + ai * 128 + m * 16;
                    float ss = 0.f;
#pragma unroll
                    for (int bj = 0; bj < 2; ++bj)
#pragma unroll
                        for (int n = 0; n < 2; ++n) { const f32x4 x = acc[ai][bj][m][n]; ss += (x.x * x.x + x.y * x.y) + (x.z * x.z + x.w * x.w); }
                    ss += __shfl_xor(ss, 16); ss += __shfl_xor(ss, 32);
                    const float rstd = __builtin_amdgcn_rsqf(ss * (1.f / 64.f) + EPS) ;
                    bf16* dst = dstb + (size_t)row * 128;
                    const bool lat = row < SEQ;
#pragma unroll
                    for (int bj = 0; bj < 2; ++bj) {
                        f32x4 x1 = acc[ai][bj][m][0] * rstd * g[bj][0], x2 = acc[ai][bj][m][1] * rstd * g[bj][1];
                        if (lat) {
                            const int pos = bj == 0 ? (row >> 6) : (row & 63);
                            const f32x4 cs0 = *(const f32x4*)(rope + (size_t)(pos * 16 + 4 * fq) * 2), cs1 = *(const f32x4*)(rope + (size_t)(pos * 16 + 4 * fq) * 2 + 4);
                            const f32x4 c = {cs0.x, cs0.z, cs1.x, cs1.z}, s = {cs0.y, cs0.w, cs1.y, cs1.w};
                            const f32x4 y1 = x1 * c - x2 * s, y2 = x2 * c + x1 * s; x1 = y1; x2 = y2;
                        }
                        x1 = x1 * oscale; x2 = x2 * oscale;
                        v2u o1, o2; o1.x = pk2(x1.x, x1.y); o1.y = pk2(x1.z, x1.w); o2.x = pk2(x2.x, x2.y); o2.y = pk2(x2.z, x2.w);
                        *(v2u*)(dst + 32 * bj + 4 * fq) = o1; *(v2u*)(dst + 32 * bj + 16 + 4 * fq) = o2;
                    }
                }
        } else {
            const int pt = u.pn - 4; const int act = pt < 8 ? 0 : (pt < 10 ? 1 : 2);
            const int col0 = pt * 256 + wc * 32 + 8 * fq;
#pragma unroll
            for (int ai = 0; ai < 2; ++ai)
#pragma unroll
                for (int m = 0; m < 4; ++m) { bf16* rowp = proj + (size_t)(row0 + ai * 128 + m * 16) * PROJW + col0;
#pragma unroll
                    for (int bj = 0; bj < 2; ++bj) { f32x4 v0 = acc[ai][bj][m][0], v1 = acc[ai][bj][m][1];
                        if (act) {
#pragma unroll
                            for (int j = 0; j < 4; ++j) { const float s0 = sigmoidf_(v0[j]), s1 = sigmoidf_(v1[j]); v0[j] = act == 1 ? v0[j] * s0 : s0; v1[j] = act == 1 ? v1[j] * s1 : s1; } }
                        v4u w; w.x = pk2(v0.x, v0.y); w.y = pk2(v0.z, v0.w); w.z = pk2(v1.x, v1.y); w.w = pk2(v1.z, v1.w);
                        *(v4u*)(rowp + bj * 128) = w; } }
        }
    }
};
struct EpiVt {
    static constexpr bool PERM = false, AFTER_DRAIN = false;
    bf16* VT;
    __device__ __forceinline__ void operator()(const f32x4 (&acc)[2][2][4][2], const Unit& u, int wr, int wc, int fr, int fq) const {
        const int row0 = u.pm * 256 + wr * 64 + fr, col0 = u.pn * 256 + wc * 32 + 4 * fq;
#pragma unroll
        for (int ai = 0; ai < 2; ++ai)
#pragma unroll
            for (int m = 0; m < 4; ++m) { bf16* rowp = VT + (size_t)(row0 + ai * 128 + m * 16) * LDV + col0;
#pragma unroll
                for (int bj = 0; bj < 2; ++bj)
#pragma unroll
                    for (int n = 0; n < 2; ++n) { const f32x4 v = acc[ai][bj][m][n]; v2u o; o.x = pk2(v.x, v.y); o.y = pk2(v.z, v.w); *(v2u*)(rowp + bj * 128 + n * 16) = o; } }
    }
};
struct EpiMerge {
    static constexpr bool PERM = false, AFTER_DRAIN = false;
    const bf16* proj; bf16* U;
    __device__ __forceinline__ void operator()(const f32x4 (&acc)[2][2][4][2], const Unit& u, int wr, int wc, int fr, int fq) const {
        const int br = u.pn >> 2, T = u.pn & 3, pm = u.pm - 65 * br;
        const int row0 = pm * 256 + wr * 64 + fr, col0 = T * 256 + wc * 32 + 8 * fq;
        const int gcol = (br ? PC_GB : PC_GA) + col0;
#pragma unroll
        for (int ai = 0; ai < 2; ++ai)
#pragma unroll
            for (int m = 0; m < 4; ++m) { const size_t row = (size_t)(row0 + ai * 128 + m * 16);
#pragma unroll
                for (int bj = 0; bj < 2; ++bj) {
                    const v4u gw = *(const v4u*)(proj + row * PROJW + gcol + bj * 128);
                    f32x4 v0 = acc[ai][bj][m][0], v1 = acc[ai][bj][m][1];
                    v0.x *= bflo(gw.x); v0.y *= bfhi(gw.x); v0.z *= bflo(gw.y); v0.w *= bfhi(gw.y);
                    v1.x *= bflo(gw.z); v1.y *= bfhi(gw.z); v1.z *= bflo(gw.w); v1.w *= bfhi(gw.w);
                    bf16* up = U + row * D + col0 + bj * 128;
                    if (br) { const v4u o = *(const v4u*)up;
                        v0.x += bflo(o.x); v0.y += bfhi(o.x); v0.z += bflo(o.y); v0.w += bfhi(o.y);
                        v1.x += bflo(o.z); v1.y += bfhi(o.z); v1.z += bflo(o.w); v1.w += bfhi(o.w); }
                    v4u w; w.x = pk2(v0.x, v0.y); w.y = pk2(v0.z, v0.w); w.z = pk2(v1.x, v1.y); w.w = pk2(v1.z, v1.w);
                    *(v4u*)up = w; } }
    }
};
struct EpiOut {
    static constexpr bool PERM = false, AFTER_DRAIN = false;
    const float* xlat; const float* xctx; float* xres; const float* g1lat; const float* g1ctx;
    __device__ __forceinline__ void operator()(const f32x4 (&acc)[2][2][4][2], const Unit& u, int wr, int wc, int fr, int fq) const {
        const int row0 = u.pm * 256 + wr * 64 + fr, col0 = u.pn * 256 + wc * 32 + 4 * fq;
        const bool isctx = u.pm >= 64;
        const float* gsrc = isctx ? g1ctx : g1lat;
        f32x4 gv[2][2];
#pragma unroll
        for (int bj = 0; bj < 2; ++bj)
#pragma unroll
            for (int n = 0; n < 2; ++n) gv[bj][n] = *(const f32x4*)(gsrc + col0 + bj * 128 + n * 16);
#pragma unroll
        for (int ai = 0; ai < 2; ++ai)
#pragma unroll
            for (int m = 0; m < 4; ++m) { const int row = row0 + ai * 128 + m * 16;
                const float* src = (isctx ? xctx + (size_t)(row - SEQ) * D : xlat + (size_t)row * D) + col0;
                float* dst = xres + (size_t)row * D + col0;
#pragma unroll
                for (int bj = 0; bj < 2; ++bj)
#pragma unroll
                    for (int n = 0; n < 2; ++n) *(f32x4*)(dst + bj * 128 + n * 16) = *(const f32x4*)(src + bj * 128 + n * 16) + gv[bj][n] * acc[ai][bj][m][n]; }
    }
};
struct EpiSwiglu {
    static constexpr bool PERM = false, AFTER_DRAIN = false;
    bf16* hdn; const float* bgu;
    __device__ __forceinline__ void operator()(const f32x4 (&acc)[2][2][4][2], const Unit& u, int wr, int wc, int fr, int fq) const {
        const int e = u.pn >> 3, T = u.pn & 7;
        const int row0 = u.pm * 256 + wr * 64 + fr, col0 = T * 128 + wc * 32 + 8 * fq;
        const float* bg = bgu + (size_t)e * 2048 + col0;
        const f32x4 bg0 = *(const f32x4*)bg, bg1 = *(const f32x4*)(bg + 4), bu0 = *(const f32x4*)(bg + 1024), bu1 = *(const f32x4*)(bg + 1028);
#pragma unroll
        for (int ai = 0; ai < 2; ++ai)
#pragma unroll
            for (int m = 0; m < 4; ++m) {
                f32x4 g0 = acc[ai][0][m][0] + bg0, g1 = acc[ai][0][m][1] + bg1, u0 = acc[ai][1][m][0] + bu0, u1 = acc[ai][1][m][1] + bu1;
                f32x4 h0, h1;
#pragma unroll
                for (int j = 0; j < 4; ++j) {
                    const float ga = fminf(g0[j], 7.f), gb = fminf(g1[j], 7.f);
                    const float ua = fminf(fmaxf(u0[j], -7.f), 7.f), ub = fminf(fmaxf(u1[j], -7.f), 7.f);
                    h0[j] = (ua + 1.f) * ga * sigmoidf_(1.702f * ga); h1[j] = (ub + 1.f) * gb * sigmoidf_(1.702f * gb);
                }
                v4u w; w.x = pk2(h0.x, h0.y); w.y = pk2(h0.z, h0.w); w.z = pk2(h1.x, h1.y); w.w = pk2(h1.z, h1.w);
                *(v4u*)(hdn + (size_t)(row0 + ai * 128 + m * 16) * D + col0) = w;
            }
    }
};
struct EpiDown {
    static constexpr bool PERM = false, AFTER_DRAIN = false;
    bf16* Y; const float* bdn;
    __device__ __forceinline__ void operator()(const f32x4 (&acc)[2][2][4][2], const Unit& u, int wr, int wc, int fr, int fq) const {
        const int e = u.pn >> 2, T = u.pn & 3;
        const int row0 = u.pm * 256 + wr * 64 + fr, col0 = T * 256 + wc * 32 + 8 * fq;
        f32x4 bv[2][2];
#pragma unroll
        for (int bj = 0; bj < 2; ++bj)
#pragma unroll
            for (int n = 0; n < 2; ++n) bv[bj][n] = *(const f32x4*)(bdn + (size_t)e * D + col0 + bj * 128 + 4 * n);
#pragma unroll
        for (int ai = 0; ai < 2; ++ai)
#pragma unroll
            for (int m = 0; m < 4; ++m) { bf16* rowp = Y + (size_t)(row0 + ai * 128 + m * 16) * D + col0;
#pragma unroll
                for (int bj = 0; bj < 2; ++bj) { const f32x4 v0 = acc[ai][bj][m][0] + bv[bj][0], v1 = acc[ai][bj][m][1] + bv[bj][1];
                    v4u w; w.x = pk2(v0.x, v0.y); w.y = pk2(v0.z, v0.w); w.z = pk2(v1.x, v1.y); w.w = pk2(v1.z, v1.w);
                    *(v4u*)(rowp + bj * 128) = w; } }
    }
};

constexpr int HL_QT = 0, HL_KT = 4352, HL_KH = 8704, HL_VT = 14848, HL_DEC = 20992, HL_AM = 21504, HL_OT = 27648, HL_ST = 36864, HL_STSZ = 34816;
constexpr int HGP = 272;

template <bool OUT>
__device__ __forceinline__ void hgrn_sweep(const Params& P, LAS unsigned char* lds, int layer, int dir, int hh, int seg, const float* Sinit, float* Uout, float* Dout, bool finalize) {
    int tid_ = threadIdx.x; asm volatile("" : "+v"(tid_));
    const int tid = tid_, lane = tid & 63, wid = __builtin_amdgcn_readfirstlane(tid >> 6), r32 = lane & 31, hi = lane >> 5;
    unsigned char* ws = P.ws;
    const bf16* proj = (const bf16*)(ws + WS_PROJ);
    const int tok0 = (seg < 64 ? seg * 256 : SEQ) + (dir ? 255 : 0), sgn = dir ? -1 : 1;
    const int db = wid & 3, vb0 = 2 * (wid >> 2);
    f32x16 S[2];
#pragma unroll
    for (int blk = 0; blk < 2; ++blk)
#pragma unroll
        for (int r = 0; r < 16; ++r) { const int d = 32 * db + (r & 3) + 8 * (r >> 2) + 4 * hi, v = 32 * (vb0 + blk) + r32; S[blk][r] = Sinit ? Sinit[(size_t)d * 128 + v] : 0.f; }
    if (OUT) {
#pragma unroll
        for (int blk = 0; blk < 2; ++blk)
#pragma unroll
            for (int g = 0; g < 4; ++g) { v2u o; o.x = pk2(S[blk][4 * g], S[blk][4 * g + 1]); o.y = pk2(S[blk][4 * g + 2], S[blk][4 * g + 3]);
                *(LAS v2u*)(lds + HL_ST + (32 * (vb0 + blk) + r32) * HGP + (32 * db + 8 * g + 4 * hi) * 2) = o; }
    }
    const int dcol = tid & 127, part = tid >> 7;
    const float lb = ((const float*)(ws + WS_LB))[((size_t)dir * DEPTH + layer) * 512 + 128 * hh + dcol];
    const int zc = (dir ? PC_ZB : PC_ZF) + 128 * hh + dcol;
    float btot = 0.f;
    int cur = 0;
    for (int c = 0; c < 16; ++c) {
        {
            float b[16], kk[4]; float run = 0.f;
#pragma unroll
            for (int s = 0; s < 16; ++s) {
                const int tok = tok0 + sgn * (16 * c + s);
                float z = bf2f(proj[(size_t)tok * PROJW + zc]); z = fminf(fmaxf(z, -80.f), 80.f);
                const float E = fast_exp(-z), den = fast_rcp(1.f + E);
                const float f = (1.f + lb * E) * den;
                run += fast_log(f); b[s] = run;
                if ((s >> 2) == part) kk[s & 3] = (1.f - lb) * E * den;
            }
            const float b15 = b[15];
            unsigned kh[2];
#pragma unroll
            for (int j = 0; j < 4; ++j) {
                float bs = 0.f;
#pragma unroll
                for (int s = 0; s < 16; ++s) bs = (s == 4 * part + j) ? b[s] : bs;
                const int s_ = 4 * part + j, tok = tok0 + sgn * (16 * c + s_);
                const float kq = kk[j];
                if (OUT) {
                    const float q = bf2f(proj[(size_t)tok * PROJW + PC_QH + 128 * hh + dcol]);
                    *(LAS bf16*)(lds + HL_QT + s_ * HGP + dcol * 2) = (bf16)(pk2(q * fast_exp(bs), 0.f) & 0xffffu);
                    *(LAS bf16*)(lds + HL_KT + s_ * HGP + dcol * 2) = (bf16)(pk2(kq * fast_exp(fminf(-bs, 80.f)), 0.f) & 0xffffu);
                }
                const float khv = kq * fast_exp(b15 - bs);
                if (j & 1) kh[j >> 1] = pk2(__uint_as_float(kh[j >> 1]), khv); else kh[j >> 1] = __float_as_uint(khv);
            }
            { v2u o; o.x = kh[0]; o.y = kh[1]; *(LAS v2u*)(lds + HL_KH + dcol * 48 + part * 8) = o; }
            if (part == 0) { *(LAS float*)(lds + HL_DEC + dcol * 4) = fast_exp(b15); btot += b15; }
            { const int s_ = tid >> 5, v4 = 4 * (tid & 31), tok = tok0 + sgn * (16 * c + s_);
              const v2u vv = *(const v2u*)(proj + (size_t)tok * PROJW + PC_VH + 128 * hh + v4);
              LAS bf16* vt = (LAS bf16*)(lds + HL_VT);
              vt[(v4 + 0) * 24 + s_] = (bf16)(vv.x & 0xffffu); vt[(v4 + 1) * 24 + s_] = (bf16)(vv.x >> 16);
              vt[(v4 + 2) * 24 + s_] = (bf16)(vv.y & 0xffffu); vt[(v4 + 3) * 24 + s_] = (bf16)(vv.y >> 16); }
        }
        __syncthreads();
        if (OUT) {
            const int t16 = lane & 15, kq4 = lane >> 4;
            bf16x8 qa[4];
#pragma unroll
            for (int ks = 0; ks < 4; ++ks) qa[ks] = *(const LAS bf16x8*)(lds + HL_QT + t16 * HGP + (32 * ks + 8 * kq4) * 2);
            f32x4 am = {0.f, 0.f, 0.f, 0.f};
#pragma unroll
            for (int ks = 0; ks < 4; ++ks) { const bf16x8 kb = *(const LAS bf16x8*)(lds + HL_KT + t16 * HGP + (32 * ks + 8 * kq4) * 2); am = __builtin_amdgcn_mfma_f32_16x16x32_bf16(qa[ks], kb, am, 0, 0, 0); }
            LAS unsigned char* amw = lds + HL_AM + wid * 768;
#pragma unroll
            for (int i = 0; i < 4; ++i) { const int t = 4 * kq4 + i; *(LAS bf16*)(amw + t * 48 + t16 * 2) = (bf16)(pk2(t16 <= t ? am[i] : 0.f, 0.f) & 0xffffu); }
            f32x4 o4 = {0.f, 0.f, 0.f, 0.f};
            const int vcol = 16 * wid + t16;
#pragma unroll
            for (int ks = 0; ks < 4; ++ks) { const bf16x8 sb = *(const LAS bf16x8*)(lds + HL_ST + cur * HL_STSZ + vcol * HGP + (32 * ks + 8 * kq4) * 2); o4 = __builtin_amdgcn_mfma_f32_16x16x32_bf16(qa[ks], sb, o4, 0, 0, 0); }
            LDS_WAIT();
            bf16x8 ama = *(const LAS bf16x8*)(amw + t16 * 48 + 16 * (kq4 & 1));
            if (kq4 >= 2) ama = (bf16x8){0, 0, 0, 0, 0, 0, 0, 0};
            const bf16x8 vbf = *(const LAS bf16x8*)(lds + HL_VT + vcol * 48 + 16 * (kq4 & 1));
            o4 = __builtin_amdgcn_mfma_f32_16x16x32_bf16(ama, vbf, o4, 0, 0, 0);
            float* obf = (float*)(ws + WS_OBF);
#pragma unroll
            for (int i = 0; i < 4; ++i) { const int t = 4 * kq4 + i, tok = tok0 + sgn * (16 * c + t);
                float* op = obf + (size_t)tok * 512 + 128 * hh + vcol;
                if (!finalize) *op = o4[i];
                else *(LAS float*)(lds + HL_OT + t * 528 + vcol * 4) = o4[i] + *op; }
        }
        {
            float dsc[16];
#pragma unroll
            for (int r = 0; r < 16; ++r) dsc[r] = *(const LAS float*)(lds + HL_DEC + (32 * db + (r & 3) + 8 * (r >> 2) + 4 * hi) * 4);
            const bf16x8 ka = *(const LAS bf16x8*)(lds + HL_KH + (32 * db + r32) * 48 + 16 * hi);
#pragma unroll
            for (int blk = 0; blk < 2; ++blk) {
#pragma unroll
                for (int r = 0; r < 16; ++r) S[blk][r] *= dsc[r];
                const bf16x8 vb = *(const LAS bf16x8*)(lds + HL_VT + (32 * (vb0 + blk) + r32) * 48 + 16 * hi);
                S[blk] = __builtin_amdgcn_mfma_f32_32x32x16_bf16(ka, vb, S[blk], 0, 0, 0);
                if (OUT) {
#pragma unroll
                    for (int g = 0; g < 4; ++g) { v2u o; o.x = pk2(S[blk][4 * g], S[blk][4 * g + 1]); o.y = pk2(S[blk][4 * g + 2], S[blk][4 * g + 3]);
                        *(LAS v2u*)(lds + HL_ST + (cur ^ 1) * HL_STSZ + (32 * (vb0 + blk) + r32) * HGP + (32 * db + 8 * g + 4 * hi) * 2) = o; }
                }
            }
        }
        __syncthreads();
        if (OUT && finalize) {
            const int t = tid >> 5, v4 = 4 * (tid & 31), tok = tok0 + sgn * (16 * c + t);
            const f32x4 o = *(const LAS f32x4*)(lds + HL_OT + t * 528 + v4 * 4);
            float ss = (o.x * o.x + o.y * o.y) + (o.z * o.z + o.w * o.w);
#pragma unroll
            for (int off = 1; off < 32; off <<= 1) ss += __shfl_xor(ss, off);
            const float rstd = __builtin_amdgcn_rsqf(ss * (1.f / 128.f) + EPS);
            const f32x4 gn = *(const f32x4*)(P.in[I_HGNG] + (size_t)layer * 128 + v4);
            const v2u gt = *(const v2u*)(proj + (size_t)tok * PROJW + PC_GH + 128 * hh + v4);
            v2u w; w.x = pk2(o.x * rstd * gn.x * bflo(gt.x), o.y * rstd * gn.y * bfhi(gt.x)); w.y = pk2(o.z * rstd * gn.z * bflo(gt.y), o.w * rstd * gn.w * bfhi(gt.y));
            *(v2u*)((bf16*)(ws + WS_OAB) + (size_t)NT * 512 + (size_t)tok * 512 + 128 * hh + v4) = w;
        }
        cur ^= 1;
    }
    if (!OUT) {
#pragma unroll
        for (int blk = 0; blk < 2; ++blk)
#pragma unroll
            for (int r = 0; r < 16; ++r) { const int d = 32 * db + (r & 3) + 8 * (r >> 2) + 4 * hi, v = 32 * (vb0 + blk) + r32; Uout[(size_t)d * 128 + v] = S[blk][r]; }
        if (part == 0) Dout[dcol] = fast_exp(fmaxf(btot, -120.f));
    }
    __syncthreads();
}

__device__ __forceinline__ void phase_hgrn1(const Params& P, LAS unsigned char* lds, int layer, int G) {
    float* U = (float*)(P.ws + WS_HGU); float* Dv = (float*)(P.ws + WS_HGD);
    for (int w = blockIdx.x; w < 512; w += G) {
        const int dir = w >> 8, hh = (w >> 6) & 3, j = w & 63;
        const int seg = (j == 0) ? 64 : (dir ? 64 - j : j - 1);
        hgrn_sweep<false>(P, lds, layer, dir, hh, seg, nullptr, U + (size_t)w * 16384, Dv + (size_t)w * 128, false);
    }
}
__device__ __forceinline__ void phase_hgrn_chain(const Params& P, int G) {
    const float* U = (const float*)(P.ws + WS_HGU); const float* Dv = (const float*)(P.ws + WS_HGD); float* Sg = (float*)(P.ws + WS_HGS);
    int tid_ = threadIdx.x; asm volatile("" : "+v"(tid_));
    for (int t = blockIdx.x * NTHR + tid_; t < 8 * 16384; t += G * NTHR) {
        const int dh = t >> 14, el = t & 16383, d = el >> 7;
        float s = 0.f;
        Sg[((size_t)dh * 65 + 0) * 16384 + el] = 0.f;
#pragma unroll 4
        for (int p = 1; p <= 64; ++p) {
            s = Dv[((size_t)dh * 64 + p - 1) * 128 + d] * s + U[((size_t)dh * 64 + p - 1) * 16384 + el];
            Sg[((size_t)dh * 65 + p) * 16384 + el] = s;
        }
    }
}
__device__ __forceinline__ void hgrn_unit2(const Params& P, LAS unsigned char* lds, int layer, int hh, int seg) {
    const float* Sg = (const float*)(P.ws + WS_HGS);
    const int pf = (seg < 64) ? seg + 1 : 0, pb = (seg < 64) ? 64 - seg : 0;
    hgrn_sweep<true>(P, lds, layer, 0, hh, seg, pf ? Sg + ((size_t)(0 * 4 + hh) * 65 + pf) * 16384 : nullptr, nullptr, nullptr, false);
    hgrn_sweep<true>(P, lds, layer, 1, hh, seg, pb ? Sg + ((size_t)(1 * 4 + hh) * 65 + pb) * 16384 : nullptr, nullptr, nullptr, true);
}

constexpr int AL_K = 0, AL_KSZ = 16384, AL_V = 2 * AL_KSZ, AL_VSZ = 16384, AL_WS = AL_V + 2 * AL_VSZ, AL_OST = AL_WS + 8 * 256;

__device__ __forceinline__ void glds16_s(const void* sbase, unsigned voff, unsigned lds_dst) {
    unsigned keep;
    { const unsigned long long a = (unsigned long long)(uintptr_t)sbase;
      const unsigned lo = __builtin_amdgcn_readfirstlane((unsigned)a), hi2 = __builtin_amdgcn_readfirstlane((unsigned)(a >> 32));
      sbase = (const void*)(uintptr_t)(((unsigned long long)hi2 << 32) | lo); lds_dst = __builtin_amdgcn_readfirstlane(lds_dst); }
    asm volatile("s_mov_b32 %0, m0\n\ts_mov_b32 m0, %3\n\ts_nop 0\n\tglobal_load_lds_dwordx4 %1, %2\n\ts_mov_b32 m0, %0" : "=&s"(keep) : "v"(voff), "s"(sbase), "s"(lds_dst) : "memory");
}
__device__ __forceinline__ void attn_unit(const Params& P, LAS unsigned char* lds, int layer, int hh, int qt, float lam, float oscale) {
    int tid = threadIdx.x; asm volatile("" : "+v"(tid));
    const int lane = tid & 63, wid = __builtin_amdgcn_readfirstlane(tid >> 6), r32 = lane & 31, hi = lane >> 5;
    const int qb = wid >> 1, mp = wid & 1;
    unsigned char* ws = P.ws;
    const int qrow0 = (qt < 128) ? qt * 128 : SEQ + (qt - 128) * 128;
    const int kt_lo = (qt < 128) ? 0 : 256, kt_hi = NT / 64;
    const bf16* Qg = (const bf16*)(ws + WS_Q) + ((size_t)hh * NT + qrow0 + 32 * qb + r32) * 128 + 64 * mp;
    const char* Kg = (const char*)((const bf16*)(ws + WS_K) + (size_t)hh * NT * 128);
    const char* Vg = (const char*)((const bf16*)(ws + WS_VT) + (size_t)hh * 128 * LDV);
    bf16x8 qf[4];
#pragma unroll
    for (int ks = 0; ks < 4; ++ks) qf[ks] = *(const bf16x8*)(Qg + 16 * ks + 8 * hi);
    f32x16 O[4];
#pragma unroll
    for (int db = 0; db < 4; ++db)
#pragma unroll
        for (int r = 0; r < 16; ++r) O[db][r] = 0.f;
    float lsum = 0.f;
    unsigned ksrc[2], vsrc[2];
#pragma unroll
    for (int jj = 0; jj < 2; ++jj) {
        const int j = 2 * wid + jj;
        { const int i = 4 * j + (lane >> 4), p = lane & 15, g = p ^ (i & 15), key = (i & ~12) | ((i & 4) << 1) | ((i & 8) >> 1); ksrc[jj] = (unsigned)(key * 256 + g * 16); }
        { const int d = 8 * j + (lane >> 3), p = lane & 7, g = p ^ ((d >> 1) & 7); vsrc[jj] = (unsigned)(d * (LDV * 2) + g * 16); }
    }
    const unsigned lds0 = (unsigned)(uintptr_t)lds;
#define ATT_DMA(t, buf) do { _Pragma("unroll") for (int jj = 0; jj < 2; ++jj) { \
        glds16_s(Kg + (size_t)(t) * 16384, ksrc[jj], lds0 + AL_K + (buf) * AL_KSZ + (2 * wid + jj) * 1024); \
        glds16_s(Vg + (size_t)(t) * 128, vsrc[jj], lds0 + AL_V + (buf) * AL_VSZ + (2 * wid + jj) * 1024); } } while (0)
    ATT_DMA(kt_lo, 0);
    asm volatile("s_waitcnt vmcnt(0)" ::: "memory");
    __syncthreads();
    int cur = 0;
    const int ksw = ((r32 & 15) ^ hi) ^ (8 * mp), vsw = ((r32 >> 1) & 7) ^ hi;
    for (int t = kt_lo; t < kt_hi; ++t) {
        if (t + 1 < kt_hi) ATT_DMA(t + 1, cur ^ 1);
        unsigned kb0 = (unsigned)(AL_K + cur * AL_KSZ + r32 * 256) ^ (unsigned)(ksw << 4), vb0 = (unsigned)(AL_V + cur * AL_VSZ + r32 * 128) ^ (unsigned)(vsw << 4);
        asm volatile("" : "+v"(kb0), "+v"(vb0));
#pragma unroll
        for (int kb = 0; kb < 2; ++kb) {
            f32x16 s;
#pragma unroll
            for (int r = 0; r < 16; ++r) s[r] = 0.f;
#pragma unroll
            for (int ks = 0; ks < 4; ++ks) { const bf16x8 kf = *(const LAS bf16x8*)(lds + ((kb0 ^ (unsigned)((2 * ks) << 4)) + kb * 8192)); s = __builtin_amdgcn_mfma_f32_32x32x16_bf16(kf, qf[ks], s, 0, 0, 0); }
            float ls = 0.f;
#pragma unroll
            for (int r = 0; r < 16; ++r) { s[r] = __builtin_amdgcn_exp2f(s[r]); ls += s[r]; }
            lsum += ls;
            bf16x8 pa[2];
#pragma unroll
            for (int f = 0; f < 2; ++f) { v4u w; w.x = pk2(s[8 * f], s[8 * f + 1]); w.y = pk2(s[8 * f + 2], s[8 * f + 3]); w.z = pk2(s[8 * f + 4], s[8 * f + 5]); w.w = pk2(s[8 * f + 6], s[8 * f + 7]);
                pa[f] = __builtin_bit_cast(bf16x8, w); }
#pragma unroll
            for (int f = 0; f < 2; ++f)
#pragma unroll
                for (int db = 0; db < 4; ++db) {
                    const bf16x8 vf = *(const LAS bf16x8*)(lds + ((vb0 ^ (unsigned)((4 * kb + 2 * f) << 4)) + db * 4096));
                    O[db] = __builtin_amdgcn_mfma_f32_32x32x16_bf16(pa[f], vf, O[db], 0, 0, 0);
                }
        }
        asm volatile("s_waitcnt vmcnt(0)" ::: "memory");
        __syncthreads();
        cur ^= 1;
    }
#undef ATT_DMA
    lsum += __shfl_xor(lsum, 32);
    LAS float* wsf = (LAS float*)(lds + AL_WS + wid * 256);
    if (hi == 0) wsf[r32] = (mp ? lam : 1.f) / lsum;
    LDS_WAIT();
    LAS float* X = (LAS float*)(lds + qb * 16384);
    if (mp == 1) {
#pragma unroll
        for (int r = 0; r < 16; ++r) { const float a = wsf[(r & 3) + 8 * (r >> 2) + 4 * hi];
#pragma unroll
            for (int db = 0; db < 4; ++db) X[(db * 16 + r) * 64 + lane] = O[db][r] * a; }
    }
    __syncthreads();
    if (mp == 0) {
        const float* sg = P.in[I_SUBLN] + (size_t)layer * 128;
        float gsc[4];
#pragma unroll
        for (int db = 0; db < 4; ++db) gsc[db] = sg[32 * db + r32] * oscale;
        LAS bf16* stg = (LAS bf16*)(lds + AL_OST + qb * 8192);
#pragma unroll
        for (int r = 0; r < 16; ++r) {
            const int q = (r & 3) + 8 * (r >> 2) + 4 * hi;
            const float a0 = wsf[q];
            float o[4], ss = 0.f;
#pragma unroll
            for (int db = 0; db < 4; ++db) { o[db] = O[db][r] * a0 - X[(db * 16 + r) * 64 + lane]; ss += o[db] * o[db]; }
#pragma unroll
            for (int off = 1; off < 32; off <<= 1) ss += __shfl_xor(ss, off);
            const float rstd = __builtin_amdgcn_rsqf(ss * (1.f / 128.f) + EPS);
#pragma unroll
            for (int db = 0; db < 4; ++db) stg[q * 128 + 32 * db + r32] = (bf16)(pk2(o[db] * rstd * gsc[db], 0.f) & 0xffffu);
        }
        LDS_WAIT();
        bf16* Ow = (bf16*)(ws + WS_OAB) + (size_t)(qrow0 + 32 * qb) * 512 + 128 * hh;
#pragma unroll
        for (int i = 0; i < 8; ++i) { const int row = 4 * i + (lane >> 4), ch = lane & 15;
            const v4u v = *(const LAS v4u*)(stg + row * 128 + ch * 8); *(v4u*)(Ow + (size_t)row * 512 + ch * 8) = v; }
    }
    __syncthreads();
}

__device__ __forceinline__ void phase_mix(const Params& P, LAS unsigned char* lds, int layer, int G, bool with_ctx) {
    int tid_ = threadIdx.x; asm volatile("" : "+v"(tid_));
    const int lane = tid_ & 63;
    const float* lq = P.in[I_LAMQK] + (size_t)layer * 4 * 64;
    const float s1 = wave_sum(lq[lane] * lq[64 + lane]), s2 = wave_sum(lq[128 + lane] * lq[192 + lane]);
    const float lam_init = 0.8f - 0.6f * expf(-0.3f * (float)layer);
    const float lam = expf(s1) - expf(s2) + lam_init;
    const int nunits = with_ctx ? 780 : 768;
    for (int u = blockIdx.x; u < nunits; u += G) {
#ifndef MIX_ONLY
#define MIX_ONLY 3
#endif
        if (u < 512) { if (MIX_ONLY & 1) { const int hh = (u & 7) >> 1, qt = ((u >> 3) << 1) | (u & 1); attn_unit(P, lds, layer, hh, qt, lam, 1.f - lam_init); } }
        else if (u < 768) { if (MIX_ONLY & 2) { const int v = u - 512; hgrn_unit2(P, lds, layer, v & 3, v >> 2); } }
        else if (u < 776) { if (MIX_ONLY & 1) { const int v = u - 768; attn_unit(P, lds, layer, v & 3, 128 + (v >> 2), lam, 1.f - lam_init); } }
        else { if (MIX_ONLY & 2) hgrn_unit2(P, lds, layer, u - 776, 64); }
    }
}

constexpr int RL_RW = 0, RL_TA = 135168, RL_TB = RL_TA + 8192, RL_INFO = RL_TB + 8192, RL_CNT = RL_INFO + 80 * 32, RL_BASE = RL_CNT + 128, RL_RSTD = RL_BASE + 128;
__device__ __forceinline__ void phase_router(const Params& P, LAS unsigned char* lds, int layer, int G, int nrows) {
    int tid_ = threadIdx.x; asm volatile("" : "+v"(tid_));
    const int tid = tid_, lane = tid & 63, wave = tid >> 6;
    unsigned char* ws = P.ws;
    LAS float* RW = (LAS float*)(lds + RL_RW); LAS float* TA = (LAS float*)(lds + RL_TA); LAS float* TB = (LAS float*)(lds + RL_TB);
    LAS unsigned* INFO = (LAS unsigned*)(lds + RL_INFO); LAS unsigned* LCNT = (LAS unsigned*)(lds + RL_CNT); LAS unsigned* GBASE = (LAS unsigned*)(lds + RL_BASE); LAS float* RSTD = (LAS float*)(lds + RL_RSTD);
    const float* rw = P.in[I_RW] + (size_t)layer * D * NE;
    for (int i = tid; i < D * NE; i += NTHR) RW[(i >> 5) * 33 + (i & 31)] = rw[i];
    for (int i = tid; i < 2048; i += NTHR) { const int w = i >> 10, j = i & 1023; const float* mv = modv_ptr(P, layer, w);
        TA[i] = P.in[I_N2G][(size_t)layer * D + j] * (1.f + mv[4096 + j]); TB[i] = mv[3072 + j]; }
    const float* xres = (const float*)(ws + WS_XRES);
    const float* rb = P.in[I_RB] + (size_t)layer * NE;
    unsigned* gcnt = (unsigned*)(ws + WS_CTL) + CW_CNT + layer * 32 * 16;
    unsigned* tokinfo = (unsigned*)(ws + WS_TOK);
    bf16* XS = (bf16*)(ws + WS_XS);
    const int RB = nrows / 256;
    for (int blk = blockIdx.x; blk < 256; blk += G) {
        if (tid < 32) LCNT[tid] = 0u;
        __syncthreads();
        const int rbase = blk * RB;
#pragma unroll 1
        for (int rl = wave; rl < RB; rl += NWAVES) {
            const int row = rbase + rl, w = row >= SEQ;
            const float* xr = xres + (size_t)row * D;
            float x[16], ss = 0.f;
#pragma unroll
            for (int k = 0; k < 16; ++k) { x[k] = xr[lane + 64 * k]; ss += x[k] * x[k]; }
            const float rstd = __builtin_amdgcn_rsqf(wave_sum(ss) * (1.f / D) + EPS);
            float p[NE];
#pragma unroll
            for (int e = 0; e < NE; ++e) p[e] = 0.f;
#pragma unroll 2
            for (int k = 0; k < 16; ++k) { const int i = lane + 64 * k; const float h = x[k] * rstd * TA[1024 * w + i] + TB[1024 * w + i];
                const LAS float* rr = RW + i * 33;
#pragma unroll
                for (int e = 0; e < NE; ++e) p[e] += h * rr[e]; }
#pragma unroll
            for (int e = 0; e < NE; ++e) { float v = p[e];
#pragma unroll
                for (int o = 1; o < 64; o <<= 1) v += __shfl_xor(v, o);
                p[e] = v + rb[e]; }
            float tv[4]; int ti[4];
#pragma unroll
            for (int k = 0; k < 4; ++k) { float best = -3.0e38f; int bi = 0;
#pragma unroll
                for (int e = 0; e < NE; ++e) { const bool gt = p[e] > best; best = gt ? p[e] : best; bi = gt ? e : bi; }
                tv[k] = best; ti[k] = bi;
#pragma unroll
                for (int e = 0; e < NE; ++e) p[e] = (e == bi) ? -3.0e38f : p[e]; }
            float wk[4], wsum = 0.f;
#pragma unroll
            for (int k = 0; k < 4; ++k) { wk[k] = expf(tv[k] - tv[0]); wsum += wk[k]; }
            if (lane == 0) {
                RSTD[rl] = rstd;
#pragma unroll
                for (int k = 0; k < 4; ++k) { const unsigned pos = __hip_atomic_fetch_add(&LCNT[ti[k]], 1u, __ATOMIC_RELAXED, __HIP_MEMORY_SCOPE_WORKGROUP); INFO[rl * 8 + 2 * k] = ((unsigned)ti[k] << 16) | pos; INFO[rl * 8 + 2 * k + 1] = __float_as_uint(wk[k] / wsum); }
            }
        }
        __syncthreads();
        if (tid < 32) GBASE[tid] = __hip_atomic_fetch_add(gcnt + tid * 16, LCNT[tid], RLX_AGENT);
        __syncthreads();
#pragma unroll 1
        for (int rl = wave; rl < RB; rl += NWAVES) {
            const int row = rbase + rl, w = row >= SEQ;
            const float* xr = xres + (size_t)row * D + 16 * lane;
            const float rstd = RSTD[rl];
            v4u o0, o1;
            {
                f32x4 v[4];
#pragma unroll
                for (int j = 0; j < 4; ++j) { const f32x4 xv = *(const f32x4*)(xr + 4 * j); const f32x4 a = *(const LAS f32x4*)(TA + 1024 * w + 16 * lane + 4 * j), b = *(const LAS f32x4*)(TB + 1024 * w + 16 * lane + 4 * j); v[j] = xv * rstd * a + b; }
                o0.x = pk2(v[0].x, v[0].y); o0.y = pk2(v[0].z, v[0].w); o0.z = pk2(v[1].x, v[1].y); o0.w = pk2(v[1].z, v[1].w);
                o1.x = pk2(v[2].x, v[2].y); o1.y = pk2(v[2].z, v[2].w); o1.z = pk2(v[3].x, v[3].y); o1.w = pk2(v[3].z, v[3].w);
            }
#pragma unroll
            for (int k = 0; k < 4; ++k) {
                const unsigned ep = INFO[rl * 8 + 2 * k], wb = INFO[rl * 8 + 2 * k + 1];
                const unsigned e = ep >> 16, slot = GBASE[e] + (ep & 0xffffu);
                bf16* dst = XS + ((size_t)e * CAP + slot) * D + 16 * lane;
                *(v4u*)dst = o0; *(v4u*)(dst + 8) = o1;
                if (lane == 0) { v4u ti4; ti4.x = e; ti4.y = slot; ti4.z = wb; ti4.w = 0u; *(v4u*)(tokinfo + (size_t)row * 16 + 4 * k) = ti4; }
            }
        }
        __syncthreads();
    }
}

__device__ __forceinline__ void phase_combine(const Params& P, LAS unsigned char* lds, int layer, int G, int nrows) {
    int tid_ = threadIdx.x; asm volatile("" : "+v"(tid_));
    const int tid = tid_, lane = tid & 63, wave = tid >> 6;
    unsigned char* ws = P.ws;
    const bool last = (layer == DEPTH - 1);
    LAS float* TA = (LAS float*)lds; LAS float* TB = (LAS float*)(lds + 8192); LAS float* TG = (LAS float*)(lds + 16384);
    for (int i = tid; i < 2048; i += NTHR) { const int w = i >> 10, j = i & 1023;
        TG[i] = modv_ptr(P, layer, w)[5120 + j];
        if (!last) { const float* mv = modv_ptr(P, layer + 1, w); TA[i] = P.in[I_N1G][(size_t)(layer + 1) * D + j] * (1.f + mv[1024 + j]); TB[i] = mv[j]; } }
    __syncthreads();
    float* xres = (float*)(ws + WS_XRES);
    const unsigned* tokinfo = (const unsigned*)(ws + WS_TOK);
    const bf16* Y = (const bf16*)(ws + WS_XS);
    bf16* H = (bf16*)(ws + WS_H);
    for (int row = blockIdx.x * NWAVES + wave; row < nrows; row += G * NWAVES) {
        const int w = row >= SEQ;
        f32x4 acc[4];
#pragma unroll
        for (int j = 0; j < 4; ++j) acc[j] = (f32x4){0.f, 0.f, 0.f, 0.f};
#pragma unroll
        for (int k = 0; k < 4; ++k) {
            const v4u ti4 = *(const v4u*)(tokinfo + (size_t)row * 16 + 4 * k);
            const float wk = __uint_as_float(ti4.z);
            const bf16* yr = Y + ((size_t)ti4.x * CAP + ti4.y) * D + 4 * lane;
#pragma unroll
            for (int j = 0; j < 4; ++j) { const v2u yv = *(const v2u*)(yr + 256 * j); acc[j] += wk * (f32x4){bflo(yv.x), bfhi(yv.x), bflo(yv.y), bfhi(yv.y)}; }
        }
        float* xr = xres + (size_t)row * D + 4 * lane;
        f32x4 v[4];
#pragma unroll
        for (int j = 0; j < 4; ++j) v[j] = *(const f32x4*)(xr + 256 * j) + *(const LAS f32x4*)(TG + 1024 * w + 4 * lane + 256 * j) * acc[j];
        if (last) {
            float* orow = P.out + (size_t)row * D + 4 * lane;
#pragma unroll
            for (int j = 0; j < 4; ++j) *(f32x4*)(orow + 256 * j) = v[j];
        } else {
#pragma unroll
            for (int j = 0; j < 4; ++j) *(f32x4*)(xr + 256 * j) = v[j];
            norm_store_row(v, TA + 1024 * w, TB + 1024 * w, H + (size_t)row * D, lane);
        }
    }
}
#define XB_TMO      128
#define XB_XCNT(j)  (256  + 64 * (j))
#define XB_XSUB(j)  (1280 + 64 * (j))
#define XB_XGEN(j)  (2304 + 64 * (j))
#define XB_TOP      3328
#define XB_TOPGEN   3392
#define XCD_BAR_WORDS 3456
#define XB_SPIN_CAP (1u << 18)

__device__ __forceinline__ unsigned xb_ld(unsigned* p)              { return __hip_atomic_load(p, __ATOMIC_RELAXED, __HIP_MEMORY_SCOPE_AGENT); }
__device__ __forceinline__ unsigned xb_add(unsigned* p, unsigned v) { return __hip_atomic_fetch_add(p, v, __ATOMIC_RELAXED, __HIP_MEMORY_SCOPE_AGENT); }
__device__ __forceinline__ unsigned xb_xcc_id() { return (unsigned)__builtin_amdgcn_s_getreg((3 << 11) | 20) & 0xFu; }
#define XB_SPIN(cond, bar) do { unsigned _sp = 0; while (cond) { __builtin_amdgcn_s_sleep(1); \
    if ((++_sp & 255u) == 0u) { if (xb_ld(&(bar)[XB_TMO])) break; if (_sp > XB_SPIN_CAP) { atomicAdd(&(bar)[XB_TMO], 1u); break; } } } } while (0)

struct XcdBarrier {
    unsigned* bar; unsigned x;
    volatile LAS unsigned* st;
};

__device__ __forceinline__ XcdBarrier xcd_barrier_post(unsigned* bar, volatile LAS unsigned* st) {
    XcdBarrier b; b.bar = bar; b.x = xb_xcc_id(); b.st = st;
    if (threadIdx.x == 0) (void)xb_add(&bar[XB_XCNT(b.x)], 1u);
    return b;
}
__device__ __forceinline__ void xcd_barrier_complete(unsigned* bar, unsigned x, unsigned& nloc, unsigned& nx) {
    const unsigned G = gridDim.x * gridDim.y * gridDim.z;
    unsigned sum, cnt, mine, sp = 0u;
    for (;;) {
        sum = 0u; cnt = 0u; mine = 0u;
#pragma unroll
        for (unsigned j = 0; j < 16; ++j) { const unsigned c = xb_ld(&bar[XB_XCNT(j)]); sum += c; cnt += (c > 0u) ? 1u : 0u; mine = (j == x) ? c : mine; }
        if (sum == G) break;
        __builtin_amdgcn_s_sleep(1);
        if ((++sp & 255u) == 0u) { if (xb_ld(&bar[XB_TMO])) break; if (sp > XB_SPIN_CAP) { atomicAdd(&bar[XB_TMO], 1u); break; } }
    }
    nloc = mine > 0u ? mine : 1u; nx = cnt > 0u ? cnt : 1u;
}

__device__ __forceinline__ void xcd_barrier(const XcdBarrier& b) {
    asm volatile("s_waitcnt vmcnt(0)" ::: "memory");
    __syncthreads();
    if (threadIdx.x == 0) {
        unsigned* bar = b.bar;
        __builtin_amdgcn_s_waitcnt(0);
        unsigned nloc = b.st[0], nx = b.st[1];
        if (nloc == 0u) { xcd_barrier_complete(bar, b.x, nloc, nx); b.st[0] = nloc; b.st[1] = nx; }
        const unsigned old = xb_add(&bar[XB_XSUB(b.x)], 1u);
        const unsigned gen = old / nloc;
        if (old + 1u == (gen + 1u) * nloc) {
            __builtin_amdgcn_fence(__ATOMIC_RELEASE, "agent");
            asm volatile("s_waitcnt vmcnt(0)" ::: "memory");
            const unsigned og = xb_add(&bar[XB_TOP], 1u);
            const unsigned tg = og / nx;
            if (og + 1u == (tg + 1u) * nx) xb_add(&bar[XB_TOPGEN], 1u);
            else XB_SPIN(xb_ld(&bar[XB_TOPGEN]) == tg, bar);
            __builtin_amdgcn_fence(__ATOMIC_ACQUIRE, "agent");
            xb_add(&bar[XB_XGEN(b.x)], 1u);
            asm volatile("s_waitcnt vmcnt(0)" ::: "memory");
        } else {
            XB_SPIN(xb_ld(&bar[XB_XGEN(b.x)]) == gen, bar);
            __builtin_amdgcn_fence(__ATOMIC_ACQUIRE, "agent");
            asm volatile("s_waitcnt vmcnt(0)" ::: "memory");
        }
    }
    __syncthreads();
}


__global__ void __launch_bounds__(NTHR, 2) fwd_kernel(Params P) {
    extern __shared__ __attribute__((aligned(16))) unsigned char lds_raw[];
    LAS unsigned char* lds = (LAS unsigned char*)lds_raw;
    volatile LAS unsigned* MISC = (volatile LAS unsigned*)(lds + MISC_OFF);
    const int tid = threadIdx.x, G = gridDim.x;
    unsigned char* ws = P.ws;
    unsigned* ctl = (unsigned*)(ws + WS_CTL);
    if (tid < 64) MISC[tid] = 0u;
    __syncthreads();
#if MK_ONE_LAUNCH
    XcdBarrier bar = xcd_barrier_post(ctl + CW_BAR, MISC + 8);
#define GRID_BAR() xcd_barrier(bar)
#else
#define GRID_BAR() do {} while (0)
#endif
    const int lo = P.ph_lo, hi = P.ph_hi;
#ifndef PHM
#define PHM 0xFFF
#endif
#define IN(k) (lo <= (k) && (k) < hi)
#define EN(b) ((PHM >> (b)) & 1)
#define SEAM(k) do { if (IN(k) && IN((k) + 1)) GRID_BAR(); } while (0)

    if (EN(10) && IN(0)) { phase_p0a(P, lds, G); SEAM(0); }
    if (EN(11) && IN(1)) { phase_p0b(P, lds, G); SEAM(1); }

    for (int l = 0; l < DEPTH; ++l) {
        const int pb = NPH_PRO + NPH_LAYER * l;
        const bool last = (l == DEPTH - 1);
        const int nrows = last ? SEQ : NT;
        bf16* H = (bf16*)(ws + WS_H);
        if (EN(0) && IN(pb + 0)) {
            { pg8::Gemm g{H, (const bf16*)(ws + WS_WIN + l * WIN_L), NT, 5632, D}; pg8::StaticOrder S; S.init(NT, 5632, G, (int)blockIdx.x);
              EpiInProj E{(bf16*)(ws + WS_Q), (bf16*)(ws + WS_K), (bf16*)(ws + WS_PROJ), P.in[I_QNG] + l * 64, P.in[I_KNG] + l * 64, (const float*)(ws + WS_ROPE)};
              pg8::gemm_phase<EpiInProj, pg8::StaticOrder, true, true>(lds, g, S, E); }
            { pg8::Gemm g{(const bf16*)(ws + WS_WV + l * WV_L), H, 512, NT, D}; pg8::StaticOrder S; S.init(512, NT, G, (int)((blockIdx.x + 106) % G));
              EpiVt E{(bf16*)(ws + WS_VT)};
              pg8::gemm_phase<EpiVt, pg8::StaticOrder, true, true>(lds, g, S, E); }
            SEAM(pb + 0);
        }
        if (EN(1) && IN(pb + 1)) { phase_hgrn1(P, lds, l, G); SEAM(pb + 1); }
        if (EN(2) && IN(pb + 2)) { phase_hgrn_chain(P, G); SEAM(pb + 2); }
        if (EN(3) && IN(pb + 3)) { phase_mix(P, lds, l, G, !last); SEAM(pb + 3); }
        if (EN(4) && IN(pb + 4)) {
            pg8::Gemm g{(const bf16*)(ws + WS_OAB), (const bf16*)(ws + WS_WAB + l * WAB_L), 2 * NT, 2048, 512};
            pg8::MergeOrder S{nrows / 256, G, (int)blockIdx.x};
            EpiMerge E{(const bf16*)(ws + WS_PROJ), (bf16*)(ws + WS_U)};
            pg8::gemm_phase<EpiMerge, pg8::MergeOrder, true, true>(lds, g, S, E);
            SEAM(pb + 4);
        }
        if (EN(5) && IN(pb + 5)) {
            pg8::Gemm g{(const bf16*)(ws + WS_U), (const bf16*)(ws + WS_WO + l * WO_L), nrows, D, D}; pg8::StaticOrder S; S.init(nrows, D, G, (int)blockIdx.x);
            const float* xres = (const float*)(ws + WS_XRES);
            EpiOut E{l == 0 ? P.in[I_X] : xres, l == 0 ? P.in[I_CTX] : xres + (size_t)SEQ * D, (float*)(ws + WS_XRES), modv_ptr(P, l, 0) + 2048, modv_ptr(P, l, 1) + 2048};
            pg8::gemm_phase<EpiOut, pg8::StaticOrder, true, true>(lds, g, S, E);
            SEAM(pb + 5);
        }
        if (EN(6) && IN(pb + 6)) { phase_router(P, lds, l, G, nrows); SEAM(pb + 6); }
        if ((EN(7) && IN(pb + 7)) || (EN(8) && IN(pb + 8))) {
            LAS int* ptab = (LAS int*)(lds + 131072);
            if (tid == 0) { const unsigned* gcnt = ctl + CW_CNT + l * 32 * 16; int run = 0;
                for (int e = 0; e < NE; ++e) { ptab[e] = run; run += (int)((__hip_atomic_load(gcnt + e * 16, RLX_AGENT) + 255u) >> 8); } ptab[32] = run; }
            __syncthreads();
            if (EN(7) && IN(pb + 7)) {
                pg8::Gemm g{(const bf16*)(ws + WS_XS), (const bf16*)(ws + WS_WGU + l * WGU_L), NE * CAP, NE * 2048, D};
                pg8::MoeOrder<3> S{ptab, G, (int)blockIdx.x};
                EpiSwiglu E{(bf16*)(ws + WS_HDN), P.in[I_BGU] + (size_t)l * NE * 2048};
                pg8::gemm_phase<EpiSwiglu, pg8::MoeOrder<3>, true, true>(lds, g, S, E);
                SEAM(pb + 7);
            }
            if (EN(8) && IN(pb + 8)) {
                pg8::Gemm g{(const bf16*)(ws + WS_HDN), (const bf16*)(ws + WS_WD + l * WD_L), NE * CAP, NE * 1024, DFF};
                pg8::MoeOrder<2> S{ptab, G, (int)blockIdx.x};
                EpiDown E{(bf16*)(ws + WS_XS), P.in[I_BDN] + (size_t)l * NE * D};
                pg8::gemm_phase<EpiDown, pg8::MoeOrder<2>, true, true>(lds, g, S, E);
                SEAM(pb + 8);
            }
        }
        if (EN(9) && IN(pb + 9)) { phase_combine(P, lds, l, G, nrows); SEAM(pb + 9); }
    }
#undef IN
#undef EN
#undef SEAM
#undef GRID_BAR
}

extern "C" void kernel_launch(void* const* d_in, const int* in_sizes, int n_in, void* d_out, int out_size, void* d_ws, size_t ws_size, hipStream_t stream) {
    static int grid = 0;
    if (grid == 0) {
        if (n_in != 24 || out_size != SEQ * D || ws_size < WS_END) { fprintf(stderr, "kernel_launch: unexpected shapes (n_in %d, out %d, ws %zu < %zu)\n", n_in, out_size, ws_size, (size_t)WS_END); grid = -1; return; }
        int dev = 0, cus = 0;
        if (hipGetDevice(&dev) != hipSuccess || hipDeviceGetAttribute(&cus, hipDeviceAttributeMultiprocessorCount, dev) != hipSuccess) { grid = -1; return; }
        if (hipFuncSetAttribute((const void*)fwd_kernel, hipFuncAttributeMaxDynamicSharedMemorySize, LDS_BYTES) != hipSuccess) { fprintf(stderr, "kernel_launch: hipFuncSetAttribute failed\n"); grid = -1; return; }
        int per_cu = 0;
        if (hipOccupancyMaxActiveBlocksPerMultiprocessor(&per_cu, (const void*)fwd_kernel, NTHR, LDS_BYTES) != hipSuccess || per_cu < 1) fprintf(stderr, "kernel_launch: occupancy query reports %d\n", per_cu);
        (void)hipGetLastError();
        grid = cus;
    }
    if (grid < 0) return;
    (void)hipMemsetAsync((char*)d_ws + WS_CTL, 0, CTL_ZERO_BYTES, stream);
    Params p{};
    for (int i = 0; i < 24; ++i) p.in[i] = (const float*)d_in[i];
    p.out = (float*)d_out; p.ws = (unsigned char*)d_ws;
#if MK_ONE_LAUNCH
    p.ph_lo = 0; p.ph_hi = NPHASES;
    hipLaunchKernelGGL(fwd_kernel, dim3(grid), dim3(NTHR), LDS_BYTES, stream, p);
#else
    for (int k = 0; k < NPHASES; ++k) { p.ph_lo = k; p.ph_hi = k + 1; hipLaunchKernelGGL(fwd_kernel, dim3(grid), dim3(NTHR), LDS_BYTES, stream, p); }
#endif
}
```

```cpp
#include <hip/hip_runtime.h>
#include <cstdio>
#include <cstdint>

#ifndef MK_ONE_LAUNCH
#define MK_ONE_LAUNCH 1
#endif

#define GAS __attribute__((address_space(1)))
#define LAS __attribute__((address_space(3)))
typedef unsigned short bf16;
typedef unsigned v4u __attribute__((ext_vector_type(4)));
typedef unsigned v2u __attribute__((ext_vector_type(2)));
typedef float f32x4 __attribute__((ext_vector_type(4)));
typedef float f32x16 __attribute__((ext_vector_type(16)));
typedef short bf16x8 __attribute__((ext_vector_type(8)));
typedef short s16x4 __attribute__((ext_vector_type(4)));
typedef float f32x2_t __attribute__((ext_vector_type(2)));
typedef __bf16 bf16x2_t __attribute__((ext_vector_type(2)));

constexpr int D = 1024, SEQ = 16384, LC = 256, NT = SEQ + LC, DEPTH = 4;
constexpr int INC = 6144, NE = 32, DFF = 1024, TOPK = 4;
constexpr int CAP = NT;
constexpr int PROJW = 4608;
constexpr int PC_QH = 0, PC_ZF = 512, PC_ZB = 1024, PC_VH = 1536, PC_GH = 2048, PC_GA = 2560, PC_GB = 3584;
constexpr int LDV = NT;
constexpr float EPS = 1e-6f;
constexpr int NWAVES = 8, NTHR = 512;
constexpr int NPH_PRO = 2, NPH_LAYER = 10, NPHASES = NPH_PRO + NPH_LAYER * DEPTH;

constexpr size_t MiB = 1u << 20;
constexpr size_t WS_CTL = 0, CTL_ZERO_BYTES = 1 * MiB;
constexpr size_t WS_MODP = 1 * MiB;
constexpr size_t WS_MODV = WS_MODP + 2 * MiB;
constexpr size_t WS_LB = WS_MODV + 1 * MiB;
constexpr size_t WS_ROPE = WS_LB + 1 * MiB;
constexpr size_t WS_WIN = WS_ROPE + 1 * MiB;
constexpr size_t WIN_L = (size_t)5632 * 1024 * 2;
constexpr size_t WS_WV = WS_WIN + 4 * WIN_L;
constexpr size_t WV_L = (size_t)512 * 1024 * 2;
constexpr size_t WS_WAB = WS_WV + 4 * WV_L;
constexpr size_t WAB_L = (size_t)2048 * 512 * 2;
constexpr size_t WS_WO = WS_WAB + 4 * WAB_L;
constexpr size_t WO_L = (size_t)1024 * 1024 * 2;
constexpr size_t WS_WGU = WS_WO + 4 * WO_L;
constexpr size_t WGU_E = (size_t)2048 * 1024 * 2, WGU_L = 32 * WGU_E;
constexpr size_t WS_WD = WS_WGU + 4 * WGU_L;
constexpr size_t WD_E = (size_t)1024 * 1024 * 2, WD_L = 32 * WD_E;
constexpr size_t WS_XRES = WS_WD + 4 * WD_L;
constexpr size_t WS_H = WS_XRES + (size_t)NT * D * 4;
constexpr size_t WS_Q = WS_H + (size_t)NT * D * 2;
constexpr size_t WS_K = WS_Q + (size_t)NT * 512 * 2;
constexpr size_t WS_VT = WS_K + (size_t)NT * 512 * 2;
constexpr size_t WS_PROJ = WS_VT + (size_t)512 * LDV * 2;
constexpr size_t WS_OAB = WS_PROJ + (size_t)NT * PROJW * 2;
constexpr size_t WS_OBF = WS_OAB + (size_t)2 * NT * 512 * 2;
constexpr size_t WS_U = WS_OBF + (size_t)NT * 512 * 4;
constexpr size_t WS_HGU = WS_U + (size_t)NT * D * 2;
constexpr size_t WS_HGD = WS_HGU + (size_t)512 * 16384 * 4;
constexpr size_t WS_HGS = WS_HGD + 1 * MiB;
constexpr size_t WS_TOK = WS_HGS + (size_t)520 * 16384 * 4;
constexpr size_t WS_XS = WS_TOK + (size_t)NT * 64;
constexpr size_t SLAB = (size_t)NE * CAP * D * 2;
constexpr size_t WS_HDN = WS_XS + SLAB;
constexpr size_t WS_END = WS_HDN + SLAB;
constexpr int CW_TMO = 0;
constexpr int CW_BAR = 4096;
constexpr int CW_CNT = 16384;

constexpr int LDS_BYTES = 162816;
constexpr int MISC_OFF = LDS_BYTES - 256;

#define RLX_AGENT __ATOMIC_RELAXED, __HIP_MEMORY_SCOPE_AGENT
__device__ __forceinline__ unsigned pk2(float lo, float hi) { f32x2_t v = {lo, hi}; bf16x2_t b = __builtin_convertvector(v, bf16x2_t); return __builtin_bit_cast(unsigned, b); }
__device__ __forceinline__ float bflo(unsigned w) { return __uint_as_float(w << 16); }
__device__ __forceinline__ float bfhi(unsigned w) { return __uint_as_float(w & 0xffff0000u); }
__device__ __forceinline__ float bf2f(bf16 b) { return __uint_as_float(((unsigned)b) << 16); }
__device__ __forceinline__ float wave_sum(float v) {
#pragma unroll
    for (int o = 1; o < 64; o <<= 1) v += __shfl_xor(v, o);
    return v;
}
__device__ __forceinline__ float fast_exp(float x) { return __builtin_amdgcn_exp2f(x * 1.4426950408889634f); }
__device__ __forceinline__ float fast_log(float x) { return __builtin_amdgcn_logf(x) * 0.6931471805599453f; }
__device__ __forceinline__ float fast_rcp(float x) { return __builtin_amdgcn_rcpf(x); }
__device__ __forceinline__ float sigmoidf_(float x) { return fast_rcp(1.f + fast_exp(-x)); }
__device__ __forceinline__ int perm8(int s) { return (s & ~31) | (((s >> 2) & 1) << 4) | (((s >> 3) & 3) << 2) | (s & 3); }

namespace pg8 {
#define PG8_LAS __attribute__((address_space(3)))
typedef unsigned short bf16_t;
typedef short bf16x8 __attribute__((ext_vector_type(8)));
typedef float f32x4 __attribute__((ext_vector_type(4)));
typedef unsigned u32x4 __attribute__((ext_vector_type(4)));
constexpr int BM = 256, BK = 64, HALF = 128, HTB = HALF * BK * 2  , STAGE_BYTES = 8 * HTB, NXCD = 8, WGM = 8;

__host__ __device__ __forceinline__ int lds_byte(int r, int c) { const int st = (r >> 4) * 2 + (c >> 5), rr = r & 15, cc = c & 31, ob = rr * 64 + cc * 2; return st * 1024 + (ob ^ (((ob >> 9) & 1) << 5)); }
__host__ __device__ __forceinline__ void stage_rc(int b, int& R, int& C) { const int st = b / 1024, sb = b % 1024, swz = sb ^ (((sb >> 9) & 1) << 5); R = (st >> 1) * 16 + swz / 64; C = (st & 1) * 32 + (swz % 64) / 2; }
__host__ __device__ __forceinline__ int perm32(int rho) { const int n = rho >> 4, i = rho & 15; return 8 * (i >> 2) + 4 * n + (i & 3); }

struct Unit { int pm, pn; };
struct Gemm { const bf16_t* A; const bf16_t* Bt; int M, N, K; };
struct StaticOrder {
    int nM, nN, nwg, G, c;
    __host__ __device__ void init(int M, int N, int G_, int c_) { nM = M / BM; nN = N / BM; nwg = nM * nN; G = G_; c = c_; }
    __host__ __device__ bool next(int i, Unit& u) const {
        const long L = (long)i * G + c; if (L >= nwg) return false;
        int wgid = (int)L; { const int q = nwg / NXCD, r = nwg % NXCD, xcd = wgid % NXCD, off = wgid / NXCD; wgid = (xcd < r ? xcd * (q + 1) : r * (q + 1) + (xcd - r) * q) + off; }
        const int nig = WGM * nN, gid = wgid / nig, fm = gid * WGM, gsz = (nM - fm) < WGM ? (nM - fm) : WGM;
        u.pm = fm + ((wgid % nig) % gsz); u.pn = (wgid % nig) / gsz; return true;
    }
    __device__ __forceinline__ void a_ready(const Unit&) const {}
    __device__ __forceinline__ void done(const Unit&) const {}
};
struct MergeOrder {
    int nM, G, c;
    __device__ bool next(int i, Unit& u) const {
        const int L = (i >> 1) * G + c, br = i & 1; if (L >= nM * 4) return false;
        u.pm = 65 * br + (L >> 2); u.pn = 4 * br + (L & 3); return true;
    }
    __device__ __forceinline__ void a_ready(const Unit&) const {}
    __device__ __forceinline__ void done(const Unit&) const {}
};
template <int NPN_LOG> struct MoeOrder {
    const PG8_LAS int* ptab; int G, c;
    __device__ bool next(int i, Unit& u) const {
        const int L = i * G + c, tr = L >> NPN_LOG, pn = L & ((1 << NPN_LOG) - 1);
        const int total = __builtin_amdgcn_readfirstlane(ptab[32]); if (tr >= total) return false;
        int e = 0;
#pragma unroll 1
        for (int j = 1; j < 32; ++j) { const int pj = __builtin_amdgcn_readfirstlane(ptab[j]); e = (tr >= pj) ? j : e; }
        const int pe = __builtin_amdgcn_readfirstlane(ptab[e]);
        u.pm = 65 * e + (tr - pe); u.pn = (e << NPN_LOG) + pn; return true;
    }
    __device__ __forceinline__ void a_ready(const Unit&) const {}
    __device__ __forceinline__ void done(const Unit&) const {}
};

template <class Epi, class Sched, bool ALIGN_EPI = false, bool SP2 = false>
__device__ __forceinline__ void gemm_phase(PG8_LAS unsigned char* lds, const Gemm g, const Sched& S, const Epi& E) {
    int tid_ = threadIdx.x; asm volatile("" : "+v"(tid_));
    const int tid = tid_, wid = __builtin_amdgcn_readfirstlane(tid >> 6), lane = tid & 63, wr = wid >> 2, wc = wid & 3, fr = lane & 15, fq = lane >> 4;
    const int K = g.K, nt = K / BK;
    unsigned voffA[2], voffB[2];
#pragma unroll
    for (int i = 0; i < 2; ++i) { int R, C; stage_rc(tid * 16 + i * 8192, R, C); const int Rb = Epi::PERM ? ((R & ~31) + perm32(R & 31)) : R;
        voffA[i] = (unsigned)(R * K + C) * 2u; voffB[i] = (unsigned)(Rb * K + C) * 2u; }
    const size_t kstep = (size_t)(BK * 2);
    const size_t hstep = (size_t)HALF * K * 2;
    const size_t tstep = 2 * hstep;
    const unsigned ldsw = (unsigned)wid * 1024u;
    const int aoff = lds_byte(wr * 64 + fr, fq * 8), boff = lds_byte(wc * 32 + fr, fq * 8);
#define PG8_SA(b, h) (((b) * 2 + (h)) * HTB)
#define PG8_SB(b, h) ((4 + (b) * 2 + (h)) * HTB)
#define PG8_STAGE(bufoff, gbase, voff) do { _Pragma("unroll") for (int _i = 0; _i < 2; ++_i) \
        __builtin_amdgcn_global_load_lds((const unsigned*)((const char*)(gbase) + (voff)[_i]), (PG8_LAS unsigned*)(lds + (bufoff) + ldsw + _i * 8192), 16, 0, 0); } while (0)
#define PG8_LDA(dst, b, h) do { _Pragma("unroll") for (int m = 0; m < 4; ++m) _Pragma("unroll") for (int k = 0; k < 2; ++k) dst[m][k] = *(const PG8_LAS bf16x8*)(lds + PG8_SA(b, h) + aoff + m * 2048 + k * 1024); } while (0)
#define PG8_LDB(dst, b, h) do { _Pragma("unroll") for (int n = 0; n < 2; ++n) _Pragma("unroll") for (int k = 0; k < 2; ++k) dst[n][k] = *(const PG8_LAS bf16x8*)(lds + PG8_SB(b, h) + boff + n * 2048 + k * 1024); } while (0)
#define PG8_MMA(ai, bj, At, Bt) do { __builtin_amdgcn_s_setprio(1); _Pragma("unroll") for (int m = 0; m < 4; ++m) _Pragma("unroll") for (int n = 0; n < 2; ++n) _Pragma("unroll") for (int k = 0; k < 2; ++k) \
        acc[ai][bj][m][n] = __builtin_amdgcn_mfma_f32_16x16x32_bf16(Bt[n][k], At[m][k], acc[ai][bj][m][n], 0, 0, 0); __builtin_amdgcn_s_setprio(0); } while (0)
#define PG8_WAIT_V(n) asm volatile("s_waitcnt vmcnt(" #n ")" ::: "memory")
#define PG8_WAIT_L(n) asm volatile("s_waitcnt lgkmcnt(" #n ")" ::: "memory")
#define PG8_BAR __builtin_amdgcn_s_barrier()
#define PG8_SCHED __builtin_amdgcn_sched_barrier(0)
    Unit cur, nxt; int ui = 0;
    if (!S.next(0, cur)) return;
    f32x4 acc[2][2][4][2];
#pragma unroll
    for (int a = 0; a < 2; ++a)
#pragma unroll
        for (int b = 0; b < 2; ++b)
#pragma unroll
            for (int m = 0; m < 4; ++m)
#pragma unroll
                for (int n = 0; n < 2; ++n) acc[a][b][m][n] = (f32x4){0.f, 0.f, 0.f, 0.f};
    bf16x8 At[4][2], B0[2][2], B1[2][2];
    const char* cA = (const char*)g.A + (size_t)cur.pm * tstep; const char* cB = (const char*)g.Bt + (size_t)cur.pn * tstep;
    S.a_ready(cur);
    if constexpr (SP2) {
        PG8_STAGE(PG8_SB(0, 0), cB, voffB); PG8_STAGE(PG8_SB(0, 1), cB + hstep, voffB); PG8_STAGE(PG8_SA(0, 0), cA, voffA); PG8_STAGE(PG8_SA(0, 1), cA + hstep, voffA);
        if (wr == 1) PG8_BAR;
        PG8_WAIT_V(2); PG8_BAR;
        PG8_STAGE(PG8_SB(1, 0), cB + kstep, voffB); PG8_STAGE(PG8_SA(1, 0), cA + kstep, voffA); PG8_STAGE(PG8_SB(1, 1), cB + hstep + kstep, voffB);
        PG8_WAIT_V(6); PG8_BAR;
    } else {
        PG8_STAGE(PG8_SB(0, 0), cB, voffB); PG8_STAGE(PG8_SA(0, 0), cA, voffA); PG8_STAGE(PG8_SB(0, 1), cB + hstep, voffB); PG8_STAGE(PG8_SA(0, 1), cA + hstep, voffA);
        if (wr == 1) PG8_BAR;
        PG8_WAIT_V(4); PG8_BAR;
        PG8_STAGE(PG8_SB(1, 0), cB + kstep, voffB); PG8_STAGE(PG8_SA(1, 0), cA + kstep, voffA); PG8_STAGE(PG8_SB(1, 1), cB + hstep + kstep, voffB);
        PG8_WAIT_V(6); PG8_BAR;
    }
    for (;;) {
        const bool has_next = S.next(ui + 1, nxt);
        const char* nA = has_next ? (const char*)g.A + (size_t)nxt.pm * tstep : cA; const char* nB = has_next ? (const char*)g.Bt + (size_t)nxt.pn * tstep : cB;
        for (int t = 0; t < nt; t += 2) {
            const bool last = (t == nt - 2);
            const char* a1 = cA + (size_t)(t + 1) * kstep;
            const char* a2 = last ? nA : cA + (size_t)(t + 2) * kstep; const char* b2 = last ? nB : cB + (size_t)(t + 2) * kstep;
            const char* a3 = a2 + kstep; const char* b3 = b2 + kstep;
            if (last && has_next) S.a_ready(nxt);
            if constexpr (SP2) {
            PG8_LDB(B0, 0, 0); PG8_LDB(B1, 0, 1); PG8_SCHED; PG8_LDA(At, 0, 0); PG8_STAGE(PG8_SA(1, 1), a1 + hstep, voffA);
            PG8_WAIT_V(8); PG8_WAIT_L(0); PG8_BAR; PG8_MMA(0, 0, At, B0); PG8_MMA(0, 1, At, B1); PG8_BAR; PG8_SCHED;
            PG8_LDA(At, 0, 1); PG8_STAGE(PG8_SB(0, 0), b2, voffB); PG8_STAGE(PG8_SB(0, 1), b2 + hstep, voffB); PG8_STAGE(PG8_SA(0, 0), a2, voffA);
            PG8_WAIT_V(8); PG8_WAIT_L(0); PG8_BAR; PG8_MMA(1, 0, At, B0); PG8_MMA(1, 1, At, B1); PG8_BAR; PG8_SCHED;
            PG8_LDB(B0, 1, 0); PG8_LDB(B1, 1, 1); PG8_SCHED; PG8_LDA(At, 1, 0); PG8_STAGE(PG8_SA(0, 1), a2 + hstep, voffA);
            PG8_WAIT_V(8); PG8_WAIT_L(0); PG8_BAR; PG8_MMA(0, 0, At, B0); PG8_MMA(0, 1, At, B1); PG8_BAR; PG8_SCHED;
            PG8_LDA(At, 1, 1); PG8_STAGE(PG8_SB(1, 0), b3, voffB); PG8_STAGE(PG8_SB(1, 1), b3 + hstep, voffB); PG8_STAGE(PG8_SA(1, 0), a3, voffA);
            PG8_WAIT_V(8); PG8_WAIT_L(0); PG8_BAR; PG8_MMA(1, 0, At, B0); PG8_MMA(1, 1, At, B1); PG8_BAR; PG8_SCHED;
            } else {
            PG8_LDB(B0, 0, 0); PG8_SCHED; PG8_LDA(At, 0, 0); PG8_STAGE(PG8_SA(1, 1), a1 + hstep, voffA);
            PG8_WAIT_L(8); PG8_BAR; PG8_WAIT_L(0); PG8_MMA(0, 0, At, B0); PG8_BAR; PG8_SCHED;
            PG8_LDB(B1, 0, 1); PG8_STAGE(PG8_SB(0, 0), b2, voffB);
            PG8_BAR; PG8_WAIT_L(0); PG8_MMA(0, 1, At, B1); PG8_BAR;
            PG8_LDA(At, 0, 1); PG8_STAGE(PG8_SA(0, 0), a2, voffA);
            PG8_BAR; PG8_WAIT_L(0); PG8_MMA(1, 0, At, B0); PG8_BAR; PG8_SCHED;
            PG8_STAGE(PG8_SB(0, 1), b2 + hstep, voffB);
            PG8_WAIT_V(6); PG8_BAR; PG8_MMA(1, 1, At, B1); PG8_BAR;
            PG8_LDB(B0, 1, 0); PG8_SCHED; PG8_LDA(At, 1, 0); PG8_STAGE(PG8_SA(0, 1), a2 + hstep, voffA);
            PG8_WAIT_L(8); PG8_BAR; PG8_WAIT_L(0); PG8_MMA(0, 0, At, B0); PG8_BAR; PG8_SCHED;
            PG8_LDB(B1, 1, 1); PG8_STAGE(PG8_SB(1, 0), b3, voffB);
            PG8_BAR; PG8_WAIT_L(0); PG8_MMA(0, 1, At, B1); PG8_BAR;
            PG8_LDA(At, 1, 1); PG8_STAGE(PG8_SA(1, 0), a3, voffA);
            PG8_BAR; PG8_WAIT_L(0); PG8_MMA(1, 0, At, B0); PG8_BAR; PG8_SCHED;
            PG8_STAGE(PG8_SB(1, 1), b3 + hstep, voffB);
            PG8_WAIT_V(6); PG8_BAR; PG8_MMA(1, 1, At, B1); PG8_BAR;
            }
        }
        if constexpr (ALIGN_EPI) { if (wr == 0) PG8_BAR; }
        if constexpr (!Epi::AFTER_DRAIN) { E(acc, cur, wr, wc, fr, fq); S.done(cur); }
        if (!has_next) break;
#pragma unroll
        for (int a = 0; a < 2; ++a)
#pragma unroll
            for (int b = 0; b < 2; ++b)
#pragma unroll
                for (int m = 0; m < 4; ++m)
#pragma unroll
                    for (int n = 0; n < 2; ++n) acc[a][b][m][n] = (f32x4){0.f, 0.f, 0.f, 0.f};
        cur = nxt; cA = nA; cB = nB; ++ui;
        if constexpr (ALIGN_EPI) { if (wr == 1) PG8_BAR; }
    }
    PG8_WAIT_V(0);
    if constexpr (!ALIGN_EPI) { if (wr == 0) PG8_BAR; }
    PG8_BAR;
    if constexpr (Epi::AFTER_DRAIN) { E.fused(acc, cur, wr, wc, fr, fq, lds, wid, lane); S.done(cur); }
#undef PG8_SA
#undef PG8_SB
#undef PG8_STAGE
#undef PG8_LDA
#undef PG8_LDB
#undef PG8_MMA
#undef PG8_WAIT_V
#undef PG8_WAIT_L
#undef PG8_BAR
#undef PG8_SCHED
}
}


struct Params { const float* in[24]; float* out; unsigned char* ws; int ph_lo, ph_hi; };
enum { I_X = 0, I_C, I_CTX, I_CCTX, I_ADAW, I_ADAB, I_N1G, I_N2G, I_WIN, I_QNG, I_KNG, I_LAMQK, I_SUBLN, I_HGLB, I_HGNG, I_WBA, I_WBB, I_WOUT, I_RW, I_RB, I_WGU, I_BGU, I_WDN, I_BDN };

#define LDS_WAIT() asm volatile("s_waitcnt lgkmcnt(0)" ::: "memory")

template <int KIND>
__device__ __forceinline__ void transpose_item(const float* __restrict__ W, int K, int N, bf16* WT, bf16* WT2, int row_off, int k0, int n0, LAS float* scr, int lane) {
#pragma unroll 4
    for (int it = 0; it < 16; ++it) {
        const int k = 4 * it + (lane >> 4), n4 = (lane & 15) * 4;
        const f32x4 v = *(const f32x4*)(W + (size_t)(k0 + k) * N + n0 + n4);
        *(LAS f32x4*)(scr + k * 64 + (n4 ^ (4 * ((k >> 3) & 7)))) = v;
    }
    LDS_WAIT();
    const int c = lane & 7;
#pragma unroll 2
    for (int j2 = 0; j2 < 8; ++j2) {
        const int nl = (lane >> 3) + 8 * j2, n = n0 + nl;
        const LAS float* s = scr + (8 * c) * 64 + (nl ^ (4 * c));
        v4u o; o.x = pk2(s[0], s[64]); o.y = pk2(s[128], s[192]); o.z = pk2(s[256], s[320]); o.w = pk2(s[384], s[448]);
        bf16* dst;
        if (KIND == 0) dst = WT + (size_t)(row_off + n) * K;
        else if (KIND == 1) dst = WT + (size_t)(row_off + perm8(n)) * K;
        else if (KIND == 2) {
            if (n < 1024) { const int tile = n >> 8, G = (n >> 6) & 3, bj = (n >> 5) & 1, e = n & 31; dst = WT + (size_t)(256 * tile + 128 * bj + 32 * G + e) * K; }
            else if (n < 1536) dst = WT2 + (size_t)(n - 1024) * K;
            else dst = WT + (size_t)(1024 + perm8(n - 1536)) * K;
        } else {
            const int half = n >> 10, nn = n & 1023;
            dst = WT + (size_t)(256 * (nn >> 7) + 128 * half + perm8(nn & 127)) * K;
        }
        *(v4u*)(dst + k0 + 8 * c) = o;
    }
    LDS_WAIT();
}

__device__ __forceinline__ void sincos_d(double x, double& s, double& c) {
    const double k = __builtin_rint(x * 0.63661977236758134308);
    double r = __builtin_fma(-k, 1.57079632679489655800e+00, x); r = __builtin_fma(-k, 6.12323399573676603587e-17, r);
    const double r2 = r * r;
    double sp = -1.0 / 1307674368000.0; sp = sp * r2 + 1.0 / 6227020800.0; sp = sp * r2 - 1.0 / 39916800.0; sp = sp * r2 + 1.0 / 362880.0; sp = sp * r2 - 1.0 / 5040.0; sp = sp * r2 + 1.0 / 120.0; sp = sp * r2 - 1.0 / 6.0; sp = sp * r2 + 1.0;
    const double sr = sp * r;
    double cp = 1.0 / 20922789888000.0; cp = cp * r2 - 1.0 / 87178291200.0; cp = cp * r2 + 1.0 / 479001600.0; cp = cp * r2 - 1.0 / 3628800.0; cp = cp * r2 + 1.0 / 40320.0; cp = cp * r2 - 1.0 / 720.0; cp = cp * r2 + 1.0 / 24.0; cp = cp * r2 - 0.5; cp = cp * r2 + 1.0;
    const int q = ((int)k) & 3;
    s = (q == 0) ? sr : (q == 1) ? cp : (q == 2) ? -sr : -cp;
    c = (q == 0) ? cp : (q == 1) ? -sr : (q == 2) ? -cp : sr;
}

__device__ __forceinline__ void phase_p0a(const Params& P, LAS unsigned char* lds, int G) {
    int tid_ = threadIdx.x; asm volatile("" : "+v"(tid_));
    const int tid = tid_, lane = tid & 63, wave = tid >> 6;
    unsigned char* ws = P.ws;
    LAS float* sil = (LAS float*)(lds + 131072);
    for (int i = tid; i < 2048; i += NTHR) { const float v = (i < 1024) ? P.in[I_C][i] : P.in[I_CCTX][i - 1024]; sil[i] = v * sigmoidf_(v); }
    __syncthreads();
    {
        float* modp = (float*)(ws + WS_MODP);
        for (int t = blockIdx.x * NTHR + tid; t < DEPTH * 8 * 6144; t += G * NTHR) {
            const int j = t % 6144, lp = t / 6144, part = lp & 7, l = lp >> 3;
            const float* w = P.in[I_ADAW] + ((size_t)l * D + part * 128) * 6144 + j;
            float a0 = 0.f, a1 = 0.f;
#pragma unroll 8
            for (int i = 0; i < 128; ++i) { const float wv = w[(size_t)i * 6144]; a0 += sil[part * 128 + i] * wv; a1 += sil[1024 + part * 128 + i] * wv; }
            modp[((size_t)(l * 8 + part) * 2 + 0) * 6144 + j] = a0;
            modp[((size_t)(l * 8 + part) * 2 + 1) * 6144 + j] = a1;
        }
    }
    {
        float* lbo = (float*)(ws + WS_LB);
        for (int t = blockIdx.x * NTHR + tid; t < 2 * 512; t += G * NTHR) {
            const int dir = t >> 9, j = t & 511;
            float v[DEPTH], mx = -1e30f;
#pragma unroll
            for (int l = 0; l < DEPTH; ++l) { v[l] = P.in[I_HGLB][((size_t)dir * DEPTH + l) * 512 + j]; mx = fmaxf(mx, v[l]); }
            float sum = 0.f;
#pragma unroll
            for (int l = 0; l < DEPTH; ++l) { v[l] = expf(v[l] - mx); sum += v[l]; }
            float cs = 0.f, first = 0.f;
#pragma unroll
            for (int l = 0; l < DEPTH; ++l) { cs += v[l] / sum; if (l == 0) first = cs; lbo[((size_t)dir * DEPTH + l) * 512 + j] = cs - first; }
        }
    }
    {
        float* rt = (float*)(ws + WS_ROPE);
        for (int t = blockIdx.x * NTHR + tid; t < 256 * 16; t += G * NTHR) {
            const int pos = t >> 4, fi = t & 15;
            const float freq = (float)exp2(-(double)fi * (13.287712379549449 / 16.0));
            const float ang = (float)pos * freq;
            double s, c; sincos_d((double)ang, s, c);
            rt[2 * t] = (float)c; rt[2 * t + 1] = (float)s;
        }
    }
    {
        LAS float* scr = (LAS float*)(lds + wave * 16384);
        const int gw = blockIdx.x * NWAVES + wave, NGW = G * NWAVES;
        constexpr int I_IN = 16 * 96, I_A = 8 * 16, I_B = 8 * 16, I_O = 16 * 16, I_GU = 16 * 32, I_DN = 16 * 16;
        constexpr int PER_L = I_IN + I_A + I_B + I_O + NE * I_GU + NE * I_DN;
        for (int it = gw; it < DEPTH * PER_L; it += NGW) {
            const int l = it / PER_L; int r = it % PER_L;
            if (r < I_IN) { const int kb = r / 96, nb = r % 96;
                transpose_item<2>(P.in[I_WIN] + (size_t)l * D * INC, D, INC, (bf16*)(ws + WS_WIN + l * WIN_L), (bf16*)(ws + WS_WV + l * WV_L), 0, 64 * kb, 64 * nb, scr, lane); continue; }
            r -= I_IN;
            if (r < I_A) { const int kb = r / 16, nb = r % 16;
                transpose_item<1>(P.in[I_WBA] + (size_t)l * 512 * D, 512, D, (bf16*)(ws + WS_WAB + l * WAB_L), nullptr, 0, 64 * kb, 64 * nb, scr, lane); continue; }
            r -= I_A;
            if (r < I_B) { const int kb = r / 16, nb = r % 16;
                transpose_item<1>(P.in[I_WBB] + (size_t)l * 512 * D, 512, D, (bf16*)(ws + WS_WAB + l * WAB_L), nullptr, 1024, 64 * kb, 64 * nb, scr, lane); continue; }
            r -= I_B;
            if (r < I_O) { const int kb = r / 16, nb = r % 16;
                transpose_item<0>(P.in[I_WOUT] + (size_t)l * D * D, D, D, (bf16*)(ws + WS_WO + l * WO_L), nullptr, 0, 64 * kb, 64 * nb, scr, lane); continue; }
            r -= I_O;
            if (r < NE * I_GU) { const int e = r / I_GU, q = r % I_GU, kb = q / 32, nb = q % 32;
                transpose_item<3>(P.in[I_WGU] + ((size_t)l * NE + e) * D * 2048, D, 2048, (bf16*)(ws + WS_WGU + l * WGU_L + e * WGU_E), nullptr, 0, 64 * kb, 64 * nb, scr, lane); continue; }
            r -= NE * I_GU;
            { const int e = r / I_DN, q = r % I_DN, kb = q / 16, nb = q % 16;
                transpose_item<1>(P.in[I_WDN] + ((size_t)l * NE + e) * DFF * D, DFF, D, (bf16*)(ws + WS_WD + l * WD_L + e * WD_E), nullptr, 0, 64 * kb, 64 * nb, scr, lane); }
        }
    }
}

__device__ __forceinline__ const float* modv_ptr(const Params& P, int l, int w) { return (const float*)(P.ws + WS_MODV) + ((size_t)l * 2 + w) * 6144; }
__device__ __forceinline__ const float* xin_row(const Params& P, int l, int row) {
    if (l == 0) return (row < SEQ) ? P.in[I_X] + (size_t)row * D : P.in[I_CTX] + (size_t)(row - SEQ) * D;
    return (const float*)(P.ws + WS_XRES) + (size_t)row * D;
}
__device__ __forceinline__ void norm_store_row(const f32x4 (&v)[4], const LAS float* A, const LAS float* B, bf16* hrow, int lane) {
    float ss = 0.f;
#pragma unroll
    for (int j = 0; j < 4; ++j) ss += (v[j].x * v[j].x + v[j].y * v[j].y) + (v[j].z * v[j].z + v[j].w * v[j].w);
    const float rstd = __builtin_amdgcn_rsqf(wave_sum(ss) * (1.f / D) + EPS);
#pragma unroll
    for (int j = 0; j < 4; ++j) {
        const f32x4 a = *(const LAS f32x4*)(A + 4 * lane + 256 * j), b = *(const LAS f32x4*)(B + 4 * lane + 256 * j);
        const f32x4 y = v[j] * rstd * a + b;
        v2u o; o.x = pk2(y.x, y.y); o.y = pk2(y.z, y.w);
        *(v2u*)(hrow + 4 * lane + 256 * j) = o;
    }
}

__device__ __forceinline__ void phase_p0b(const Params& P, LAS unsigned char* lds, int G) {
    int tid_ = threadIdx.x; asm volatile("" : "+v"(tid_));
    const int tid = tid_, lane = tid & 63, wave = tid >> 6;
    unsigned char* ws = P.ws;
    const float* modp = (const float*)(ws + WS_MODP);
    float* modv = (float*)(ws + WS_MODV);
    for (int t = blockIdx.x * NTHR + tid; t < DEPTH * 2 * 6144; t += G * NTHR) {
        const int j = t % 6144, lw = t / 6144, w = lw & 1, l = lw >> 1;
        float a = P.in[I_ADAB][(size_t)l * 6144 + j];
#pragma unroll
        for (int p = 0; p < 8; ++p) a += modp[((size_t)(l * 8 + p) * 2 + w) * 6144 + j];
        modv[t] = a;
    }
    LAS float* TA = (LAS float*)lds;
    LAS float* TB = (LAS float*)(lds + 8192);
    for (int i = tid; i < 2048; i += NTHR) {
        const int w = i >> 10, j = i & 1023;
        float sh = P.in[I_ADAB][j], sc = P.in[I_ADAB][1024 + j];
#pragma unroll
        for (int p = 0; p < 8; ++p) { sh += modp[((size_t)p * 2 + w) * 6144 + j]; sc += modp[((size_t)p * 2 + w) * 6144 + 1024 + j]; }
        TA[i] = P.in[I_N1G][j] * (1.f + sc); TB[i] = sh;
    }
    __syncthreads();
    bf16* H = (bf16*)(ws + WS_H);
    for (int row = blockIdx.x * NWAVES + wave; row < NT; row += G * NWAVES) {
        const float* xr = xin_row(P, 0, row); const int w = row >= SEQ;
        f32x4 v[4];
#pragma unroll
        for (int j = 0; j < 4; ++j) v[j] = *(const f32x4*)(xr + 4 * lane + 256 * j);
        norm_store_row(v, TA + 1024 * w, TB + 1024 * w, H + (size_t)row * D, lane);
    }
}

using pg8::Unit;

struct EpiInProj {
    static constexpr bool PERM = false, AFTER_DRAIN = false;
    bf16* Q; bf16* K; bf16* proj; const float* qn_g; const float* kn_g; const float* rope;
    __device__ __forceinline__ void operator()(const f32x4 (&acc)[2][2][4][2], const Unit& u, int wr, int wc, int fr, int fq) const {
        const int row0 = u.pm * 256 + wr * 64 + fr;
        if (u.pn < 4) {
            const bool isq = u.pn < 2; const int gg = 4 * (u.pn & 1) + wc, hh = gg >> 1, mm = gg & 1;
            const float* gv = isq ? qn_g : kn_g; bf16* dstb = (isq ? Q : K) + (size_t)hh * NT * 128 + 64 * mm;
            const float oscale = isq ? 0.125f * 1.4426950408889634f : 1.f;
            f32x4 g[2][2];
#pragma unroll
            for (int bj = 0; bj < 2; ++bj)
#pragma unroll
                for (int n = 0; n < 2; ++n) g[bj][n] = *(const f32x4*)(gv + 32 * bj + 16 * n + 4 * fq);
#pragma unroll
            for (int ai = 0; ai < 2; ++ai)
#pragma unroll
                for (int m = 0; m < 4; ++m) {
                    const int row = row0 + ai * 128 + m * 16;
                    float ss = 0.f;
#pragma unroll
                    for (int bj = 0; bj < 2; ++bj)
#pragma unroll
                        for (int n = 0; n < 2; ++n) { const f32x4 x = acc[ai][bj][m][n]; ss += (x.x * x.x + x.y * x.y) + (x.z * x.z + x.w * x.w); }
                    ss += __shfl_xor(ss, 16); ss += __shfl_xor(ss, 32);
                    const float rstd = __builtin_amdgcn_rsqf(ss * (1.f / 64.f) + EPS) ;
                    bf16* dst = dstb + (size_t)row * 128;
                    const bool lat = row < SEQ;
#pragma unroll
                    for (int bj = 0; bj < 2; ++bj) {
                        f32x4 x1 = acc[ai][bj][m][0] * rstd * g[bj][0], x2 = acc[ai][bj][m][1] * rstd * g[bj][1];
                        if (lat) {
                            const int pos = bj == 0 ? (row >> 6) : (row & 63);
                            const f32x4 cs0 = *(const f32x4*)(rope + (size_t)(pos * 16 + 4 * fq) * 2), cs1 = *(const f32x4*)(rope + (size_t)(pos * 16 + 4 * fq) * 2 + 4);
                            const f32x4 c = {cs0.x, cs0.z, cs1.x, cs1.z}, s = {cs0.y, cs0.w, cs1.y, cs1.w};
                            const f32x4 y1 = x1 * c - x2 * s, y2 = x2 * c + x1 * s; x1 = y1; x2 = y2;
                        }
                        x1 = x1 * oscale; x2 = x2 * oscale;
                        v2u o1, o2; o1.x = pk2(x1.x, x1.y); o1.y = pk2(x1.z, x1.w); o2.x = pk2(x2.x, x2.y); o2.y = pk2(x2.z, x2.w);
                        *(v2u*)(dst + 32 * bj + 4 * fq) = o1; *(v2u*)(dst + 32 * bj + 16 + 4 * fq) = o2;
                    }
                }
        } else {
            const int pt = u.pn - 4; const int act = pt < 8 ? 0 : (pt < 10 ? 1 : 2);
            const int col0 = pt * 256 + wc * 32 + 8 * fq;
#pragma unroll
            for (int ai = 0; ai < 2; ++ai)
#pragma unroll
                for (int m = 0; m < 4; ++m) { bf16* rowp = proj + (size_t)(row0 + ai * 128 + m * 16) * PROJW + col0;
#pragma unroll
                    for (int bj = 0; bj < 2; ++bj) { f32x4 v0 = acc[ai][bj][m][0], v1 = acc[ai][bj][m][1];
                        if (act) {
#pragma unroll
                            for (int j = 0; j < 4; ++j) { const float s0 = sigmoidf_(v0[j]), s1 = sigmoidf_(v1[j]); v0[j] = act == 1 ? v0[j] * s0 : s0; v1[j] = act == 1 ? v1[j] * s1 : s1; } }
                        v4u w; w.x = pk2(v0.x, v0.y); w.y = pk2(v0.z, v0.w); w.z = pk2(v1.x, v1.y); w.w = pk2(v1.z, v1.w);
                        *(v4u*)(rowp + bj * 128) = w; } }
        }
    }
};
struct EpiVt {
    static constexpr bool PERM = false, AFTER_DRAIN = false;
    bf16* VT;
    __device__ __forceinline__ void operator()(const f32x4 (&acc)[2][2][4][2], const Unit& u, int wr, int wc, int fr, int fq) const {
        const int row0 = u.pm * 256 + wr * 64 + fr, col0 = u.pn * 256 + wc * 32 + 4 * fq;
#pragma unroll
        for (int ai = 0; ai < 2; ++ai)
#pragma unroll
            for (int m = 0; m < 4; ++m) { bf16* rowp = VT + (size_t)(row0 + ai * 128 + m * 16) * LDV + col0;
#pragma unroll
                for (int bj = 0; bj < 2; ++bj)
#pragma unroll
                    for (int n = 0; n < 2; ++n) { const f32x4 v = acc[ai][bj][m][n]; v2u o; o.x = pk2(v.x, v.y); o.y = pk2(v.z, v.w); *(v2u*)(rowp + bj * 128 + n * 16) = o; } }
    }
};
struct EpiMerge {
    static constexpr bool PERM = false, AFTER_DRAIN = false;
    const bf16* proj; bf16* U;
    __device__ __forceinline__ void operator()(const f32x4 (&acc)[2][2][4][2], const Unit& u, int wr, int wc, int fr, int fq) const {
        const int br = u.pn >> 2, T = u.pn & 3, pm = u.pm - 65 * br;
        const int row0 = pm * 256 + wr * 64 + fr, col0 = T * 256 + wc * 32 + 8 * fq;
        const int gcol = (br ? PC_GB : PC_GA) + col0;
#pragma unroll
        for (int ai = 0; ai < 2; ++ai)
#pragma unroll
            for (int m = 0; m < 4; ++m) { const size_t row = (size_t)(row0 + ai * 128 + m * 16);
#pragma unroll
                for (int bj = 0; bj < 2; ++bj) {
                    const v4u gw = *(const v4u*)(proj + row * PROJW + gcol + bj * 128);
                    f32x4 v0 = acc[ai][bj][m][0], v1 = acc[ai][bj][m][1];
                    v0.x *= bflo(gw.x); v0.y *= bfhi(gw.x); v0.z *= bflo(gw.y); v0.w *= bfhi(gw.y);
                    v1.x *= bflo(gw.z); v1.y *= bfhi(gw.z); v1.z *= bflo(gw.w); v1.w *= bfhi(gw.w);
                    bf16* up = U + row * D + col0 + bj * 128;
                    if (br) { const v4u o = *(const v4u*)up;
                        v0.x += bflo(o.x); v0.y += bfhi(o.x); v0.z += bflo(o.y); v0.w += bfhi(o.y);
                        v1.x += bflo(o.z); v1.y += bfhi(o.z); v1.z += bflo(o.w); v1.w += bfhi(o.w); }
                    v4u w; w.x = pk2(v0.x, v0.y); w.y = pk2(v0.z, v0.w); w.z = pk2(v1.x, v1.y); w.w = pk2(v1.z, v1.w);
                    *(v4u*)up = w; } }
    }
};
struct EpiOut {
    static constexpr bool PERM = false, AFTER_DRAIN = false;
    const float* xlat; const float* xctx; float* xres; const float* g1lat; const float* g1ctx;
    __device__ __forceinline__ void operator()(const f32x4 (&acc)[2][2][4][2], const Unit& u, int wr, int wc, int fr, int fq) const {
        const int row0 = u.pm * 256 + wr * 64 + fr, col0 = u.pn * 256 + wc * 32 + 4 * fq;
        const bool isctx = u.pm >= 64;
        const float* gsrc = isctx ? g1ctx : g1lat;
        f32x4 gv[2][2];
#pragma unroll
        for (int bj = 0; bj < 2; ++bj)
#pragma unroll
            for (int n = 0; n < 2; ++n) gv[bj][n] = *(const f32x4*)(gsrc + col0 + bj * 128 + n * 16);
#pragma unroll
        for (int ai = 0; ai < 2; ++ai)
#pragma unroll
            for (int m = 0; m < 4; ++m) { const int row = row0 + ai * 128 + m * 16;
                const float* src = (isctx ? xctx + (size_t)(row - SEQ) * D : xlat + (size_t)row * D) + col0;
                float* dst = xres + (size_t)row * D + col0;
#pragma unroll
                for (int bj = 0; bj < 2; ++bj)
#pragma unroll
                    for (int n = 0; n < 2; ++n) *(f32x4*)(dst + bj * 128 + n * 16) = *(const f32x4*)(src + bj * 128 + n * 16) + gv[bj][n] * acc[ai][bj][m][n]; }
    }
};
struct EpiSwiglu {
    static constexpr bool PERM = false, AFTER_DRAIN = false;
    bf16* hdn; const float* bgu;
    __device__ __forceinline__ void operator()(const f32x4 (&acc)[2][2][4][2], const Unit& u, int wr, int wc, int fr, int fq) const {
        const int e = u.pn >> 3, T = u.pn & 7;
        const int row0 = u.pm * 256 + wr * 64 + fr, col0 = T * 128 + wc * 32 + 8 * fq;
        const float* bg = bgu + (size_t)e * 2048 + col0;
        const f32x4 bg0 = *(const f32x4*)bg, bg1 = *(const f32x4*)(bg + 4), bu0 = *(const f32x4*)(bg + 1024), bu1 = *(const f32x4*)(bg + 1028);
#pragma unroll
        for (int ai = 0; ai < 2; ++ai)
#pragma unroll
            for (int m = 0; m < 4; ++m) {
                f32x4 g0 = acc[ai][0][m][0] + bg0, g1 = acc[ai][0][m][1] + bg1, u0 = acc[ai][1][m][0] + bu0, u1 = acc[ai][1][m][1] + bu1;
                f32x4 h0, h1;
#pragma unroll
                for (int j = 0; j < 4; ++j) {
                    const float ga = fminf(g0[j], 7.f), gb = fminf(g1[j], 7.f);
                    const float ua = fminf(fmaxf(u0[j], -7.f), 7.f), ub = fminf(fmaxf(u1[j], -7.f), 7.f);
                    h0[j] = (ua + 1.f) * ga * sigmoidf_(1.702f * ga); h1[j] = (ub + 1.f) * gb * sigmoidf_(1.702f * gb);
                }
                v4u w; w.x = pk2(h0.x, h0.y); w.y = pk2(h0.z, h0.w); w.z = pk2(h1.x, h1.y); w.w = pk2(h1.z, h1.w);
                *(v4u*)(hdn + (size_t)(row0 + ai * 128 + m * 16) * D + col0) = w;
            }
    }
};
struct EpiDown {
    static constexpr bool PERM = false, AFTER_DRAIN = false;
    bf16* Y; const float* bdn;
    __device__ __forceinline__ void operator()(const f32x4 (&acc)[2][2][4][2], const Unit& u, int wr, int wc, int fr, int fq) const {
        const int e = u.pn >> 2, T = u.pn & 3;
        const int row0 = u.pm * 256 + wr * 64 + fr, col0 = T * 256 + wc * 32 + 8 * fq;
        f32x4 bv[2][2];
#pragma unroll
        for (int bj = 0; bj < 2; ++bj)
#pragma unroll
            for (int n = 0; n < 2; ++n) bv[bj][n] = *(const f32x4*)(bdn + (size_t)e * D + col0 + bj * 128 + 4 * n);
#pragma unroll
        for (int ai = 0; ai < 2; ++ai)
#pragma unroll
            for (int m = 0; m < 4; ++m) { bf16* rowp = Y + (size_t)(row0 + ai * 128 + m * 16) * D + col0;
#pragma unroll
                for (int bj = 0; bj < 2; ++bj) { const f32x4 v0 = acc[ai][bj][m][0] + bv[bj][0], v1 = acc[ai][bj][m][1] + bv[bj][1];
                    v4u w; w.x = pk2(v0.x, v0.y); w.y = pk2(v0.z, v0.w); w.z = pk2(v1.x, v1.y); w.w = pk2(v1.z, v1.w);
                    *(v4u*)(rowp + bj * 128) = w; } }
    }
};

constexpr int HL_QT = 0, HL_KT = 4352, HL_KH = 8704, HL_VT = 14848, HL_DEC = 20992, HL_AM = 21504, HL_OT = 27648, HL_ST = 36864, HL_STSZ = 34816;
constexpr int HGP = 272;

template <bool OUT>
__device__ __forceinline__ void hgrn_sweep(const Params& P, LAS unsigned char* lds, int layer, int dir, int hh, int seg, const float* Sinit, float* Uout, float* Dout, bool finalize) {
    int tid_ = threadIdx.x; asm volatile("" : "+v"(tid_));
    const int tid = tid_, lane = tid & 63, wid = __builtin_amdgcn_readfirstlane(tid >> 6), r32 = lane & 31, hi = lane >> 5;
    unsigned char* ws = P.ws;
    const bf16* proj = (const bf16*)(ws + WS_PROJ);
    const int tok0 = (seg < 64 ? seg * 256 : SEQ) + (dir ? 255 : 0), sgn = dir ? -1 : 1;
    const int db = wid & 3, vb0 = 2 * (wid >> 2);
    f32x16 S[2];
#pragma unroll
    for (int blk = 0; blk < 2; ++blk)
#pragma unroll
        for (int r = 0; r < 16; ++r) { const int d = 32 * db + (r & 3) + 8 * (r >> 2) + 4 * hi, v = 32 * (vb0 + blk) + r32; S[blk][r] = Sinit ? Sinit[(size_t)d * 128 + v] : 0.f; }
    if (OUT) {
#pragma unroll
        for (int blk = 0; blk < 2; ++blk)
#pragma unroll
            for (int g = 0; g < 4; ++g) { v2u o; o.x = pk2(S[blk][4 * g], S[blk][4 * g + 1]); o.y = pk2(S[blk][4 * g + 2], S[blk][4 * g + 3]);
                *(LAS v2u*)(lds + HL_ST + (32 * (vb0 + blk) + r32) * HGP + (32 * db + 8 * g + 4 * hi) * 2) = o; }
    }
    const int dcol = tid & 127, part = tid >> 7;
    const float lb = ((const float*)(ws + WS_LB))[((size_t)dir * DEPTH + layer) * 512 + 128 * hh + dcol];
    const int zc = (dir ? PC_ZB : PC_ZF) + 128 * hh + dcol;
    float btot = 0.f;
    int cur = 0;
    for (int c = 0; c < 16; ++c) {
        {
            float b[16], kk[4]; float run = 0.f;
#pragma unroll
            for (int s = 0; s < 16; ++s) {
                const int tok = tok0 + sgn * (16 * c + s);
                float z = bf2f(proj[(size_t)tok * PROJW + zc]); z = fminf(fmaxf(z, -80.f), 80.f);
                const float E = fast_exp(-z), den = fast_rcp(1.f + E);
                const float f = (1.f + lb * E) * den;
                run += fast_log(f); b[s] = run;
                if ((s >> 2) == part) kk[s & 3] = (1.f - lb) * E * den;
            }
            const float b15 = b[15];
            unsigned kh[2];
#pragma unroll
            for (int j = 0; j < 4; ++j) {
                float bs = 0.f;
#pragma unroll
                for (int s = 0; s < 16; ++s) bs = (s == 4 * part + j) ? b[s] : bs;
                const int s_ = 4 * part + j, tok = tok0 + sgn * (16 * c + s_);
                const float kq = kk[j];
                if (OUT) {
                    const float q = bf2f(proj[(size_t)tok * PROJW + PC_QH + 128 * hh + dcol]);
                    *(LAS bf16*)(lds + HL_QT + s_ * HGP + dcol * 2) = (bf16)(pk2(q * fast_exp(bs), 0.f) & 0xffffu);
                    *(LAS bf16*)(lds + HL_KT + s_ * HGP + dcol * 2) = (bf16)(pk2(kq * fast_exp(fminf(-bs, 80.f)), 0.f) & 0xffffu);
                }
                const float khv = kq * fast_exp(b15 - bs);
                if (j & 1) kh[j >> 1] = pk2(__uint_as_float(kh[j >> 1]), khv); else kh[j >> 1] = __float_as_uint(khv);
            }
            { v2u o; o.x = kh[0]; o.y = kh[1]; *(LAS v2u*)(lds + HL_KH + dcol * 48 + part * 8) = o; }
            if (part == 0) { *(LAS float*)(lds + HL_DEC + dcol * 4) = fast_exp(b15); btot += b15; }
            { const int s_ = tid >> 5, v4 = 4 * (tid & 31), tok = tok0 + sgn * (16 * c + s_);
              const v2u vv = *(const v2u*)(proj + (size_t)tok * PROJW + PC_VH + 128 * hh + v4);
              LAS bf16* vt = (LAS bf16*)(lds + HL_VT);
              vt[(v4 + 0) * 24 + s_] = (bf16)(vv.x & 0xffffu); vt[(v4 + 1) * 24 + s_] = (bf16)(vv.x >> 16);
              vt[(v4 + 2) * 24 + s_] = (bf16)(vv.y & 0xffffu); vt[(v4 + 3) * 24 + s_] = (bf16)(vv.y >> 16); }
        }
        __syncthreads();
        if (OUT) {
            const int t16 = lane & 15, kq4 = lane >> 4;
            bf16x8 qa[4];
#pragma unroll
            for (int ks = 0; ks < 4; ++ks) qa[ks] = *(const LAS bf16x8*)(lds + HL_QT + t16 * HGP + (32 * ks + 8 * kq4) * 2);
            f32x4 am = {0.f, 0.f, 0.f, 0.f};
#pragma unroll
            for (int ks = 0; ks < 4; ++ks) { const bf16x8 kb = *(const LAS bf16x8*)(lds + HL_KT + t16 * HGP + (32 * ks + 8 * kq4) * 2); am = __builtin_amdgcn_mfma_f32_16x16x32_bf16(qa[ks], kb, am, 0, 0, 0); }
            LAS unsigned char* amw = lds + HL_AM + wid * 768;
#pragma unroll
            for (int i = 0; i < 4; ++i) { const int t = 4 * kq4 + i; *(LAS bf16*)(amw + t * 48 + t16 * 2) = (bf16)(pk2(t16 <= t ? am[i] : 0.f, 0.f) & 0xffffu); }
            f32x4 o4 = {0.f, 0.f, 0.f, 0.f};
            const int vcol = 16 * wid + t16;
#pragma unroll
            for (int ks = 0; ks < 4; ++ks) { const bf16x8 sb = *(const LAS bf16x8*)(lds + HL_ST + cur * HL_STSZ + vcol * HGP + (32 * ks + 8 * kq4) * 2); o4 = __builtin_amdgcn_mfma_f32_16x16x32_bf16(qa[ks], sb, o4, 0, 0, 0); }
            LDS_WAIT();
            bf16x8 ama = *(const LAS bf16x8*)(amw + t16 * 48 + 16 * (kq4 & 1));
            if (kq4 >= 2) ama = (bf16x8){0, 0, 0, 0, 0, 0, 0, 0};
            const bf16x8 vbf = *(const LAS bf16x8*)(lds + HL_VT + vcol * 48 + 16 * (kq4 & 1));
            o4 = __builtin_amdgcn_mfma_f32_16x16x32_bf16(ama, vbf, o4, 0, 0, 0);
            float* obf = (float*)(ws + WS_OBF);
#pragma unroll
            for (int i = 0; i < 4; ++i) { const int t = 4 * kq4 + i, tok = tok0 + sgn * (16 * c + t);
                float* op = obf + (size_t)tok * 512 + 128 * hh + vcol;
                if (!finalize) *op = o4[i];
                else *(LAS float*)(lds + HL_OT + t * 528 + vcol * 4) = o4[i] + *op; }
        }
        {
            float dsc[16];
#pragma unroll
            for (int r = 0; r < 16; ++r) dsc[r] = *(const LAS float*)(lds + HL_DEC + (32 * db + (r & 3) + 8 * (r >> 2) + 4 * hi) * 4);
            const bf16x8 ka = *(const LAS bf16x8*)(lds + HL_KH + (32 * db + r32) * 48 + 16 * hi);
#pragma unroll
            for (int blk = 0; blk < 2; ++blk) {
#pragma unroll
                for (int r = 0; r < 16; ++r) S[blk][r] *= dsc[r];
                const bf16x8 vb = *(const LAS bf16x8*)(lds + HL_VT + (32 * (vb0 + blk) + r32) * 48 + 16 * hi);
                S[blk] = __builtin_amdgcn_mfma_f32_32x32x16_bf16(ka, vb, S[blk], 0, 0, 0);
                if (OUT) {
#pragma unroll
                    for (int g = 0; g < 4; ++g) { v2u o; o.x = pk2(S[blk][4 * g], S[blk][4 * g + 1]); o.y = pk2(S[blk][4 * g + 2], S[blk][4 * g + 3]);
                        *(LAS v2u*)(lds + HL_ST + (cur ^ 1) * HL_STSZ + (32 * (vb0 + blk) + r32) * HGP + (32 * db + 8 * g + 4 * hi) * 2) = o; }
                }
            }
        }
        __syncthreads();
        if (OUT && finalize) {
            const int t = tid >> 5, v4 = 4 * (tid & 31), tok = tok0 + sgn * (16 * c + t);
            const f32x4 o = *(const LAS f32x4*)(lds + HL_OT + t * 528 + v4 * 4);
            float ss = (o.x * o.x + o.y * o.y) + (o.z * o.z + o.w * o.w);
#pragma unroll
            for (int off = 1; off < 32; off <<= 1) ss += __shfl_xor(ss, off);
            const float rstd = __builtin_amdgcn_rsqf(ss * (1.f / 128.f) + EPS);
            const f32x4 gn = *(const f32x4*)(P.in[I_HGNG] + (size_t)layer * 128 + v4);
            const v2u gt = *(const v2u*)(proj + (size_t)tok * PROJW + PC_GH + 128 * hh + v4);
            v2u w; w.x = pk2(o.x * rstd * gn.x * bflo(gt.x), o.y * rstd * gn.y * bfhi(gt.x)); w.y = pk2(o.z * rstd * gn.z * bflo(gt.y), o.w * rstd * gn.w * bfhi(gt.y));
            *(v2u*)((bf16*)(ws + WS_OAB) + (size_t)NT * 512 + (size_t)tok * 512 + 128 * hh + v4) = w;
        }
        cur ^= 1;
    }
    if (!OUT) {
#pragma unroll
        for (int blk = 0; blk < 2; ++blk)
#pragma unroll
            for (int r = 0; r < 16; ++r) { const int d = 32 * db + (r & 3) + 8 * (r >> 2) + 4 * hi, v = 32 * (vb0 + blk) + r32; Uout[(size_t)d * 128 + v] = S[blk][r]; }
        if (part == 0) Dout[dcol] = fast_exp(fmaxf(btot, -120.f));
    }
    __syncthreads();
}

__device__ __forceinline__ void phase_hgrn1(const Params& P, LAS unsigned char* lds, int layer, int G) {
    float* U = (float*)(P.ws + WS_HGU); float* Dv = (float*)(P.ws + WS_HGD);
    for (int w = blockIdx.x; w < 512; w += G) {
        const int dir = w >> 8, hh = (w >> 6) & 3, j = w & 63;
        const int seg = (j == 0) ? 64 : (dir ? 64 - j : j - 1);
        hgrn_sweep<false>(P, lds, layer, dir, hh, seg, nullptr, U + (size_t)w * 16384, Dv + (size_t)w * 128, false);
    }
}
__device__ __forceinline__ void phase_hgrn_chain(const Params& P, int G) {
    const float* U = (const float*)(P.ws + WS_HGU); const float* Dv = (const float*)(P.ws + WS_HGD); float* Sg = (float*)(P.ws + WS_HGS);
    int tid_ = threadIdx.x; asm volatile("" : "+v"(tid_));
    for (int t = blockIdx.x * NTHR + tid_; t < 8 * 16384; t += G * NTHR) {
        const int dh = t >> 14, el = t & 16383, d = el >> 7;
        float s = 0.f;
        Sg[((size_t)dh * 65 + 0) * 16384 + el] = 0.f;
#pragma unroll 4
        for (int p = 1; p <= 64; ++p) {
            s = Dv[((size_t)dh * 64 + p - 1) * 128 + d] * s + U[((size_t)dh * 64 + p - 1) * 16384 + el];
            Sg[((size_t)dh * 65 + p) * 16384 + el] = s;
        }
    }
}
__device__ __forceinline__ void hgrn_unit2(const Params& P, LAS unsigned char* lds, int layer, int hh, int seg) {
    const float* Sg = (const float*)(P.ws + WS_HGS);
    const int pf = (seg < 64) ? seg + 1 : 0, pb = (seg < 64) ? 64 - seg : 0;
    hgrn_sweep<true>(P, lds, layer, 0, hh, seg, pf ? Sg + ((size_t)(0 * 4 + hh) * 65 + pf) * 16384 : nullptr, nullptr, nullptr, false);
    hgrn_sweep<true>(P, lds, layer, 1, hh, seg, pb ? Sg + ((size_t)(1 * 4 + hh) * 65 + pb) * 16384 : nullptr, nullptr, nullptr, true);
}

constexpr int AL_K = 0, AL_KSZ = 16384, AL_V = 2 * AL_KSZ, AL_VSZ = 16384, AL_WS = AL_V + 2 * AL_VSZ, AL_OST = AL_WS + 8 * 256;

__device__ __forceinline__ void glds16_s(const void* sbase, unsigned voff, unsigned lds_dst) {
    unsigned keep;
    { const unsigned long long a = (unsigned long long)(uintptr_t)sbase;
      const unsigned lo = __builtin_amdgcn_readfirstlane((unsigned)a), hi2 = __builtin_amdgcn_readfirstlane((unsigned)(a >> 32));
      sbase = (const void*)(uintptr_t)(((unsigned long long)hi2 << 32) | lo); lds_dst = __builtin_amdgcn_readfirstlane(lds_dst); }
    asm volatile("s_mov_b32 %0, m0\n\ts_mov_b32 m0, %3\n\ts_nop 0\n\tglobal_load_lds_dwordx4 %1, %2\n\ts_mov_b32 m0, %0" : "=&s"(keep) : "v"(voff), "s"(sbase), "s"(lds_dst) : "memory");
}
__device__ __forceinline__ void attn_unit(const Params& P, LAS unsigned char* lds, int layer, int hh, int qt, float lam, float oscale) {
    int tid = threadIdx.x; asm volatile("" : "+v"(tid));
    const int lane = tid & 63, wid = __builtin_amdgcn_readfirstlane(tid >> 6), r32 = lane & 31, hi = lane >> 5;
    const int qb = wid >> 1, mp = wid & 1;
    unsigned char* ws = P.ws;
    const int qrow0 = (qt < 128) ? qt * 128 : SEQ + (qt - 128) * 128;
    const int kt_lo = (qt < 128) ? 0 : 256, kt_hi = NT / 64;
    const bf16* Qg = (const bf16*)(ws + WS_Q) + ((size_t)hh * NT + qrow0 + 32 * qb + r32) * 128 + 64 * mp;
    const char* Kg = (const char*)((const bf16*)(ws + WS_K) + (size_t)hh * NT * 128);
    const char* Vg = (const char*)((const bf16*)(ws + WS_VT) + (size_t)hh * 128 * LDV);
    bf16x8 qf[4];
#pragma unroll
    for (int ks = 0; ks < 4; ++ks) qf[ks] = *(const bf16x8*)(Qg + 16 * ks + 8 * hi);
    f32x16 O[4];
#pragma unroll
    for (int db = 0; db < 4; ++db)
#pragma unroll
        for (int r = 0; r < 16; ++r) O[db][r] = 0.f;
    float lsum = 0.f;
    unsigned ksrc[2], vsrc[2];
#pragma unroll
    for (int jj = 0; jj < 2; ++jj) {
        const int j = 2 * wid + jj;
        { const int i = 4 * j + (lane >> 4), p = lane & 15, g = p ^ (i & 15), key = (i & ~12) | ((i & 4) << 1) | ((i & 8) >> 1); ksrc[jj] = (unsigned)(key * 256 + g * 16); }
        { const int d = 8 * j + (lane >> 3), p = lane & 7, g = p ^ ((d >> 1) & 7); vsrc[jj] = (unsigned)(d * (LDV * 2) + g * 16); }
    }
    const unsigned lds0 = (unsigned)(uintptr_t)lds;
#define ATT_DMA(t, buf) do { _Pragma("unroll") for (int jj = 0; jj < 2; ++jj) { \
        glds16_s(Kg + (size_t)(t) * 16384, ksrc[jj], lds0 + AL_K + (buf) * AL_KSZ + (2 * wid + jj) * 1024); \
        glds16_s(Vg + (size_t)(t) * 128, vsrc[jj], lds0 + AL_V + (buf) * AL_VSZ + (2 * wid + jj) * 1024); } } while (0)
    ATT_DMA(kt_lo, 0);
    asm volatile("s_waitcnt vmcnt(0)" ::: "memory");
    __syncthreads();
    int cur = 0;
    const int ksw = ((r32 & 15) ^ hi) ^ (8 * mp), vsw = ((r32 >> 1) & 7) ^ hi;
    for (int t = kt_lo; t < kt_hi; ++t) {
        if (t + 1 < kt_hi) ATT_DMA(t + 1, cur ^ 1);
        unsigned kb0 = (unsigned)(AL_K + cur * AL_KSZ + r32 * 256) ^ (unsigned)(ksw << 4), vb0 = (unsigned)(AL_V + cur * AL_VSZ + r32 * 128) ^ (unsigned)(vsw << 4);
        asm volatile("" : "+v"(kb0), "+v"(vb0));
#pragma unroll
        for (int kb = 0; kb < 2; ++kb) {
            f32x16 s;
#pragma unroll
            for (int r = 0; r < 16; ++r) s[r] = 0.f;
#pragma unroll
            for (int ks = 0; ks < 4; ++ks) { const bf16x8 kf = *(const LAS bf16x8*)(lds + ((kb0 ^ (unsigned)((2 * ks) << 4)) + kb * 8192)); s = __builtin_amdgcn_mfma_f32_32x32x16_bf16(kf, qf[ks], s, 0, 0, 0); }
            float ls = 0.f;
#pragma unroll
            for (int r = 0; r < 16; ++r) { s[r] = __builtin_amdgcn_exp2f(s[r]); ls += s[r]; }
            lsum += ls;
            bf16x8 pa[2];
#pragma unroll
            for (int f = 0; f < 2; ++f) { v4u w; w.x = pk2(s[8 * f], s[8 * f + 1]); w.y = pk2(s[8 * f + 2], s[8 * f + 3]); w.z = pk2(s[8 * f + 4], s[8 * f + 5]); w.w = pk2(s[8 * f + 6], s[8 * f + 7]);
                pa[f] = __builtin_bit_cast(bf16x8, w); }
#pragma unroll
            for (int f = 0; f < 2; ++f)
#pragma unroll
                for (int db = 0; db < 4; ++db) {
                    const bf16x8 vf = *(const LAS bf16x8*)(lds + ((vb0 ^ (unsigned)((4 * kb + 2 * f) << 4)) + db * 4096));
                    O[db] = __builtin_amdgcn_mfma_f32_32x32x16_bf16(pa[f], vf, O[db], 0, 0, 0);
                }
        }
        asm volatile("s_waitcnt vmcnt(0)" ::: "memory");
        __syncthreads();
        cur ^= 1;
    }
#undef ATT_DMA
    lsum += __shfl_xor(lsum, 32);
    LAS float* wsf = (LAS float*)(lds + AL_WS + wid * 256);
    if (hi == 0) wsf[r32] = (mp ? lam : 1.f) / lsum;
    LDS_WAIT();
    LAS float* X = (LAS float*)(lds + qb * 16384);
    if (mp == 1) {
#pragma unroll
        for (int r = 0; r < 16; ++r) { const float a = wsf[(r & 3) + 8 * (r >> 2) + 4 * hi];
#pragma unroll
            for (int db = 0; db < 4; ++db) X[(db * 16 + r) * 64 + lane] = O[db][r] * a; }
    }
    __syncthreads();
    if (mp == 0) {
        const float* sg = P.in[I_SUBLN] + (size_t)layer * 128;
        float gsc[4];
#pragma unroll
        for (int db = 0; db < 4; ++db) gsc[db] = sg[32 * db + r32] * oscale;
        LAS bf16* stg = (LAS bf16*)(lds + AL_OST + qb * 8192);
#pragma unroll
        for (int r = 0; r < 16; ++r) {
            const int q = (r & 3) + 8 * (r >> 2) + 4 * hi;
            const float a0 = wsf[q];
            float o[4], ss = 0.f;
#pragma unroll
            for (int db = 0; db < 4; ++db) { o[db] = O[db][r] * a0 - X[(db * 16 + r) * 64 + lane]; ss += o[db] * o[db]; }
#pragma unroll
            for (int off = 1; off < 32; off <<= 1) ss += __shfl_xor(ss, off);
            const float rstd = __builtin_amdgcn_rsqf(ss * (1.f / 128.f) + EPS);
#pragma unroll
            for (int db = 0; db < 4; ++db) stg[q * 128 + 32 * db + r32] = (bf16)(pk2(o[db] * rstd * gsc[db], 0.f) & 0xffffu);
        }
        LDS_WAIT();
        bf16* Ow = (bf16*)(ws + WS_OAB) + (size_t)(qrow0 + 32 * qb) * 512 + 128 * hh;
#pragma unroll
        for (int i = 0; i < 8; ++i) { const int row = 4 * i + (lane >> 4), ch = lane & 15;
            const v4u v = *(const LAS v4u*)(stg + row * 128 + ch * 8); *(v4u*)(Ow + (size_t)row * 512 + ch * 8) = v; }
    }
    __syncthreads();
}

__device__ __forceinline__ void phase_mix(const Params& P, LAS unsigned char* lds, int layer, int G, bool with_ctx) {
    int tid_ = threadIdx.x; asm volatile("" : "+v"(tid_));
    const int lane = tid_ & 63;
    const float* lq = P.in[I_LAMQK] + (size_t)layer * 4 * 64;
    const float s1 = wave_sum(lq[lane] * lq[64 + lane]), s2 = wave_sum(lq[128 + lane] * lq[192 + lane]);
    const float lam_init = 0.8f - 0.6f * expf(-0.3f * (float)layer);
    const float lam = expf(s1) - expf(s2) + lam_init;
    const int nunits = with_ctx ? 780 : 768;
    for (int u = blockIdx.x; u < nunits; u += G) {
#ifndef MIX_ONLY
#define MIX_ONLY 3
#endif
        if (u < 512) { if (MIX_ONLY & 1) { const int hh = (u & 7) >> 1, qt = ((u >> 3) << 1) | (u & 1); attn_unit(P, lds, layer, hh, qt, lam, 1.f - lam_init); } }
        else if (u < 768) { if (MIX_ONLY & 2) { const int v = u - 512; hgrn_unit2(P, lds, layer, v & 3, v >> 2); } }
        else if (u < 776) { if (MIX_ONLY & 1) { const int v = u - 768; attn_unit(P, lds, layer, v & 3, 128 + (v >> 2), lam, 1.f - lam_init); } }
        else { if (MIX_ONLY & 2) hgrn_unit2(P, lds, layer, u - 776, 64); }
    }
}

constexpr int RL_RW = 0, RL_TA = 135168, RL_TB = RL_TA + 8192, RL_INFO = RL_TB + 8192, RL_CNT = RL_INFO + 80 * 32, RL_BASE = RL_CNT + 128, RL_RSTD = RL_BASE + 128;
__device__ __forceinline__ void phase_router(const Params& P, LAS unsigned char* lds, int layer, int G, int nrows) {
    int tid_ = threadIdx.x; asm volatile("" : "+v"(tid_));
    const int tid = tid_, lane = tid & 63, wave = tid >> 6;
    unsigned char* ws = P.ws;
    LAS float* RW = (LAS float*)(lds + RL_RW); LAS float* TA = (LAS float*)(lds + RL_TA); LAS float* TB = (LAS float*)(lds + RL_TB);
    LAS unsigned* INFO = (LAS unsigned*)(lds + RL_INFO); LAS unsigned* LCNT = (LAS unsigned*)(lds + RL_CNT); LAS unsigned* GBASE = (LAS unsigned*)(lds + RL_BASE); LAS float* RSTD = (LAS float*)(lds + RL_RSTD);
    const float* rw = P.in[I_RW] + (size_t)layer * D * NE;
    for (int i = tid; i < D * NE; i += NTHR) RW[(i >> 5) * 33 + (i & 31)] = rw[i];
    for (int i = tid; i < 2048; i += NTHR) { const int w = i >> 10, j = i & 1023; const float* mv = modv_ptr(P, layer, w);
        TA[i] = P.in[I_N2G][(size_t)layer * D + j] * (1.f + mv[4096 + j]); TB[i] = mv[3072 + j]; }
    const float* xres = (const float*)(ws + WS_XRES);
    const float* rb = P.in[I_RB] + (size_t)layer * NE;
    unsigned* gcnt = (unsigned*)(ws + WS_CTL) + CW_CNT + layer * 32 * 16;
    unsigned* tokinfo = (unsigned*)(ws + WS_TOK);
    bf16* XS = (bf16*)(ws + WS_XS);
    const int RB = nrows / 256;
    for (int blk = blockIdx.x; blk < 256; blk += G) {
        if (tid < 32) LCNT[tid] = 0u;
        __syncthreads();
        const int rbase = blk * RB;
#pragma unroll 1
        for (int rl = wave; rl < RB; rl += NWAVES) {
            const int row = rbase + rl, w = row >= SEQ;
            const float* xr = xres + (size_t)row * D;
            float x[16], ss = 0.f;
#pragma unroll
            for (int k = 0; k < 16; ++k) { x[k] = xr[lane + 64 * k]; ss += x[k] * x[k]; }
            const float rstd = __builtin_amdgcn_rsqf(wave_sum(ss) * (1.f / D) + EPS);
            float p[NE];
#pragma unroll
            for (int e = 0; e < NE; ++e) p[e] = 0.f;
#pragma unroll 2
            for (int k = 0; k < 16; ++k) { const int i = lane + 64 * k; const float h = x[k] * rstd * TA[1024 * w + i] + TB[1024 * w + i];
                const LAS float* rr = RW + i * 33;
#pragma unroll
                for (int e = 0; e < NE; ++e) p[e] += h * rr[e]; }
#pragma unroll
            for (int e = 0; e < NE; ++e) { float v = p[e];
#pragma unroll
                for (int o = 1; o < 64; o <<= 1) v += __shfl_xor(v, o);
                p[e] = v + rb[e]; }
            float tv[4]; int ti[4];
#pragma unroll
            for (int k = 0; k < 4; ++k) { float best = -3.0e38f; int bi = 0;
#pragma unroll
                for (int e = 0; e < NE; ++e) { const bool gt = p[e] > best; best = gt ? p[e] : best; bi = gt ? e : bi; }
                tv[k] = best; ti[k] = bi;
#pragma unroll
                for (int e = 0; e < NE; ++e) p[e] = (e == bi) ? -3.0e38f : p[e]; }
            float wk[4], wsum = 0.f;
#pragma unroll
            for (int k = 0; k < 4; ++k) { wk[k] = expf(tv[k] - tv[0]); wsum += wk[k]; }
            if (lane == 0) {
                RSTD[rl] = rstd;
#pragma unroll
                for (int k = 0; k < 4; ++k) { const unsigned pos = __hip_atomic_fetch_add(&LCNT[ti[k]], 1u, __ATOMIC_RELAXED, __HIP_MEMORY_SCOPE_WORKGROUP); INFO[rl * 8 + 2 * k] = ((unsigned)ti[k] << 16) | pos; INFO[rl * 8 + 2 * k + 1] = __float_as_uint(wk[k] / wsum); }
            }
        }
        __syncthreads();
        if (tid < 32) GBASE[tid] = __hip_atomic_fetch_add(gcnt + tid * 16, LCNT[tid], RLX_AGENT);
        __syncthreads();
#pragma unroll 1
        for (int rl = wave; rl < RB; rl += NWAVES) {
            const int row = rbase + rl, w = row >= SEQ;
            const float* xr = xres + (size_t)row * D + 16 * lane;
            const float rstd = RSTD[rl];
            v4u o0, o1;
            {
                f32x4 v[4];
#pragma unroll
                for (int j = 0; j < 4; ++j) { const f32x4 xv = *(const f32x4*)(xr + 4 * j); const f32x4 a = *(const LAS f32x4*)(TA + 1024 * w + 16 * lane + 4 * j), b = *(const LAS f32x4*)(TB + 1024 * w + 16 * lane + 4 * j); v[j] = xv * rstd * a + b; }
                o0.x = pk2(v[0].x, v[0].y); o0.y = pk2(v[0].z, v[0].w); o0.z = pk2(v[1].x, v[1].y); o0.w = pk2(v[1].z, v[1].w);
                o1.x = pk2(v[2].x, v[2].y); o1.y = pk2(v[2].z, v[2].w); o1.z = pk2(v[3].x, v[3].y); o1.w = pk2(v[3].z, v[3].w);
            }
#pragma unroll
            for (int k = 0; k < 4; ++k) {
                const unsigned ep = INFO[rl * 8 + 2 * k], wb = INFO[rl * 8 + 2 * k + 1];
                const unsigned e = ep >> 16, slot = GBASE[e] + (ep & 0xffffu);
                bf16* dst = XS + ((size_t)e * CAP + slot) * D + 16 * lane;
                *(v4u*)dst = o0; *(v4u*)(dst + 8) = o1;
                if (lane == 0) { v4u ti4; ti4.x = e; ti4.y = slot; ti4.z = wb; ti4.w = 0u; *(v4u*)(tokinfo + (size_t)row * 16 + 4 * k) = ti4; }
            }
        }
        __syncthreads();
    }
}

__device__ __forceinline__ void phase_combine(const Params& P, LAS unsigned char* lds, int layer, int G, int nrows) {
    int tid_ = threadIdx.x; asm volatile("" : "+v"(tid_));
    const int tid = tid_, lane = tid & 63, wave = tid >> 6;
    unsigned char* ws = P.ws;
    const bool last = (layer == DEPTH - 1);
    LAS float* TA = (LAS float*)lds; LAS float* TB = (LAS float*)(lds + 8192); LAS float* TG = (LAS float*)(lds + 16384);
    for (int i = tid; i < 2048; i += NTHR) { const int w = i >> 10, j = i & 1023;
        TG[i] = modv_ptr(P, layer, w)[5120 + j];
        if (!last) { const float* mv = modv_ptr(P, layer + 1, w); TA[i] = P.in[I_N1G][(size_t)(layer + 1) * D + j] * (1.f + mv[1024 + j]); TB[i] = mv[j]; } }
    __syncthreads();
    float* xres = (float*)(ws + WS_XRES);
    const unsigned* tokinfo = (const unsigned*)(ws + WS_TOK);
    const bf16* Y = (const bf16*)(ws + WS_XS);
    bf16* H = (bf16*)(ws + WS_H);
    for (int row = blockIdx.x * NWAVES + wave; row < nrows; row += G * NWAVES) {
        const int w = row >= SEQ;
        f32x4 acc[4];
#pragma unroll
        for (int j = 0; j < 4; ++j) acc[j] = (f32x4){0.f, 0.f, 0.f, 0.f};
#pragma unroll
        for (int k = 0; k < 4; ++k) {
            const v4u ti4 = *(const v4u*)(tokinfo + (size_t)row * 16 + 4 * k);
            const float wk = __uint_as_float(ti4.z);
            const bf16* yr = Y + ((size_t)ti4.x * CAP + ti4.y) * D + 4 * lane;
#pragma unroll
            for (int j = 0; j < 4; ++j) { const v2u yv = *(const v2u*)(yr + 256 * j); acc[j] += wk * (f32x4){bflo(yv.x), bfhi(yv.x), bflo(yv.y), bfhi(yv.y)}; }
        }
        float* xr = xres + (size_t)row * D + 4 * lane;
        f32x4 v[4];
#pragma unroll
        for (int j = 0; j < 4; ++j) v[j] = *(const f32x4*)(xr + 256 * j) + *(const LAS f32x4*)(TG + 1024 * w + 4 * lane + 256 * j) * acc[j];
        if (last) {
            float* orow = P.out + (size_t)row * D + 4 * lane;
#pragma unroll
            for (int j = 0; j < 4; ++j) *(f32x4*)(orow + 256 * j) = v[j];
        } else {
#pragma unroll
            for (int j = 0; j < 4; ++j) *(f32x4*)(xr + 256 * j) = v[j];
            norm_store_row(v, TA + 1024 * w, TB + 1024 * w, H + (size_t)row * D, lane);
        }
    }
}
#define XB_TMO      128
#define XB_XCNT(j)  (256  + 64 * (j))
#define XB_XSUB(j)  (1280 + 64 * (j))
#define XB_XGEN(j)  (2304 + 64 * (j))
#define XB_TOP      3328
#define XB_TOPGEN   3392
#define XCD_BAR_WORDS 3456
#define XB_SPIN_CAP (1u << 18)

__device__ __forceinline__ unsigned xb_ld(unsigned* p)              { return __hip_atomic_load(p, __ATOMIC_RELAXED, __HIP_MEMORY_SCOPE_AGENT); }
__device__ __forceinline__ unsigned xb_add(unsigned* p, unsigned v) { return __hip_atomic_fetch_add(p, v, __ATOMIC_RELAXED, __HIP_MEMORY_SCOPE_AGENT); }
__device__ __forceinline__ unsigned xb_xcc_id() { return (unsigned)__builtin_amdgcn_s_getreg((3 << 11) | 20) & 0xFu; }
#define XB_SPIN(cond, bar) do { unsigned _sp = 0; while (cond) { __builtin_amdgcn_s_sleep(1); \
    if ((++_sp & 255u) == 0u) { if (xb_ld(&(bar)[XB_TMO])) break; if (_sp > XB_SPIN_CAP) { atomicAdd(&(bar)[XB_TMO], 1u); break; } } } } while (0)

struct XcdBarrier {
    unsigned* bar; unsigned x;
    volatile LAS unsigned* st;
};

__device__ __forceinline__ XcdBarrier xcd_barrier_post(unsigned* bar, volatile LAS unsigned* st) {
    XcdBarrier b; b.bar = bar; b.x = xb_xcc_id(); b.st = st;
    if (threadIdx.x == 0) (void)xb_add(&bar[XB_XCNT(b.x)], 1u);
    return b;
}
__device__ __forceinline__ void xcd_barrier_complete(unsigned* bar, unsigned x, unsigned& nloc, unsigned& nx) {
    const unsigned G = gridDim.x * gridDim.y * gridDim.z;
    unsigned sum, cnt, mine, sp = 0u;
    for (;;) {
        sum = 0u; cnt = 0u; mine = 0u;
#pragma unroll
        for (unsigned j = 0; j < 16; ++j) { const unsigned c = xb_ld(&bar[XB_XCNT(j)]); sum += c; cnt += (c > 0u) ? 1u : 0u; mine = (j == x) ? c : mine; }
        if (sum == G) break;
        __builtin_amdgcn_s_sleep(1);
        if ((++sp & 255u) == 0u) { if (xb_ld(&bar[XB_TMO])) break; if (sp > XB_SPIN_CAP) { atomicAdd(&bar[XB_TMO], 1u); break; } }
    }
    nloc = mine > 0u ? mine : 1u; nx = cnt > 0u ? cnt : 1u;
}

__device__ __forceinline__ void xcd_barrier(const XcdBarrier& b) {
    asm volatile("s_waitcnt vmcnt(0)" ::: "memory");
    __syncthreads();
    if (threadIdx.x == 0) {
        unsigned* bar = b.bar;
        __builtin_amdgcn_s_waitcnt(0);
        unsigned nloc = b.st[0], nx = b.st[1];
        if (nloc == 0u) { xcd_barrier_complete(bar, b.x, nloc, nx); b.st[0] = nloc; b.st[1] = nx; }
        const unsigned old = xb_add(&bar[XB_XSUB(b.x)], 1u);
        const unsigned gen = old / nloc;
        if (old + 1u == (gen + 1u) * nloc) {
            __builtin_amdgcn_fence(__ATOMIC_RELEASE, "agent");
            asm volatile("s_waitcnt vmcnt(0)" ::: "memory");
            const unsigned og = xb_add(&bar[XB_TOP], 1u);
            const unsigned tg = og / nx;
            if (og + 1u == (tg + 1u) * nx) xb_add(&bar[XB_TOPGEN], 1u);
            else XB_SPIN(xb_ld(&bar[XB_TOPGEN]) == tg, bar);
            __builtin_amdgcn_fence(__ATOMIC_ACQUIRE, "agent");
            xb_add(&bar[XB_XGEN(b.x)], 1u);
            asm volatile("s_waitcnt vmcnt(0)" ::: "memory");
        } else {
            XB_SPIN(xb_ld(&bar[XB_XGEN(b.x)]) == gen, bar);
            __builtin_amdgcn_fence(__ATOMIC_ACQUIRE, "agent");
            asm volatile("s_waitcnt vmcnt(0)" ::: "memory");
        }
    }
    __syncthreads();
}


__global__ void __launch_bounds__(NTHR, 2) fwd_kernel(Params P) {
    extern __shared__ __attribute__((aligned(16))) unsigned char lds_raw[];
    LAS unsigned char* lds = (LAS unsigned char*)lds_raw;
    volatile LAS unsigned* MISC = (volatile LAS unsigned*)(lds + MISC_OFF);
    const int tid = threadIdx.x, G = gridDim.x;
    unsigned char* ws = P.ws;
    unsigned* ctl = (unsigned*)(ws + WS_CTL);
    if (tid < 64) MISC[tid] = 0u;
    __syncthreads();
#if MK_ONE_LAUNCH
    XcdBarrier bar = xcd_barrier_post(ctl + CW_BAR, MISC + 8);
#define GRID_BAR() xcd_barrier(bar)
#else
#define GRID_BAR() do {} while (0)
#endif
    const int lo = P.ph_lo, hi = P.ph_hi;
#ifndef PHM
#define PHM 0xFFF
#endif
#define IN(k) (lo <= (k) && (k) < hi)
#define EN(b) ((PHM >> (b)) & 1)
#define SEAM(k) do { if (IN(k) && IN((k) + 1)) GRID_BAR(); } while (0)

    if (EN(10) && IN(0)) { phase_p0a(P, lds, G); SEAM(0); }
    if (EN(11) && IN(1)) { phase_p0b(P, lds, G); SEAM(1); }

    for (int l = 0; l < DEPTH; ++l) {
        const int pb = NPH_PRO + NPH_LAYER * l;
        const bool last = (l == DEPTH - 1);
        const int nrows = last ? SEQ : NT;
        bf16* H = (bf16*)(ws + WS_H);
        if (EN(0) && IN(pb + 0)) {
            { pg8::Gemm g{H, (const bf16*)(ws + WS_WIN + l * WIN_L), NT, 5632, D}; pg8::StaticOrder S; S.init(NT, 5632, G, (int)blockIdx.x);
              EpiInProj E{(bf16*)(ws + WS_Q), (bf16*)(ws + WS_K), (bf16*)(ws + WS_PROJ), P.in[I_QNG] + l * 64, P.in[I_KNG] + l * 64, (const float*)(ws + WS_ROPE)};
              pg8::gemm_phase<EpiInProj, pg8::StaticOrder, true, true>(lds, g, S, E); }
            { pg8::Gemm g{(const bf16*)(ws + WS_WV + l * WV_L), H, 512, NT, D}; pg8::StaticOrder S; S.init(512, NT, G, (int)((blockIdx.x + 106) % G));
              EpiVt E{(bf16*)(ws + WS_VT)};
              pg8::gemm_phase<EpiVt, pg8::StaticOrder, true, true>(lds, g, S, E); }
            SEAM(pb + 0);
        }
        if (EN(1) && IN(pb + 1)) { phase_hgrn1(P, lds, l, G); SEAM(pb + 1); }
        if (EN(2) && IN(pb + 2)) { phase_hgrn_chain(P, G); SEAM(pb + 2); }
        if (EN(3) && IN(pb + 3)) { phase_mix(P, lds, l, G, !last); SEAM(pb + 3); }
        if (EN(4) && IN(pb + 4)) {
            pg8::Gemm g{(const bf16*)(ws + WS_OAB), (const bf16*)(ws + WS_WAB + l * WAB_L), 2 * NT, 2048, 512};
            pg8::MergeOrder S{nrows / 256, G, (int)blockIdx.x};
            EpiMerge E{(const bf16*)(ws + WS_PROJ), (bf16*)(ws + WS_U)};
            pg8::gemm_phase<EpiMerge, pg8::MergeOrder, true, true>(lds, g, S, E);
            SEAM(pb + 4);
        }
        if (EN(5) && IN(pb + 5)) {
            pg8::Gemm g{(const bf16*)(ws + WS_U), (const bf16*)(ws + WS_WO + l * WO_L), nrows, D, D}; pg8::StaticOrder S; S.init(nrows, D, G, (int)blockIdx.x);
            const float* xres = (const float*)(ws + WS_XRES);
            EpiOut E{l == 0 ? P.in[I_X] : xres, l == 0 ? P.in[I_CTX] : xres + (size_t)SEQ * D, (float*)(ws + WS_XRES), modv_ptr(P, l, 0) + 2048, modv_ptr(P, l, 1) + 2048};
            pg8::gemm_phase<EpiOut, pg8::StaticOrder, true, true>(lds, g, S, E);
            SEAM(pb + 5);
        }
        if (EN(6) && IN(pb + 6)) { phase_router(P, lds, l, G, nrows); SEAM(pb + 6); }
        if ((EN(7) && IN(pb + 7)) || (EN(8) && IN(pb + 8))) {
            LAS int* ptab = (LAS int*)(lds + 131072);
            if (tid == 0) { const unsigned* gcnt = ctl + CW_CNT + l * 32 * 16; int run = 0;
                for (int e = 0; e < NE; ++e) { ptab[e] = run; run += (int)((__hip_atomic_load(gcnt + e * 16, RLX_AGENT) + 255u) >> 8); } ptab[32] = run; }
            __syncthreads();
            if (EN(7) && IN(pb + 7)) {
                pg8::Gemm g{(const bf16*)(ws + WS_XS), (const bf16*)(ws + WS_WGU + l * WGU_L), NE * CAP, NE * 2048, D};
                pg8::MoeOrder<3> S{ptab, G, (int)blockIdx.x};
                EpiSwiglu E{(bf16*)(ws + WS_HDN), P.in[I_BGU] + (size_t)l * NE * 2048};
                pg8::gemm_phase<EpiSwiglu, pg8::MoeOrder<3>, true, true>(lds, g, S, E);
                SEAM(pb + 7);
            }
            if (EN(8) && IN(pb + 8)) {
                pg8::Gemm g{(const bf16*)(ws + WS_HDN), (const bf16*)(ws + WS_WD + l * WD_L), NE * CAP, NE * 1024, DFF};
                pg8::MoeOrder<2> S{ptab, G, (int)blockIdx.x};
                EpiDown E{(bf16*)(ws + WS_XS), P.in[I_BDN] + (size_t)l * NE * D};
                pg8::gemm_phase<EpiDown, pg8::MoeOrder<2>, true, true>(lds, g, S, E);
                SEAM(pb + 8);
            }
        }
        if (EN(9) && IN(pb + 9)) { phase_combine(P, lds, l, G, nrows); SEAM(pb + 9); }
    }
#undef IN
#undef EN
#undef SEAM
#undef GRID_BAR
}

extern "C" void kernel_launch(void* const* d_in, const int* in_sizes, int n_in, void* d_out, int out_size, void* d_ws, size_t ws_size, hipStream_t stream) {
    static int grid = 0;
    if (grid == 0) {
        if (n_in != 24 || out_size != SEQ * D || ws_size < WS_END) { fprintf(stderr, "kernel_launch: unexpected shapes (n_in %d, out %d, ws %zu < %zu)\n", n_in, out_size, ws_size, (size_t)WS_END); grid = -1; return; }
        int dev = 0, cus = 0;
        if (hipGetDevice(&dev) != hipSuccess || hipDeviceGetAttribute(&cus, hipDeviceAttributeMultiprocessorCount, dev) != hipSuccess) { grid = -1; return; }
        if (hipFuncSetAttribute((const void*)fwd_kernel, hipFuncAttributeMaxDynamicSharedMemorySize, LDS_BYTES) != hipSuccess) { fprintf(stderr, "kernel_launch: hipFuncSetAttribute failed\n"); grid = -1; return; }
        int per_cu = 0;
        if (hipOccupancyMaxActiveBlocksPerMultiprocessor(&per_cu, (const void*)fwd_kernel, NTHR, LDS_BYTES) != hipSuccess || per_cu < 1) fprintf(stderr, "kernel_launch: occupancy query reports %d\n", per_cu);
        (void)hipGetLastError();
        grid = cus;
    }
    if (grid < 0) return;
    (void)hipMemsetAsync((char*)d_ws + WS_CTL, 0, CTL_ZERO_BYTES, stream);
    Params p{};
    for (int i = 0; i < 24; ++i) p.in[i] = (const float*)d_in[i];
    p.out = (float*)d_out; p.ws = (unsigned char*)d_ws;
#if MK_ONE_LAUNCH
    p.ph_lo = 0; p.ph_hi = NPHASES;
    hipLaunchKernelGGL(fwd_kernel, dim3(grid), dim3(NTHR), LDS_BYTES, stream, p);
#else
    for (int k = 0; k < NPHASES; ++k) { p.ph_lo = k; p.ph_hi = k + 1; hipLaunchKernelGGL(fwd_kernel, dim3(grid), dim3(NTHR), LDS_BYTES, stream, p); }
#endif
}
```

```cpp
#include <hip/hip_runtime.h>
#include <cstdio>
#include <cstdint>

#ifndef MK_ONE_LAUNCH
#define MK_ONE_LAUNCH 1
#endif

#define GAS __attribute__((address_space(1)))
#define LAS __attribute__((address_space(3)))
typedef unsigned short bf16;
typedef unsigned v4u __attribute__((ext_vector_type(4)));
typedef unsigned v2u __attribute__((ext_vector_type(2)));
typedef float f32x4 __attribute__((ext_vector_type(4)));
typedef float f32x16 __attribute__((ext_vector_type(16)));
typedef short bf16x8 __attribute__((ext_vector_type(8)));
typedef short s16x4 __attribute__((ext_vector_type(4)));
typedef float f32x2_t __attribute__((ext_vector_type(2)));
typedef __bf16 bf16x2_t __attribute__((ext_vector_type(2)));

constexpr int D = 1024, SEQ = 16384, LC = 256, NT = SEQ + LC, DEPTH = 4;
constexpr int INC = 6144, NE = 32, DFF = 1024, TOPK = 4;
constexpr int CAP = NT;
constexpr int PROJW = 4608;
constexpr int PC_QH = 0, PC_ZF = 512, PC_ZB = 1024, PC_VH = 1536, PC_GH = 2048, PC_GA = 2560, PC_GB = 3584;
constexpr int LDV = NT;
constexpr float EPS = 1e-6f;
constexpr int NWAVES = 8, NTHR = 512;
constexpr int NPH_PRO = 2, NPH_LAYER = 11, NPHASES = NPH_PRO + NPH_LAYER * DEPTH;

constexpr size_t MiB = 1u << 20;
constexpr size_t WS_CTL = 0, CTL_ZERO_BYTES = 1 * MiB;
constexpr size_t WS_MODP = 1 * MiB;
constexpr size_t WS_MODV = WS_MODP + 2 * MiB;
constexpr size_t WS_LB = WS_MODV + 1 * MiB;
constexpr size_t WS_ROPE = WS_LB + 1 * MiB;
constexpr size_t WS_WIN = WS_ROPE + 1 * MiB;
constexpr size_t WIN_L = (size_t)5632 * 1024 * 2;
constexpr size_t WS_WV = WS_WIN + 4 * WIN_L;
constexpr size_t WV_L = (size_t)512 * 1024 * 2;
constexpr size_t WS_WAB = WS_WV + 4 * WV_L;
constexpr size_t WAB_L = (size_t)2048 * 512 * 2;
constexpr size_t WS_WO = WS_WAB + 4 * WAB_L;
constexpr size_t WO_L = (size_t)1024 * 1024 * 2;
constexpr size_t WS_WGU = WS_WO + 4 * WO_L;
constexpr size_t WGU_E = (size_t)2048 * 1024 * 2, WGU_L = 32 * WGU_E;
constexpr size_t WS_WD = WS_WGU + 4 * WGU_L;
constexpr size_t WD_E = (size_t)1024 * 1024 * 2, WD_L = 32 * WD_E;
constexpr size_t WS_XRES = WS_WD + 4 * WD_L;
constexpr size_t WS_H = WS_XRES + (size_t)NT * D * 4;
constexpr size_t WS_Q = WS_H + (size_t)NT * D * 2;
constexpr size_t WS_K = WS_Q + (size_t)NT * 512 * 2;
constexpr size_t WS_VT = WS_K + (size_t)NT * 512 * 2;
constexpr size_t WS_PROJ = WS_VT + (size_t)512 * LDV * 2;
constexpr size_t WS_OAB = WS_PROJ + (size_t)NT * PROJW * 2;
constexpr size_t WS_OBF = WS_OAB + (size_t)2 * NT * 512 * 2;
constexpr size_t WS_U = WS_OBF + (size_t)NT * 512 * 4;
constexpr size_t WS_HGU = WS_U + (size_t)NT * D * 2;
constexpr size_t WS_HGD = WS_HGU + (size_t)512 * 16384 * 4;
constexpr size_t WS_HGS = WS_HGD + 1 * MiB;
constexpr size_t WS_TOK = WS_HGS + (size_t)520 * 16384 * 4;
constexpr size_t WS_XS = WS_TOK + (size_t)NT * 64;
constexpr size_t SLAB = (size_t)NE * CAP * D * 2;
constexpr size_t WS_HDN = WS_XS + SLAB;
constexpr size_t WS_END = WS_HDN + SLAB;
constexpr int IM_BYTES = 21504;
constexpr size_t WS_IMG = WS_END;
constexpr size_t WS_END2 = WS_IMG + (size_t)8 * 65 * 16 * IM_BYTES;
constexpr int RW_PITCH = 2064, RW_IMG = 2 * 32 * RW_PITCH;
constexpr size_t WS_RWIMG = WS_END2;
constexpr size_t WS_END3 = WS_RWIMG + (size_t)DEPTH * RW_IMG + 4096;
constexpr int CW_TMO = 0;
constexpr int CW_BAR = 4096;
constexpr int CW_CNT = 16384;

constexpr int LDS_BYTES = 162816;
constexpr int MISC_OFF = LDS_BYTES - 256;

#define RLX_AGENT __ATOMIC_RELAXED, __HIP_MEMORY_SCOPE_AGENT
__device__ __forceinline__ unsigned pk2(float lo, float hi) { f32x2_t v = {lo, hi}; bf16x2_t b = __builtin_convertvector(v, bf16x2_t); return __builtin_bit_cast(unsigned, b); }
__device__ __forceinline__ float bflo(unsigned w) { return __uint_as_float(w << 16); }
__device__ __forceinline__ float bfhi(unsigned w) { return __uint_as_float(w & 0xffff0000u); }
__device__ __forceinline__ float bf2f(bf16 b) { return __uint_as_float(((unsigned)b) << 16); }
__device__ __forceinline__ int fresh_tid(int wv) { int l; asm volatile("v_mbcnt_lo_u32_b32 %0, -1, 0\n\tv_mbcnt_hi_u32_b32 %0, -1, %0" : "=v"(l)); return wv * 64 + l; }
__device__ __forceinline__ float shx(float v, int off, int lane) { return __int_as_float(__builtin_amdgcn_ds_bpermute((lane ^ off) << 2, __float_as_int(v))); }
__device__ __forceinline__ float wave_sum(float v, int lane) {
#pragma unroll
    for (int o = 1; o < 64; o <<= 1) v += shx(v, o, lane);
    return v;
}
__device__ __forceinline__ float fast_exp(float x) { return __builtin_amdgcn_exp2f(x * 1.4426950408889634f); }
__device__ __forceinline__ float fast_log(float x) { return __builtin_amdgcn_logf(x) * 0.6931471805599453f; }
__device__ __forceinline__ float fast_rcp(float x) { return __builtin_amdgcn_rcpf(x); }
__device__ __forceinline__ float sigmoidf_(float x) { return fast_rcp(1.f + fast_exp(-x)); }
__device__ __forceinline__ unsigned pk_fp8x4(float a, float b, float c, float d) { int p = __builtin_amdgcn_cvt_pk_fp8_f32(a, b, 0, false); p = __builtin_amdgcn_cvt_pk_fp8_f32(c, d, p, true); return (unsigned)p; }
constexpr float W8_SCALE = 32.f;
__device__ __forceinline__ int perm8(int s) { return (s & ~31) | (((s >> 2) & 1) << 4) | (((s >> 3) & 3) << 2) | (s & 3); }

namespace pg8 {
#define PG8_LAS __attribute__((address_space(3)))
typedef unsigned short bf16_t;
typedef short bf16x8 __attribute__((ext_vector_type(8)));
typedef float f32x4 __attribute__((ext_vector_type(4)));
typedef unsigned u32x4 __attribute__((ext_vector_type(4)));
constexpr int BM = 256, BK = 64, HALF = 128, HTB = HALF * BK * 2  , STAGE_BYTES = 8 * HTB, NXCD = 8, WGM = 1;

__host__ __device__ __forceinline__ int lds_byte(int r, int c) { const int st = (r >> 4) * 2 + (c >> 5), rr = r & 15, cc = c & 31, ob = rr * 64 + cc * 2; return st * 1024 + (ob ^ (((ob >> 9) & 1) << 5)); }
__host__ __device__ __forceinline__ void stage_rc(int b, int& R, int& C) { const int st = b / 1024, sb = b % 1024, swz = sb ^ (((sb >> 9) & 1) << 5); R = (st >> 1) * 16 + swz / 64; C = (st & 1) * 32 + (swz % 64) / 2; }
__host__ __device__ __forceinline__ int perm32(int rho) { const int n = rho >> 4, i = rho & 15; return 8 * (i >> 2) + 4 * n + (i & 3); }

struct Unit { int pm, pn; };
struct Gemm { const bf16_t* A; const bf16_t* Bt; int M, N, K; };
struct StaticOrder {
    int nM, nN, nwg, G, c;
    __host__ __device__ void init(int M, int N, int G_, int c_) { nM = M / BM; nN = N / BM; nwg = nM * nN; G = G_; c = c_; }
    __host__ __device__ bool next(int i, Unit& u) const {
        const long L = (long)i * G + c; if (L >= nwg) return false;
        int wgid = (int)L; { const int q = nwg / NXCD, r = nwg % NXCD, xcd = wgid % NXCD, off = wgid / NXCD; wgid = (xcd < r ? xcd * (q + 1) : r * (q + 1) + (xcd - r) * q) + off; }
        const int nig = WGM * nN, gid = wgid / nig, fm = gid * WGM, gsz = (nM - fm) < WGM ? (nM - fm) : WGM;
        u.pm = fm + ((wgid % nig) % gsz); u.pn = (wgid % nig) / gsz; return true;
    }
    __device__ __forceinline__ void a_ready(const Unit&) const {}
    __device__ __forceinline__ void done(const Unit&) const {}
};
struct MergeOrder {
    int nM, G, c;
    __device__ bool next(int i, Unit& u) const {
        const int br = i & 1; int L = (i >> 1) * G + c;
        if ((G & 31) == 0) { const int x = c & 7, q = c >> 3; L = (((i >> 1) * 8 + x) * (G >> 5) + (q >> 2)) * 4 + (q & 3); }
        if (L >= nM * 4) return false;
        u.pm = 65 * br + (L >> 2); u.pn = 4 * br + (L & 3); return true;
    }
    __device__ __forceinline__ void a_ready(const Unit&) const {}
    __device__ __forceinline__ void done(const Unit&) const {}
};
struct MoeOrder {
    const PG8_LAS unsigned* utab;
    __device__ bool next(int i, Unit& u) const {
        if (i >= 32) return false;
        const unsigned v = (unsigned)__builtin_amdgcn_readfirstlane((int)utab[i]); if (v == 0xffffffffu) return false;
        u.pm = (int)(v >> 16); u.pn = (int)(v & 0xffffu); return true;
    }
    __device__ __forceinline__ void a_ready(const Unit&) const {}
    __device__ __forceinline__ void done(const Unit&) const {}
};

template <class Epi, class Sched, bool ALIGN_EPI = false, bool SP2 = false>
__device__ __forceinline__ void gemm_phase(PG8_LAS unsigned char* lds, const Gemm g, const Sched& S, const Epi& E, int wv) {
    int tid_ = fresh_tid(wv);
    const int tid = tid_, wid = __builtin_amdgcn_readfirstlane(tid >> 6), lane = tid & 63, wr = wid >> 2, wc = wid & 3, fr = lane & 15, fq = lane >> 4;
    const int K = g.K, nt = K / BK;
    unsigned voffA[2], voffB[2];
#pragma unroll
    for (int i = 0; i < 2; ++i) { int R, C; stage_rc(tid * 16 + i * 8192, R, C); const int Rb = Epi::PERM ? ((R & ~31) + perm32(R & 31)) : R;
        voffA[i] = (unsigned)(R * K + C) * 2u; voffB[i] = (unsigned)(Rb * K + C) * 2u; }
    const size_t kstep = (size_t)(BK * 2);
    const size_t hstep = (size_t)HALF * K * 2;
    const size_t tstep = 2 * hstep;
    const unsigned ldsw = (unsigned)wid * 1024u;
    const int aoff = lds_byte(wr * 64 + fr, fq * 8), boff = lds_byte(wc * 32 + fr, fq * 8);
#define PG8_SA(b, h) (((b) * 2 + (h)) * HTB)
#define PG8_SB(b, h) ((4 + (b) * 2 + (h)) * HTB)
#define PG8_STAGE(bufoff, gbase, voff) do { _Pragma("unroll") for (int _i = 0; _i < 2; ++_i) \
        __builtin_amdgcn_global_load_lds((const unsigned*)((const char*)(gbase) + (voff)[_i]), (PG8_LAS unsigned*)(lds + (bufoff) + ldsw + _i * 8192), 16, 0, 0); } while (0)
#define PG8_LD8(p_) __builtin_shufflevector(*(const PG8_LAS v4i_*)(p_), *(const PG8_LAS v4i_*)((p_) + 1024), 0, 1, 2, 3, 4, 5, 6, 7)
#define PG8_LDA(dst, b, h) do { if constexpr (Epi::FP8) { _Pragma("unroll") for (int m = 0; m < 4; ++m) dst##8[m] = PG8_LD8(lds + PG8_SA(b, h) + aoff + m * 2048); } \
        else { _Pragma("unroll") for (int m = 0; m < 4; ++m) _Pragma("unroll") for (int k = 0; k < 2; ++k) dst[m][k] = *(const PG8_LAS bf16x8*)(lds + PG8_SA(b, h) + aoff + m * 2048 + k * 1024); } } while (0)
#define PG8_LDB(dst, b, h) do { if constexpr (Epi::FP8) { _Pragma("unroll") for (int n = 0; n < 2; ++n) dst##8[n] = PG8_LD8(lds + PG8_SB(b, h) + boff + n * 2048); } \
        else { _Pragma("unroll") for (int n = 0; n < 2; ++n) _Pragma("unroll") for (int k = 0; k < 2; ++k) dst[n][k] = *(const PG8_LAS bf16x8*)(lds + PG8_SB(b, h) + boff + n * 2048 + k * 1024); } } while (0)
#define PG8_MMA(ai, bj, At, Bt) do { if constexpr (Epi::FP8) __builtin_amdgcn_sched_barrier(0);     \
        __builtin_amdgcn_s_setprio(1); _Pragma("unroll") for (int m = 0; m < 4; ++m) _Pragma("unroll") for (int n = 0; n < 2; ++n) { \
        if constexpr (Epi::FP8)   \
            acc[ai][bj][m][n] = __builtin_amdgcn_mfma_scale_f32_16x16x128_f8f6f4(Bt##8[n], At##8[m], acc[ai][bj][m][n], 0, 0, 0, 0, 0, 0);     \
        else { _Pragma("unroll") for (int k = 0; k < 2; ++k) acc[ai][bj][m][n] = __builtin_amdgcn_mfma_f32_16x16x32_bf16(Bt[n][k], At[m][k], acc[ai][bj][m][n], 0, 0, 0); } } \
        if constexpr (Epi::FP8) { _Pragma("unroll") for (int m = 0; m < 4; ++m) _Pragma("unroll") for (int n = 0; n < 2; ++n) asm volatile("" : "+v"(acc[ai][bj][m][n])); }     \
        __builtin_amdgcn_s_setprio(0); if constexpr (Epi::FP8) __builtin_amdgcn_sched_barrier(0); } while (0)
#define PG8_WAIT_V(n) asm volatile("s_waitcnt vmcnt(" #n ")" ::: "memory")
#define PG8_WAIT_L(n) asm volatile("s_waitcnt lgkmcnt(" #n ")" ::: "memory")
#define PG8_BAR __builtin_amdgcn_s_barrier()
#define PG8_SCHED __builtin_amdgcn_sched_barrier(0)
    Unit cur, nxt; int ui = 0;
    if (!S.next(0, cur)) return;
    f32x4 acc[2][2][4][2];
#pragma unroll
    for (int a = 0; a < 2; ++a)
#pragma unroll
        for (int b = 0; b < 2; ++b)
#pragma unroll
            for (int m = 0; m < 4; ++m)
#pragma unroll
                for (int n = 0; n < 2; ++n) acc[a][b][m][n] = (f32x4){0.f, 0.f, 0.f, 0.f};
    typedef int v4i_ __attribute__((ext_vector_type(4))); typedef int v8i_ __attribute__((ext_vector_type(8)));
    bf16x8 At[4][2], B0[2][2], B1[2][2]; v8i_ At8[4], B08[2], B18[2];
    const char* cA = (const char*)g.A + (size_t)cur.pm * tstep; const char* cB = (const char*)g.Bt + (size_t)cur.pn * tstep;
    S.a_ready(cur);
    if constexpr (SP2) {
        PG8_STAGE(PG8_SB(0, 0), cB, voffB); PG8_STAGE(PG8_SB(0, 1), cB + hstep, voffB); PG8_STAGE(PG8_SA(0, 0), cA, voffA); PG8_STAGE(PG8_SA(0, 1), cA + hstep, voffA);
        if (wr == 1) PG8_BAR;
        PG8_WAIT_V(2); PG8_BAR;
        PG8_STAGE(PG8_SB(1, 0), cB + kstep, voffB); PG8_STAGE(PG8_SA(1, 0), cA + kstep, voffA); PG8_STAGE(PG8_SB(1, 1), cB + hstep + kstep, voffB);
        PG8_WAIT_V(6); PG8_BAR;
    } else {
        PG8_STAGE(PG8_SB(0, 0), cB, voffB); PG8_STAGE(PG8_SA(0, 0), cA, voffA); PG8_STAGE(PG8_SB(0, 1), cB + hstep, voffB); PG8_STAGE(PG8_SA(0, 1), cA + hstep, voffA);
        if (wr == 1) PG8_BAR;
        PG8_WAIT_V(4); PG8_BAR;
        PG8_STAGE(PG8_SB(1, 0), cB + kstep, voffB); PG8_STAGE(PG8_SA(1, 0), cA + kstep, voffA); PG8_STAGE(PG8_SB(1, 1), cB + hstep + kstep, voffB);
        PG8_WAIT_V(6); PG8_BAR;
    }
    for (;;) {
        const bool has_next = S.next(ui + 1, nxt);
        const char* nA = has_next ? (const char*)g.A + (size_t)nxt.pm * tstep : cA; const char* nB = has_next ? (const char*)g.Bt + (size_t)nxt.pn * tstep : cB;
        for (int t = 0; t < nt; t += 2) {
            const bool last = (t == nt - 2);
            const char* a1 = cA + (size_t)(t + 1) * kstep;
            const char* a2 = last ? nA : cA + (size_t)(t + 2) * kstep; const char* b2 = last ? nB : cB + (size_t)(t + 2) * kstep;
            const char* a3 = a2 + kstep; const char* b3 = b2 + kstep;
            if (last && has_next) S.a_ready(nxt);
            if constexpr (SP2) {
            PG8_LDB(B0, 0, 0); PG8_LDB(B1, 0, 1); PG8_SCHED; PG8_LDA(At, 0, 0); PG8_STAGE(PG8_SA(1, 1), a1 + hstep, voffA);
            PG8_WAIT_V(8); PG8_WAIT_L(0); PG8_BAR; PG8_MMA(0, 0, At, B0); PG8_MMA(0, 1, At, B1); PG8_BAR; PG8_SCHED;
            PG8_LDA(At, 0, 1); PG8_STAGE(PG8_SB(0, 0), b2, voffB); PG8_STAGE(PG8_SB(0, 1), b2 + hstep, voffB); PG8_STAGE(PG8_SA(0, 0), a2, voffA);
            PG8_WAIT_V(8); PG8_WAIT_L(0); PG8_BAR; PG8_MMA(1, 0, At, B0); PG8_MMA(1, 1, At, B1); PG8_BAR; PG8_SCHED;
            PG8_LDB(B0, 1, 0); PG8_LDB(B1, 1, 1); PG8_SCHED; PG8_LDA(At, 1, 0); PG8_STAGE(PG8_SA(0, 1), a2 + hstep, voffA);
            PG8_WAIT_V(8); PG8_WAIT_L(0); PG8_BAR; PG8_MMA(0, 0, At, B0); PG8_MMA(0, 1, At, B1); PG8_BAR; PG8_SCHED;
            PG8_LDA(At, 1, 1); PG8_STAGE(PG8_SB(1, 0), b3, voffB); PG8_STAGE(PG8_SB(1, 1), b3 + hstep, voffB); PG8_STAGE(PG8_SA(1, 0), a3, voffA);
            PG8_WAIT_V(8); PG8_WAIT_L(0); PG8_BAR; PG8_MMA(1, 0, At, B0); PG8_MMA(1, 1, At, B1); PG8_BAR; PG8_SCHED;
            } else {
            PG8_LDB(B0, 0, 0); PG8_SCHED; PG8_LDA(At, 0, 0); PG8_STAGE(PG8_SA(1, 1), a1 + hstep, voffA);
            PG8_WAIT_L(8); PG8_BAR; PG8_WAIT_L(0); PG8_MMA(0, 0, At, B0); PG8_BAR; PG8_SCHED;
            PG8_LDB(B1, 0, 1); PG8_STAGE(PG8_SB(0, 0), b2, voffB);
            PG8_BAR; PG8_WAIT_L(0); PG8_MMA(0, 1, At, B1); PG8_BAR;
            PG8_LDA(At, 0, 1); PG8_STAGE(PG8_SA(0, 0), a2, voffA);
            PG8_BAR; PG8_WAIT_L(0); PG8_MMA(1, 0, At, B0); PG8_BAR; PG8_SCHED;
            PG8_STAGE(PG8_SB(0, 1), b2 + hstep, voffB);
            PG8_WAIT_V(6); PG8_BAR; PG8_MMA(1, 1, At, B1); PG8_BAR;
            PG8_LDB(B0, 1, 0); PG8_SCHED; PG8_LDA(At, 1, 0); PG8_STAGE(PG8_SA(0, 1), a2 + hstep, voffA);
            PG8_WAIT_L(8); PG8_BAR; PG8_WAIT_L(0); PG8_MMA(0, 0, At, B0); PG8_BAR; PG8_SCHED;
            PG8_LDB(B1, 1, 1); PG8_STAGE(PG8_SB(1, 0), b3, voffB);
            PG8_BAR; PG8_WAIT_L(0); PG8_MMA(0, 1, At, B1); PG8_BAR;
            PG8_LDA(At, 1, 1); PG8_STAGE(PG8_SA(1, 0), a3, voffA);
            PG8_BAR; PG8_WAIT_L(0); PG8_MMA(1, 0, At, B0); PG8_BAR; PG8_SCHED;
            PG8_STAGE(PG8_SB(1, 1), b3 + hstep, voffB);
            PG8_WAIT_V(6); PG8_BAR; PG8_MMA(1, 1, At, B1); PG8_BAR;
            }
        }
        if constexpr (ALIGN_EPI) { if (wr == 0) PG8_BAR; }
        if constexpr (Epi::FP8) { _Pragma("unroll") for (int ai = 0; ai < 2; ++ai) _Pragma("unroll") for (int bj = 0; bj < 2; ++bj) _Pragma("unroll") for (int m = 0; m < 4; ++m) _Pragma("unroll") for (int n = 0; n < 2; ++n) acc[ai][bj][m][n] *= (1.f / W8_SCALE); }
        if constexpr (!Epi::AFTER_DRAIN) { E(acc, cur, wr, wc, fr, fq); S.done(cur); }
        if (!has_next) break;
#pragma unroll
        for (int a = 0; a < 2; ++a)
#pragma unroll
            for (int b = 0; b < 2; ++b)
#pragma unroll
                for (int m = 0; m < 4; ++m)
#pragma unroll
                    for (int n = 0; n < 2; ++n) acc[a][b][m][n] = (f32x4){0.f, 0.f, 0.f, 0.f};
        cur = nxt; cA = nA; cB = nB; ++ui;
        if constexpr (ALIGN_EPI) { if (wr == 1) PG8_BAR; }
    }
    PG8_WAIT_V(0);
    if constexpr (!ALIGN_EPI) { if (wr == 0) PG8_BAR; }
    PG8_BAR;
    if constexpr (Epi::AFTER_DRAIN) { E.fused(acc, cur, wr, wc, fr, fq, lds, wid, lane); S.done(cur); }
#undef PG8_SA
#undef PG8_SB
#undef PG8_STAGE
#undef PG8_LDA
#undef PG8_LD8
#undef PG8_LDB
#undef PG8_MMA
#undef PG8_WAIT_V
#undef PG8_WAIT_L
#undef PG8_BAR
#undef PG8_SCHED
}
}


struct Params { const float* in[24]; float* out; unsigned char* ws; int ph_lo, ph_hi; };
enum { I_X = 0, I_C, I_CTX, I_CCTX, I_ADAW, I_ADAB, I_N1G, I_N2G, I_WIN, I_QNG, I_KNG, I_LAMQK, I_SUBLN, I_HGLB, I_HGNG, I_WBA, I_WBB, I_WOUT, I_RW, I_RB, I_WGU, I_BGU, I_WDN, I_BDN };

#define LDS_WAIT() asm volatile("s_waitcnt lgkmcnt(0)" ::: "memory")

template <int KIND, bool FP8 = false>
__device__ __forceinline__ void transpose_item(const float* __restrict__ W, int K, int N, bf16* WT, bf16* WT2, int row_off, int k0, int n0, LAS float* scr, int lane) {
#pragma unroll 4
    for (int it = 0; it < 16; ++it) {
        const int k = 4 * it + (lane >> 4), n4 = (lane & 15) * 4;
        const f32x4 v = __builtin_nontemporal_load((const f32x4*)(W + (size_t)(k0 + k) * N + n0 + n4));
        *(LAS f32x4*)(scr + k * 64 + (n4 ^ (4 * ((k >> 3) & 7)))) = v;
    }
    LDS_WAIT();
    const int c = lane & 7;
#pragma unroll 2
    for (int j2 = 0; j2 < 8; ++j2) {
        const int nl = (lane >> 3) + 8 * j2, n = n0 + nl;
        const LAS float* s = scr + (8 * c) * 64 + (nl ^ (4 * c));
        v4u o; o.x = pk2(s[0], s[64]); o.y = pk2(s[128], s[192]); o.z = pk2(s[256], s[320]); o.w = pk2(s[384], s[448]);
        bf16* base = WT; size_t row;
        if (KIND == 0) row = (size_t)(row_off + n);
        else if (KIND == 1) row = (size_t)(row_off + perm8(n));
        else if (KIND == 2) {
            if (n < 1024) { const int tile = n >> 8, G = (n >> 6) & 3, bj = (n >> 5) & 1, e = n & 31; row = (size_t)(256 * tile + 128 * bj + 32 * G + e); }
            else if (n < 1536) { base = WT2; row = (size_t)(n - 1024); }
            else if (n < 3584) {
                const int Q = (n - 1536) >> 9, rem = (n - 1536) & 511, hh = rem >> 7, d = rem & 127, dd = d & 63;
                const int p = 128 * (Q >> 1) + 32 * (dd >> 4) + 16 * (Q & 1) + 4 * ((dd >> 2) & 3) + (dd & 3);
                row = (size_t)(1024 + 256 * (2 * hh + (d >> 6)) + p); }
            else row = (size_t)(3072 + perm8(n - 3584));
        } else {
            const int half = n >> 10, nn = n & 1023;
            row = (size_t)(256 * (nn >> 7) + 128 * half + perm8(nn & 127));
        }
        if (!FP8) __builtin_nontemporal_store(o, (v4u*)(base + row * K + k0 + 8 * c));
        else { v2u o8; o8.x = pk_fp8x4(s[0] * W8_SCALE, s[64] * W8_SCALE, s[128] * W8_SCALE, s[192] * W8_SCALE); o8.y = pk_fp8x4(s[256] * W8_SCALE, s[320] * W8_SCALE, s[384] * W8_SCALE, s[448] * W8_SCALE);
               __builtin_nontemporal_store(o8, (v2u*)((unsigned char*)base + row * K + k0 + 8 * c)); }
    }
    LDS_WAIT();
}

__device__ __forceinline__ void sincos_d(double x, double& s, double& c) {
    const double k = __builtin_rint(x * 0.63661977236758134308);
    double r = __builtin_fma(-k, 1.57079632679489655800e+00, x); r = __builtin_fma(-k, 6.12323399573676603587e-17, r);
    const double r2 = r * r;
    double sp = -1.0 / 1307674368000.0; sp = sp * r2 + 1.0 / 6227020800.0; sp = sp * r2 - 1.0 / 39916800.0; sp = sp * r2 + 1.0 / 362880.0; sp = sp * r2 - 1.0 / 5040.0; sp = sp * r2 + 1.0 / 120.0; sp = sp * r2 - 1.0 / 6.0; sp = sp * r2 + 1.0;
    const double sr = sp * r;
    double cp = 1.0 / 20922789888000.0; cp = cp * r2 - 1.0 / 87178291200.0; cp = cp * r2 + 1.0 / 479001600.0; cp = cp * r2 - 1.0 / 3628800.0; cp = cp * r2 + 1.0 / 40320.0; cp = cp * r2 - 1.0 / 720.0; cp = cp * r2 + 1.0 / 24.0; cp = cp * r2 - 0.5; cp = cp * r2 + 1.0;
    const int q = ((int)k) & 3;
    s = (q == 0) ? sr : (q == 1) ? cp : (q == 2) ? -sr : -cp;
    c = (q == 0) ? cp : (q == 1) ? -sr : (q == 2) ? -cp : sr;
}

constexpr int CI_IN = 16 * 96, CI_A = 8 * 16, CI_B = 8 * 16, CI_O = 16 * 16, CI_GU = 16 * 32, CI_DN = 16 * 16;
constexpr int PER_L = CI_IN + CI_A + CI_B + CI_O + NE * CI_GU + NE * CI_DN;
__device__ __forceinline__ void convert_items(const Params& P, LAS unsigned char* lds, int it0, int it1, int gwg, int nwg, int wv) {
    int tid_ = fresh_tid(wv);
    const int lane = tid_ & 63, wave = __builtin_amdgcn_readfirstlane(tid_ >> 6);
    GAS unsigned char* wsg_ = (GAS unsigned char*)P.ws; asm volatile("" : "+s"(wsg_)); unsigned char* ws = (unsigned char*)wsg_;
    LAS float* scr = (LAS float*)(lds + wave * 16384);
    constexpr int I_IN = CI_IN, I_A = CI_A, I_B = CI_B, I_O = CI_O, I_GU = CI_GU, I_DN = CI_DN;
#pragma unroll 1
    for (int it = it0 + gwg * NWAVES + wave; it < it1; it += nwg * NWAVES) {
        const int l = it / PER_L; int r = it % PER_L;
        if (r < I_IN) { const int kb = r / 96, nb = r % 96;
            transpose_item<2, true>(P.in[I_WIN] + (size_t)l * D * INC, D, INC, (bf16*)(ws + WS_WIN + l * WIN_L), (bf16*)(ws + WS_WV + l * WV_L), 0, 64 * kb, 64 * nb, scr, lane); continue; }
        r -= I_IN;
        if (r < I_A) { const int kb = r / 16, nb = r % 16;
            transpose_item<1>(P.in[I_WBA] + (size_t)l * 512 * D, 512, D, (bf16*)(ws + WS_WAB + l * WAB_L), nullptr, 0, 64 * kb, 64 * nb, scr, lane); continue; }
        r -= I_A;
        if (r < I_B) { const int kb = r / 16, nb = r % 16;
            transpose_item<1>(P.in[I_WBB] + (size_t)l * 512 * D, 512, D, (bf16*)(ws + WS_WAB + l * WAB_L), nullptr, 1024, 64 * kb, 64 * nb, scr, lane); continue; }
        r -= I_B;
        if (r < I_O) { const int kb = r / 16, nb = r % 16;
            transpose_item<0>(P.in[I_WOUT] + (size_t)l * D * D, D, D, (bf16*)(ws + WS_WO + l * WO_L), nullptr, 0, 64 * kb, 64 * nb, scr, lane); continue; }
        r -= I_O;
        if (r < NE * I_GU) { const int e = r / I_GU, q = r % I_GU, kb = q / 32, nb = q % 32;
            transpose_item<3, true>(P.in[I_WGU] + ((size_t)l * NE + e) * D * 2048, D, 2048, (bf16*)(ws + WS_WGU + l * WGU_L + e * (WGU_E / 2)), nullptr, 0, 64 * kb, 64 * nb, scr, lane); continue; }
        r -= NE * I_GU;
        { const int e = r / I_DN, q = r % I_DN, kb = q / 16, nb = q % 16;
            transpose_item<1, true>(P.in[I_WDN] + ((size_t)l * NE + e) * DFF * D, DFF, D, (bf16*)(ws + WS_WD + l * WD_L + e * (WD_E / 2)), nullptr, 0, 64 * kb, 64 * nb, scr, lane); }
    }
}

__device__ __forceinline__ void phase_p0a(const Params& P, LAS unsigned char* lds, int G, int wv) {
    int tid_ = fresh_tid(wv);
    const int tid = tid_, lane = tid & 63, wave = tid >> 6;
    GAS unsigned char* wsg_ = (GAS unsigned char*)P.ws; asm volatile("" : "+s"(wsg_)); unsigned char* ws = (unsigned char*)wsg_;
    LAS float* sil = (LAS float*)(lds + 131072);
    for (int i = tid; i < 2048; i += NTHR) { const float v = (i < 1024) ? P.in[I_C][i] : P.in[I_CCTX][i - 1024]; sil[i] = v * sigmoidf_(v); }
    __syncthreads();
    {
        float* modp = (float*)(ws + WS_MODP);
        for (int t = blockIdx.x * NTHR + tid; t < DEPTH * 8 * 6144; t += G * NTHR) {
            const int j = t % 6144, lp = t / 6144, part = lp & 7, l = lp >> 3;
            const float* w = P.in[I_ADAW] + ((size_t)l * D + part * 128) * 6144 + j;
            float a0 = 0.f, a1 = 0.f;
#pragma unroll 8
            for (int i = 0; i < 128; ++i) { const float wv = w[(size_t)i * 6144]; a0 += sil[part * 128 + i] * wv; a1 += sil[1024 + part * 128 + i] * wv; }
            modp[((size_t)(l * 8 + part) * 2 + 0) * 6144 + j] = a0;
            modp[((size_t)(l * 8 + part) * 2 + 1) * 6144 + j] = a1;
        }
    }
    {
        float* lbo = (float*)(ws + WS_LB);
        for (int t = blockIdx.x * NTHR + tid; t < 2 * 512; t += G * NTHR) {
            const int dir = t >> 9, j = t & 511;
            float v[DEPTH], mx = -1e30f;
#pragma unroll
            for (int l = 0; l < DEPTH; ++l) { v[l] = P.in[I_HGLB][((size_t)dir * DEPTH + l) * 512 + j]; mx = fmaxf(mx, v[l]); }
            float sum = 0.f;
#pragma unroll
            for (int l = 0; l < DEPTH; ++l) { v[l] = expf(v[l] - mx); sum += v[l]; }
            float cs = 0.f, first = 0.f;
#pragma unroll
            for (int l = 0; l < DEPTH; ++l) { cs += v[l] / sum; if (l == 0) first = cs; lbo[((size_t)dir * DEPTH + l) * 512 + j] = cs - first; }
        }
    }
    {
        float* rt = (float*)(ws + WS_ROPE);
        for (int t = blockIdx.x * NTHR + tid; t < 256 * 16; t += G * NTHR) {
            const int pos = t >> 4, fi = t & 15;
            const float freq = (float)exp2(-(double)fi * (13.287712379549449 / 16.0));
            const float ang = (float)pos * freq;
            double s, c; sincos_d((double)ang, s, c);
            rt[2 * t] = (float)c; rt[2 * t + 1] = (float)s;
        }
    }
    {
        for (int t = blockIdx.x * NTHR + tid; t < DEPTH * D * NE; t += G * NTHR) {
            const int e = t & 31, k = (t >> 5) & 1023, l = t >> 15;
            const float v = P.in[I_RW][t];
            const unsigned hi = pk2(v, 0.f) & 0xffffu; const unsigned lo = pk2(v - bflo(hi), 0.f) & 0xffffu;
            unsigned char* img = ws + WS_RWIMG + (size_t)l * RW_IMG;
            *(bf16*)(img + e * RW_PITCH + k * 2) = (bf16)hi; *(bf16*)(img + 32 * RW_PITCH + e * RW_PITCH + k * 2) = (bf16)lo;
        }
    }
    {
        convert_items(P, lds, 0, (G == 256) ? PER_L : DEPTH * PER_L, (int)blockIdx.x, G, wv);
    }
}

__device__ __forceinline__ const float* modv_ptr(const Params& P, int l, int w) { return (const float*)(P.ws + WS_MODV) + ((size_t)l * 2 + w) * 6144; }
__device__ __forceinline__ const float* xin_row(const Params& P, int l, int row) {
    if (l == 0) return (row < SEQ) ? P.in[I_X] + (size_t)row * D : P.in[I_CTX] + (size_t)(row - SEQ) * D;
    return (const float*)(P.ws + WS_XRES) + (size_t)row * D;
}
__device__ __forceinline__ void norm_store_row(const f32x4 (&v)[4], const LAS float* A, const LAS float* B, unsigned char* hrow, int lane) {
    float ss = 0.f;
#pragma unroll
    for (int j = 0; j < 4; ++j) ss += (v[j].x * v[j].x + v[j].y * v[j].y) + (v[j].z * v[j].z + v[j].w * v[j].w);
    const float rstd = __builtin_amdgcn_rsqf(wave_sum(ss, lane) * (1.f / D) + EPS);
#pragma unroll
    for (int j = 0; j < 4; ++j) {
        const f32x4 a = *(const LAS f32x4*)(A + 4 * lane + 256 * j), b = *(const LAS f32x4*)(B + 4 * lane + 256 * j);
        const f32x4 y = v[j] * rstd * a + b;
        *(unsigned*)(hrow + 4 * lane + 256 * j) = pk_fp8x4(y.x, y.y, y.z, y.w);
    }
}

__device__ __forceinline__ void phase_p0b(const Params& P, LAS unsigned char* lds, int G, int wv) {
    int tid_ = fresh_tid(wv);
    const int tid = tid_, lane = tid & 63, wave = tid >> 6;
    GAS unsigned char* wsg_ = (GAS unsigned char*)P.ws; asm volatile("" : "+s"(wsg_)); unsigned char* ws = (unsigned char*)wsg_;
    const float* modp = (const float*)(ws + WS_MODP);
    float* modv = (float*)(ws + WS_MODV);
    for (int t = blockIdx.x * NTHR + tid; t < DEPTH * 2 * 6144; t += G * NTHR) {
        const int j = t % 6144, lw = t / 6144, w = lw & 1, l = lw >> 1;
        float a = P.in[I_ADAB][(size_t)l * 6144 + j];
#pragma unroll
        for (int p = 0; p < 8; ++p) a += modp[((size_t)(l * 8 + p) * 2 + w) * 6144 + j];
        modv[t] = a;
    }
    LAS float* TA = (LAS float*)lds;
    LAS float* TB = (LAS float*)(lds + 8192);
    for (int i = tid; i < 2048; i += NTHR) {
        const int w = i >> 10, j = i & 1023;
        float sh = P.in[I_ADAB][j], sc = P.in[I_ADAB][1024 + j];
#pragma unroll
        for (int p = 0; p < 8; ++p) { sh += modp[((size_t)p * 2 + w) * 6144 + j]; sc += modp[((size_t)p * 2 + w) * 6144 + 1024 + j]; }
        TA[i] = P.in[I_N1G][j] * (1.f + sc); TB[i] = sh;
    }
    __syncthreads();
    bf16* H = (bf16*)(ws + WS_H);
    for (int row = blockIdx.x * NWAVES + wave; row < NT; row += G * NWAVES) {
        const float* xr = xin_row(P, 0, row); const int w = row >= SEQ;
        f32x4 v[4];
#pragma unroll
        for (int j = 0; j < 4; ++j) v[j] = *(const f32x4*)(xr + 4 * lane + 256 * j);
        norm_store_row(v, TA + 1024 * w, TB + 1024 * w, (unsigned char*)H + (size_t)row * D, lane);
        bf16* xb = (bf16*)(ws + WS_XRES) + (size_t)row * D + 4 * lane;
#pragma unroll
        for (int j = 0; j < 4; ++j) { v2u o; o.x = pk2(v[j].x, v[j].y); o.y = pk2(v[j].z, v[j].w); *(v2u*)(xb + 256 * j) = o; }
    }
}

using pg8::Unit;

struct EpiInProj {
    static constexpr bool PERM = false, AFTER_DRAIN = false, FP8 = true;
    bf16* Q; bf16* K; bf16* proj; const float* qn_g; const float* kn_g; const float* rope; unsigned char* img; const float* lbl;
    __device__ __forceinline__ void operator()(const f32x4 (&acc)[2][2][4][2], const Unit& u, int wr, int wc, int fr, int fq) const {
        const int row0 = u.pm * 256 + wr * 64 + fr;
        if (u.pn < 4) {
            const bool isq = u.pn < 2; const int gg = 4 * (u.pn & 1) + wc, hh = gg >> 1, mm = gg & 1;
            const float* gv = isq ? qn_g : kn_g; unsigned char* dstb = (unsigned char*)(isq ? Q : K) + (size_t)hh * NT * 128 + 64 * mm;
            const float oscale = isq ? 0.125f * 1.4426950408889634f : 1.f;
            f32x4 g[2][2];
#pragma unroll
            for (int bj = 0; bj < 2; ++bj)
#pragma unroll
                for (int n = 0; n < 2; ++n) g[bj][n] = *(const f32x4*)(gv + 32 * bj + 16 * n + 4 * fq);
#pragma unroll
            for (int ai = 0; ai < 2; ++ai)
#pragma unroll
                for (int m = 0; m < 4; ++m) {
                    const int row = row0 + ai * 128 + m * 16;
                    float ss = 0.f;
#pragma unroll
                    for (int bj = 0; bj < 2; ++bj)
#pragma unroll
                        for (int n = 0; n < 2; ++n) { const f32x4 x = acc[ai][bj][m][n]; ss += (x.x * x.x + x.y * x.y) + (x.z * x.z + x.w * x.w); }
                    { const int ln_ = 16 * fq + fr; ss += shx(ss, 16, ln_); ss += shx(ss, 32, ln_); }
                    const float rstd = __builtin_amdgcn_rsqf(ss * (1.f / 64.f) + EPS) ;
                    unsigned char* dst = dstb + (size_t)row * 128;
                    const bool lat = row < SEQ;
#pragma unroll
                    for (int bj = 0; bj < 2; ++bj) {
                        f32x4 x1 = acc[ai][bj][m][0] * rstd * g[bj][0], x2 = acc[ai][bj][m][1] * rstd * g[bj][1];
                        if (lat) {
                            const int pos = bj == 0 ? (row >> 6) : (row & 63);
                            const f32x4 cs0 = *(const f32x4*)(rope + (size_t)(pos * 16 + 4 * fq) * 2), cs1 = *(const f32x4*)(rope + (size_t)(pos * 16 + 4 * fq) * 2 + 4);
                            const f32x4 c = {cs0.x, cs0.z, cs1.x, cs1.z}, s = {cs0.y, cs0.w, cs1.y, cs1.w};
                            const f32x4 y1 = x1 * c - x2 * s, y2 = x2 * c + x1 * s; x1 = y1; x2 = y2;
                        }
                        x1 = x1 * oscale; x2 = x2 * oscale;
                        *(unsigned*)(dst + 32 * bj + 4 * fq) = pk_fp8x4(x1.x, x1.y, x1.z, x1.w); *(unsigned*)(dst + 32 * bj + 16 + 4 * fq) = pk_fp8x4(x2.x, x2.y, x2.z, x2.w);
                    }
                }
        } else if (u.pn < 12) {
            const int T = u.pn - 4, hh = T >> 1, d0 = 64 * (T & 1) + 16 * wc + 4 * fq, ln_ = 16 * fq + fr;
            const f32x4 lbf = *(const f32x4*)(lbl + 128 * hh + d0), lbb = *(const f32x4*)(lbl + (size_t)DEPTH * 512 + 128 * hh + d0);
#pragma unroll
            for (int ai = 0; ai < 2; ++ai)
#pragma unroll
                for (int m = 0; m < 4; ++m) {
                    const int rg = u.pm * 256 + ai * 128 + wr * 64 + m * 16;
                    const int seg = rg < SEQ ? (rg >> 8) : 64, cf = ((rg < SEQ ? rg : rg - SEQ) & 255) >> 4;
                    const f32x4 qv = acc[ai][0][m][0], vv = acc[ai][1][m][1];
#pragma unroll
                    for (int dir = 0; dir < 2; ++dir) {
                        const f32x4 zv = dir ? acc[ai][1][m][0] : acc[ai][0][m][1], lb = dir ? lbb : lbf;
                        const int s_ = dir ? 15 - fr : fr, c_ = dir ? 15 - cf : cf;
                        unsigned char* im = img + (size_t)((((dir * 4 + hh) * 65 + seg) * 16) + c_) * IM_BYTES;
                        float qt[4], kt[4], kh[4], dc[4];
#pragma unroll
                        for (int i = 0; i < 4; ++i) {
                            const float zc = fminf(fmaxf(zv[i], -80.f), 80.f), E = fast_exp(-zc), den = fast_rcp(1.f + E);
                            const float g = fast_log((1.f + lb[i] * E) * den), kk = (1.f - lb[i]) * E * den;
                            float b = g;
                            if (dir == 0) { b += __int_as_float(__builtin_amdgcn_update_dpp(0, __float_as_int(b), 0x111, 0xf, 0xf, true)); b += __int_as_float(__builtin_amdgcn_update_dpp(0, __float_as_int(b), 0x112, 0xf, 0xf, true));
                                            b += __int_as_float(__builtin_amdgcn_update_dpp(0, __float_as_int(b), 0x114, 0xf, 0xf, true)); b += __int_as_float(__builtin_amdgcn_update_dpp(0, __float_as_int(b), 0x118, 0xf, 0xf, true)); }
                            else          { b += __int_as_float(__builtin_amdgcn_update_dpp(0, __float_as_int(b), 0x101, 0xf, 0xf, true)); b += __int_as_float(__builtin_amdgcn_update_dpp(0, __float_as_int(b), 0x102, 0xf, 0xf, true));
                                            b += __int_as_float(__builtin_amdgcn_update_dpp(0, __float_as_int(b), 0x104, 0xf, 0xf, true)); b += __int_as_float(__builtin_amdgcn_update_dpp(0, __float_as_int(b), 0x108, 0xf, 0xf, true)); }
                            const float bl = __int_as_float(__builtin_amdgcn_ds_bpermute((dir ? (ln_ & ~15) : (ln_ | 15)) << 2, __float_as_int(b)));
                            qt[i] = qv[i] * fast_exp(b); kt[i] = kk * fast_exp(fminf(-b, 80.f)); kh[i] = kk * fast_exp(bl - b); dc[i] = fast_exp(bl);
                        }
                        { v2u o; o.x = pk2(qt[0], qt[1]); o.y = pk2(qt[2], qt[3]); *(v2u*)(im + 0 + s_ * 272 + d0 * 2) = o; }
                        { v2u o; o.x = pk2(kt[0], kt[1]); o.y = pk2(kt[2], kt[3]); *(v2u*)(im + 4352 + s_ * 272 + d0 * 2) = o; }
#pragma unroll
                        for (int i = 0; i < 4; ++i) { *(bf16*)(im + 8704 + (d0 + i) * 48 + s_ * 2) = (bf16)(pk2(kh[i], 0.f) & 0xffffu); *(bf16*)(im + 14848 + (d0 + i) * 48 + s_ * 2) = (bf16)(pk2(vv[i], 0.f) & 0xffffu); }
                        if (s_ == 15) *(f32x4*)(im + 20992 + d0 * 4) = (f32x4){dc[0], dc[1], dc[2], dc[3]};
                    }
                }
        } else {
            const int pt = u.pn - 4; const int act = pt < 10 ? 1 : 2;
            const int col0 = pt * 256 + wc * 32 + 8 * fq;
#pragma unroll
            for (int ai = 0; ai < 2; ++ai)
#pragma unroll
                for (int m = 0; m < 4; ++m) { bf16* rowp = proj + (size_t)(row0 + ai * 128 + m * 16) * PROJW + col0;
#pragma unroll
                    for (int bj = 0; bj < 2; ++bj) { f32x4 v0 = acc[ai][bj][m][0], v1 = acc[ai][bj][m][1];
#pragma unroll
                        for (int j = 0; j < 4; ++j) { const float s0 = sigmoidf_(v0[j]), s1 = sigmoidf_(v1[j]); v0[j] = act == 1 ? v0[j] * s0 : s0; v1[j] = act == 1 ? v1[j] * s1 : s1; }
                        v4u w; w.x = pk2(v0.x, v0.y); w.y = pk2(v0.z, v0.w); w.z = pk2(v1.x, v1.y); w.w = pk2(v1.z, v1.w);
                        *(v4u*)(rowp + bj * 128) = w; } }
        }
    }
};
struct EpiVt {
    static constexpr bool PERM = false, AFTER_DRAIN = false, FP8 = true;
    bf16* VT;
    __device__ __forceinline__ void operator()(const f32x4 (&acc)[2][2][4][2], const Unit& u, int wr, int wc, int fr, int fq) const {
        const int row0 = u.pm * 256 + wr * 64 + fr, col0 = u.pn * 256 + wc * 32 + 4 * fq;
#pragma unroll
        for (int ai = 0; ai < 2; ++ai)
#pragma unroll
            for (int m = 0; m < 4; ++m) { unsigned char* rowp = (unsigned char*)VT + (size_t)(row0 + ai * 128 + m * 16) * LDV + col0;
#pragma unroll
                for (int bj = 0; bj < 2; ++bj)
#pragma unroll
                    for (int n = 0; n < 2; ++n) { const f32x4 v = acc[ai][bj][m][n]; *(unsigned*)(rowp + bj * 128 + n * 16) = pk_fp8x4(v.x, v.y, v.z, v.w); } }
    }
};
struct EpiMerge {
    static constexpr bool PERM = false, AFTER_DRAIN = false, FP8 = false;
    const bf16* proj; bf16* U;
    __device__ __forceinline__ void operator()(const f32x4 (&acc)[2][2][4][2], const Unit& u, int wr, int wc, int fr, int fq) const {
        const int br = u.pn >> 2, T = u.pn & 3, pm = u.pm - 65 * br;
        const int row0 = pm * 256 + wr * 64 + fr, col0 = T * 256 + wc * 32 + 8 * fq;
        const int gcol = (br ? PC_GB : PC_GA) + col0;
#pragma unroll
        for (int ai = 0; ai < 2; ++ai)
#pragma unroll
            for (int m = 0; m < 4; ++m) { const size_t row = (size_t)(row0 + ai * 128 + m * 16);
#pragma unroll
                for (int bj = 0; bj < 2; ++bj) {
                    const v4u gw = *(const v4u*)(proj + row * PROJW + gcol + bj * 128);
                    f32x4 v0 = acc[ai][bj][m][0], v1 = acc[ai][bj][m][1];
                    v0.x *= bflo(gw.x); v0.y *= bfhi(gw.x); v0.z *= bflo(gw.y); v0.w *= bfhi(gw.y);
                    v1.x *= bflo(gw.z); v1.y *= bfhi(gw.z); v1.z *= bflo(gw.w); v1.w *= bfhi(gw.w);
                    bf16* up = U + row * D + col0 + bj * 128;
                    if (br) { const v4u o = *(const v4u*)up;
                        v0.x += bflo(o.x); v0.y += bfhi(o.x); v0.z += bflo(o.y); v0.w += bfhi(o.y);
                        v1.x += bflo(o.z); v1.y += bfhi(o.z); v1.z += bflo(o.w); v1.w += bfhi(o.w); }
                    v4u w; w.x = pk2(v0.x, v0.y); w.y = pk2(v0.z, v0.w); w.z = pk2(v1.x, v1.y); w.w = pk2(v1.z, v1.w);
                    *(v4u*)up = w; } }
    }
};
struct EpiOut {
    static constexpr bool PERM = false, AFTER_DRAIN = false, FP8 = false;
    const bf16* xsrc; bf16* xres; const float* g1lat; const float* g1ctx;
    __device__ __forceinline__ void operator()(const f32x4 (&acc)[2][2][4][2], const Unit& u, int wr, int wc, int fr, int fq) const {
        const int row0 = u.pm * 256 + wr * 64 + fr, col0 = u.pn * 256 + wc * 32 + 4 * fq;
        const bool isctx = u.pm >= 64;
        const float* gsrc = isctx ? g1ctx : g1lat;
        f32x4 gv[2][2];
#pragma unroll
        for (int bj = 0; bj < 2; ++bj)
#pragma unroll
            for (int n = 0; n < 2; ++n) gv[bj][n] = *(const f32x4*)(gsrc + col0 + bj * 128 + n * 16);
#pragma unroll
        for (int ai = 0; ai < 2; ++ai)
#pragma unroll
            for (int m = 0; m < 4; ++m) { const int row = row0 + ai * 128 + m * 16;
                const bf16* src = xsrc + (size_t)row * D + col0;
                bf16* dst = xres + (size_t)row * D + col0;
#pragma unroll
                for (int bj = 0; bj < 2; ++bj)
#pragma unroll
                    for (int n = 0; n < 2; ++n) { const v2u xv = *(const v2u*)(src + bj * 128 + n * 16);
                        const f32x4 y = (f32x4){bflo(xv.x), bfhi(xv.x), bflo(xv.y), bfhi(xv.y)} + gv[bj][n] * acc[ai][bj][m][n];
                        v2u o; o.x = pk2(y.x, y.y); o.y = pk2(y.z, y.w); *(v2u*)(dst + bj * 128 + n * 16) = o; } }
    }
};
struct EpiSwiglu {
    static constexpr bool PERM = false, AFTER_DRAIN = false, FP8 = true;
    bf16* hdn; const float* bgu;
    __device__ __forceinline__ void operator()(const f32x4 (&acc)[2][2][4][2], const Unit& u, int wr, int wc, int fr, int fq) const {
        const int e = u.pn >> 3, T = u.pn & 7;
        const int row0 = u.pm * 256 + wr * 64 + fr, col0 = T * 128 + wc * 32 + 8 * fq;
        const float* bg = bgu + (size_t)e * 2048 + col0;
        const f32x4 bg0 = *(const f32x4*)bg, bg1 = *(const f32x4*)(bg + 4), bu0 = *(const f32x4*)(bg + 1024), bu1 = *(const f32x4*)(bg + 1028);
#pragma unroll
        for (int ai = 0; ai < 2; ++ai)
#pragma unroll
            for (int m = 0; m < 4; ++m) {
                f32x4 g0 = acc[ai][0][m][0] + bg0, g1 = acc[ai][0][m][1] + bg1, u0 = acc[ai][1][m][0] + bu0, u1 = acc[ai][1][m][1] + bu1;
                f32x4 h0, h1;
#pragma unroll
                for (int j = 0; j < 4; ++j) {
                    const float ga = fminf(g0[j], 7.f), gb = fminf(g1[j], 7.f);
                    const float ua = fminf(fmaxf(u0[j], -7.f), 7.f), ub = fminf(fmaxf(u1[j], -7.f), 7.f);
                    h0[j] = (ua + 1.f) * ga * sigmoidf_(1.702f * ga); h1[j] = (ub + 1.f) * gb * sigmoidf_(1.702f * gb);
                }
                v2u w; w.x = pk_fp8x4(h0.x, h0.y, h0.z, h0.w); w.y = pk_fp8x4(h1.x, h1.y, h1.z, h1.w);
                *(v2u*)((unsigned char*)hdn + (size_t)(row0 + ai * 128 + m * 16) * D + col0) = w;
            }
    }
};
struct EpiDown {
    static constexpr bool PERM = false, AFTER_DRAIN = false, FP8 = true;
    bf16* Y; const float* bdn;
    __device__ __forceinline__ void operator()(const f32x4 (&acc)[2][2][4][2], const Unit& u, int wr, int wc, int fr, int fq) const {
        const int e = u.pn >> 2, T = u.pn & 3;
        const int row0 = u.pm * 256 + wr * 64 + fr, col0 = T * 256 + wc * 32 + 8 * fq;
        f32x4 bv[2][2];
#pragma unroll
        for (int bj = 0; bj < 2; ++bj)
#pragma unroll
            for (int n = 0; n < 2; ++n) bv[bj][n] = *(const f32x4*)(bdn + (size_t)e * D + col0 + bj * 128 + 4 * n);
#pragma unroll
        for (int ai = 0; ai < 2; ++ai)
#pragma unroll
            for (int m = 0; m < 4; ++m) { bf16* rowp = Y + (size_t)(row0 + ai * 128 + m * 16) * D + col0;
#pragma unroll
                for (int bj = 0; bj < 2; ++bj) { const f32x4 v0 = acc[ai][bj][m][0] + bv[bj][0], v1 = acc[ai][bj][m][1] + bv[bj][1];
                    v4u w; w.x = pk2(v0.x, v0.y); w.y = pk2(v0.z, v0.w); w.z = pk2(v1.x, v1.y); w.w = pk2(v1.z, v1.w);
                    *(v4u*)(rowp + bj * 128) = w; } }
    }
};

constexpr int IM_QT = 0, IM_KT = 4352, IM_KH = 8704, IM_VT = 14848, IM_DEC = 20992;
constexpr int HGP = 272;
constexpr int HL_IMG = 0, HL_ST = 2 * IM_BYTES, HL_STSZ = 34816, HL_OT = HL_ST + 2 * HL_STSZ, HL_OTSZ = 8448, HL_OF = HL_OT + 2 * HL_OTSZ, HL_GT = HL_OF + 2 * 8192, HL_AM = HL_GT + 2 * 4096;

__device__ __forceinline__ void glds16_s(const void* sbase, unsigned voff, unsigned lds_dst);

__device__ __forceinline__ void phase_hgrn_build(const Params& P, int layer, int G, int wv) {
    int tid_ = fresh_tid(wv);
    const int tid = tid_, d = tid & 127;
    GAS unsigned char* wsg_ = (GAS unsigned char*)P.ws; asm volatile("" : "+s"(wsg_)); unsigned char* ws = (unsigned char*)wsg_;
    const bf16* proj = (const bf16*)(ws + WS_PROJ);
    for (int task = blockIdx.x * 4 + (tid >> 7); task < 8 * 65 * 16; task += G * 4) {
        const int c = task & 15, sg = (task >> 4) % 65, dh = task / (16 * 65), dir = dh >> 2, hh = dh & 3;
        const int tok0 = (sg < 64 ? sg * 256 : SEQ) + (dir ? 255 : 0), sgn = dir ? -1 : 1;
        const float lb = ((const float*)(ws + WS_LB))[((size_t)dir * DEPTH + layer) * 512 + 128 * hh + d];
        const bf16* base = proj + (size_t)(tok0 + sgn * 16 * c) * PROJW + 128 * hh + d;
        const long rstep = (long)sgn * PROJW;
        float z[16], q[16]; unsigned short vv[16];
#pragma unroll
        for (int s = 0; s < 16; ++s) { const bf16* r = base + s * rstep; z[s] = bf2f(r[dir ? PC_ZB : PC_ZF]); q[s] = bf2f(r[PC_QH]); vv[s] = r[PC_VH]; }
        float b[16], kk[16], run = 0.f;
#pragma unroll
        for (int s = 0; s < 16; ++s) {
            const float zz = fminf(fmaxf(z[s], -80.f), 80.f), E = fast_exp(-zz), den = fast_rcp(1.f + E);
            run += fast_log((1.f + lb * E) * den); b[s] = run; kk[s] = (1.f - lb) * E * den;
        }
        unsigned char* img = ws + WS_IMG + (size_t)task * IM_BYTES;
        unsigned khw[8], vtw[8];
#pragma unroll
        for (int s = 0; s < 16; ++s) {
            *(bf16*)(img + IM_QT + s * HGP + d * 2) = (bf16)(pk2(q[s] * fast_exp(b[s]), 0.f) & 0xffffu);
            *(bf16*)(img + IM_KT + s * HGP + d * 2) = (bf16)(pk2(kk[s] * fast_exp(fminf(-b[s], 80.f)), 0.f) & 0xffffu);
        }
#pragma unroll
        for (int j = 0; j < 8; ++j) { khw[j] = pk2(kk[2 * j] * fast_exp(b[15] - b[2 * j]), kk[2 * j + 1] * fast_exp(b[15] - b[2 * j + 1])); vtw[j] = (unsigned)vv[2 * j] | ((unsigned)vv[2 * j + 1] << 16); }
        *(v4u*)(img + IM_KH + d * 48) = (v4u){khw[0], khw[1], khw[2], khw[3]}; *(v4u*)(img + IM_KH + d * 48 + 16) = (v4u){khw[4], khw[5], khw[6], khw[7]};
        *(v4u*)(img + IM_VT + d * 48) = (v4u){vtw[0], vtw[1], vtw[2], vtw[3]}; *(v4u*)(img + IM_VT + d * 48 + 16) = (v4u){vtw[4], vtw[5], vtw[6], vtw[7]};
        *(float*)(img + IM_DEC + d * 4) = fast_exp(b[15]);
    }
}

template <int MODE>
__device__ __forceinline__ void hgrn_sweep(const Params& P, LAS unsigned char* lds, int layer, int dir, int hh, int seg, const float* Sinit, float* Uout, float* Dout, int wv) {
    int tid_ = fresh_tid(wv);
    const int tid = tid_, lane = tid & 63, wid = __builtin_amdgcn_readfirstlane(tid >> 6), r32 = lane & 31, hi = lane >> 5;
    GAS unsigned char* wsg_ = (GAS unsigned char*)P.ws; asm volatile("" : "+s"(wsg_)); unsigned char* ws = (unsigned char*)wsg_;
    const int tok0 = (seg < 64 ? seg * 256 : SEQ) + (dir ? 255 : 0), sgn = dir ? -1 : 1;
    constexpr int NV = (MODE == 0) ? 2 : 4;
    const int db = wid & 3, vb0 = (MODE == 0) ? 2 * (wid >> 2) : 0;
    const bool srole = (MODE == 0) || wid >= 4, orole = (MODE != 0) && wid < 4;
    const unsigned lds0 = (unsigned)(uintptr_t)lds;
    const unsigned char* img0 = ws + WS_IMG + (size_t)(((dir * 4 + hh) * 65 + seg) * 16) * IM_BYTES;
    constexpr int P0 = (MODE == 0) ? 8 : 0;
#define HG_DMA_IMG(c) do { _Pragma("unroll") for (int j = 0; j < 3; ++j) { const int pc = wid + 8 * j; if (pc >= P0 && pc < 21) \
        glds16_s(img0 + (size_t)(c) * IM_BYTES + pc * 1024, (unsigned)lane * 16u, lds0 + HL_IMG + ((c) & 1) * IM_BYTES + pc * 1024); } } while (0)
#define HG_DMA_FIN(c) do { { const int t = 2 * wid + (lane >> 5), tok = tok0 + sgn * (16 * (c) + t); \
        glds16_s(ws + WS_OBF, (unsigned)(((size_t)tok * 512 + 128 * hh) * 4 + (lane & 31) * 16), lds0 + HL_OF + ((c) & 1) * 8192 + wid * 1024); } \
      if (wid < 4) { const int t = 4 * wid + (lane >> 4), tok = tok0 + sgn * (16 * (c) + t); \
        glds16_s(ws + WS_PROJ, (unsigned)(((size_t)tok * PROJW + PC_GH + 128 * hh) * 2 + (lane & 15) * 16), lds0 + HL_GT + ((c) & 1) * 4096 + wid * 1024); } } while (0)
    HG_DMA_IMG(0);
    f32x16 S[NV];
#pragma unroll
    for (int blk = 0; blk < NV; ++blk)
#pragma unroll
        for (int r = 0; r < 16; ++r) { const int d = 32 * db + (r & 3) + 8 * (r >> 2) + 4 * hi, v = 32 * (vb0 + blk) + r32; S[blk][r] = (Sinit && srole) ? Sinit[(size_t)d * 128 + v] : 0.f; }
    if (MODE != 0 && srole) {
#pragma unroll
        for (int blk = 0; blk < NV; ++blk)
#pragma unroll
            for (int g = 0; g < 4; ++g) { v2u o; o.x = pk2(S[blk][4 * g], S[blk][4 * g + 1]); o.y = pk2(S[blk][4 * g + 2], S[blk][4 * g + 3]);
                *(LAS v2u*)(lds + HL_ST + (32 * (vb0 + blk) + r32) * HGP + (32 * db + 8 * g + 4 * hi) * 2) = o; }
    }
    float dtot = 1.f;
    const f32x4 gnv = *(const f32x4*)(P.in[I_HGNG] + (size_t)layer * 128 + 4 * (tid & 31));
#define HG_FINALIZE(c) do { const int t = tid >> 5, v4 = 4 * (tid & 31), tok = tok0 + sgn * (16 * (c) + t); \
        const f32x4 o = *(const LAS f32x4*)(lds + HL_OT + ((c) & 1) * HL_OTSZ + t * 528 + v4 * 4) + *(const LAS f32x4*)(lds + HL_OF + ((c) & 1) * 8192 + t * 512 + v4 * 4); \
        float ss = (o.x * o.x + o.y * o.y) + (o.z * o.z + o.w * o.w); \
        _Pragma("unroll") for (int off = 1; off < 32; off <<= 1) ss += shx(ss, off, lane); \
        const float rstd = __builtin_amdgcn_rsqf(ss * (1.f / 128.f) + EPS); \
        const f32x4 gn = gnv; \
        const v2u gt = *(const LAS v2u*)(lds + HL_GT + ((c) & 1) * 4096 + t * 256 + v4 * 2); \
        v2u w; w.x = pk2(o.x * rstd * gn.x * bflo(gt.x), o.y * rstd * gn.y * bfhi(gt.x)); w.y = pk2(o.z * rstd * gn.z * bflo(gt.y), o.w * rstd * gn.w * bfhi(gt.y)); \
        *(v2u*)((bf16*)(ws + WS_OAB) + (size_t)NT * 512 + (size_t)tok * 512 + 128 * hh + v4) = w; } while (0)
    for (int c = 0; c < 16; ++c) {
        if (c >= 1 && MODE == 1 && orole) asm volatile("s_waitcnt vmcnt(8)" ::: "memory");
        else if (c >= 2 && MODE == 2) asm volatile("s_waitcnt vmcnt(1)" ::: "memory");
        else asm volatile("s_waitcnt vmcnt(0)" ::: "memory");
        __syncthreads();
        if (c + 1 < 16) HG_DMA_IMG(c + 1);
        if (MODE == 2) { HG_DMA_FIN(c); if (c > 0) HG_FINALIZE(c - 1); }
        const LAS unsigned char* im = lds + HL_IMG + (c & 1) * IM_BYTES;
        const int cur = c & 1;
        if (orole) {
            const int t16 = lane & 15, kq4 = lane >> 4;
            bf16x8 qa[4];
#pragma unroll
            for (int ks = 0; ks < 4; ++ks) qa[ks] = *(const LAS bf16x8*)(im + IM_QT + t16 * HGP + (32 * ks + 8 * kq4) * 2);
            f32x4 am = {0.f, 0.f, 0.f, 0.f};
#pragma unroll
            for (int ks = 0; ks < 4; ++ks) { const bf16x8 kb = *(const LAS bf16x8*)(im + IM_KT + t16 * HGP + (32 * ks + 8 * kq4) * 2); am = __builtin_amdgcn_mfma_f32_16x16x32_bf16(qa[ks], kb, am, 0, 0, 0); }
            LAS unsigned char* amw = lds + HL_AM + wid * 768;
#pragma unroll
            for (int i = 0; i < 4; ++i) { const int t = 4 * kq4 + i; *(LAS bf16*)(amw + t * 48 + t16 * 2) = (bf16)(pk2(t16 <= t ? am[i] : 0.f, 0.f) & 0xffffu); }
            f32x4 o4[2];
#pragma unroll
            for (int b2 = 0; b2 < 2; ++b2) { o4[b2] = (f32x4){0.f, 0.f, 0.f, 0.f}; const int vcol = 32 * wid + 16 * b2 + t16;
#pragma unroll
                for (int ks = 0; ks < 4; ++ks) { const bf16x8 sb = *(const LAS bf16x8*)(lds + HL_ST + cur * HL_STSZ + vcol * HGP + (32 * ks + 8 * kq4) * 2); o4[b2] = __builtin_amdgcn_mfma_f32_16x16x32_bf16(qa[ks], sb, o4[b2], 0, 0, 0); } }
            LDS_WAIT();
            bf16x8 ama = *(const LAS bf16x8*)(amw + t16 * 48 + 16 * (kq4 & 1));
            if (kq4 >= 2) ama = (bf16x8){0, 0, 0, 0, 0, 0, 0, 0};
#pragma unroll
            for (int b2 = 0; b2 < 2; ++b2) { const int vcol = 32 * wid + 16 * b2 + t16;
                const bf16x8 vbf = *(const LAS bf16x8*)(im + IM_VT + vcol * 48 + 16 * (kq4 & 1));
                o4[b2] = __builtin_amdgcn_mfma_f32_16x16x32_bf16(ama, vbf, o4[b2], 0, 0, 0);
#pragma unroll
                for (int i = 0; i < 4; ++i) { const int t = 4 * kq4 + i;
                    if (MODE == 1) { const int tok = tok0 + sgn * (16 * c + t); ((float*)(ws + WS_OBF))[(size_t)tok * 512 + 128 * hh + vcol] = o4[b2][i]; }
                    else *(LAS float*)(lds + HL_OT + cur * HL_OTSZ + t * 528 + vcol * 4) = o4[b2][i]; } }
        }
        if (srole) {
            float dsc[16];
#pragma unroll
            for (int r = 0; r < 16; ++r) dsc[r] = *(const LAS float*)(im + IM_DEC + (32 * db + (r & 3) + 8 * (r >> 2) + 4 * hi) * 4);
            if (MODE == 0 && tid < 128) dtot *= *(const LAS float*)(im + IM_DEC + tid * 4);
            const bf16x8 ka = *(const LAS bf16x8*)(im + IM_KH + (32 * db + r32) * 48 + 16 * hi);
#pragma unroll
            for (int blk = 0; blk < NV; ++blk) {
#pragma unroll
                for (int r = 0; r < 16; ++r) S[blk][r] *= dsc[r];
                const bf16x8 vb = *(const LAS bf16x8*)(im + IM_VT + (32 * (vb0 + blk) + r32) * 48 + 16 * hi);
                S[blk] = __builtin_amdgcn_mfma_f32_32x32x16_bf16(ka, vb, S[blk], 0, 0, 0);
                if (MODE != 0) {
#pragma unroll
                    for (int g = 0; g < 4; ++g) { v2u o; o.x = pk2(S[blk][4 * g], S[blk][4 * g + 1]); o.y = pk2(S[blk][4 * g + 2], S[blk][4 * g + 3]);
                        *(LAS v2u*)(lds + HL_ST + (cur ^ 1) * HL_STSZ + (32 * (vb0 + blk) + r32) * HGP + (32 * db + 8 * g + 4 * hi) * 2) = o; }
                }
            }
        }
    }
    asm volatile("s_waitcnt vmcnt(0)" ::: "memory");
    __syncthreads();
    if (MODE == 2) HG_FINALIZE(15);
    if (MODE == 0) {
#pragma unroll
        for (int blk = 0; blk < NV; ++blk)
#pragma unroll
            for (int r = 0; r < 16; ++r) { const int d = 32 * db + (r & 3) + 8 * (r >> 2) + 4 * hi, v = 32 * (vb0 + blk) + r32; Uout[(size_t)d * 128 + v] = S[blk][r]; }
        if (tid < 128) Dout[tid] = dtot;
    }
    asm volatile("s_waitcnt vmcnt(0)" ::: "memory");
    __syncthreads();
#undef HG_DMA_IMG
#undef HG_DMA_FIN
#undef HG_FINALIZE
}

__device__ __forceinline__ void phase_hgrn1(const Params& P, LAS unsigned char* lds, int layer, int G, int wv) {
    float* U = (float*)(P.ws + WS_HGU); float* Dv = (float*)(P.ws + WS_HGD);
    for (int w = blockIdx.x; w < 512; w += G) {
        const int dir = w >> 8, hh = (w >> 6) & 3, j = w & 63;
        const int seg = (j == 0) ? 64 : (dir ? 64 - j : j - 1);
        hgrn_sweep<0>(P, lds, layer, dir, hh, seg, nullptr, U + (size_t)w * 16384, Dv + (size_t)w * 128, wv);
    }
}
__device__ __forceinline__ void phase_hgrn_chain(const Params& P, int G, int wv) {
    const float* U = (const float*)(P.ws + WS_HGU); const float* Dv = (const float*)(P.ws + WS_HGD); float* Sg = (float*)(P.ws + WS_HGS);
    int tid_ = fresh_tid(wv);
    for (int t = blockIdx.x * NTHR + tid_; t < 8 * 16384; t += G * NTHR) {
        const int dh = t >> 14, el = t & 16383, d = el >> 7;
        float s = 0.f;
        Sg[((size_t)dh * 65 + 0) * 16384 + el] = 0.f;
#pragma unroll
        for (int h = 0; h < 2; ++h) {
            float uu[32], dd[32];
#pragma unroll
            for (int p = 0; p < 32; ++p) { uu[p] = U[((size_t)dh * 64 + 32 * h + p) * 16384 + el]; dd[p] = Dv[((size_t)dh * 64 + 32 * h + p) * 128 + d]; }
#pragma unroll
            for (int p = 0; p < 32; ++p) { s = dd[p] * s + uu[p]; Sg[((size_t)dh * 65 + 32 * h + p + 1) * 16384 + el] = s; }
        }
    }
}
__device__ __forceinline__ void hgrn_unit2(const Params& P, LAS unsigned char* lds, int layer, int hh, int seg, int wv) {
    const float* Sg = (const float*)(P.ws + WS_HGS);
    const int pf = (seg < 64) ? seg + 1 : 0, pb = (seg < 64) ? 64 - seg : 0;
    hgrn_sweep<1>(P, lds, layer, 0, hh, seg, pf ? Sg + ((size_t)(0 * 4 + hh) * 65 + pf) * 16384 : nullptr, nullptr, nullptr, wv);
    hgrn_sweep<2>(P, lds, layer, 1, hh, seg, pb ? Sg + ((size_t)(1 * 4 + hh) * 65 + pb) * 16384 : nullptr, nullptr, nullptr, wv);
}

constexpr int AL_K = 0, AL_KSZ = 8192, AL_V = 2 * AL_KSZ, AL_VSZ = 8192, AL_WS = 65536, AL_OST = AL_WS + 8 * 256;

__device__ __forceinline__ void glds16_s(const void* sbase, unsigned voff, unsigned lds_dst) {
    unsigned keep;
    { const unsigned long long a = (unsigned long long)(uintptr_t)sbase;
      const unsigned lo = __builtin_amdgcn_readfirstlane((unsigned)a), hi2 = __builtin_amdgcn_readfirstlane((unsigned)(a >> 32));
      sbase = (const void*)(uintptr_t)(((unsigned long long)hi2 << 32) | lo); lds_dst = __builtin_amdgcn_readfirstlane(lds_dst); }
    asm volatile("s_mov_b32 %0, m0\n\ts_mov_b32 m0, %3\n\ts_nop 0\n\tglobal_load_lds_dwordx4 %1, %2\n\ts_mov_b32 m0, %0" : "=&s"(keep) : "v"(voff), "s"(sbase), "s"(lds_dst) : "memory");
}
__device__ __forceinline__ void attn_unit(const Params& P, LAS unsigned char* lds, int layer, int hh, int qt, float lam, float oscale, int wv) {
    int tid = fresh_tid(wv);
    const int lane = tid & 63, wid = __builtin_amdgcn_readfirstlane(tid >> 6), r32 = lane & 31, hi = lane >> 5;
    const int qg = wid >> 1, mp = wid & 1;
    GAS unsigned char* wsg_ = (GAS unsigned char*)P.ws; asm volatile("" : "+s"(wsg_)); unsigned char* ws = (unsigned char*)wsg_;
    const int qrow0 = (qt < 64) ? qt * 256 : SEQ;
    const int kt_lo = (qt < 64) ? 0 : 256, kt_hi = NT / 64;
    const unsigned char* Qg = ws + WS_Q + ((size_t)hh * NT + qrow0 + 64 * qg + r32) * 128 + 64 * mp + 32 * hi;
    const char* Kg = (const char*)(ws + WS_K) + (size_t)hh * NT * 128;
    const char* Vg = (const char*)(ws + WS_VT) + (size_t)hh * 128 * LDV;
    typedef int v4i_ __attribute__((ext_vector_type(4))); typedef int v8i_ __attribute__((ext_vector_type(8)));
    v8i_ qf[2];
#pragma unroll
    for (int q2 = 0; q2 < 2; ++q2) qf[q2] = __builtin_shufflevector(*(const v4i_*)(Qg + (size_t)q2 * 32 * 128), *(const v4i_*)(Qg + (size_t)q2 * 32 * 128 + 16), 0, 1, 2, 3, 4, 5, 6, 7);
    f32x16 O[2][4];
#pragma unroll
    for (int q2 = 0; q2 < 2; ++q2)
#pragma unroll
        for (int db = 0; db < 4; ++db)
#pragma unroll
            for (int r = 0; r < 16; ++r) O[q2][db][r] = 0.f;
    float lsum0 = 0.f, lsum1 = 0.f;
    const unsigned lds0 = (unsigned)(uintptr_t)lds;
    const int ki_ = 8 * wid + (lane >> 3), vi_ = 16 * wid + (lane >> 2);
    const unsigned ko_ = (unsigned)((32 * ((ki_ >> 2) & 1) + 16 * (ki_ >> 5) + (ki_ & 3) + 4 * ((ki_ & 31) >> 3)) * 128 + (((lane & 7) ^ ((ki_ >> 1) & 7)) << 4));
    const unsigned vo_ = (unsigned)(vi_ * LDV + (((lane & 3) ^ ((vi_ >> 2) & 3)) << 4));
#define ATT_DMA(t, buf) do { \
        glds16_s(Kg + (size_t)(t) * 8192, ko_, lds0 + AL_K + (buf) * AL_KSZ + wid * 1024); \
        glds16_s(Vg + (size_t)(t) * 64, vo_, lds0 + AL_V + (buf) * AL_VSZ + wid * 1024); } while (0)
    ATT_DMA(kt_lo, 0);
    asm volatile("s_waitcnt vmcnt(0)" ::: "memory");
    __syncthreads();
    asm volatile("" : "+v"(qf[0]), "+v"(qf[1]));
    if (wid >= 4) __builtin_amdgcn_s_setprio(1);
    int cur = 0;
    const int ksw = (4 * mp + 2 * hi) ^ ((r32 >> 1) & 7), vsw = (2 * hi) ^ ((r32 >> 2) & 3);
    for (int t = kt_lo; t < kt_hi; ++t) {
        if (t + 1 < kt_hi) ATT_DMA(t + 1, cur ^ 1);
        unsigned kb0 = (unsigned)(AL_K + cur * AL_KSZ + r32 * 128 + (ksw << 4)), vb0 = (unsigned)(AL_V + cur * AL_VSZ + r32 * 64 + (vsw << 4));
        asm volatile("" : "+v"(kb0), "+v"(vb0));
        v8i_ kf[2], pa[2];
#pragma unroll
        for (int kb = 0; kb < 2; ++kb) kf[kb] = __builtin_shufflevector(*(const LAS v4i_*)(lds + kb0 + kb * 4096), *(const LAS v4i_*)(lds + (kb0 ^ 16u) + kb * 4096), 0, 1, 2, 3, 4, 5, 6, 7);
#pragma unroll
        for (int q2 = 0; q2 < 2; ++q2) {
            f32x16 s[2];
#pragma unroll
            for (int kb = 0; kb < 2; ++kb) {
#pragma unroll
                for (int r = 0; r < 16; ++r) s[kb][r] = 0.f;
                s[kb] = __builtin_amdgcn_mfma_scale_f32_32x32x64_f8f6f4(kf[kb], qf[q2], s[kb], 0, 0, 0, 0, 0, 0);
            }
            float ls = 0.f;
#pragma unroll
            for (int kb = 0; kb < 2; ++kb)
#pragma unroll
                for (int r = 0; r < 16; ++r) { s[kb][r] = __builtin_amdgcn_exp2f(s[kb][r]); ls += s[kb][r]; }
            if (q2 == 0) lsum0 += ls; else lsum1 += ls;
#pragma unroll
            for (int kb = 0; kb < 2; ++kb)
#pragma unroll
                for (int w = 0; w < 4; ++w) { int p; asm volatile("" : "=v"(p)); p = __builtin_amdgcn_cvt_pk_bf8_f32(s[kb][4 * w], s[kb][4 * w + 1], p, false);        p = __builtin_amdgcn_cvt_pk_bf8_f32(s[kb][4 * w + 2], s[kb][4 * w + 3], p, true); pa[q2][4 * kb + w] = p; }
        }
        {
            v8i_ vcur = __builtin_shufflevector(*(const LAS v4i_*)(lds + vb0), *(const LAS v4i_*)(lds + (vb0 ^ 16u)), 0, 1, 2, 3, 4, 5, 6, 7);
#pragma unroll
            for (int db = 0; db < 4; ++db) {
                v8i_ vnext = vcur;
                if (db < 3) vnext = __builtin_shufflevector(*(const LAS v4i_*)(lds + vb0 + (db + 1) * 2048), *(const LAS v4i_*)(lds + (vb0 ^ 16u) + (db + 1) * 2048), 0, 1, 2, 3, 4, 5, 6, 7);
                O[0][db] = __builtin_amdgcn_mfma_scale_f32_32x32x64_f8f6f4(pa[0], vcur, O[0][db], 1, 0, 0, 0, 0, 0);
                O[1][db] = __builtin_amdgcn_mfma_scale_f32_32x32x64_f8f6f4(pa[1], vcur, O[1][db], 1, 0, 0, 0, 0, 0);
                vcur = vnext;
            }
        }
        asm volatile("s_waitcnt vmcnt(0)" ::: "memory");
        __syncthreads();
        cur ^= 1;
    }
#undef ATT_DMA
    __builtin_amdgcn_s_setprio(0);
    lsum0 += shx(lsum0, 32, lane); lsum1 += shx(lsum1, 32, lane);
    LAS float* wsf = (LAS float*)(lds + AL_WS + wid * 256);
    if (hi == 0) { wsf[r32] = (mp ? lam : 1.f) / lsum0; wsf[32 + r32] = (mp ? lam : 1.f) / lsum1; }
    LDS_WAIT();
    LAS float* X = (LAS float*)(lds + qg * 16384);
    const float* sg = P.in[I_SUBLN] + (size_t)layer * 128;
    LAS bf16* stg = (LAS bf16*)(lds + AL_OST + qg * 8192);
#pragma unroll
    for (int q2 = 0; q2 < 2; ++q2) {
        if (mp == 1) {
#pragma unroll
            for (int r = 0; r < 16; ++r) { const float a = wsf[32 * q2 + (r & 3) + 8 * (r >> 2) + 4 * hi];
#pragma unroll
                for (int db = 0; db < 4; ++db) X[(db * 16 + r) * 64 + lane] = O[q2][db][r] * a; }
        }
        __syncthreads();
        if (mp == 0) {
            float gsc[4];
#pragma unroll
            for (int db = 0; db < 4; ++db) gsc[db] = sg[32 * db + r32] * oscale;
#pragma unroll
            for (int r = 0; r < 16; ++r) {
                const int q = (r & 3) + 8 * (r >> 2) + 4 * hi;
                const float a0 = wsf[32 * q2 + q];
                float o[4], ss = 0.f;
#pragma unroll
                for (int db = 0; db < 4; ++db) { o[db] = O[q2][db][r] * a0 - X[(db * 16 + r) * 64 + lane]; ss += o[db] * o[db]; }
#pragma unroll
                for (int off = 1; off < 32; off <<= 1) ss += shx(ss, off, lane);
                const float rstd = __builtin_amdgcn_rsqf(ss * (1.f / 128.f) + EPS);
#pragma unroll
                for (int db = 0; db < 4; ++db) stg[q * 128 + 32 * db + r32] = (bf16)(pk2(o[db] * rstd * gsc[db], 0.f) & 0xffffu);
            }
            LDS_WAIT();
            bf16* Ow = (bf16*)(ws + WS_OAB) + (size_t)(qrow0 + 64 * qg + 32 * q2) * 512 + 128 * hh;
#pragma unroll
            for (int i = 0; i < 8; ++i) { const int row = 4 * i + (lane >> 4), ch = lane & 15;
                const v4u v = *(const LAS v4u*)(stg + row * 128 + ch * 8); *(v4u*)(Ow + (size_t)row * 512 + ch * 8) = v; }
        }
        __syncthreads();
    }
}

__device__ __forceinline__ void phase_mix(const Params& P, LAS unsigned char* lds, int layer, int G, bool with_ctx, int wv, int KINDS) {
    int tid_ = fresh_tid(wv);
    const int lane = tid_ & 63;
    const float* lq = P.in[I_LAMQK] + (size_t)layer * 4 * 64;
    const float s1 = wave_sum(lq[lane] * lq[64 + lane], lane), s2 = wave_sum(lq[128 + lane] * lq[192 + lane], lane);
    const float lam_init = __int_as_float(__builtin_amdgcn_readfirstlane(__float_as_int(0.8f - 0.6f * expf(-0.3f * (float)layer))));
    const float lam = __int_as_float(__builtin_amdgcn_readfirstlane(__float_as_int(expf(s1) - expf(s2) + lam_init)));
    if (KINDS & 1) {
        const int na = with_ctx ? 260 : 256;
#pragma unroll 1
        for (int u = blockIdx.x; u < na; u += G) {
            const int hh = (u < 256) ? ((u & 7) >> 1) : (u - 256), qt = (u < 256) ? (((u >> 3) << 1) | (u & 1)) : 64;
            attn_unit(P, lds, layer, hh, qt, lam, __int_as_float(__builtin_amdgcn_readfirstlane(__float_as_int(1.f - lam_init))), wv);
        }
    }
    if (KINDS & 2) {
        const int nh = with_ctx ? 260 : 256;
#pragma unroll 1
        for (int k = 0; ; ++k) {
            int v;
            if (G == 256) { const int c = (int)blockIdx.x; if (k == 0) v = c; else if (k == 1 && with_ctx && c >= 4 && c < 8) v = 252 + c; else break; }
            else { v = (int)blockIdx.x + k * G; if (v >= nh) break; }
            hgrn_unit2(P, lds, layer, v & 3, v >> 2, wv);
        }
    }
}

constexpr int RL_RW = 0, RL_TA = RW_IMG, RL_TB = RL_TA + 8192, RL_LOG = RL_TB + 8192, RL_INFO = RL_LOG + 80 * 33 * 4, RL_CNT = RL_INFO + 80 * 32, RL_BASE = RL_CNT + 128, RL_RSTD = RL_BASE + 128;
__device__ __forceinline__ void phase_router(const Params& P, LAS unsigned char* lds, int layer, int G, int nrows, int wv) {
    int tid_ = fresh_tid(wv);
    const int tid = tid_, lane = tid & 63, wave = __builtin_amdgcn_readfirstlane(tid >> 6);
    GAS unsigned char* wsg_ = (GAS unsigned char*)P.ws; asm volatile("" : "+s"(wsg_)); unsigned char* ws = (unsigned char*)wsg_;
    LAS float* TA = (LAS float*)(lds + RL_TA); LAS float* TB = (LAS float*)(lds + RL_TB); LAS float* LOG = (LAS float*)(lds + RL_LOG);
    LAS unsigned* INFO = (LAS unsigned*)(lds + RL_INFO); LAS unsigned* LCNT = (LAS unsigned*)(lds + RL_CNT); LAS unsigned* GBASE = (LAS unsigned*)(lds + RL_BASE); LAS float* RSTD = (LAS float*)(lds + RL_RSTD);
    { const unsigned lds0 = (unsigned)(uintptr_t)lds; const unsigned char* img = ws + WS_RWIMG + (size_t)layer * RW_IMG;
      for (int pc = wave; pc < RW_IMG / 1024; pc += NWAVES) glds16_s(img + (size_t)pc * 1024, (unsigned)lane * 16u, lds0 + RL_RW + pc * 1024); }
    for (int i = tid; i < 2048; i += NTHR) { const int w = i >> 10, j = i & 1023; const float* mv = modv_ptr(P, layer, w);
        TA[i] = P.in[I_N2G][(size_t)layer * D + j] * (1.f + mv[4096 + j]); TB[i] = mv[3072 + j]; }
    const bf16* xres = (const bf16*)(ws + WS_XRES);
    const float* rb = P.in[I_RB] + (size_t)layer * NE;
    unsigned* gcnt = (unsigned*)(ws + WS_CTL) + CW_CNT + layer * 32 * 16;
    unsigned* tokinfo = (unsigned*)(ws + WS_TOK);
    bf16* XS = (bf16*)(ws + WS_XS);
    const int RB = nrows / 256;
    asm volatile("s_waitcnt vmcnt(0)" ::: "memory");
    for (int blk = blockIdx.x; blk < 256; blk += G) {
#define RROW(r) ((r) < 64 ? 64 * blk + (r) : SEQ + blk)
        if (tid < 32) LCNT[tid] = 0u;
#pragma unroll 1
        for (int rl = wave; rl < RB; rl += NWAVES) {
            const bf16* xr = xres + (size_t)RROW(rl) * D;
            float ss = 0.f;
#pragma unroll
            for (int k = 0; k < 4; ++k) { const v2u xw = *(const v2u*)(xr + 4 * lane + 256 * k); const f32x4 x = {bflo(xw.x), bfhi(xw.x), bflo(xw.y), bfhi(xw.y)}; ss += (x.x * x.x + x.y * x.y) + (x.z * x.z + x.w * x.w); }
            ss = wave_sum(ss, lane);
            if (lane == 0) RSTD[rl] = __builtin_amdgcn_rsqf(ss * (1.f / D) + EPS);
        }
        __syncthreads();
        if (16 * wave < RB) {
            const int r16 = lane & 15, kq = lane >> 4, r = 16 * wave + r16, rc = r < RB ? r : RB - 1, row = RROW(rc), wsel = row >= SEQ;
            const float rstd = RSTD[rc];
            const bf16* xr = xres + (size_t)row * D + 8 * kq;
            const LAS float* ta = TA + 1024 * wsel + 8 * kq; const LAS float* tb = TB + 1024 * wsel + 8 * kq;
            const LAS unsigned char* bh = lds + RL_RW + r16 * RW_PITCH + 16 * kq;
            f32x4 acc0 = {0.f, 0.f, 0.f, 0.f}, acc1 = {0.f, 0.f, 0.f, 0.f};
#pragma unroll 4
            for (int ks = 0; ks < 32; ++ks) {
                const v4u xw = *(const v4u*)(xr + 32 * ks); const f32x4 x0 = {bflo(xw.x), bfhi(xw.x), bflo(xw.y), bfhi(xw.y)}, x1 = {bflo(xw.z), bfhi(xw.z), bflo(xw.w), bfhi(xw.w)};
                const f32x4 a0 = *(const LAS f32x4*)(ta + 32 * ks), a1 = *(const LAS f32x4*)(ta + 32 * ks + 4), b0 = *(const LAS f32x4*)(tb + 32 * ks), b1 = *(const LAS f32x4*)(tb + 32 * ks + 4);
                const f32x4 h0 = x0 * rstd * a0 + b0, h1 = x1 * rstd * a1 + b1;
                v4u hw, lw;
                hw.x = pk2(h0.x, h0.y); hw.y = pk2(h0.z, h0.w); hw.z = pk2(h1.x, h1.y); hw.w = pk2(h1.z, h1.w);
                lw.x = pk2(h0.x - bflo(hw.x), h0.y - bfhi(hw.x)); lw.y = pk2(h0.z - bflo(hw.y), h0.w - bfhi(hw.y)); lw.z = pk2(h1.x - bflo(hw.z), h1.y - bfhi(hw.z)); lw.w = pk2(h1.z - bflo(hw.w), h1.w - bfhi(hw.w));
                const bf16x8 ah = __builtin_bit_cast(bf16x8, hw), al = __builtin_bit_cast(bf16x8, lw);
                const bf16x8 wh0 = *(const LAS bf16x8*)(bh + 64 * ks), wh1 = *(const LAS bf16x8*)(bh + 16 * RW_PITCH + 64 * ks);
                const bf16x8 wl0 = *(const LAS bf16x8*)(bh + 32 * RW_PITCH + 64 * ks), wl1 = *(const LAS bf16x8*)(bh + 48 * RW_PITCH + 64 * ks);
                acc0 = __builtin_amdgcn_mfma_f32_16x16x32_bf16(ah, wh0, acc0, 0, 0, 0); acc0 = __builtin_amdgcn_mfma_f32_16x16x32_bf16(ah, wl0, acc0, 0, 0, 0); acc0 = __builtin_amdgcn_mfma_f32_16x16x32_bf16(al, wh0, acc0, 0, 0, 0);
                acc1 = __builtin_amdgcn_mfma_f32_16x16x32_bf16(ah, wh1, acc1, 0, 0, 0); acc1 = __builtin_amdgcn_mfma_f32_16x16x32_bf16(ah, wl1, acc1, 0, 0, 0); acc1 = __builtin_amdgcn_mfma_f32_16x16x32_bf16(al, wh1, acc1, 0, 0, 0);
            }
#pragma unroll
            for (int i = 0; i < 4; ++i) { const int rr = 16 * wave + 4 * kq + i; if (rr < RB) { LOG[rr * 33 + r16] = acc0[i]; LOG[rr * 33 + 16 + r16] = acc1[i]; } }
        }
        __syncthreads();
        if (tid < RB) {
            float p[NE];
#pragma unroll
            for (int e = 0; e < NE; ++e) p[e] = LOG[tid * 33 + e] + rb[e];
            float tv[4]; int ti[4];
#pragma unroll
            for (int k = 0; k < 4; ++k) { float best = -3.0e38f; int bi = 0;
#pragma unroll
                for (int e = 0; e < NE; ++e) { const bool gt = p[e] > best; best = gt ? p[e] : best; bi = gt ? e : bi; }
                tv[k] = best; ti[k] = bi;
#pragma unroll
                for (int e = 0; e < NE; ++e) p[e] = (e == bi) ? -3.0e38f : p[e]; }
            float wk[4], wsum = 0.f;
#pragma unroll
            for (int k = 0; k < 4; ++k) { wk[k] = expf(tv[k] - tv[0]); wsum += wk[k]; }
#pragma unroll
            for (int k = 0; k < 4; ++k) { const unsigned pos = __hip_atomic_fetch_add(&LCNT[ti[k]], 1u, __ATOMIC_RELAXED, __HIP_MEMORY_SCOPE_WORKGROUP); INFO[tid * 8 + 2 * k] = ((unsigned)ti[k] << 16) | pos; INFO[tid * 8 + 2 * k + 1] = __float_as_uint(wk[k] / wsum); }
        }
        __syncthreads();
        if (tid < 32) GBASE[tid] = __hip_atomic_fetch_add(gcnt + tid * 16, LCNT[tid], RLX_AGENT);
        __syncthreads();
#pragma unroll 1
        for (int rl = wave; rl < RB; rl += NWAVES) {
            const int row = RROW(rl), w = row >= SEQ;
            const bf16* xr = xres + (size_t)row * D + 16 * lane;
            const float rstd = RSTD[rl];
            v4u o8;
            {
                f32x4 v[4];
#pragma unroll
                for (int j = 0; j < 4; ++j) { const v2u xw = *(const v2u*)(xr + 4 * j); const f32x4 xv = {bflo(xw.x), bfhi(xw.x), bflo(xw.y), bfhi(xw.y)}; const f32x4 a = *(const LAS f32x4*)(TA + 1024 * w + 16 * lane + 4 * j), b = *(const LAS f32x4*)(TB + 1024 * w + 16 * lane + 4 * j); v[j] = xv * rstd * a + b; }
                o8.x = pk_fp8x4(v[0].x, v[0].y, v[0].z, v[0].w); o8.y = pk_fp8x4(v[1].x, v[1].y, v[1].z, v[1].w); o8.z = pk_fp8x4(v[2].x, v[2].y, v[2].z, v[2].w); o8.w = pk_fp8x4(v[3].x, v[3].y, v[3].z, v[3].w);
            }
#pragma unroll
            for (int k = 0; k < 4; ++k) {
                const unsigned ep = INFO[rl * 8 + 2 * k], wb = INFO[rl * 8 + 2 * k + 1];
                const unsigned e = ep >> 16, slot = GBASE[e] + (ep & 0xffffu);
                unsigned char* dst = (unsigned char*)XS + ((size_t)e * CAP + slot) * D + 16 * lane;
                *(v4u*)dst = o8;
                if (lane == 0) { v4u ti4; ti4.x = e; ti4.y = slot; ti4.z = wb; ti4.w = 0u; *(v4u*)(tokinfo + (size_t)row * 16 + 4 * k) = ti4; }
            }
        }
        __syncthreads();
#undef RROW
    }
}

template <bool DRY>
__device__ __forceinline__ void phase_combine(const Params& P, LAS unsigned char* lds, int layer, int G, int nrows, int wv) {
    int tid_ = fresh_tid(wv);
    const int tid = tid_, lane = tid & 63, wave = tid >> 6;
    GAS unsigned char* wsg_ = (GAS unsigned char*)P.ws; asm volatile("" : "+s"(wsg_)); unsigned char* ws = (unsigned char*)wsg_;
    const bool last = (layer == DEPTH - 1);
    LAS float* TA = (LAS float*)lds; LAS float* TB = (LAS float*)(lds + 8192); LAS float* TG = (LAS float*)(lds + 16384);
    for (int i = tid; i < 2048; i += NTHR) { const int w = i >> 10, j = i & 1023;
        TG[i] = modv_ptr(P, layer, w)[5120 + j];
        if (!last) { const float* mv = modv_ptr(P, layer + 1, w); TA[i] = P.in[I_N1G][(size_t)(layer + 1) * D + j] * (1.f + mv[1024 + j]); TB[i] = mv[j]; } }
    __syncthreads();
    bf16* xres = (bf16*)(ws + WS_XRES);
    bf16* xdst = DRY ? (bf16*)(ws + WS_HDN) : xres;
    const unsigned* tokinfo = (const unsigned*)(ws + WS_TOK);
    const bf16* Y = (const bf16*)(ws + WS_XS);
    bf16* H = DRY ? (bf16*)(ws + WS_HDN + (size_t)NT * D * 4) : (bf16*)(ws + WS_H);
#pragma unroll 2
    for (int row = blockIdx.x * NWAVES + wave; row < nrows; row += G * NWAVES) {
        const int w = row >= SEQ;
        f32x4 acc[4];
#pragma unroll
        for (int j = 0; j < 4; ++j) acc[j] = (f32x4){0.f, 0.f, 0.f, 0.f};
#pragma unroll
        for (int k = 0; k < 4; ++k) {
            const v4u ti4 = *(const v4u*)(tokinfo + (size_t)row * 16 + 4 * k);
            const float wk = __uint_as_float(ti4.z);
            const bf16* yr = Y + ((size_t)ti4.x * CAP + ti4.y) * D + 4 * lane;
#pragma unroll
            for (int j = 0; j < 4; ++j) { const v2u yv = *(const v2u*)(yr + 256 * j); acc[j] += wk * (f32x4){bflo(yv.x), bfhi(yv.x), bflo(yv.y), bfhi(yv.y)}; }
        }
        const bf16* xr = xres + (size_t)row * D + 4 * lane;
        f32x4 v[4];
#pragma unroll
        for (int j = 0; j < 4; ++j) { const v2u xw = *(const v2u*)(xr + 256 * j); v[j] = (f32x4){bflo(xw.x), bfhi(xw.x), bflo(xw.y), bfhi(xw.y)} + *(const LAS f32x4*)(TG + 1024 * w + 4 * lane + 256 * j) * acc[j]; }
        if (last) {
            float* orow = (DRY ? (float*)xdst : P.out) + (size_t)row * D + 4 * lane;
#pragma unroll
            for (int j = 0; j < 4; ++j) *(f32x4*)(orow + 256 * j) = v[j];
        } else {
#pragma unroll
            for (int j = 0; j < 4; ++j) { v2u o; o.x = pk2(v[j].x, v[j].y); o.y = pk2(v[j].z, v[j].w); *(v2u*)(xdst + (size_t)row * D + 4 * lane + 256 * j) = o; }
            norm_store_row(v, TA + 1024 * w, TB + 1024 * w, (unsigned char*)H + (size_t)row * D, lane);
        }
    }
}
#define XB_TMO      128
#define XB_XCNT(j)  (256  + 64 * (j))
#define XB_XSUB(j)  (1280 + 64 * (j))
#define XB_XGEN(j)  (2304 + 64 * (j))
#define XB_TOP      3328
#define XB_TOPGEN   3392
#define XCD_BAR_WORDS 3456
#define XB_SPIN_CAP (1u << 18)

__device__ __forceinline__ unsigned xb_ld(unsigned* p)              { return __hip_atomic_load(p, __ATOMIC_RELAXED, __HIP_MEMORY_SCOPE_AGENT); }
__device__ __forceinline__ unsigned xb_add(unsigned* p, unsigned v) { return __hip_atomic_fetch_add(p, v, __ATOMIC_RELAXED, __HIP_MEMORY_SCOPE_AGENT); }
__device__ __forceinline__ unsigned xb_xcc_id() { return (unsigned)__builtin_amdgcn_s_getreg((3 << 11) | 20) & 0xFu; }
#define XB_SPIN(cond, bar) do { unsigned _sp = 0; while (cond) { __builtin_amdgcn_s_sleep(1); \
    if ((++_sp & 255u) == 0u) { if (xb_ld(&(bar)[XB_TMO])) break; if (_sp > XB_SPIN_CAP) { atomicAdd(&(bar)[XB_TMO], 1u); break; } } } } while (0)

struct XcdBarrier {
    int wv; unsigned* bar; unsigned x;
    volatile LAS unsigned* st;
};

__device__ __forceinline__ XcdBarrier xcd_barrier_post(unsigned* bar, volatile LAS unsigned* st, int wv) {
    XcdBarrier b; b.wv = wv; b.bar = bar; b.x = xb_xcc_id(); b.st = st;
    if (fresh_tid(wv) == 0) (void)xb_add(&bar[XB_XCNT(b.x)], 1u);
    return b;
}
__device__ __forceinline__ void xcd_barrier_complete(unsigned* bar, unsigned x, unsigned& nloc, unsigned& nx) {
    const unsigned G = gridDim.x * gridDim.y * gridDim.z;
    unsigned sum, cnt, mine, sp = 0u;
    for (;;) {
        sum = 0u; cnt = 0u; mine = 0u;
#pragma unroll
        for (unsigned j = 0; j < 16; ++j) { const unsigned c = xb_ld(&bar[XB_XCNT(j)]); sum += c; cnt += (c > 0u) ? 1u : 0u; mine = (j == x) ? c : mine; }
        if (sum == G) break;
        __builtin_amdgcn_s_sleep(1);
        if ((++sp & 255u) == 0u) { if (xb_ld(&bar[XB_TMO])) break; if (sp > XB_SPIN_CAP) { atomicAdd(&bar[XB_TMO], 1u); break; } }
    }
    nloc = mine > 0u ? mine : 1u; nx = cnt > 0u ? cnt : 1u;
}

__device__ __forceinline__ void xcd_barrier(const XcdBarrier& b) {
    asm volatile("s_waitcnt vmcnt(0)" ::: "memory");
    __syncthreads();
    if (fresh_tid(b.wv) == 0) {
        unsigned* bar = b.bar;
        __builtin_amdgcn_s_waitcnt(0);
        unsigned nloc = b.st[0], nx = b.st[1];
        if (nloc == 0u) { xcd_barrier_complete(bar, b.x, nloc, nx); b.st[0] = nloc; b.st[1] = nx; }
        const unsigned old = xb_add(&bar[XB_XSUB(b.x)], 1u);
        const unsigned gen = old / nloc;
        if (old + 1u == (gen + 1u) * nloc) {
            __builtin_amdgcn_fence(__ATOMIC_RELEASE, "agent");
            asm volatile("s_waitcnt vmcnt(0)" ::: "memory");
            const unsigned og = xb_add(&bar[XB_TOP], 1u);
            const unsigned tg = og / nx;
            if (og + 1u == (tg + 1u) * nx) xb_add(&bar[XB_TOPGEN], 1u);
            else XB_SPIN(xb_ld(&bar[XB_TOPGEN]) == tg, bar);
            __builtin_amdgcn_fence(__ATOMIC_ACQUIRE, "agent");
            xb_add(&bar[XB_XGEN(b.x)], 1u);
            asm volatile("s_waitcnt vmcnt(0)" ::: "memory");
        } else {
            XB_SPIN(xb_ld(&bar[XB_XGEN(b.x)]) == gen, bar);
            __builtin_amdgcn_fence(__ATOMIC_ACQUIRE, "agent");
            asm volatile("s_waitcnt vmcnt(0)" ::: "memory");
        }
    }
    __syncthreads();
}


__global__ void __launch_bounds__(NTHR, 2) fwd_kernel(Params P) {
    extern __shared__ __attribute__((aligned(16))) unsigned char lds_raw[];
    LAS unsigned char* lds = (LAS unsigned char*)lds_raw;
    volatile LAS unsigned* MISC = (volatile LAS unsigned*)(lds + MISC_OFF);
    const int wv = __builtin_amdgcn_readfirstlane((int)(threadIdx.x >> 6)), G = gridDim.x;
#define tid fresh_tid(wv)
    unsigned char* ws = P.ws;
    unsigned* ctl = (unsigned*)(ws + WS_CTL);
    if (tid < 64) MISC[tid] = 0u;
    __syncthreads();
#if MK_ONE_LAUNCH
    XcdBarrier bar = xcd_barrier_post(ctl + CW_BAR, MISC + 8, wv);
#define GRID_BAR() xcd_barrier(bar)
#else
#define GRID_BAR() do {} while (0)
#endif
    const int lo = P.ph_lo, hi = P.ph_hi;
#ifndef PHM
#define PHM 0x3FFF
#endif
#define IN(k) (lo <= (k) && (k) < hi)
#define EN(b) ((PHM >> (b)) & 1)
#ifdef PROBE_PH
    unsigned long long* stamps = (unsigned long long*)(ws + WS_CTL + 512 * 1024);
#define STAMP(k) do { if (blockIdx.x == 0 && tid == 0) stamps[k] = __builtin_amdgcn_s_memrealtime(); } while (0)
#else
#define STAMP(k) do {} while (0)
#endif
    STAMP(0);
#define SEAM(k) do { int lo_ = lo, hi_ = hi; asm volatile("" : "+s"(lo_), "+s"(hi_));     \
        if (lo_ <= (k) && (k) + 1 < hi_) GRID_BAR(); STAMP((k) + 1); } while (0)

    constexpr int BG_A = 5120, BG_D = 8192, BG_E = 6656;
#ifndef DUP_PH
#define DUP_PH -1
#endif
#define DUPQ(t) (DUP_PH == (t))
    if (EN(12) && IN(0)) { phase_p0a(P, lds, G, wv); if (DUPQ(10)) { GRID_BAR(); phase_p0a(P, lds, G, wv); } SEAM(0); }
    if (EN(13) && IN(1)) { phase_p0b(P, lds, G, wv); SEAM(1); }

    for (int l = 0; l < DEPTH; ++l) {
        const int pb = NPH_PRO + NPH_LAYER * l;
        const bool last = (l == DEPTH - 1);
        const int nrows = last ? SEQ : NT;
        bf16* H = (bf16*)(ws + WS_H);
        if (EN(0) && IN(pb + 0)) {
            GAS unsigned char* wsg_ = (GAS unsigned char*)P.ws; asm volatile("" : "+s"(wsg_)); unsigned char* ws = (unsigned char*)wsg_;
            for (int rep = 0; rep < (DUPQ(0) ? 2 : 1); ++rep) {
            if (rep) GRID_BAR();
            { pg8::Gemm g{H, (const bf16*)(ws + WS_WIN + l * WIN_L), NT, 5632, D / 2};        int c1 = (int)blockIdx.x; asm volatile("" : "+s"(c1)); pg8::StaticOrder S; S.init(NT, 5632, G, c1);
              EpiInProj E{(bf16*)(ws + WS_Q), (bf16*)(ws + WS_K), (bf16*)(ws + WS_PROJ), P.in[I_QNG] + l * 64, P.in[I_KNG] + l * 64, (const float*)(ws + WS_ROPE), ws + WS_IMG, (const float*)(ws + WS_LB) + (size_t)l * 512};
              pg8::gemm_phase<EpiInProj, pg8::StaticOrder, true, true>(lds, g, S, E, wv); }
            { pg8::Gemm g{(const bf16*)(ws + WS_WV + l * WV_L), H, 512, NT, D / 2}; int c2 = (int)(blockIdx.x + 106 < (unsigned)G ? blockIdx.x + 106 : (blockIdx.x + 106) % (unsigned)G); asm volatile("" : "+s"(c2));
              pg8::StaticOrder S; S.init(512, NT, G, c2);
              EpiVt E{(bf16*)(ws + WS_VT)};
              pg8::gemm_phase<EpiVt, pg8::StaticOrder, true, true>(lds, g, S, E, wv); }
            }
            if (!last && G == 256) { const int c = (int)blockIdx.x; __syncthreads(); if (c >= 24) convert_items(P, lds, PER_L * (l + 1), PER_L * (l + 1) + BG_A, c - 24, 232, wv); }
            SEAM(pb + 0);
        }
        if (EN(2) && IN(pb + 2)) { phase_hgrn1(P, lds, l, G, wv); if (DUPQ(1)) { GRID_BAR(); phase_hgrn1(P, lds, l, G, wv); } SEAM(pb + 2); }
        if (EN(3) && IN(pb + 3)) { phase_hgrn_chain(P, G, wv); if (DUPQ(2)) { GRID_BAR(); phase_hgrn_chain(P, G, wv); } SEAM(pb + 3); }
        if (EN(4) && IN(pb + 4)) {
#pragma unroll 1
            for (int rep = 0; rep < ((DUPQ(31) || DUPQ(32)) ? 2 : 1); ++rep) { if (rep) GRID_BAR(); phase_mix(P, lds, l, G, !last, wv, rep == 0 ? 3 : (DUPQ(31) ? 1 : 2)); }
            if (!last && G == 256) { const int c = (int)blockIdx.x; __syncthreads(); if (c >= 8) convert_items(P, lds, PER_L * (l + 1) + BG_A, PER_L * (l + 1) + BG_A + BG_D, c - 8, 248, wv); }
            SEAM(pb + 4); }
        if (EN(5) && IN(pb + 5)) {
            GAS unsigned char* wsg_ = (GAS unsigned char*)P.ws; asm volatile("" : "+s"(wsg_)); unsigned char* ws = (unsigned char*)wsg_;
            pg8::Gemm g{(const bf16*)(ws + WS_OAB), (const bf16*)(ws + WS_WAB + l * WAB_L), 2 * NT, 2048, 512};
            pg8::MergeOrder S{nrows / 256, G, (int)blockIdx.x};
            EpiMerge E{(const bf16*)(ws + WS_PROJ), (bf16*)(ws + WS_U)};
            pg8::gemm_phase<EpiMerge, pg8::MergeOrder, true, true>(lds, g, S, E, wv);
            if (DUPQ(50)) { GRID_BAR(); pg8::gemm_phase<EpiMerge, pg8::MergeOrder, true, true>(lds, g, S, E, wv); }
            if (!last && G == 256) { const int c = (int)blockIdx.x; __syncthreads(); if (!((c & 7) == 0 && c < 32)) { const int nb = (c + 7) >> 3; convert_items(P, lds, PER_L * (l + 1) + BG_A + BG_D, PER_L * (l + 1) + BG_A + BG_D + BG_E, c - (nb < 4 ? nb : 4), 252, wv); } }
            SEAM(pb + 5);
        }
        if (EN(6) && IN(pb + 6)) {
            GAS unsigned char* wsg_ = (GAS unsigned char*)P.ws; asm volatile("" : "+s"(wsg_)); unsigned char* ws = (unsigned char*)wsg_;
            pg8::Gemm g{(const bf16*)(ws + WS_U), (const bf16*)(ws + WS_WO + l * WO_L), nrows, D, D}; pg8::StaticOrder S; S.init(nrows, D, G, (int)blockIdx.x);
            EpiOut E{(const bf16*)(ws + WS_XRES), (bf16*)(ws + WS_XRES), modv_ptr(P, l, 0) + 2048, modv_ptr(P, l, 1) + 2048};
            if (DUPQ(6)) { EpiOut E2 = E; E2.xres = (bf16*)(ws + WS_HDN); pg8::gemm_phase<EpiOut, pg8::StaticOrder, true, true>(lds, g, S, E2, wv); GRID_BAR(); }
            pg8::gemm_phase<EpiOut, pg8::StaticOrder, true, true>(lds, g, S, E, wv);
            if (!last && G == 256) { const int c = (int)blockIdx.x; __syncthreads(); if (c >= 4) convert_items(P, lds, PER_L * (l + 1) + BG_A + BG_D + BG_E, PER_L * (l + 2), c - 4, 252, wv); }
            SEAM(pb + 6);
        }
        if (EN(7) && IN(pb + 7)) {
#pragma unroll 1
            for (int rep = 0; rep < (DUPQ(7) ? 2 : 1); ++rep) {
                if (rep) { GRID_BAR(); if (blockIdx.x == 0 && tid < 32) __hip_atomic_store(ctl + CW_CNT + l * 32 * 16 + tid * 16, 0u, RLX_AGENT); GRID_BAR(); }
                phase_router(P, lds, l, G, nrows, wv); }
            SEAM(pb + 7); }
        if ((EN(8) && IN(pb + 8)) || (EN(9) && IN(pb + 9))) {
            GAS unsigned char* wsg_ = (GAS unsigned char*)P.ws; asm volatile("" : "+s"(wsg_)); unsigned char* ws = (unsigned char*)wsg_;
            LAS unsigned* utab8 = (LAS unsigned*)(lds + 131072); LAS unsigned* utab4 = utab8 + 32; LAS int* ptab = (LAS int*)(utab8 + 64);
            { const int t_ = tid;
              if (t_ == 0) { const unsigned* gcnt = ctl + CW_CNT + l * 32 * 16; int run = 0;
                  for (int e = 0; e < NE; ++e) { ptab[e] = run; run += (int)((__hip_atomic_load(gcnt + e * 16, RLX_AGENT) + 255u) >> 8); } ptab[32] = run; }
              __syncthreads();
              if (t_ < 64) { const int i = t_ & 31, lg = (t_ < 32) ? 3 : 2; const int c_ = (int)blockIdx.x;
                  int tr, pn;
                  if ((G & 63) == 0) { const int x = c_ & 7, q = c_ >> 3, per = (G >> 3) >> lg; pn = q & ((1 << lg) - 1); tr = (i * 8 + x) * per + (q >> lg); }
                  else { const int L = i * G + c_; tr = L >> lg; pn = L & ((1 << lg) - 1); }
                  unsigned v = 0xffffffffu;
                  if (tr < ptab[32]) { int e = 0; for (int j = 1; j < 32; ++j) e = (tr >= ptab[j]) ? j : e; v = ((unsigned)(65 * e + (tr - ptab[e])) << 16) | (unsigned)((e << lg) + pn); }
                  (t_ < 32 ? utab8 : utab4)[i] = v; }
              __syncthreads(); }
            if (EN(8) && IN(pb + 8)) {
                pg8::Gemm g{(const bf16*)(ws + WS_XS), (const bf16*)(ws + WS_WGU + l * WGU_L), NE * CAP, NE * 2048, D / 2};
                pg8::MoeOrder S{utab8};
                EpiSwiglu E{(bf16*)(ws + WS_HDN), P.in[I_BGU] + (size_t)l * NE * 2048};
                pg8::gemm_phase<EpiSwiglu, pg8::MoeOrder, true, true>(lds, g, S, E, wv);
                if (DUPQ(8)) { GRID_BAR(); pg8::gemm_phase<EpiSwiglu, pg8::MoeOrder, true, true>(lds, g, S, E, wv); }
                SEAM(pb + 8);
            }
            if (EN(9) && IN(pb + 9)) {
                pg8::Gemm g{(const bf16*)(ws + WS_HDN), (const bf16*)(ws + WS_WD + l * WD_L), NE * CAP, NE * 1024, DFF / 2};
                pg8::MoeOrder S{utab4};
                EpiDown E{(bf16*)(ws + WS_XS), P.in[I_BDN] + (size_t)l * NE * D};
                pg8::gemm_phase<EpiDown, pg8::MoeOrder, true, true>(lds, g, S, E, wv);
                if (DUPQ(9)) { GRID_BAR(); pg8::gemm_phase<EpiDown, pg8::MoeOrder, true, true>(lds, g, S, E, wv); }
                SEAM(pb + 9);
            }
        }
        if (EN(10) && IN(pb + 10)) { if (DUPQ(11)) { phase_combine<true>(P, lds, l, G, nrows, wv); GRID_BAR(); } phase_combine<false>(P, lds, l, G, nrows, wv); SEAM(pb + 10); }
    }
#ifdef PROBE_PH
    if (blockIdx.x == 0 && tid == 0) {
        unsigned long long tot = 0;
        for (int k = 0; k < NPHASES; ++k) { const int ty = k < 2 ? 12 + k : (k - 2) % 11; if (ty == PROBE_PH || PROBE_PH == 99) tot += stamps[k + 1] - stamps[k]; }
        *(float*)(ws + WS_CTL + 768 * 1024) = 1.f + (float)tot * (1.f / 10000.f);
    }
    GRID_BAR();
    { const float sc = 1.f + *(const float*)(ws + WS_CTL + 768 * 1024);
      for (size_t i = (size_t)blockIdx.x * NTHR + tid; i < (size_t)SEQ * D; i += (size_t)G * NTHR) P.out[i] *= sc; }
#endif
#undef tid
#undef IN
#undef EN
#undef SEAM
#undef GRID_BAR
}

extern "C" void kernel_launch(void* const* d_in, const int* in_sizes, int n_in, void* d_out, int out_size, void* d_ws, size_t ws_size, hipStream_t stream) {
    static int grid = 0;
    if (grid == 0) {
        if (n_in != 24 || out_size != SEQ * D || ws_size < WS_END3) { fprintf(stderr, "kernel_launch: unexpected shapes (n_in %d, out %d, ws %zu < %zu)\n", n_in, out_size, ws_size, (size_t)WS_END3); grid = -1; return; }
        int dev = 0, cus = 0;
        if (hipGetDevice(&dev) != hipSuccess || hipDeviceGetAttribute(&cus, hipDeviceAttributeMultiprocessorCount, dev) != hipSuccess) { grid = -1; return; }
        if (hipFuncSetAttribute((const void*)fwd_kernel, hipFuncAttributeMaxDynamicSharedMemorySize, LDS_BYTES) != hipSuccess) { fprintf(stderr, "kernel_launch: hipFuncSetAttribute failed\n"); grid = -1; return; }
        int per_cu = 0;
        if (hipOccupancyMaxActiveBlocksPerMultiprocessor(&per_cu, (const void*)fwd_kernel, NTHR, LDS_BYTES) != hipSuccess || per_cu < 1) fprintf(stderr, "kernel_launch: occupancy query reports %d\n", per_cu);
        (void)hipGetLastError();
        grid = cus;
    }
    if (grid < 0) return;
    (void)hipMemsetAsync((char*)d_ws + WS_CTL, 0, CTL_ZERO_BYTES, stream);
    Params p{};
    for (int i = 0; i < 24; ++i) p.in[i] = (const float*)d_in[i];
    p.out = (float*)d_out; p.ws = (unsigned char*)d_ws;
#if MK_ONE_LAUNCH
    p.ph_lo = 0; p.ph_hi = NPHASES;
    hipLaunchKernelGGL(fwd_kernel, dim3(grid), dim3(NTHR), LDS_BYTES, stream, p);
#else
    for (int k = 0; k < NPHASES; ++k) { p.ph_lo = k; p.ph_hi = k + 1; hipLaunchKernelGGL(fwd_kernel, dim3(grid), dim3(NTHR), LDS_BYTES, stream, p); }
#endif
}
```

```cpp
#include <hip/hip_runtime.h>
#include <cstdio>
#include <cstdint>

#ifndef MK_ONE_LAUNCH
#define MK_ONE_LAUNCH 1
#endif

#define GAS __attribute__((address_space(1)))
#define LAS __attribute__((address_space(3)))
typedef unsigned short bf16;
typedef unsigned v4u __attribute__((ext_vector_type(4)));
typedef unsigned v2u __attribute__((ext_vector_type(2)));
typedef float f32x4 __attribute__((ext_vector_type(4)));
typedef float f32x16 __attribute__((ext_vector_type(16)));
typedef short bf16x8 __attribute__((ext_vector_type(8)));
typedef short s16x4 __attribute__((ext_vector_type(4)));
typedef float f32x2_t __attribute__((ext_vector_type(2)));
typedef __bf16 bf16x2_t __attribute__((ext_vector_type(2)));

constexpr int D = 1024, SEQ = 16384, LC = 256, NT = SEQ + LC, DEPTH = 4;
constexpr int INC = 6144, NE = 32, DFF = 1024, TOPK = 4;
constexpr int CAP = NT;
constexpr int PROJW = 4608;
constexpr int PC_QH = 0, PC_ZF = 512, PC_ZB = 1024, PC_VH = 1536, PC_GH = 2048, PC_GA = 2560, PC_GB = 3584;
constexpr int LDV = NT;
constexpr float EPS = 1e-6f;
constexpr int NWAVES = 8, NTHR = 512;
constexpr int NPH_PRO = 2, NPH_LAYER = 11, NPHASES = NPH_PRO + NPH_LAYER * DEPTH;

constexpr size_t MiB = 1u << 20;
constexpr size_t WS_CTL = 0, CTL_ZERO_BYTES = 1 * MiB;
constexpr size_t WS_MODP = 1 * MiB;
constexpr size_t WS_MODV = WS_MODP + 2 * MiB;
constexpr size_t WS_LB = WS_MODV + 1 * MiB;
constexpr size_t WS_ROPE = WS_LB + 1 * MiB;
constexpr size_t WS_WIN = WS_ROPE + 1 * MiB;
constexpr size_t WIN_L = (size_t)5632 * 1024 * 2;
constexpr size_t WS_WV = WS_WIN + 4 * WIN_L;
constexpr size_t WV_L = (size_t)512 * 1024 * 2;
constexpr size_t WS_WAB = WS_WV + 4 * WV_L;
constexpr size_t WAB_L = (size_t)2048 * 512 * 2;
constexpr size_t WS_WO = WS_WAB + 4 * WAB_L;
constexpr size_t WO_L = (size_t)1024 * 1024 * 2;
constexpr size_t WS_WGU = WS_WO + 4 * WO_L;
constexpr size_t WGU_E = (size_t)2048 * 1024 * 2, WGU_L = 32 * WGU_E;
constexpr size_t WS_WD = WS_WGU + 4 * WGU_L;
constexpr size_t WD_E = (size_t)1024 * 1024 * 2, WD_L = 32 * WD_E;
constexpr size_t WS_XRES = WS_WD + 4 * WD_L;
constexpr size_t WS_H = WS_XRES + (size_t)NT * D * 4;
constexpr size_t WS_Q = WS_H + (size_t)NT * D * 2;
constexpr size_t WS_K = WS_Q + (size_t)NT * 512 * 2;
constexpr size_t WS_VT = WS_K + (size_t)NT * 512 * 2;
constexpr size_t WS_PROJ = WS_VT + (size_t)512 * LDV * 2;
constexpr size_t WS_OAB = WS_PROJ + (size_t)NT * PROJW * 2;
constexpr size_t WS_OBF = WS_OAB + (size_t)2 * NT * 512 * 2;
constexpr size_t WS_U = WS_OBF + (size_t)NT * 512 * 4;
constexpr size_t WS_HGU = WS_U + (size_t)NT * D * 2;
constexpr size_t WS_HGD = WS_HGU + (size_t)512 * 16384 * 4;
constexpr size_t WS_HGS = WS_HGD + 1 * MiB;
constexpr size_t WS_TOK = WS_HGS + (size_t)520 * 16384 * 4;
constexpr size_t WS_XS = WS_TOK + (size_t)NT * 64;
constexpr size_t SLAB = (size_t)NE * CAP * D * 2;
constexpr size_t WS_HDN = WS_XS + SLAB;
constexpr size_t WS_END = WS_HDN + SLAB;
constexpr int IM_BYTES = 21504;
constexpr size_t WS_IMG = WS_END;
constexpr size_t WS_END2 = WS_IMG + (size_t)8 * 65 * 16 * IM_BYTES;
constexpr int RW_PITCH = 2064, RW_IMG = 2 * 32 * RW_PITCH;
constexpr size_t WS_RWIMG = WS_END2;
constexpr size_t WS_END3 = WS_RWIMG + (size_t)DEPTH * RW_IMG + 4096;
constexpr int CW_TMO = 0;
constexpr int CW_BAR = 4096;
constexpr int CW_CNT = 16384;

constexpr int LDS_BYTES = 162816;
constexpr int MISC_OFF = LDS_BYTES - 256;

#define RLX_AGENT __ATOMIC_RELAXED, __HIP_MEMORY_SCOPE_AGENT
__device__ __forceinline__ unsigned pk2(float lo, float hi) { f32x2_t v = {lo, hi}; bf16x2_t b = __builtin_convertvector(v, bf16x2_t); return __builtin_bit_cast(unsigned, b); }
__device__ __forceinline__ float bflo(unsigned w) { return __uint_as_float(w << 16); }
__device__ __forceinline__ float bfhi(unsigned w) { return __uint_as_float(w & 0xffff0000u); }
__device__ __forceinline__ float bf2f(bf16 b) { return __uint_as_float(((unsigned)b) << 16); }
__device__ __forceinline__ int fresh_tid(int wv) { int l; asm volatile("v_mbcnt_lo_u32_b32 %0, -1, 0\n\tv_mbcnt_hi_u32_b32 %0, -1, %0" : "=v"(l)); return wv * 64 + l; }
__device__ __forceinline__ float shx(float v, int off, int lane) { return __int_as_float(__builtin_amdgcn_ds_bpermute((lane ^ off) << 2, __float_as_int(v))); }
__device__ __forceinline__ float wave_sum(float v, int lane) {
#pragma unroll
    for (int o = 1; o < 64; o <<= 1) v += shx(v, o, lane);
    return v;
}
__device__ __forceinline__ float fast_exp(float x) { return __builtin_amdgcn_exp2f(x * 1.4426950408889634f); }
__device__ __forceinline__ float fast_log(float x) { return __builtin_amdgcn_logf(x) * 0.6931471805599453f; }
__device__ __forceinline__ float fast_rcp(float x) { return __builtin_amdgcn_rcpf(x); }
__device__ __forceinline__ float sigmoidf_(float x) { return fast_rcp(1.f + fast_exp(-x)); }
__device__ __forceinline__ unsigned pk_fp8x4(float a, float b, float c, float d) { int p = __builtin_amdgcn_cvt_pk_fp8_f32(a, b, 0, false); p = __builtin_amdgcn_cvt_pk_fp8_f32(c, d, p, true); return (unsigned)p; }
constexpr float W8_SCALE = 32.f;
__device__ __forceinline__ int perm8(int s) { return (s & ~31) | (((s >> 2) & 1) << 4) | (((s >> 3) & 3) << 2) | (s & 3); }

namespace pg8 {
#define PG8_LAS __attribute__((address_space(3)))
typedef unsigned short bf16_t;
typedef short bf16x8 __attribute__((ext_vector_type(8)));
typedef float f32x4 __attribute__((ext_vector_type(4)));
typedef unsigned u32x4 __attribute__((ext_vector_type(4)));
constexpr int BM = 256, BK = 64, HALF = 128, HTB = HALF * BK * 2  , STAGE_BYTES = 8 * HTB, NXCD = 8, WGM = 3;

__host__ __device__ __forceinline__ int lds_byte(int r, int c) { const int st = (r >> 4) * 2 + (c >> 5), rr = r & 15, cc = c & 31, ob = rr * 64 + cc * 2; return st * 1024 + (ob ^ (((ob >> 9) & 1) << 5)); }
__host__ __device__ __forceinline__ void stage_rc(int b, int& R, int& C) { const int st = b / 1024, sb = b % 1024, swz = sb ^ (((sb >> 9) & 1) << 5); R = (st >> 1) * 16 + swz / 64; C = (st & 1) * 32 + (swz % 64) / 2; }
__host__ __device__ __forceinline__ int perm32(int rho) { const int n = rho >> 4, i = rho & 15; return 8 * (i >> 2) + 4 * n + (i & 3); }

struct Unit { int pm, pn; };
struct Gemm { const bf16_t* A; const bf16_t* Bt; int M, N, K; };
struct StaticOrder {
    int nM, nN, nwg, G, c;
    __host__ __device__ void init(int M, int N, int G_, int c_) { nM = M / BM; nN = N / BM; nwg = nM * nN; G = G_; c = c_; }
    __host__ __device__ bool next(int i, Unit& u) const {
        const long L = (long)i * G + c; if (L >= nwg) return false;
        int wgid = (int)L; { const int q = nwg / NXCD, r = nwg % NXCD, xcd = wgid % NXCD, off = wgid / NXCD; wgid = (xcd < r ? xcd * (q + 1) : r * (q + 1) + (xcd - r) * q) + off; }
        const int nig = WGM * nN, gid = wgid / nig, fm = gid * WGM, gsz = (nM - fm) < WGM ? (nM - fm) : WGM;
        u.pm = fm + ((wgid % nig) % gsz); u.pn = (wgid % nig) / gsz; return true;
    }
    __device__ __forceinline__ void a_ready(const Unit&) const {}
    __device__ __forceinline__ void done(const Unit&) const {}
};
struct MergeOrder {
    int nM, G, c;
    __device__ bool next(int i, Unit& u) const {
        const int br = i & 1; int L = (i >> 1) * G + c;
        if ((G & 31) == 0) { const int x = c & 7, q = c >> 3; L = (((i >> 1) * 8 + x) * (G >> 5) + (q >> 2)) * 4 + (q & 3); }
        if (L >= nM * 4) return false;
        u.pm = 65 * br + (L >> 2); u.pn = 4 * br + (L & 3); return true;
    }
    __device__ __forceinline__ void a_ready(const Unit&) const {}
    __device__ __forceinline__ void done(const Unit&) const {}
};
struct MoeOrder {
    const PG8_LAS unsigned* utab;
    __device__ bool next(int i, Unit& u) const {
        if (i >= 32) return false;
        const unsigned v = (unsigned)__builtin_amdgcn_readfirstlane((int)utab[i]); if (v == 0xffffffffu) return false;
        u.pm = (int)(v >> 16); u.pn = (int)(v & 0xffffu); return true;
    }
    __device__ __forceinline__ void a_ready(const Unit&) const {}
    __device__ __forceinline__ void done(const Unit&) const {}
};

template <class Epi, class Sched, bool ALIGN_EPI = false, bool SP2 = false>
__device__ __forceinline__ void gemm_phase(PG8_LAS unsigned char* lds, const Gemm g, const Sched& S, const Epi& E, int wv) {
    int tid_ = fresh_tid(wv);
    const int tid = tid_, wid = __builtin_amdgcn_readfirstlane(tid >> 6), lane = tid & 63, wr = wid >> 2, wc = wid & 3, fr = lane & 15, fq = lane >> 4;
    const int K = g.K, nt = K / BK;
    unsigned voffA[2], voffB[2];
#pragma unroll
    for (int i = 0; i < 2; ++i) { int R, C; stage_rc(tid * 16 + i * 8192, R, C); const int Rb = Epi::PERM ? ((R & ~31) + perm32(R & 31)) : R;
        voffA[i] = (unsigned)(R * K + C) * 2u; voffB[i] = (unsigned)(Rb * K + C) * 2u; }
    const size_t kstep = (size_t)(BK * 2);
    const size_t hstep = (size_t)HALF * K * 2;
    const size_t tstep = 2 * hstep;
    const unsigned ldsw = (unsigned)wid * 1024u;
    const int aoff = lds_byte(wr * 64 + fr, fq * 8), boff = lds_byte(wc * 32 + fr, fq * 8);
#define PG8_SA(b, h) (((b) * 2 + (h)) * HTB)
#define PG8_SB(b, h) ((4 + (b) * 2 + (h)) * HTB)
#define PG8_STAGE(bufoff, gbase, voff) do { _Pragma("unroll") for (int _i = 0; _i < 2; ++_i) \
        __builtin_amdgcn_global_load_lds((const unsigned*)((const char*)(gbase) + (voff)[_i]), (PG8_LAS unsigned*)(lds + (bufoff) + ldsw + _i * 8192), 16, 0, 0); } while (0)
#define PG8_LD8(p_) __builtin_shufflevector(*(const PG8_LAS v4i_*)(p_), *(const PG8_LAS v4i_*)((p_) + 1024), 0, 1, 2, 3, 4, 5, 6, 7)
#define PG8_LDA(dst, b, h) do { if constexpr (Epi::FP8) { _Pragma("unroll") for (int m = 0; m < 4; ++m) dst##8[m] = PG8_LD8(lds + PG8_SA(b, h) + aoff + m * 2048); } \
        else { _Pragma("unroll") for (int m = 0; m < 4; ++m) _Pragma("unroll") for (int k = 0; k < 2; ++k) dst[m][k] = *(const PG8_LAS bf16x8*)(lds + PG8_SA(b, h) + aoff + m * 2048 + k * 1024); } } while (0)
#define PG8_LDB(dst, b, h) do { if constexpr (Epi::FP8) { _Pragma("unroll") for (int n = 0; n < 2; ++n) dst##8[n] = PG8_LD8(lds + PG8_SB(b, h) + boff + n * 2048); } \
        else { _Pragma("unroll") for (int n = 0; n < 2; ++n) _Pragma("unroll") for (int k = 0; k < 2; ++k) dst[n][k] = *(const PG8_LAS bf16x8*)(lds + PG8_SB(b, h) + boff + n * 2048 + k * 1024); } } while (0)
#define PG8_MMA(ai, bj, At, Bt) do { if constexpr (Epi::FP8) __builtin_amdgcn_sched_barrier(0);     \
        __builtin_amdgcn_s_setprio(1); _Pragma("unroll") for (int m = 0; m < 4; ++m) _Pragma("unroll") for (int n = 0; n < 2; ++n) { \
        if constexpr (Epi::FP8)   \
            acc[ai][bj][m][n] = __builtin_amdgcn_mfma_scale_f32_16x16x128_f8f6f4(Bt##8[n], At##8[m], acc[ai][bj][m][n], 0, 0, 0, 0, 0, 0);     \
        else { _Pragma("unroll") for (int k = 0; k < 2; ++k) acc[ai][bj][m][n] = __builtin_amdgcn_mfma_f32_16x16x32_bf16(Bt[n][k], At[m][k], acc[ai][bj][m][n], 0, 0, 0); } } \
        if constexpr (Epi::FP8) { _Pragma("unroll") for (int m = 0; m < 4; ++m) _Pragma("unroll") for (int n = 0; n < 2; ++n) asm volatile("" : "+v"(acc[ai][bj][m][n])); }     \
        __builtin_amdgcn_s_setprio(0); if constexpr (Epi::FP8) __builtin_amdgcn_sched_barrier(0); } while (0)
#define PG8_WAIT_V(n) asm volatile("s_waitcnt vmcnt(" #n ")" ::: "memory")
#define PG8_WAIT_L(n) asm volatile("s_waitcnt lgkmcnt(" #n ")" ::: "memory")
#define PG8_BAR __builtin_amdgcn_s_barrier()
#define PG8_SCHED __builtin_amdgcn_sched_barrier(0)
    Unit cur, nxt; int ui = 0;
    if (!S.next(0, cur)) return;
    f32x4 acc[2][2][4][2];
#pragma unroll
    for (int a = 0; a < 2; ++a)
#pragma unroll
        for (int b = 0; b < 2; ++b)
#pragma unroll
            for (int m = 0; m < 4; ++m)
#pragma unroll
                for (int n = 0; n < 2; ++n) acc[a][b][m][n] = (f32x4){0.f, 0.f, 0.f, 0.f};
    typedef int v4i_ __attribute__((ext_vector_type(4))); typedef int v8i_ __attribute__((ext_vector_type(8)));
    bf16x8 At[4][2], B0[2][2], B1[2][2]; v8i_ At8[4], B08[2], B18[2];
    const char* cA = (const char*)g.A + (size_t)cur.pm * tstep; const char* cB = (const char*)g.Bt + (size_t)cur.pn * tstep;
    S.a_ready(cur);
    if constexpr (SP2) {
        PG8_STAGE(PG8_SB(0, 0), cB, voffB); PG8_STAGE(PG8_SB(0, 1), cB + hstep, voffB); PG8_STAGE(PG8_SA(0, 0), cA, voffA); PG8_STAGE(PG8_SA(0, 1), cA + hstep, voffA);
        if (wr == 1) PG8_BAR;
        PG8_WAIT_V(2); PG8_BAR;
        PG8_STAGE(PG8_SB(1, 0), cB + kstep, voffB); PG8_STAGE(PG8_SA(1, 0), cA + kstep, voffA); PG8_STAGE(PG8_SB(1, 1), cB + hstep + kstep, voffB);
        PG8_WAIT_V(6); PG8_BAR;
    } else {
        PG8_STAGE(PG8_SB(0, 0), cB, voffB); PG8_STAGE(PG8_SA(0, 0), cA, voffA); PG8_STAGE(PG8_SB(0, 1), cB + hstep, voffB); PG8_STAGE(PG8_SA(0, 1), cA + hstep, voffA);
        if (wr == 1) PG8_BAR;
        PG8_WAIT_V(4); PG8_BAR;
        PG8_STAGE(PG8_SB(1, 0), cB + kstep, voffB); PG8_STAGE(PG8_SA(1, 0), cA + kstep, voffA); PG8_STAGE(PG8_SB(1, 1), cB + hstep + kstep, voffB);
        PG8_WAIT_V(6); PG8_BAR;
    }
    for (;;) {
        const bool has_next = S.next(ui + 1, nxt);
        const char* nA = has_next ? (const char*)g.A + (size_t)nxt.pm * tstep : cA; const char* nB = has_next ? (const char*)g.Bt + (size_t)nxt.pn * tstep : cB;
        for (int t = 0; t < nt; t += 2) {
            const bool last = (t == nt - 2);
            const char* a1 = cA + (size_t)(t + 1) * kstep;
            const char* a2 = last ? nA : cA + (size_t)(t + 2) * kstep; const char* b2 = last ? nB : cB + (size_t)(t + 2) * kstep;
            const char* a3 = a2 + kstep; const char* b3 = b2 + kstep;
            if (last && has_next) S.a_ready(nxt);
            if constexpr (SP2) {
            PG8_LDB(B0, 0, 0); PG8_LDB(B1, 0, 1); PG8_SCHED; PG8_LDA(At, 0, 0); PG8_STAGE(PG8_SA(1, 1), a1 + hstep, voffA);
            PG8_WAIT_V(8); PG8_WAIT_L(0); PG8_BAR; PG8_MMA(0, 0, At, B0); PG8_MMA(0, 1, At, B1); PG8_BAR; PG8_SCHED;
            PG8_LDA(At, 0, 1); PG8_STAGE(PG8_SB(0, 0), b2, voffB); PG8_STAGE(PG8_SB(0, 1), b2 + hstep, voffB); PG8_STAGE(PG8_SA(0, 0), a2, voffA);
            PG8_WAIT_V(8); PG8_WAIT_L(0); PG8_BAR; PG8_MMA(1, 0, At, B0); PG8_MMA(1, 1, At, B1); PG8_BAR; PG8_SCHED;
            PG8_LDB(B0, 1, 0); PG8_LDB(B1, 1, 1); PG8_SCHED; PG8_LDA(At, 1, 0); PG8_STAGE(PG8_SA(0, 1), a2 + hstep, voffA);
            PG8_WAIT_V(8); PG8_WAIT_L(0); PG8_BAR; PG8_MMA(0, 0, At, B0); PG8_MMA(0, 1, At, B1); PG8_BAR; PG8_SCHED;
            PG8_LDA(At, 1, 1); PG8_STAGE(PG8_SB(1, 0), b3, voffB); PG8_STAGE(PG8_SB(1, 1), b3 + hstep, voffB); PG8_STAGE(PG8_SA(1, 0), a3, voffA);
            PG8_WAIT_V(8); PG8_WAIT_L(0); PG8_BAR; PG8_MMA(1, 0, At, B0); PG8_MMA(1, 1, At, B1); PG8_BAR; PG8_SCHED;
            } else {
            PG8_LDB(B0, 0, 0); PG8_SCHED; PG8_LDA(At, 0, 0); PG8_STAGE(PG8_SA(1, 1), a1 + hstep, voffA);
            PG8_WAIT_L(8); PG8_BAR; PG8_WAIT_L(0); PG8_MMA(0, 0, At, B0); PG8_BAR; PG8_SCHED;
            PG8_LDB(B1, 0, 1); PG8_STAGE(PG8_SB(0, 0), b2, voffB);
            PG8_BAR; PG8_WAIT_L(0); PG8_MMA(0, 1, At, B1); PG8_BAR;
            PG8_LDA(At, 0, 1); PG8_STAGE(PG8_SA(0, 0), a2, voffA);
            PG8_BAR; PG8_WAIT_L(0); PG8_MMA(1, 0, At, B0); PG8_BAR; PG8_SCHED;
            PG8_STAGE(PG8_SB(0, 1), b2 + hstep, voffB);
            PG8_WAIT_V(6); PG8_BAR; PG8_MMA(1, 1, At, B1); PG8_BAR;
            PG8_LDB(B0, 1, 0); PG8_SCHED; PG8_LDA(At, 1, 0); PG8_STAGE(PG8_SA(0, 1), a2 + hstep, voffA);
            PG8_WAIT_L(8); PG8_BAR; PG8_WAIT_L(0); PG8_MMA(0, 0, At, B0); PG8_BAR; PG8_SCHED;
            PG8_LDB(B1, 1, 1); PG8_STAGE(PG8_SB(1, 0), b3, voffB);
            PG8_BAR; PG8_WAIT_L(0); PG8_MMA(0, 1, At, B1); PG8_BAR;
            PG8_LDA(At, 1, 1); PG8_STAGE(PG8_SA(1, 0), a3, voffA);
            PG8_BAR; PG8_WAIT_L(0); PG8_MMA(1, 0, At, B0); PG8_BAR; PG8_SCHED;
            PG8_STAGE(PG8_SB(1, 1), b3 + hstep, voffB);
            PG8_WAIT_V(6); PG8_BAR; PG8_MMA(1, 1, At, B1); PG8_BAR;
            }
        }
        if constexpr (ALIGN_EPI) { if (wr == 0) PG8_BAR; }
        if constexpr (Epi::FP8) { _Pragma("unroll") for (int ai = 0; ai < 2; ++ai) _Pragma("unroll") for (int bj = 0; bj < 2; ++bj) _Pragma("unroll") for (int m = 0; m < 4; ++m) _Pragma("unroll") for (int n = 0; n < 2; ++n) acc[ai][bj][m][n] *= (1.f / W8_SCALE); }
        if constexpr (!Epi::AFTER_DRAIN) { E(acc, cur, wr, wc, fr, fq); S.done(cur); }
        if (!has_next) break;
#pragma unroll
        for (int a = 0; a < 2; ++a)
#pragma unroll
            for (int b = 0; b < 2; ++b)
#pragma unroll
                for (int m = 0; m < 4; ++m)
#pragma unroll
                    for (int n = 0; n < 2; ++n) acc[a][b][m][n] = (f32x4){0.f, 0.f, 0.f, 0.f};
        cur = nxt; cA = nA; cB = nB; ++ui;
        if constexpr (ALIGN_EPI) { if (wr == 1) PG8_BAR; }
    }
    PG8_WAIT_V(0);
    if constexpr (!ALIGN_EPI) { if (wr == 0) PG8_BAR; }
    PG8_BAR;
    if constexpr (Epi::AFTER_DRAIN) { E.fused(acc, cur, wr, wc, fr, fq, lds, wid, lane); S.done(cur); }
#undef PG8_SA
#undef PG8_SB
#undef PG8_STAGE
#undef PG8_LDA
#undef PG8_LD8
#undef PG8_LDB
#undef PG8_MMA
#undef PG8_WAIT_V
#undef PG8_WAIT_L
#undef PG8_BAR
#undef PG8_SCHED
}
}


struct Params { const float* in[24]; float* out; unsigned char* ws; int ph_lo, ph_hi; };
enum { I_X = 0, I_C, I_CTX, I_CCTX, I_ADAW, I_ADAB, I_N1G, I_N2G, I_WIN, I_QNG, I_KNG, I_LAMQK, I_SUBLN, I_HGLB, I_HGNG, I_WBA, I_WBB, I_WOUT, I_RW, I_RB, I_WGU, I_BGU, I_WDN, I_BDN };

#define LDS_WAIT() asm volatile("s_waitcnt lgkmcnt(0)" ::: "memory")

template <int KIND, bool FP8 = false>
__device__ __forceinline__ void transpose_item(const float* __restrict__ W, int K, int N, bf16* WT, bf16* WT2, int row_off, int k0, int n0, LAS float* scr, int lane) {
#pragma unroll 4
    for (int it = 0; it < 16; ++it) {
        const int k = 4 * it + (lane >> 4), n4 = (lane & 15) * 4;
        const f32x4 v = __builtin_nontemporal_load((const f32x4*)(W + (size_t)(k0 + k) * N + n0 + n4));
        *(LAS f32x4*)(scr + k * 64 + (n4 ^ (4 * ((k >> 3) & 7)))) = v;
    }
    LDS_WAIT();
    const int c = lane & 7;
#pragma unroll 2
    for (int j2 = 0; j2 < 8; ++j2) {
        const int nl = (lane >> 3) + 8 * j2, n = n0 + nl;
        const LAS float* s = scr + (8 * c) * 64 + (nl ^ (4 * c));
        v4u o; o.x = pk2(s[0], s[64]); o.y = pk2(s[128], s[192]); o.z = pk2(s[256], s[320]); o.w = pk2(s[384], s[448]);
        bf16* base = WT; size_t row;
        if (KIND == 0) row = (size_t)(row_off + n);
        else if (KIND == 1) row = (size_t)(row_off + perm8(n));
        else if (KIND == 2) {
            if (n < 1024) { const int tile = n >> 8, G = (n >> 6) & 3, bj = (n >> 5) & 1, e = n & 31; row = (size_t)(256 * tile + 128 * bj + 32 * G + e); }
            else if (n < 1536) { base = WT2; row = (size_t)(n - 1024); }
            else if (n < 3584) {
                const int Q = (n - 1536) >> 9, rem = (n - 1536) & 511, hh = rem >> 7, d = rem & 127, dd = d & 63;
                const int p = 128 * (Q >> 1) + 32 * (dd >> 4) + 16 * (Q & 1) + 4 * ((dd >> 2) & 3) + (dd & 3);
                row = (size_t)(1024 + 256 * (2 * hh + (d >> 6)) + p); }
            else row = (size_t)(3072 + perm8(n - 3584));
        } else {
            const int half = n >> 10, nn = n & 1023;
            row = (size_t)(256 * (nn >> 7) + 128 * half + perm8(nn & 127));
        }
        if (!FP8) __builtin_nontemporal_store(o, (v4u*)(base + row * K + k0 + 8 * c));
        else { v2u o8; o8.x = pk_fp8x4(s[0] * W8_SCALE, s[64] * W8_SCALE, s[128] * W8_SCALE, s[192] * W8_SCALE); o8.y = pk_fp8x4(s[256] * W8_SCALE, s[320] * W8_SCALE, s[384] * W8_SCALE, s[448] * W8_SCALE);
               __builtin_nontemporal_store(o8, (v2u*)((unsigned char*)base + row * K + k0 + 8 * c)); }
    }
    LDS_WAIT();
}

__device__ __forceinline__ void sincos_d(double x, double& s, double& c) {
    const double k = __builtin_rint(x * 0.63661977236758134308);
    double r = __builtin_fma(-k, 1.57079632679489655800e+00, x); r = __builtin_fma(-k, 6.12323399573676603587e-17, r);
    const double r2 = r * r;
    double sp = -1.0 / 1307674368000.0; sp = sp * r2 + 1.0 / 6227020800.0; sp = sp * r2 - 1.0 / 39916800.0; sp = sp * r2 + 1.0 / 362880.0; sp = sp * r2 - 1.0 / 5040.0; sp = sp * r2 + 1.0 / 120.0; sp = sp * r2 - 1.0 / 6.0; sp = sp * r2 + 1.0;
    const double sr = sp * r;
    double cp = 1.0 / 20922789888000.0; cp = cp * r2 - 1.0 / 87178291200.0; cp = cp * r2 + 1.0 / 479001600.0; cp = cp * r2 - 1.0 / 3628800.0; cp = cp * r2 + 1.0 / 40320.0; cp = cp * r2 - 1.0 / 720.0; cp = cp * r2 + 1.0 / 24.0; cp = cp * r2 - 0.5; cp = cp * r2 + 1.0;
    const int q = ((int)k) & 3;
    s = (q == 0) ? sr : (q == 1) ? cp : (q == 2) ? -sr : -cp;
    c = (q == 0) ? cp : (q == 1) ? -sr : (q == 2) ? -cp : sr;
}

constexpr int CI_IN = 16 * 96, CI_A = 8 * 16, CI_B = 8 * 16, CI_O = 16 * 16, CI_GU = 16 * 32, CI_DN = 16 * 16;
constexpr int PER_L = CI_IN + CI_A + CI_B + CI_O + NE * CI_GU + NE * CI_DN;
__device__ __forceinline__ void convert_items(const Params& P, LAS unsigned char* lds, int it0, int it1, int gwg, int nwg, int wv) {
    int tid_ = fresh_tid(wv);
    const int lane = tid_ & 63, wave = __builtin_amdgcn_readfirstlane(tid_ >> 6);
    GAS unsigned char* wsg_ = (GAS unsigned char*)P.ws; asm volatile("" : "+s"(wsg_)); unsigned char* ws = (unsigned char*)wsg_;
    LAS float* scr = (LAS float*)(lds + wave * 16384);
    constexpr int I_IN = CI_IN, I_A = CI_A, I_B = CI_B, I_O = CI_O, I_GU = CI_GU, I_DN = CI_DN;
#pragma unroll 1
    for (int it = it0 + gwg * NWAVES + wave; it < it1; it += nwg * NWAVES) {
        const int l = it / PER_L; int r = it % PER_L;
        if (r < I_IN) { const int kb = r / 96, nb = r % 96;
            transpose_item<2, true>(P.in[I_WIN] + (size_t)l * D * INC, D, INC, (bf16*)(ws + WS_WIN + l * WIN_L), (bf16*)(ws + WS_WV + l * WV_L), 0, 64 * kb, 64 * nb, scr, lane); continue; }
        r -= I_IN;
        if (r < I_A) { const int kb = r / 16, nb = r % 16;
            transpose_item<1>(P.in[I_WBA] + (size_t)l * 512 * D, 512, D, (bf16*)(ws + WS_WAB + l * WAB_L), nullptr, 0, 64 * kb, 64 * nb, scr, lane); continue; }
        r -= I_A;
        if (r < I_B) { const int kb = r / 16, nb = r % 16;
            transpose_item<1>(P.in[I_WBB] + (size_t)l * 512 * D, 512, D, (bf16*)(ws + WS_WAB + l * WAB_L), nullptr, 1024, 64 * kb, 64 * nb, scr, lane); continue; }
        r -= I_B;
        if (r < I_O) { const int kb = r / 16, nb = r % 16;
            transpose_item<0>(P.in[I_WOUT] + (size_t)l * D * D, D, D, (bf16*)(ws + WS_WO + l * WO_L), nullptr, 0, 64 * kb, 64 * nb, scr, lane); continue; }
        r -= I_O;
        if (r < NE * I_GU) { const int e = r / I_GU, q = r % I_GU, kb = q / 32, nb = q % 32;
            transpose_item<3, true>(P.in[I_WGU] + ((size_t)l * NE + e) * D * 2048, D, 2048, (bf16*)(ws + WS_WGU + l * WGU_L + e * (WGU_E / 2)), nullptr, 0, 64 * kb, 64 * nb, scr, lane); continue; }
        r -= NE * I_GU;
        { const int e = r / I_DN, q = r % I_DN, kb = q / 16, nb = q % 16;
            transpose_item<1, true>(P.in[I_WDN] + ((size_t)l * NE + e) * DFF * D, DFF, D, (bf16*)(ws + WS_WD + l * WD_L + e * (WD_E / 2)), nullptr, 0, 64 * kb, 64 * nb, scr, lane); }
    }
}

__device__ __forceinline__ void phase_p0a(const Params& P, LAS unsigned char* lds, int G, int wv) {
    int tid_ = fresh_tid(wv);
    const int tid = tid_, lane = tid & 63, wave = tid >> 6;
    GAS unsigned char* wsg_ = (GAS unsigned char*)P.ws; asm volatile("" : "+s"(wsg_)); unsigned char* ws = (unsigned char*)wsg_;
    LAS float* sil = (LAS float*)(lds + 131072);
    for (int i = tid; i < 2048; i += NTHR) { const float v = (i < 1024) ? P.in[I_C][i] : P.in[I_CCTX][i - 1024]; sil[i] = v * sigmoidf_(v); }
    __syncthreads();
    {
        float* modp = (float*)(ws + WS_MODP);
        for (int t = blockIdx.x * NTHR + tid; t < DEPTH * 8 * 6144; t += G * NTHR) {
            const int j = t % 6144, lp = t / 6144, part = lp & 7, l = lp >> 3;
            const float* w = P.in[I_ADAW] + ((size_t)l * D + part * 128) * 6144 + j;
            float a0 = 0.f, a1 = 0.f;
#pragma unroll 8
            for (int i = 0; i < 128; ++i) { const float wv = w[(size_t)i * 6144]; a0 += sil[part * 128 + i] * wv; a1 += sil[1024 + part * 128 + i] * wv; }
            modp[((size_t)(l * 8 + part) * 2 + 0) * 6144 + j] = a0;
            modp[((size_t)(l * 8 + part) * 2 + 1) * 6144 + j] = a1;
        }
    }
    {
        float* lbo = (float*)(ws + WS_LB);
        for (int t = blockIdx.x * NTHR + tid; t < 2 * 512; t += G * NTHR) {
            const int dir = t >> 9, j = t & 511;
            float v[DEPTH], mx = -1e30f;
#pragma unroll
            for (int l = 0; l < DEPTH; ++l) { v[l] = P.in[I_HGLB][((size_t)dir * DEPTH + l) * 512 + j]; mx = fmaxf(mx, v[l]); }
            float sum = 0.f;
#pragma unroll
            for (int l = 0; l < DEPTH; ++l) { v[l] = expf(v[l] - mx); sum += v[l]; }
            float cs = 0.f, first = 0.f;
#pragma unroll
            for (int l = 0; l < DEPTH; ++l) { cs += v[l] / sum; if (l == 0) first = cs; lbo[((size_t)dir * DEPTH + l) * 512 + j] = cs - first; }
        }
    }
    {
        float* rt = (float*)(ws + WS_ROPE);
        for (int t = blockIdx.x * NTHR + tid; t < 256 * 16; t += G * NTHR) {
            const int pos = t >> 4, fi = t & 15;
            const float freq = (float)exp2(-(double)fi * (13.287712379549449 / 16.0));
            const float ang = (float)pos * freq;
            double s, c; sincos_d((double)ang, s, c);
            rt[2 * t] = (float)c; rt[2 * t + 1] = (float)s;
        }
    }
    {
        for (int t = blockIdx.x * NTHR + tid; t < DEPTH * D * NE; t += G * NTHR) {
            const int e = t & 31, k = (t >> 5) & 1023, l = t >> 15;
            const float v = P.in[I_RW][t];
            const unsigned hi = pk2(v, 0.f) & 0xffffu; const unsigned lo = pk2(v - bflo(hi), 0.f) & 0xffffu;
            unsigned char* img = ws + WS_RWIMG + (size_t)l * RW_IMG;
            *(bf16*)(img + e * RW_PITCH + k * 2) = (bf16)hi; *(bf16*)(img + 32 * RW_PITCH + e * RW_PITCH + k * 2) = (bf16)lo;
        }
    }
    {
        convert_items(P, lds, 0, (G == 256) ? PER_L : DEPTH * PER_L, (int)blockIdx.x, G, wv);
    }
}

__device__ __forceinline__ const float* modv_ptr(const Params& P, int l, int w) { return (const float*)(P.ws + WS_MODV) + ((size_t)l * 2 + w) * 6144; }
__device__ __forceinline__ const float* xin_row(const Params& P, int l, int row) {
    if (l == 0) return (row < SEQ) ? P.in[I_X] + (size_t)row * D : P.in[I_CTX] + (size_t)(row - SEQ) * D;
    return (const float*)(P.ws + WS_XRES) + (size_t)row * D;
}
__device__ __forceinline__ void norm_store_row(const f32x4 (&v)[4], const LAS float* A, const LAS float* B, unsigned char* hrow, int lane) {
    float ss = 0.f;
#pragma unroll
    for (int j = 0; j < 4; ++j) ss += (v[j].x * v[j].x + v[j].y * v[j].y) + (v[j].z * v[j].z + v[j].w * v[j].w);
    const float rstd = __builtin_amdgcn_rsqf(wave_sum(ss, lane) * (1.f / D) + EPS);
#pragma unroll
    for (int j = 0; j < 4; ++j) {
        const f32x4 a = *(const LAS f32x4*)(A + 4 * lane + 256 * j), b = *(const LAS f32x4*)(B + 4 * lane + 256 * j);
        const f32x4 y = v[j] * rstd * a + b;
        *(unsigned*)(hrow + 4 * lane + 256 * j) = pk_fp8x4(y.x, y.y, y.z, y.w);
    }
}

__device__ __forceinline__ void phase_p0b(const Params& P, LAS unsigned char* lds, int G, int wv) {
    int tid_ = fresh_tid(wv);
    const int tid = tid_, lane = tid & 63, wave = tid >> 6;
    GAS unsigned char* wsg_ = (GAS unsigned char*)P.ws; asm volatile("" : "+s"(wsg_)); unsigned char* ws = (unsigned char*)wsg_;
    const float* modp = (const float*)(ws + WS_MODP);
    float* modv = (float*)(ws + WS_MODV);
    for (int t = blockIdx.x * NTHR + tid; t < DEPTH * 2 * 6144; t += G * NTHR) {
        const int j = t % 6144, lw = t / 6144, w = lw & 1, l = lw >> 1;
        float a = P.in[I_ADAB][(size_t)l * 6144 + j];
#pragma unroll
        for (int p = 0; p < 8; ++p) a += modp[((size_t)(l * 8 + p) * 2 + w) * 6144 + j];
        modv[t] = a;
    }
    LAS float* TA = (LAS float*)lds;
    LAS float* TB = (LAS float*)(lds + 8192);
    for (int i = tid; i < 2048; i += NTHR) {
        const int w = i >> 10, j = i & 1023;
        float sh = P.in[I_ADAB][j], sc = P.in[I_ADAB][1024 + j];
#pragma unroll
        for (int p = 0; p < 8; ++p) { sh += modp[((size_t)p * 2 + w) * 6144 + j]; sc += modp[((size_t)p * 2 + w) * 6144 + 1024 + j]; }
        TA[i] = P.in[I_N1G][j] * (1.f + sc); TB[i] = sh;
    }
    __syncthreads();
    bf16* H = (bf16*)(ws + WS_H);
    for (int row = blockIdx.x * NWAVES + wave; row < NT; row += G * NWAVES) {
        const float* xr = xin_row(P, 0, row); const int w = row >= SEQ;
        f32x4 v[4];
#pragma unroll
        for (int j = 0; j < 4; ++j) v[j] = *(const f32x4*)(xr + 4 * lane + 256 * j);
        norm_store_row(v, TA + 1024 * w, TB + 1024 * w, (unsigned char*)H + (size_t)row * D, lane);
        bf16* xb = (bf16*)(ws + WS_XRES) + (size_t)row * D + 4 * lane;
#pragma unroll
        for (int j = 0; j < 4; ++j) { v2u o; o.x = pk2(v[j].x, v[j].y); o.y = pk2(v[j].z, v[j].w); *(v2u*)(xb + 256 * j) = o; }
    }
}

using pg8::Unit;

struct EpiInProj {
    static constexpr bool PERM = false, AFTER_DRAIN = false, FP8 = true;
    bf16* Q; bf16* K; bf16* proj; const float* qn_g; const float* kn_g; const float* rope; unsigned char* img; const float* lbl;
    __device__ __forceinline__ void operator()(const f32x4 (&acc)[2][2][4][2], const Unit& u, int wr, int wc, int fr, int fq) const {
        const int row0 = u.pm * 256 + wr * 64 + fr;
        if (u.pn < 4) {
            const bool isq = u.pn < 2; const int gg = 4 * (u.pn & 1) + wc, hh = gg >> 1, mm = gg & 1;
            const float* gv = isq ? qn_g : kn_g; unsigned char* dstb = (unsigned char*)(isq ? Q : K) + (size_t)hh * NT * 128 + 64 * mm;
            const float oscale = isq ? 0.125f * 1.4426950408889634f : 1.f;
            f32x4 g[2][2];
#pragma unroll
            for (int bj = 0; bj < 2; ++bj)
#pragma unroll
                for (int n = 0; n < 2; ++n) g[bj][n] = *(const f32x4*)(gv + 32 * bj + 16 * n + 4 * fq);
#pragma unroll
            for (int ai = 0; ai < 2; ++ai)
#pragma unroll
                for (int m = 0; m < 4; ++m) {
                    const int row = row0 + ai * 128 + m * 16;
                    float ss = 0.f;
#pragma unroll
                    for (int bj = 0; bj < 2; ++bj)
#pragma unroll
                        for (int n = 0; n < 2; ++n) { const f32x4 x = acc[ai][bj][m][n]; ss += (x.x * x.x + x.y * x.y) + (x.z * x.z + x.w * x.w); }
                    { const int ln_ = 16 * fq + fr; ss += shx(ss, 16, ln_); ss += shx(ss, 32, ln_); }
                    const float rstd = __builtin_amdgcn_rsqf(ss * (1.f / 64.f) + EPS) ;
                    unsigned char* dst = dstb + (size_t)row * 128;
                    const bool lat = row < SEQ;
#pragma unroll
                    for (int bj = 0; bj < 2; ++bj) {
                        f32x4 x1 = acc[ai][bj][m][0] * rstd * g[bj][0], x2 = acc[ai][bj][m][1] * rstd * g[bj][1];
                        if (lat) {
                            const int pos = bj == 0 ? (row >> 6) : (row & 63);
                            const f32x4 cs0 = *(const f32x4*)(rope + (size_t)(pos * 16 + 4 * fq) * 2), cs1 = *(const f32x4*)(rope + (size_t)(pos * 16 + 4 * fq) * 2 + 4);
                            const f32x4 c = {cs0.x, cs0.z, cs1.x, cs1.z}, s = {cs0.y, cs0.w, cs1.y, cs1.w};
                            const f32x4 y1 = x1 * c - x2 * s, y2 = x2 * c + x1 * s; x1 = y1; x2 = y2;
                        }
                        x1 = x1 * oscale; x2 = x2 * oscale;
                        *(unsigned*)(dst + 32 * bj + 4 * fq) = pk_fp8x4(x1.x, x1.y, x1.z, x1.w); *(unsigned*)(dst + 32 * bj + 16 + 4 * fq) = pk_fp8x4(x2.x, x2.y, x2.z, x2.w);
                    }
                }
        } else if (u.pn < 12) {
            const int T = u.pn - 4, hh = T >> 1, d0 = 64 * (T & 1) + 16 * wc + 4 * fq, ln_ = 16 * fq + fr;
            const f32x4 lbf = *(const f32x4*)(lbl + 128 * hh + d0), lbb = *(const f32x4*)(lbl + (size_t)DEPTH * 512 + 128 * hh + d0);
#pragma unroll
            for (int ai = 0; ai < 2; ++ai)
#pragma unroll
                for (int m = 0; m < 4; ++m) {
                    const int rg = u.pm * 256 + ai * 128 + wr * 64 + m * 16;
                    const int seg = rg < SEQ ? (rg >> 8) : 64, cf = ((rg < SEQ ? rg : rg - SEQ) & 255) >> 4;
                    const f32x4 qv = acc[ai][0][m][0], vv = acc[ai][1][m][1];
#pragma unroll
                    for (int dir = 0; dir < 2; ++dir) {
                        const f32x4 zv = dir ? acc[ai][1][m][0] : acc[ai][0][m][1], lb = dir ? lbb : lbf;
                        const int s_ = dir ? 15 - fr : fr, c_ = dir ? 15 - cf : cf;
                        unsigned char* im = img + (size_t)((((dir * 4 + hh) * 65 + seg) * 16) + c_) * IM_BYTES;
                        float qt[4], kt[4], kh[4], dc[4];
#pragma unroll
                        for (int i = 0; i < 4; ++i) {
                            const float zc = fminf(fmaxf(zv[i], -80.f), 80.f), E = fast_exp(-zc), den = fast_rcp(1.f + E);
                            const float g = fast_log((1.f + lb[i] * E) * den), kk = (1.f - lb[i]) * E * den;
                            float b = g;
                            if (dir == 0) { b += __int_as_float(__builtin_amdgcn_update_dpp(0, __float_as_int(b), 0x111, 0xf, 0xf, true)); b += __int_as_float(__builtin_amdgcn_update_dpp(0, __float_as_int(b), 0x112, 0xf, 0xf, true));
                                            b += __int_as_float(__builtin_amdgcn_update_dpp(0, __float_as_int(b), 0x114, 0xf, 0xf, true)); b += __int_as_float(__builtin_amdgcn_update_dpp(0, __float_as_int(b), 0x118, 0xf, 0xf, true)); }
                            else          { b += __int_as_float(__builtin_amdgcn_update_dpp(0, __float_as_int(b), 0x101, 0xf, 0xf, true)); b += __int_as_float(__builtin_amdgcn_update_dpp(0, __float_as_int(b), 0x102, 0xf, 0xf, true));
                                            b += __int_as_float(__builtin_amdgcn_update_dpp(0, __float_as_int(b), 0x104, 0xf, 0xf, true)); b += __int_as_float(__builtin_amdgcn_update_dpp(0, __float_as_int(b), 0x108, 0xf, 0xf, true)); }
                            const float bl = __int_as_float(__builtin_amdgcn_ds_bpermute((dir ? (ln_ & ~15) : (ln_ | 15)) << 2, __float_as_int(b)));
                            qt[i] = qv[i] * fast_exp(b); kt[i] = kk * fast_exp(fminf(-b, 80.f)); kh[i] = kk * fast_exp(bl - b); dc[i] = fast_exp(bl);
                        }
                        { v2u o; o.x = pk2(qt[0], qt[1]); o.y = pk2(qt[2], qt[3]); *(v2u*)(im + 0 + s_ * 272 + d0 * 2) = o; }
                        { v2u o; o.x = pk2(kt[0], kt[1]); o.y = pk2(kt[2], kt[3]); *(v2u*)(im + 4352 + s_ * 272 + d0 * 2) = o; }
#pragma unroll
                        for (int i = 0; i < 4; ++i) { *(bf16*)(im + 8704 + (d0 + i) * 48 + s_ * 2) = (bf16)(pk2(kh[i], 0.f) & 0xffffu); *(bf16*)(im + 14848 + (d0 + i) * 48 + s_ * 2) = (bf16)(pk2(vv[i], 0.f) & 0xffffu); }
                        if (s_ == 15) *(f32x4*)(im + 20992 + d0 * 4) = (f32x4){dc[0], dc[1], dc[2], dc[3]};
                    }
                }
        } else {
            const int pt = u.pn - 4; const int act = pt < 10 ? 1 : 2;
            const int col0 = pt * 256 + wc * 32 + 8 * fq;
#pragma unroll
            for (int ai = 0; ai < 2; ++ai)
#pragma unroll
                for (int m = 0; m < 4; ++m) { bf16* rowp = proj + (size_t)(row0 + ai * 128 + m * 16) * PROJW + col0;
#pragma unroll
                    for (int bj = 0; bj < 2; ++bj) { f32x4 v0 = acc[ai][bj][m][0], v1 = acc[ai][bj][m][1];
#pragma unroll
                        for (int j = 0; j < 4; ++j) { const float s0 = sigmoidf_(v0[j]), s1 = sigmoidf_(v1[j]); v0[j] = act == 1 ? v0[j] * s0 : s0; v1[j] = act == 1 ? v1[j] * s1 : s1; }
                        v4u w; w.x = pk2(v0.x, v0.y); w.y = pk2(v0.z, v0.w); w.z = pk2(v1.x, v1.y); w.w = pk2(v1.z, v1.w);
                        *(v4u*)(rowp + bj * 128) = w; } }
        }
    }
};
struct EpiVt {
    static constexpr bool PERM = false, AFTER_DRAIN = false, FP8 = true;
    bf16* VT;
    __device__ __forceinline__ void operator()(const f32x4 (&acc)[2][2][4][2], const Unit& u, int wr, int wc, int fr, int fq) const {
        const int row0 = u.pm * 256 + wr * 64 + fr, col0 = u.pn * 256 + wc * 32 + 4 * fq;
#pragma unroll
        for (int ai = 0; ai < 2; ++ai)
#pragma unroll
            for (int m = 0; m < 4; ++m) { unsigned char* rowp = (unsigned char*)VT + (size_t)(row0 + ai * 128 + m * 16) * LDV + col0;
#pragma unroll
                for (int bj = 0; bj < 2; ++bj)
#pragma unroll
                    for (int n = 0; n < 2; ++n) { const f32x4 v = acc[ai][bj][m][n]; *(unsigned*)(rowp + bj * 128 + n * 16) = pk_fp8x4(v.x, v.y, v.z, v.w); } }
    }
};
struct EpiMerge {
    static constexpr bool PERM = false, AFTER_DRAIN = false, FP8 = false;
    const bf16* proj; bf16* U;
    __device__ __forceinline__ void operator()(const f32x4 (&acc)[2][2][4][2], const Unit& u, int wr, int wc, int fr, int fq) const {
        const int br = u.pn >> 2, T = u.pn & 3, pm = u.pm - 65 * br;
        const int row0 = pm * 256 + wr * 64 + fr, col0 = T * 256 + wc * 32 + 8 * fq;
        const int gcol = (br ? PC_GB : PC_GA) + col0;
#pragma unroll
        for (int ai = 0; ai < 2; ++ai)
#pragma unroll
            for (int m = 0; m < 4; ++m) { const size_t row = (size_t)(row0 + ai * 128 + m * 16);
#pragma unroll
                for (int bj = 0; bj < 2; ++bj) {
                    const v4u gw = *(const v4u*)(proj + row * PROJW + gcol + bj * 128);
                    f32x4 v0 = acc[ai][bj][m][0], v1 = acc[ai][bj][m][1];
                    v0.x *= bflo(gw.x); v0.y *= bfhi(gw.x); v0.z *= bflo(gw.y); v0.w *= bfhi(gw.y);
                    v1.x *= bflo(gw.z); v1.y *= bfhi(gw.z); v1.z *= bflo(gw.w); v1.w *= bfhi(gw.w);
                    bf16* up = U + row * D + col0 + bj * 128;
                    if (br) { const v4u o = *(const v4u*)up;
                        v0.x += bflo(o.x); v0.y += bfhi(o.x); v0.z += bflo(o.y); v0.w += bfhi(o.y);
                        v1.x += bflo(o.z); v1.y += bfhi(o.z); v1.z += bflo(o.w); v1.w += bfhi(o.w); }
                    v4u w; w.x = pk2(v0.x, v0.y); w.y = pk2(v0.z, v0.w); w.z = pk2(v1.x, v1.y); w.w = pk2(v1.z, v1.w);
                    *(v4u*)up = w; } }
    }
};
struct EpiOut {
    static constexpr bool PERM = false, AFTER_DRAIN = false, FP8 = false;
    const bf16* xsrc; bf16* xres; const float* g1lat; const float* g1ctx;
    __device__ __forceinline__ void operator()(const f32x4 (&acc)[2][2][4][2], const Unit& u, int wr, int wc, int fr, int fq) const {
        const int row0 = u.pm * 256 + wr * 64 + fr, col0 = u.pn * 256 + wc * 32 + 4 * fq;
        const bool isctx = u.pm >= 64;
        const float* gsrc = isctx ? g1ctx : g1lat;
        f32x4 gv[2][2];
#pragma unroll
        for (int bj = 0; bj < 2; ++bj)
#pragma unroll
            for (int n = 0; n < 2; ++n) gv[bj][n] = *(const f32x4*)(gsrc + col0 + bj * 128 + n * 16);
#pragma unroll
        for (int ai = 0; ai < 2; ++ai)
#pragma unroll
            for (int m = 0; m < 4; ++m) { const int row = row0 + ai * 128 + m * 16;
                const bf16* src = xsrc + (size_t)row * D + col0;
                bf16* dst = xres + (size_t)row * D + col0;
#pragma unroll
                for (int bj = 0; bj < 2; ++bj)
#pragma unroll
                    for (int n = 0; n < 2; ++n) { const v2u xv = *(const v2u*)(src + bj * 128 + n * 16);
                        const f32x4 y = (f32x4){bflo(xv.x), bfhi(xv.x), bflo(xv.y), bfhi(xv.y)} + gv[bj][n] * acc[ai][bj][m][n];
                        v2u o; o.x = pk2(y.x, y.y); o.y = pk2(y.z, y.w); *(v2u*)(dst + bj * 128 + n * 16) = o; } }
    }
};
struct EpiSwiglu {
    static constexpr bool PERM = false, AFTER_DRAIN = false, FP8 = true;
    bf16* hdn; const float* bgu;
    __device__ __forceinline__ void operator()(const f32x4 (&acc)[2][2][4][2], const Unit& u, int wr, int wc, int fr, int fq) const {
        const int e = u.pn >> 3, T = u.pn & 7;
        const int row0 = u.pm * 256 + wr * 64 + fr, col0 = T * 128 + wc * 32 + 8 * fq;
        const float* bg = bgu + (size_t)e * 2048 + col0;
        const f32x4 bg0 = *(const f32x4*)bg, bg1 = *(const f32x4*)(bg + 4), bu0 = *(const f32x4*)(bg + 1024), bu1 = *(const f32x4*)(bg + 1028);
#pragma unroll
        for (int ai = 0; ai < 2; ++ai)
#pragma unroll
            for (int m = 0; m < 4; ++m) {
                f32x4 g0 = acc[ai][0][m][0] + bg0, g1 = acc[ai][0][m][1] + bg1, u0 = acc[ai][1][m][0] + bu0, u1 = acc[ai][1][m][1] + bu1;
                f32x4 h0, h1;
#pragma unroll
                for (int j = 0; j < 4; ++j) {
                    const float ga = fminf(g0[j], 7.f), gb = fminf(g1[j], 7.f);
                    const float ua = fminf(fmaxf(u0[j], -7.f), 7.f), ub = fminf(fmaxf(u1[j], -7.f), 7.f);
                    h0[j] = (ua + 1.f) * ga * sigmoidf_(1.702f * ga); h1[j] = (ub + 1.f) * gb * sigmoidf_(1.702f * gb);
                }
                v2u w; w.x = pk_fp8x4(h0.x, h0.y, h0.z, h0.w); w.y = pk_fp8x4(h1.x, h1.y, h1.z, h1.w);
                *(v2u*)((unsigned char*)hdn + (size_t)(row0 + ai * 128 + m * 16) * D + col0) = w;
            }
    }
};
struct EpiDown {
    static constexpr bool PERM = false, AFTER_DRAIN = false, FP8 = true;
    bf16* Y; const float* bdn;
    __device__ __forceinline__ void operator()(const f32x4 (&acc)[2][2][4][2], const Unit& u, int wr, int wc, int fr, int fq) const {
        const int e = u.pn >> 2, T = u.pn & 3;
        const int row0 = u.pm * 256 + wr * 64 + fr, col0 = T * 256 + wc * 32 + 8 * fq;
        f32x4 bv[2][2];
#pragma unroll
        for (int bj = 0; bj < 2; ++bj)
#pragma unroll
            for (int n = 0; n < 2; ++n) bv[bj][n] = *(const f32x4*)(bdn + (size_t)e * D + col0 + bj * 128 + 4 * n);
#pragma unroll
        for (int ai = 0; ai < 2; ++ai)
#pragma unroll
            for (int m = 0; m < 4; ++m) { bf16* rowp = Y + (size_t)(row0 + ai * 128 + m * 16) * D + col0;
#pragma unroll
                for (int bj = 0; bj < 2; ++bj) { const f32x4 v0 = acc[ai][bj][m][0] + bv[bj][0], v1 = acc[ai][bj][m][1] + bv[bj][1];
                    v4u w; w.x = pk2(v0.x, v0.y); w.y = pk2(v0.z, v0.w); w.z = pk2(v1.x, v1.y); w.w = pk2(v1.z, v1.w);
                    *(v4u*)(rowp + bj * 128) = w; } }
    }
};

constexpr int IM_QT = 0, IM_KT = 4352, IM_KH = 8704, IM_VT = 14848, IM_DEC = 20992;
constexpr int HGP = 272;
constexpr int HL_IMG = 0, HL_ST = 2 * IM_BYTES, HL_STSZ = 34816, HL_OT = HL_ST + 2 * HL_STSZ, HL_OTSZ = 8448, HL_OF = HL_OT + 2 * HL_OTSZ, HL_GT = HL_OF + 2 * 8192, HL_AM = HL_GT + 2 * 4096;

__device__ __forceinline__ void glds16_s(const void* sbase, unsigned voff, unsigned lds_dst);

__device__ __forceinline__ void phase_hgrn_build(const Params& P, int layer, int G, int wv) {
    int tid_ = fresh_tid(wv);
    const int tid = tid_, d = tid & 127;
    GAS unsigned char* wsg_ = (GAS unsigned char*)P.ws; asm volatile("" : "+s"(wsg_)); unsigned char* ws = (unsigned char*)wsg_;
    const bf16* proj = (const bf16*)(ws + WS_PROJ);
    for (int task = blockIdx.x * 4 + (tid >> 7); task < 8 * 65 * 16; task += G * 4) {
        const int c = task & 15, sg = (task >> 4) % 65, dh = task / (16 * 65), dir = dh >> 2, hh = dh & 3;
        const int tok0 = (sg < 64 ? sg * 256 : SEQ) + (dir ? 255 : 0), sgn = dir ? -1 : 1;
        const float lb = ((const float*)(ws + WS_LB))[((size_t)dir * DEPTH + layer) * 512 + 128 * hh + d];
        const bf16* base = proj + (size_t)(tok0 + sgn * 16 * c) * PROJW + 128 * hh + d;
        const long rstep = (long)sgn * PROJW;
        float z[16], q[16]; unsigned short vv[16];
#pragma unroll
        for (int s = 0; s < 16; ++s) { const bf16* r = base + s * rstep; z[s] = bf2f(r[dir ? PC_ZB : PC_ZF]); q[s] = bf2f(r[PC_QH]); vv[s] = r[PC_VH]; }
        float b[16], kk[16], run = 0.f;
#pragma unroll
        for (int s = 0; s < 16; ++s) {
            const float zz = fminf(fmaxf(z[s], -80.f), 80.f), E = fast_exp(-zz), den = fast_rcp(1.f + E);
            run += fast_log((1.f + lb * E) * den); b[s] = run; kk[s] = (1.f - lb) * E * den;
        }
        unsigned char* img = ws + WS_IMG + (size_t)task * IM_BYTES;
        unsigned khw[8], vtw[8];
#pragma unroll
        for (int s = 0; s < 16; ++s) {
            *(bf16*)(img + IM_QT + s * HGP + d * 2) = (bf16)(pk2(q[s] * fast_exp(b[s]), 0.f) & 0xffffu);
            *(bf16*)(img + IM_KT + s * HGP + d * 2) = (bf16)(pk2(kk[s] * fast_exp(fminf(-b[s], 80.f)), 0.f) & 0xffffu);
        }
#pragma unroll
        for (int j = 0; j < 8; ++j) { khw[j] = pk2(kk[2 * j] * fast_exp(b[15] - b[2 * j]), kk[2 * j + 1] * fast_exp(b[15] - b[2 * j + 1])); vtw[j] = (unsigned)vv[2 * j] | ((unsigned)vv[2 * j + 1] << 16); }
        *(v4u*)(img + IM_KH + d * 48) = (v4u){khw[0], khw[1], khw[2], khw[3]}; *(v4u*)(img + IM_KH + d * 48 + 16) = (v4u){khw[4], khw[5], khw[6], khw[7]};
        *(v4u*)(img + IM_VT + d * 48) = (v4u){vtw[0], vtw[1], vtw[2], vtw[3]}; *(v4u*)(img + IM_VT + d * 48 + 16) = (v4u){vtw[4], vtw[5], vtw[6], vtw[7]};
        *(float*)(img + IM_DEC + d * 4) = fast_exp(b[15]);
    }
}

template <int MODE>
__device__ __forceinline__ void hgrn_sweep(const Params& P, LAS unsigned char* lds, int layer, int dir, int hh, int seg, const float* Sinit, float* Uout, float* Dout, int wv) {
    int tid_ = fresh_tid(wv);
    const int tid = tid_, lane = tid & 63, wid = __builtin_amdgcn_readfirstlane(tid >> 6), r32 = lane & 31, hi = lane >> 5;
    GAS unsigned char* wsg_ = (GAS unsigned char*)P.ws; asm volatile("" : "+s"(wsg_)); unsigned char* ws = (unsigned char*)wsg_;
    const int tok0 = (seg < 64 ? seg * 256 : SEQ) + (dir ? 255 : 0), sgn = dir ? -1 : 1;
    constexpr int NV = (MODE == 0) ? 2 : 4;
    const int db = wid & 3, vb0 = (MODE == 0) ? 2 * (wid >> 2) : 0;
    const bool srole = (MODE == 0) || wid >= 4, orole = (MODE != 0) && wid < 4;
    const unsigned lds0 = (unsigned)(uintptr_t)lds;
    const unsigned char* img0 = ws + WS_IMG + (size_t)(((dir * 4 + hh) * 65 + seg) * 16) * IM_BYTES;
    constexpr int P0 = (MODE == 0) ? 8 : 0;
#define HG_DMA_IMG(c) do { _Pragma("unroll") for (int j = 0; j < 3; ++j) { const int pc = wid + 8 * j; if (pc >= P0 && pc < 21) \
        glds16_s(img0 + (size_t)(c) * IM_BYTES + pc * 1024, (unsigned)lane * 16u, lds0 + HL_IMG + ((c) & 1) * IM_BYTES + pc * 1024); } } while (0)
#define HG_DMA_FIN(c) do { { const int t = 2 * wid + (lane >> 5), tok = tok0 + sgn * (16 * (c) + t); \
        glds16_s(ws + WS_OBF, (unsigned)(((size_t)tok * 512 + 128 * hh) * 4 + (lane & 31) * 16), lds0 + HL_OF + ((c) & 1) * 8192 + wid * 1024); } \
      if (wid < 4) { const int t = 4 * wid + (lane >> 4), tok = tok0 + sgn * (16 * (c) + t); \
        glds16_s(ws + WS_PROJ, (unsigned)(((size_t)tok * PROJW + PC_GH + 128 * hh) * 2 + (lane & 15) * 16), lds0 + HL_GT + ((c) & 1) * 4096 + wid * 1024); } } while (0)
    HG_DMA_IMG(0);
    f32x16 S[NV];
#pragma unroll
    for (int blk = 0; blk < NV; ++blk)
#pragma unroll
        for (int r = 0; r < 16; ++r) { const int d = 32 * db + (r & 3) + 8 * (r >> 2) + 4 * hi, v = 32 * (vb0 + blk) + r32; S[blk][r] = (Sinit && srole) ? Sinit[(size_t)d * 128 + v] : 0.f; }
    if (MODE != 0 && srole) {
#pragma unroll
        for (int blk = 0; blk < NV; ++blk)
#pragma unroll
            for (int g = 0; g < 4; ++g) { v2u o; o.x = pk2(S[blk][4 * g], S[blk][4 * g + 1]); o.y = pk2(S[blk][4 * g + 2], S[blk][4 * g + 3]);
                *(LAS v2u*)(lds + HL_ST + (32 * (vb0 + blk) + r32) * HGP + (32 * db + 8 * g + 4 * hi) * 2) = o; }
    }
    float dtot = 1.f;
    const f32x4 gnv = *(const f32x4*)(P.in[I_HGNG] + (size_t)layer * 128 + 4 * (tid & 31));
#define HG_FINALIZE(c) do { const int t = tid >> 5, v4 = 4 * (tid & 31), tok = tok0 + sgn * (16 * (c) + t); \
        const f32x4 o = *(const LAS f32x4*)(lds + HL_OT + ((c) & 1) * HL_OTSZ + t * 528 + v4 * 4) + *(const LAS f32x4*)(lds + HL_OF + ((c) & 1) * 8192 + t * 512 + v4 * 4); \
        float ss = (o.x * o.x + o.y * o.y) + (o.z * o.z + o.w * o.w); \
        _Pragma("unroll") for (int off = 1; off < 32; off <<= 1) ss += shx(ss, off, lane); \
        const float rstd = __builtin_amdgcn_rsqf(ss * (1.f / 128.f) + EPS); \
        const f32x4 gn = gnv; \
        const v2u gt = *(const LAS v2u*)(lds + HL_GT + ((c) & 1) * 4096 + t * 256 + v4 * 2); \
        v2u w; w.x = pk2(o.x * rstd * gn.x * bflo(gt.x), o.y * rstd * gn.y * bfhi(gt.x)); w.y = pk2(o.z * rstd * gn.z * bflo(gt.y), o.w * rstd * gn.w * bfhi(gt.y)); \
        *(v2u*)((bf16*)(ws + WS_OAB) + (size_t)NT * 512 + (size_t)tok * 512 + 128 * hh + v4) = w; } while (0)
    for (int c = 0; c < 16; ++c) {
        if (c >= 1 && MODE == 1 && orole) asm volatile("s_waitcnt vmcnt(8)" ::: "memory");
        else if (c >= 2 && MODE == 2) asm volatile("s_waitcnt vmcnt(1)" ::: "memory");
        else asm volatile("s_waitcnt vmcnt(0)" ::: "memory");
        __syncthreads();
        if (c + 1 < 16) HG_DMA_IMG(c + 1);
        if (MODE == 2) { HG_DMA_FIN(c); if (c > 0) HG_FINALIZE(c - 1); }
        const LAS unsigned char* im = lds + HL_IMG + (c & 1) * IM_BYTES;
        const int cur = c & 1;
        if (orole) {
            const int t16 = lane & 15, kq4 = lane >> 4;
            bf16x8 qa[4];
#pragma unroll
            for (int ks = 0; ks < 4; ++ks) qa[ks] = *(const LAS bf16x8*)(im + IM_QT + t16 * HGP + (32 * ks + 8 * kq4) * 2);
            f32x4 am = {0.f, 0.f, 0.f, 0.f};
#pragma unroll
            for (int ks = 0; ks < 4; ++ks) { const bf16x8 kb = *(const LAS bf16x8*)(im + IM_KT + t16 * HGP + (32 * ks + 8 * kq4) * 2); am = __builtin_amdgcn_mfma_f32_16x16x32_bf16(qa[ks], kb, am, 0, 0, 0); }
            LAS unsigned char* amw = lds + HL_AM + wid * 768;
#pragma unroll
            for (int i = 0; i < 4; ++i) { const int t = 4 * kq4 + i; *(LAS bf16*)(amw + t * 48 + t16 * 2) = (bf16)(pk2(t16 <= t ? am[i] : 0.f, 0.f) & 0xffffu); }
            f32x4 o4[2];
#pragma unroll
            for (int b2 = 0; b2 < 2; ++b2) { o4[b2] = (f32x4){0.f, 0.f, 0.f, 0.f}; const int vcol = 32 * wid + 16 * b2 + t16;
#pragma unroll
                for (int ks = 0; ks < 4; ++ks) { const bf16x8 sb = *(const LAS bf16x8*)(lds + HL_ST + cur * HL_STSZ + vcol * HGP + (32 * ks + 8 * kq4) * 2); o4[b2] = __builtin_amdgcn_mfma_f32_16x16x32_bf16(qa[ks], sb, o4[b2], 0, 0, 0); } }
            LDS_WAIT();
            bf16x8 ama = *(const LAS bf16x8*)(amw + t16 * 48 + 16 * (kq4 & 1));
            if (kq4 >= 2) ama = (bf16x8){0, 0, 0, 0, 0, 0, 0, 0};
#pragma unroll
            for (int b2 = 0; b2 < 2; ++b2) { const int vcol = 32 * wid + 16 * b2 + t16;
                const bf16x8 vbf = *(const LAS bf16x8*)(im + IM_VT + vcol * 48 + 16 * (kq4 & 1));
                o4[b2] = __builtin_amdgcn_mfma_f32_16x16x32_bf16(ama, vbf, o4[b2], 0, 0, 0);
#pragma unroll
                for (int i = 0; i < 4; ++i) { const int t = 4 * kq4 + i;
                    if (MODE == 1) { const int tok = tok0 + sgn * (16 * c + t); ((float*)(ws + WS_OBF))[(size_t)tok * 512 + 128 * hh + vcol] = o4[b2][i]; }
                    else *(LAS float*)(lds + HL_OT + cur * HL_OTSZ + t * 528 + vcol * 4) = o4[b2][i]; } }
        }
        if (srole) {
            float dsc[16];
#pragma unroll
            for (int r = 0; r < 16; ++r) dsc[r] = *(const LAS float*)(im + IM_DEC + (32 * db + (r & 3) + 8 * (r >> 2) + 4 * hi) * 4);
            if (MODE == 0 && tid < 128) dtot *= *(const LAS float*)(im + IM_DEC + tid * 4);
            const bf16x8 ka = *(const LAS bf16x8*)(im + IM_KH + (32 * db + r32) * 48 + 16 * hi);
#pragma unroll
            for (int blk = 0; blk < NV; ++blk) {
#pragma unroll
                for (int r = 0; r < 16; ++r) S[blk][r] *= dsc[r];
                const bf16x8 vb = *(const LAS bf16x8*)(im + IM_VT + (32 * (vb0 + blk) + r32) * 48 + 16 * hi);
                S[blk] = __builtin_amdgcn_mfma_f32_32x32x16_bf16(ka, vb, S[blk], 0, 0, 0);
                if (MODE != 0) {
#pragma unroll
                    for (int g = 0; g < 4; ++g) { v2u o; o.x = pk2(S[blk][4 * g], S[blk][4 * g + 1]); o.y = pk2(S[blk][4 * g + 2], S[blk][4 * g + 3]);
                        *(LAS v2u*)(lds + HL_ST + (cur ^ 1) * HL_STSZ + (32 * (vb0 + blk) + r32) * HGP + (32 * db + 8 * g + 4 * hi) * 2) = o; }
                }
            }
        }
    }
    asm volatile("s_waitcnt vmcnt(0)" ::: "memory");
    __syncthreads();
    if (MODE == 2) HG_FINALIZE(15);
    if (MODE == 0) {
#pragma unroll
        for (int blk = 0; blk < NV; ++blk)
#pragma unroll
            for (int r = 0; r < 16; ++r) { const int d = 32 * db + (r & 3) + 8 * (r >> 2) + 4 * hi, v = 32 * (vb0 + blk) + r32; Uout[(size_t)d * 128 + v] = S[blk][r]; }
        if (tid < 128) Dout[tid] = dtot;
    }
    asm volatile("s_waitcnt vmcnt(0)" ::: "memory");
    __syncthreads();
#undef HG_DMA_IMG
#undef HG_DMA_FIN
#undef HG_FINALIZE
}

__device__ __forceinline__ void phase_hgrn1(const Params& P, LAS unsigned char* lds, int layer, int G, int wv) {
    float* U = (float*)(P.ws + WS_HGU); float* Dv = (float*)(P.ws + WS_HGD);
    for (int w = blockIdx.x; w < 512; w += G) {
        const int dir = w >> 8, hh = (w >> 6) & 3, j = w & 63;
        const int seg = (j == 0) ? 64 : (dir ? 64 - j : j - 1);
        hgrn_sweep<0>(P, lds, layer, dir, hh, seg, nullptr, U + (size_t)w * 16384, Dv + (size_t)w * 128, wv);
    }
}
__device__ __forceinline__ void phase_hgrn_chain(const Params& P, int G, int wv) {
    const float* U = (const float*)(P.ws + WS_HGU); const float* Dv = (const float*)(P.ws + WS_HGD); float* Sg = (float*)(P.ws + WS_HGS);
    int tid_ = fresh_tid(wv);
    for (int t = blockIdx.x * NTHR + tid_; t < 8 * 16384; t += G * NTHR) {
        const int dh = t >> 14, el = t & 16383, d = el >> 7;
        float s = 0.f;
        Sg[((size_t)dh * 65 + 0) * 16384 + el] = 0.f;
#pragma unroll
        for (int h = 0; h < 2; ++h) {
            float uu[32], dd[32];
#pragma unroll
            for (int p = 0; p < 32; ++p) { uu[p] = U[((size_t)dh * 64 + 32 * h + p) * 16384 + el]; dd[p] = Dv[((size_t)dh * 64 + 32 * h + p) * 128 + d]; }
#pragma unroll
            for (int p = 0; p < 32; ++p) { s = dd[p] * s + uu[p]; Sg[((size_t)dh * 65 + 32 * h + p + 1) * 16384 + el] = s; }
        }
    }
}
__device__ __forceinline__ void hgrn_unit2(const Params& P, LAS unsigned char* lds, int layer, int hh, int seg, int wv) {
    const float* Sg = (const float*)(P.ws + WS_HGS);
    const int pf = (seg < 64) ? seg + 1 : 0, pb = (seg < 64) ? 64 - seg : 0;
    hgrn_sweep<1>(P, lds, layer, 0, hh, seg, pf ? Sg + ((size_t)(0 * 4 + hh) * 65 + pf) * 16384 : nullptr, nullptr, nullptr, wv);
    hgrn_sweep<2>(P, lds, layer, 1, hh, seg, pb ? Sg + ((size_t)(1 * 4 + hh) * 65 + pb) * 16384 : nullptr, nullptr, nullptr, wv);
}

constexpr int AL_K = 0, AL_KSZ = 8192, AL_V = 2 * AL_KSZ, AL_VSZ = 8192, AL_WS = 65536, AL_OST = AL_WS + 8 * 256;

__device__ __forceinline__ void glds16_s(const void* sbase, unsigned voff, unsigned lds_dst) {
    unsigned keep;
    { const unsigned long long a = (unsigned long long)(uintptr_t)sbase;
      const unsigned lo = __builtin_amdgcn_readfirstlane((unsigned)a), hi2 = __builtin_amdgcn_readfirstlane((unsigned)(a >> 32));
      sbase = (const void*)(uintptr_t)(((unsigned long long)hi2 << 32) | lo); lds_dst = __builtin_amdgcn_readfirstlane(lds_dst); }
    asm volatile("s_mov_b32 %0, m0\n\ts_mov_b32 m0, %3\n\ts_nop 0\n\tglobal_load_lds_dwordx4 %1, %2\n\ts_mov_b32 m0, %0" : "=&s"(keep) : "v"(voff), "s"(sbase), "s"(lds_dst) : "memory");
}
__device__ __forceinline__ void attn_unit(const Params& P, LAS unsigned char* lds, int layer, int hh, int qt, float lam, float oscale, int wv) {
    int tid = fresh_tid(wv);
    const int lane = tid & 63, wid = __builtin_amdgcn_readfirstlane(tid >> 6), r32 = lane & 31, hi = lane >> 5;
    const int qg = wid >> 1, mp = wid & 1;
    GAS unsigned char* wsg_ = (GAS unsigned char*)P.ws; asm volatile("" : "+s"(wsg_)); unsigned char* ws = (unsigned char*)wsg_;
    const int qrow0 = (qt < 64) ? qt * 256 : SEQ;
    const int kt_lo = (qt < 64) ? 0 : 256, kt_hi = NT / 64;
    const unsigned char* Qg = ws + WS_Q + ((size_t)hh * NT + qrow0 + 64 * qg + r32) * 128 + 64 * mp + 32 * hi;
    const char* Kg = (const char*)(ws + WS_K) + (size_t)hh * NT * 128;
    const char* Vg = (const char*)(ws + WS_VT) + (size_t)hh * 128 * LDV;
    typedef int v4i_ __attribute__((ext_vector_type(4))); typedef int v8i_ __attribute__((ext_vector_type(8)));
    v8i_ qf[2];
#pragma unroll
    for (int q2 = 0; q2 < 2; ++q2) qf[q2] = __builtin_shufflevector(*(const v4i_*)(Qg + (size_t)q2 * 32 * 128), *(const v4i_*)(Qg + (size_t)q2 * 32 * 128 + 16), 0, 1, 2, 3, 4, 5, 6, 7);
    f32x16 O[2][4];
#pragma unroll
    for (int q2 = 0; q2 < 2; ++q2)
#pragma unroll
        for (int db = 0; db < 4; ++db)
#pragma unroll
            for (int r = 0; r < 16; ++r) O[q2][db][r] = 0.f;
    float lsum0 = 0.f, lsum1 = 0.f;
    const unsigned lds0 = (unsigned)(uintptr_t)lds;
    const int ki_ = 8 * wid + (lane >> 3), vi_ = 16 * wid + (lane >> 2);
    const unsigned ko_ = (unsigned)((32 * ((ki_ >> 2) & 1) + 16 * (ki_ >> 5) + (ki_ & 3) + 4 * ((ki_ & 31) >> 3)) * 128 + (((lane & 7) ^ ((ki_ >> 1) & 7)) << 4));
    const unsigned vo_ = (unsigned)(vi_ * LDV + (((lane & 3) ^ ((vi_ >> 2) & 3)) << 4));
#define ATT_DMA(t, buf) do { \
        glds16_s(Kg + (size_t)(t) * 8192, ko_, lds0 + AL_K + (buf) * AL_KSZ + wid * 1024); \
        glds16_s(Vg + (size_t)(t) * 64, vo_, lds0 + AL_V + (buf) * AL_VSZ + wid * 1024); } while (0)
    ATT_DMA(kt_lo, 0);
    asm volatile("s_waitcnt vmcnt(0)" ::: "memory");
    __syncthreads();
    asm volatile("" : "+v"(qf[0]), "+v"(qf[1]));
    if (wid >= 4) __builtin_amdgcn_s_setprio(1);
    int cur = 0;
    const int ksw = (4 * mp + 2 * hi) ^ ((r32 >> 1) & 7), vsw = (2 * hi) ^ ((r32 >> 2) & 3);
    for (int t = kt_lo; t < kt_hi; ++t) {
        if (t + 1 < kt_hi) ATT_DMA(t + 1, cur ^ 1);
        unsigned kb0 = (unsigned)(AL_K + cur * AL_KSZ + r32 * 128 + (ksw << 4)), vb0 = (unsigned)(AL_V + cur * AL_VSZ + r32 * 64 + (vsw << 4));
        asm volatile("" : "+v"(kb0), "+v"(vb0));
        v8i_ kf[2], pa[2];
#pragma unroll
        for (int kb = 0; kb < 2; ++kb) kf[kb] = __builtin_shufflevector(*(const LAS v4i_*)(lds + kb0 + kb * 4096), *(const LAS v4i_*)(lds + (kb0 ^ 16u) + kb * 4096), 0, 1, 2, 3, 4, 5, 6, 7);
#pragma unroll
        for (int q2 = 0; q2 < 2; ++q2) {
            f32x16 s[2];
#pragma unroll
            for (int kb = 0; kb < 2; ++kb) {
#pragma unroll
                for (int r = 0; r < 16; ++r) s[kb][r] = 0.f;
                s[kb] = __builtin_amdgcn_mfma_scale_f32_32x32x64_f8f6f4(kf[kb], qf[q2], s[kb], 0, 0, 0, 0, 0, 0);
            }
            float ls = 0.f;
#pragma unroll
            for (int kb = 0; kb < 2; ++kb)
#pragma unroll
                for (int r = 0; r < 16; ++r) { s[kb][r] = __builtin_amdgcn_exp2f(s[kb][r]); ls += s[kb][r]; }
            if (q2 == 0) lsum0 += ls; else lsum1 += ls;
#pragma unroll
            for (int kb = 0; kb < 2; ++kb)
#pragma unroll
                for (int w = 0; w < 4; ++w) { int p; asm volatile("" : "=v"(p)); p = __builtin_amdgcn_cvt_pk_bf8_f32(s[kb][4 * w], s[kb][4 * w + 1], p, false);        p = __builtin_amdgcn_cvt_pk_bf8_f32(s[kb][4 * w + 2], s[kb][4 * w + 3], p, true); pa[q2][4 * kb + w] = p; }
        }
        {
            v8i_ vcur = __builtin_shufflevector(*(const LAS v4i_*)(lds + vb0), *(const LAS v4i_*)(lds + (vb0 ^ 16u)), 0, 1, 2, 3, 4, 5, 6, 7);
#pragma unroll
            for (int db = 0; db < 4; ++db) {
                v8i_ vnext = vcur;
                if (db < 3) vnext = __builtin_shufflevector(*(const LAS v4i_*)(lds + vb0 + (db + 1) * 2048), *(const LAS v4i_*)(lds + (vb0 ^ 16u) + (db + 1) * 2048), 0, 1, 2, 3, 4, 5, 6, 7);
                O[0][db] = __builtin_amdgcn_mfma_scale_f32_32x32x64_f8f6f4(pa[0], vcur, O[0][db], 1, 0, 0, 0, 0, 0);
                O[1][db] = __builtin_amdgcn_mfma_scale_f32_32x32x64_f8f6f4(pa[1], vcur, O[1][db], 1, 0, 0, 0, 0, 0);
                vcur = vnext;
            }
        }
        asm volatile("s_waitcnt vmcnt(0)" ::: "memory");
        __syncthreads();
        cur ^= 1;
    }
#undef ATT_DMA
    __builtin_amdgcn_s_setprio(0);
    lsum0 += shx(lsum0, 32, lane); lsum1 += shx(lsum1, 32, lane);
    LAS float* wsf = (LAS float*)(lds + AL_WS + wid * 256);
    if (hi == 0) { wsf[r32] = (mp ? lam : 1.f) / lsum0; wsf[32 + r32] = (mp ? lam : 1.f) / lsum1; }
    LDS_WAIT();
    LAS float* X = (LAS float*)(lds + qg * 16384);
    const float* sg = P.in[I_SUBLN] + (size_t)layer * 128;
    LAS bf16* stg = (LAS bf16*)(lds + AL_OST + qg * 8192);
#pragma unroll
    for (int q2 = 0; q2 < 2; ++q2) {
        if (mp == 1) {
#pragma unroll
            for (int r = 0; r < 16; ++r) { const float a = wsf[32 * q2 + (r & 3) + 8 * (r >> 2) + 4 * hi];
#pragma unroll
                for (int db = 0; db < 4; ++db) X[(db * 16 + r) * 64 + lane] = O[q2][db][r] * a; }
        }
        __syncthreads();
        if (mp == 0) {
            float gsc[4];
#pragma unroll
            for (int db = 0; db < 4; ++db) gsc[db] = sg[32 * db + r32] * oscale;
#pragma unroll
            for (int r = 0; r < 16; ++r) {
                const int q = (r & 3) + 8 * (r >> 2) + 4 * hi;
                const float a0 = wsf[32 * q2 + q];
                float o[4], ss = 0.f;
#pragma unroll
                for (int db = 0; db < 4; ++db) { o[db] = O[q2][db][r] * a0 - X[(db * 16 + r) * 64 + lane]; ss += o[db] * o[db]; }
#pragma unroll
                for (int off = 1; off < 32; off <<= 1) ss += shx(ss, off, lane);
                const float rstd = __builtin_amdgcn_rsqf(ss * (1.f / 128.f) + EPS);
#pragma unroll
                for (int db = 0; db < 4; ++db) stg[q * 128 + 32 * db + r32] = (bf16)(pk2(o[db] * rstd * gsc[db], 0.f) & 0xffffu);
            }
            LDS_WAIT();
            bf16* Ow = (bf16*)(ws + WS_OAB) + (size_t)(qrow0 + 64 * qg + 32 * q2) * 512 + 128 * hh;
#pragma unroll
            for (int i = 0; i < 8; ++i) { const int row = 4 * i + (lane >> 4), ch = lane & 15;
                const v4u v = *(const LAS v4u*)(stg + row * 128 + ch * 8); *(v4u*)(Ow + (size_t)row * 512 + ch * 8) = v; }
        }
        __syncthreads();
    }
}

__device__ __forceinline__ void phase_mix(const Params& P, LAS unsigned char* lds, int layer, int G, bool with_ctx, int wv, int KINDS) {
    int tid_ = fresh_tid(wv);
    const int lane = tid_ & 63;
    const float* lq = P.in[I_LAMQK] + (size_t)layer * 4 * 64;
    const float s1 = wave_sum(lq[lane] * lq[64 + lane], lane), s2 = wave_sum(lq[128 + lane] * lq[192 + lane], lane);
    const float lam_init = __int_as_float(__builtin_amdgcn_readfirstlane(__float_as_int(0.8f - 0.6f * expf(-0.3f * (float)layer))));
    const float lam = __int_as_float(__builtin_amdgcn_readfirstlane(__float_as_int(expf(s1) - expf(s2) + lam_init)));
    if (KINDS & 1) {
        const int na = with_ctx ? 260 : 256;
#pragma unroll 1
        for (int u = blockIdx.x; u < na; u += G) {
            const int hh = (u < 256) ? ((u & 7) >> 1) : (u - 256), qt = (u < 256) ? (((u >> 3) << 1) | (u & 1)) : 64;
            attn_unit(P, lds, layer, hh, qt, lam, __int_as_float(__builtin_amdgcn_readfirstlane(__float_as_int(1.f - lam_init))), wv);
        }
    }
    if (KINDS & 2) {
        const int nh = with_ctx ? 260 : 256;
#pragma unroll 1
        for (int k = 0; ; ++k) {
            int v;
            if (G == 256) { const int c = (int)blockIdx.x; if (k == 0) v = c; else if (k == 1 && with_ctx && c >= 4 && c < 8) v = 252 + c; else break; }
            else { v = (int)blockIdx.x + k * G; if (v >= nh) break; }
            hgrn_unit2(P, lds, layer, v & 3, v >> 2, wv);
        }
    }
}

constexpr int RL_RW = 0, RL_TA = RW_IMG, RL_TB = RL_TA + 8192, RL_LOG = RL_TB + 8192, RL_INFO = RL_LOG + 80 * 33 * 4, RL_CNT = RL_INFO + 80 * 32, RL_BASE = RL_CNT + 128, RL_RSTD = RL_BASE + 128;
__device__ __forceinline__ void phase_router(const Params& P, LAS unsigned char* lds, int layer, int G, int nrows, int wv) {
    int tid_ = fresh_tid(wv);
    const int tid = tid_, lane = tid & 63, wave = __builtin_amdgcn_readfirstlane(tid >> 6);
    GAS unsigned char* wsg_ = (GAS unsigned char*)P.ws; asm volatile("" : "+s"(wsg_)); unsigned char* ws = (unsigned char*)wsg_;
    LAS float* TA = (LAS float*)(lds + RL_TA); LAS float* TB = (LAS float*)(lds + RL_TB); LAS float* LOG = (LAS float*)(lds + RL_LOG);
    LAS unsigned* INFO = (LAS unsigned*)(lds + RL_INFO); LAS unsigned* LCNT = (LAS unsigned*)(lds + RL_CNT); LAS unsigned* GBASE = (LAS unsigned*)(lds + RL_BASE); LAS float* RSTD = (LAS float*)(lds + RL_RSTD);
    { const unsigned lds0 = (unsigned)(uintptr_t)lds; const unsigned char* img = ws + WS_RWIMG + (size_t)layer * RW_IMG;
      for (int pc = wave; pc < RW_IMG / 1024; pc += NWAVES) glds16_s(img + (size_t)pc * 1024, (unsigned)lane * 16u, lds0 + RL_RW + pc * 1024); }
    for (int i = tid; i < 2048; i += NTHR) { const int w = i >> 10, j = i & 1023; const float* mv = modv_ptr(P, layer, w);
        TA[i] = P.in[I_N2G][(size_t)layer * D + j] * (1.f + mv[4096 + j]); TB[i] = mv[3072 + j]; }
    const bf16* xres = (const bf16*)(ws + WS_XRES);
    const float* rb = P.in[I_RB] + (size_t)layer * NE;
    unsigned* gcnt = (unsigned*)(ws + WS_CTL) + CW_CNT + layer * 32 * 16;
    unsigned* tokinfo = (unsigned*)(ws + WS_TOK);
    bf16* XS = (bf16*)(ws + WS_XS);
    const int RB = nrows / 256;
    asm volatile("s_waitcnt vmcnt(0)" ::: "memory");
    for (int blk = blockIdx.x; blk < 256; blk += G) {
#define RROW(r) ((r) < 64 ? 64 * blk + (r) : SEQ + blk)
        if (tid < 32) LCNT[tid] = 0u;
#pragma unroll 1
        for (int rl = wave; rl < RB; rl += NWAVES) {
            const bf16* xr = xres + (size_t)RROW(rl) * D;
            float ss = 0.f;
#pragma unroll
            for (int k = 0; k < 4; ++k) { const v2u xw = *(const v2u*)(xr + 4 * lane + 256 * k); const f32x4 x = {bflo(xw.x), bfhi(xw.x), bflo(xw.y), bfhi(xw.y)}; ss += (x.x * x.x + x.y * x.y) + (x.z * x.z + x.w * x.w); }
            ss = wave_sum(ss, lane);
            if (lane == 0) RSTD[rl] = __builtin_amdgcn_rsqf(ss * (1.f / D) + EPS);
        }
        __syncthreads();
        if (16 * wave < RB) {
            const int r16 = lane & 15, kq = lane >> 4, r = 16 * wave + r16, rc = r < RB ? r : RB - 1, row = RROW(rc), wsel = row >= SEQ;
            const float rstd = RSTD[rc];
            const bf16* xr = xres + (size_t)row * D + 8 * kq;
            const LAS float* ta = TA + 1024 * wsel + 8 * kq; const LAS float* tb = TB + 1024 * wsel + 8 * kq;
            const LAS unsigned char* bh = lds + RL_RW + r16 * RW_PITCH + 16 * kq;
            f32x4 acc0 = {0.f, 0.f, 0.f, 0.f}, acc1 = {0.f, 0.f, 0.f, 0.f};
#pragma unroll 4
            for (int ks = 0; ks < 32; ++ks) {
                const v4u xw = *(const v4u*)(xr + 32 * ks); const f32x4 x0 = {bflo(xw.x), bfhi(xw.x), bflo(xw.y), bfhi(xw.y)}, x1 = {bflo(xw.z), bfhi(xw.z), bflo(xw.w), bfhi(xw.w)};
                const f32x4 a0 = *(const LAS f32x4*)(ta + 32 * ks), a1 = *(const LAS f32x4*)(ta + 32 * ks + 4), b0 = *(const LAS f32x4*)(tb + 32 * ks), b1 = *(const LAS f32x4*)(tb + 32 * ks + 4);
                const f32x4 h0 = x0 * rstd * a0 + b0, h1 = x1 * rstd * a1 + b1;
                v4u hw, lw;
                hw.x = pk2(h0.x, h0.y); hw.y = pk2(h0.z, h0.w); hw.z = pk2(h1.x, h1.y); hw.w = pk2(h1.z, h1.w);
                lw.x = pk2(h0.x - bflo(hw.x), h0.y - bfhi(hw.x)); lw.y = pk2(h0.z - bflo(hw.y), h0.w - bfhi(hw.y)); lw.z = pk2(h1.x - bflo(hw.z), h1.y - bfhi(hw.z)); lw.w = pk2(h1.z - bflo(hw.w), h1.w - bfhi(hw.w));
                const bf16x8 ah = __builtin_bit_cast(bf16x8, hw), al = __builtin_bit_cast(bf16x8, lw);
                const bf16x8 wh0 = *(const LAS bf16x8*)(bh + 64 * ks), wh1 = *(const LAS bf16x8*)(bh + 16 * RW_PITCH + 64 * ks);
                const bf16x8 wl0 = *(const LAS bf16x8*)(bh + 32 * RW_PITCH + 64 * ks), wl1 = *(const LAS bf16x8*)(bh + 48 * RW_PITCH + 64 * ks);
                acc0 = __builtin_amdgcn_mfma_f32_16x16x32_bf16(ah, wh0, acc0, 0, 0, 0); acc0 = __builtin_amdgcn_mfma_f32_16x16x32_bf16(ah, wl0, acc0, 0, 0, 0); acc0 = __builtin_amdgcn_mfma_f32_16x16x32_bf16(al, wh0, acc0, 0, 0, 0);
                acc1 = __builtin_amdgcn_mfma_f32_16x16x32_bf16(ah, wh1, acc1, 0, 0, 0); acc1 = __builtin_amdgcn_mfma_f32_16x16x32_bf16(ah, wl1, acc1, 0, 0, 0); acc1 = __builtin_amdgcn_mfma_f32_16x16x32_bf16(al, wh1, acc1, 0, 0, 0);
            }
#pragma unroll
            for (int i = 0; i < 4; ++i) { const int rr = 16 * wave + 4 * kq + i; if (rr < RB) { LOG[rr * 33 + r16] = acc0[i]; LOG[rr * 33 + 16 + r16] = acc1[i]; } }
        }
        __syncthreads();
        if (tid < RB) {
            float p[NE];
#pragma unroll
            for (int e = 0; e < NE; ++e) p[e] = LOG[tid * 33 + e] + rb[e];
            float tv[4]; int ti[4];
#pragma unroll
            for (int k = 0; k < 4; ++k) { float best = -3.0e38f; int bi = 0;
#pragma unroll
                for (int e = 0; e < NE; ++e) { const bool gt = p[e] > best; best = gt ? p[e] : best; bi = gt ? e : bi; }
                tv[k] = best; ti[k] = bi;
#pragma unroll
                for (int e = 0; e < NE; ++e) p[e] = (e == bi) ? -3.0e38f : p[e]; }
            float wk[4], wsum = 0.f;
#pragma unroll
            for (int k = 0; k < 4; ++k) { wk[k] = expf(tv[k] - tv[0]); wsum += wk[k]; }
#pragma unroll
            for (int k = 0; k < 4; ++k) { const unsigned pos = __hip_atomic_fetch_add(&LCNT[ti[k]], 1u, __ATOMIC_RELAXED, __HIP_MEMORY_SCOPE_WORKGROUP); INFO[tid * 8 + 2 * k] = ((unsigned)ti[k] << 16) | pos; INFO[tid * 8 + 2 * k + 1] = __float_as_uint(wk[k] / wsum); }
        }
        __syncthreads();
        if (tid < 32) GBASE[tid] = __hip_atomic_fetch_add(gcnt + tid * 16, LCNT[tid], RLX_AGENT);
        __syncthreads();
#pragma unroll 1
        for (int rl = wave; rl < RB; rl += NWAVES) {
            const int row = RROW(rl), w = row >= SEQ;
            const bf16* xr = xres + (size_t)row * D + 16 * lane;
            const float rstd = RSTD[rl];
            v4u o8;
            {
                f32x4 v[4];
#pragma unroll
                for (int j = 0; j < 4; ++j) { const v2u xw = *(const v2u*)(xr + 4 * j); const f32x4 xv = {bflo(xw.x), bfhi(xw.x), bflo(xw.y), bfhi(xw.y)}; const f32x4 a = *(const LAS f32x4*)(TA + 1024 * w + 16 * lane + 4 * j), b = *(const LAS f32x4*)(TB + 1024 * w + 16 * lane + 4 * j); v[j] = xv * rstd * a + b; }
                o8.x = pk_fp8x4(v[0].x, v[0].y, v[0].z, v[0].w); o8.y = pk_fp8x4(v[1].x, v[1].y, v[1].z, v[1].w); o8.z = pk_fp8x4(v[2].x, v[2].y, v[2].z, v[2].w); o8.w = pk_fp8x4(v[3].x, v[3].y, v[3].z, v[3].w);
            }
#pragma unroll
            for (int k = 0; k < 4; ++k) {
                const unsigned ep = INFO[rl * 8 + 2 * k], wb = INFO[rl * 8 + 2 * k + 1];
                const unsigned e = ep >> 16, slot = GBASE[e] + (ep & 0xffffu);
                unsigned char* dst = (unsigned char*)XS + ((size_t)e * CAP + slot) * D + 16 * lane;
                *(v4u*)dst = o8;
                if (lane == 0) { v4u ti4; ti4.x = e; ti4.y = slot; ti4.z = wb; ti4.w = 0u; *(v4u*)(tokinfo + (size_t)row * 16 + 4 * k) = ti4; }
            }
        }
        __syncthreads();
#undef RROW
    }
}

template <bool DRY>
__device__ __forceinline__ void phase_combine(const Params& P, LAS unsigned char* lds, int layer, int G, int nrows, int wv) {
    int tid_ = fresh_tid(wv);
    const int tid = tid_, lane = tid & 63, wave = tid >> 6;
    GAS unsigned char* wsg_ = (GAS unsigned char*)P.ws; asm volatile("" : "+s"(wsg_)); unsigned char* ws = (unsigned char*)wsg_;
    const bool last = (layer == DEPTH - 1);
    LAS float* TA = (LAS float*)lds; LAS float* TB = (LAS float*)(lds + 8192); LAS float* TG = (LAS float*)(lds + 16384);
    for (int i = tid; i < 2048; i += NTHR) { const int w = i >> 10, j = i & 1023;
        TG[i] = modv_ptr(P, layer, w)[5120 + j];
        if (!last) { const float* mv = modv_ptr(P, layer + 1, w); TA[i] = P.in[I_N1G][(size_t)(layer + 1) * D + j] * (1.f + mv[1024 + j]); TB[i] = mv[j]; } }
    __syncthreads();
    bf16* xres = (bf16*)(ws + WS_XRES);
    bf16* xdst = DRY ? (bf16*)(ws + WS_HDN) : xres;
    const unsigned* tokinfo = (const unsigned*)(ws + WS_TOK);
    const bf16* Y = (const bf16*)(ws + WS_XS);
    bf16* H = DRY ? (bf16*)(ws + WS_HDN + (size_t)NT * D * 4) : (bf16*)(ws + WS_H);
#pragma unroll 2
    for (int row = blockIdx.x * NWAVES + wave; row < nrows; row += G * NWAVES) {
        const int w = row >= SEQ;
        f32x4 acc[4];
#pragma unroll
        for (int j = 0; j < 4; ++j) acc[j] = (f32x4){0.f, 0.f, 0.f, 0.f};
#pragma unroll
        for (int k = 0; k < 4; ++k) {
            const v4u ti4 = *(const v4u*)(tokinfo + (size_t)row * 16 + 4 * k);
            const float wk = __uint_as_float(ti4.z);
            const bf16* yr = Y + ((size_t)ti4.x * CAP + ti4.y) * D + 4 * lane;
#pragma unroll
            for (int j = 0; j < 4; ++j) { const v2u yv = *(const v2u*)(yr + 256 * j); acc[j] += wk * (f32x4){bflo(yv.x), bfhi(yv.x), bflo(yv.y), bfhi(yv.y)}; }
        }
        const bf16* xr = xres + (size_t)row * D + 4 * lane;
        f32x4 v[4];
#pragma unroll
        for (int j = 0; j < 4; ++j) { const v2u xw = *(const v2u*)(xr + 256 * j); v[j] = (f32x4){bflo(xw.x), bfhi(xw.x), bflo(xw.y), bfhi(xw.y)} + *(const LAS f32x4*)(TG + 1024 * w + 4 * lane + 256 * j) * acc[j]; }
        if (last) {
            float* orow = (DRY ? (float*)xdst : P.out) + (size_t)row * D + 4 * lane;
#pragma unroll
            for (int j = 0; j < 4; ++j) *(f32x4*)(orow + 256 * j) = v[j];
        } else {
#pragma unroll
            for (int j = 0; j < 4; ++j) { v2u o; o.x = pk2(v[j].x, v[j].y); o.y = pk2(v[j].z, v[j].w); *(v2u*)(xdst + (size_t)row * D + 4 * lane + 256 * j) = o; }
            norm_store_row(v, TA + 1024 * w, TB + 1024 * w, (unsigned char*)H + (size_t)row * D, lane);
        }
    }
}
#define XB_TMO      128
#define XB_XCNT(j)  (256  + 64 * (j))
#define XB_XSUB(j)  (1280 + 64 * (j))
#define XB_XGEN(j)  (2304 + 64 * (j))
#define XB_TOP      3328
#define XB_TOPGEN   3392
#define XCD_BAR_WORDS 3456
#define XB_SPIN_CAP (1u << 18)

__device__ __forceinline__ unsigned xb_ld(unsigned* p)              { return __hip_atomic_load(p, __ATOMIC_RELAXED, __HIP_MEMORY_SCOPE_AGENT); }
__device__ __forceinline__ unsigned xb_add(unsigned* p, unsigned v) { return __hip_atomic_fetch_add(p, v, __ATOMIC_RELAXED, __HIP_MEMORY_SCOPE_AGENT); }
__device__ __forceinline__ unsigned xb_xcc_id() { return (unsigned)__builtin_amdgcn_s_getreg((3 << 11) | 20) & 0xFu; }
#define XB_SPIN(cond, bar) do { unsigned _sp = 0; while (cond) { __builtin_amdgcn_s_sleep(1); \
    if ((++_sp & 255u) == 0u) { if (xb_ld(&(bar)[XB_TMO])) break; if (_sp > XB_SPIN_CAP) { atomicAdd(&(bar)[XB_TMO], 1u); break; } } } } while (0)

struct XcdBarrier {
    int wv; unsigned* bar; unsigned x;
    volatile LAS unsigned* st;
};

__device__ __forceinline__ XcdBarrier xcd_barrier_post(unsigned* bar, volatile LAS unsigned* st, int wv) {
    XcdBarrier b; b.wv = wv; b.bar = bar; b.x = xb_xcc_id(); b.st = st;
    if (fresh_tid(wv) == 0) (void)xb_add(&bar[XB_XCNT(b.x)], 1u);
    return b;
}
__device__ __forceinline__ void xcd_barrier_complete(unsigned* bar, unsigned x, unsigned& nloc, unsigned& nx) {
    const unsigned G = gridDim.x * gridDim.y * gridDim.z;
    unsigned sum, cnt, mine, sp = 0u;
    for (;;) {
        sum = 0u; cnt = 0u; mine = 0u;
#pragma unroll
        for (unsigned j = 0; j < 16; ++j) { const unsigned c = xb_ld(&bar[XB_XCNT(j)]); sum += c; cnt += (c > 0u) ? 1u : 0u; mine = (j == x) ? c : mine; }
        if (sum == G) break;
        __builtin_amdgcn_s_sleep(1);
        if ((++sp & 255u) == 0u) { if (xb_ld(&bar[XB_TMO])) break; if (sp > XB_SPIN_CAP) { atomicAdd(&bar[XB_TMO], 1u); break; } }
    }
    nloc = mine > 0u ? mine : 1u; nx = cnt > 0u ? cnt : 1u;
}

__device__ __forceinline__ void xcd_barrier(const XcdBarrier& b) {
    asm volatile("s_waitcnt vmcnt(0)" ::: "memory");
    __syncthreads();
    if (fresh_tid(b.wv) == 0) {
        unsigned* bar = b.bar;
        __builtin_amdgcn_s_waitcnt(0);
        unsigned nloc = b.st[0], nx = b.st[1];
        if (nloc == 0u) { xcd_barrier_complete(bar, b.x, nloc, nx); b.st[0] = nloc; b.st[1] = nx; }
        const unsigned old = xb_add(&bar[XB_XSUB(b.x)], 1u);
        const unsigned gen = old / nloc;
        if (old + 1u == (gen + 1u) * nloc) {
            __builtin_amdgcn_fence(__ATOMIC_RELEASE, "agent");
            asm volatile("s_waitcnt vmcnt(0)" ::: "memory");
            const unsigned og = xb_add(&bar[XB_TOP], 1u);
            const unsigned tg = og / nx;
            if (og + 1u == (tg + 1u) * nx) xb_add(&bar[XB_TOPGEN], 1u);
            else XB_SPIN(xb_ld(&bar[XB_TOPGEN]) == tg, bar);
            __builtin_amdgcn_fence(__ATOMIC_ACQUIRE, "agent");
            xb_add(&bar[XB_XGEN(b.x)], 1u);
            asm volatile("s_waitcnt vmcnt(0)" ::: "memory");
        } else {
            XB_SPIN(xb_ld(&bar[XB_XGEN(b.x)]) == gen, bar);
            __builtin_amdgcn_fence(__ATOMIC_ACQUIRE, "agent");
            asm volatile("s_waitcnt vmcnt(0)" ::: "memory");
        }
    }
    __syncthreads();
}


__global__ void __launch_bounds__(NTHR, 2) fwd_kernel(Params P) {
    extern __shared__ __attribute__((aligned(16))) unsigned char lds_raw[];
    LAS unsigned char* lds = (LAS unsigned char*)lds_raw;
    volatile LAS unsigned* MISC = (volatile LAS unsigned*)(lds + MISC_OFF);
    const int wv = __builtin_amdgcn_readfirstlane((int)(threadIdx.x >> 6)), G = gridDim.x;
#define tid fresh_tid(wv)
    unsigned char* ws = P.ws;
    unsigned* ctl = (unsigned*)(ws + WS_CTL);
    if (tid < 64) MISC[tid] = 0u;
    __syncthreads();
#if MK_ONE_LAUNCH
    XcdBarrier bar = xcd_barrier_post(ctl + CW_BAR, MISC + 8, wv);
#define GRID_BAR() xcd_barrier(bar)
#else
#define GRID_BAR() do {} while (0)
#endif
    const int lo = P.ph_lo, hi = P.ph_hi;
#ifndef PHM
#define PHM 0x3FFF
#endif
#define IN(k) (lo <= (k) && (k) < hi)
#define EN(b) ((PHM >> (b)) & 1)
#ifdef PROBE_PH
    unsigned long long* stamps = (unsigned long long*)(ws + WS_CTL + 512 * 1024);
#define STAMP(k) do { if (blockIdx.x == 0 && tid == 0) stamps[k] = __builtin_amdgcn_s_memrealtime(); } while (0)
#else
#define STAMP(k) do {} while (0)
#endif
    STAMP(0);
#define SEAM(k) do { int lo_ = lo, hi_ = hi; asm volatile("" : "+s"(lo_), "+s"(hi_));     \
        if (lo_ <= (k) && (k) + 1 < hi_) GRID_BAR(); STAMP((k) + 1); } while (0)

    constexpr int BG_A = 5120, BG_D = 8192, BG_E = 6656;
#ifndef DUP_PH
#define DUP_PH -1
#endif
#define DUPQ(t) (DUP_PH == (t))
    if (EN(12) && IN(0)) { phase_p0a(P, lds, G, wv); if (DUPQ(10)) { GRID_BAR(); phase_p0a(P, lds, G, wv); } SEAM(0); }
    if (EN(13) && IN(1)) { phase_p0b(P, lds, G, wv); SEAM(1); }

    for (int l = 0; l < DEPTH; ++l) {
        const int pb = NPH_PRO + NPH_LAYER * l;
        const bool last = (l == DEPTH - 1);
        const int nrows = last ? SEQ : NT;
        bf16* H = (bf16*)(ws + WS_H);
        if (EN(0) && IN(pb + 0)) {
            GAS unsigned char* wsg_ = (GAS unsigned char*)P.ws; asm volatile("" : "+s"(wsg_)); unsigned char* ws = (unsigned char*)wsg_;
            for (int rep = 0; rep < (DUPQ(0) ? 2 : 1); ++rep) {
            if (rep) GRID_BAR();
            { pg8::Gemm g{H, (const bf16*)(ws + WS_WIN + l * WIN_L), NT, 5632, D / 2};        int c1 = (int)blockIdx.x; asm volatile("" : "+s"(c1)); pg8::StaticOrder S; S.init(NT, 5632, G, c1);
              EpiInProj E{(bf16*)(ws + WS_Q), (bf16*)(ws + WS_K), (bf16*)(ws + WS_PROJ), P.in[I_QNG] + l * 64, P.in[I_KNG] + l * 64, (const float*)(ws + WS_ROPE), ws + WS_IMG, (const float*)(ws + WS_LB) + (size_t)l * 512};
              pg8::gemm_phase<EpiInProj, pg8::StaticOrder, true, true>(lds, g, S, E, wv); }
            { pg8::Gemm g{(const bf16*)(ws + WS_WV + l * WV_L), H, 512, NT, D / 2}; int c2 = (int)(blockIdx.x + 106 < (unsigned)G ? blockIdx.x + 106 : (blockIdx.x + 106) % (unsigned)G); asm volatile("" : "+s"(c2));
              pg8::StaticOrder S; S.init(512, NT, G, c2);
              EpiVt E{(bf16*)(ws + WS_VT)};
              pg8::gemm_phase<EpiVt, pg8::StaticOrder, true, true>(lds, g, S, E, wv); }
            }
            if (!last && G == 256) { const int c = (int)blockIdx.x; __syncthreads(); if (c >= 24) convert_items(P, lds, PER_L * (l + 1), PER_L * (l + 1) + BG_A, c - 24, 232, wv); }
            SEAM(pb + 0);
        }
        if (EN(2) && IN(pb + 2)) { phase_hgrn1(P, lds, l, G, wv); if (DUPQ(1)) { GRID_BAR(); phase_hgrn1(P, lds, l, G, wv); } SEAM(pb + 2); }
        if (EN(3) && IN(pb + 3)) { phase_hgrn_chain(P, G, wv); if (DUPQ(2)) { GRID_BAR(); phase_hgrn_chain(P, G, wv); } SEAM(pb + 3); }
        if (EN(4) && IN(pb + 4)) {
#pragma unroll 1
            for (int rep = 0; rep < ((DUPQ(31) || DUPQ(32)) ? 2 : 1); ++rep) { if (rep) GRID_BAR(); phase_mix(P, lds, l, G, !last, wv, rep == 0 ? 3 : (DUPQ(31) ? 1 : 2)); }
            if (!last && G == 256) { const int c = (int)blockIdx.x; __syncthreads(); if (c >= 8) convert_items(P, lds, PER_L * (l + 1) + BG_A, PER_L * (l + 1) + BG_A + BG_D, c - 8, 248, wv); }
            SEAM(pb + 4); }
        if (EN(5) && IN(pb + 5)) {
            GAS unsigned char* wsg_ = (GAS unsigned char*)P.ws; asm volatile("" : "+s"(wsg_)); unsigned char* ws = (unsigned char*)wsg_;
            pg8::Gemm g{(const bf16*)(ws + WS_OAB), (const bf16*)(ws + WS_WAB + l * WAB_L), 2 * NT, 2048, 512};
            pg8::MergeOrder S{nrows / 256, G, (int)blockIdx.x};
            EpiMerge E{(const bf16*)(ws + WS_PROJ), (bf16*)(ws + WS_U)};
            pg8::gemm_phase<EpiMerge, pg8::MergeOrder, true, true>(lds, g, S, E, wv);
            if (DUPQ(50)) { GRID_BAR(); pg8::gemm_phase<EpiMerge, pg8::MergeOrder, true, true>(lds, g, S, E, wv); }
            if (!last && G == 256) { const int c = (int)blockIdx.x; __syncthreads(); if (!((c & 7) == 0 && c < 32)) { const int nb = (c + 7) >> 3; convert_items(P, lds, PER_L * (l + 1) + BG_A + BG_D, PER_L * (l + 1) + BG_A + BG_D + BG_E, c - (nb < 4 ? nb : 4), 252, wv); } }
            SEAM(pb + 5);
        }
        if (EN(6) && IN(pb + 6)) {
            GAS unsigned char* wsg_ = (GAS unsigned char*)P.ws; asm volatile("" : "+s"(wsg_)); unsigned char* ws = (unsigned char*)wsg_;
            pg8::Gemm g{(const bf16*)(ws + WS_U), (const bf16*)(ws + WS_WO + l * WO_L), nrows, D, D}; pg8::StaticOrder S; S.init(nrows, D, G, (int)blockIdx.x);
            EpiOut E{(const bf16*)(ws + WS_XRES), (bf16*)(ws + WS_XRES), modv_ptr(P, l, 0) + 2048, modv_ptr(P, l, 1) + 2048};
            if (DUPQ(6)) { EpiOut E2 = E; E2.xres = (bf16*)(ws + WS_HDN); pg8::gemm_phase<EpiOut, pg8::StaticOrder, true, true>(lds, g, S, E2, wv); GRID_BAR(); }
            pg8::gemm_phase<EpiOut, pg8::StaticOrder, true, true>(lds, g, S, E, wv);
            if (!last && G == 256) { const int c = (int)blockIdx.x; __syncthreads(); if (c >= 4) convert_items(P, lds, PER_L * (l + 1) + BG_A + BG_D + BG_E, PER_L * (l + 2), c - 4, 252, wv); }
            SEAM(pb + 6);
        }
        if (EN(7) && IN(pb + 7)) {
#pragma unroll 1
            for (int rep = 0; rep < (DUPQ(7) ? 2 : 1); ++rep) {
                if (rep) { GRID_BAR(); if (blockIdx.x == 0 && tid < 32) __hip_atomic_store(ctl + CW_CNT + l * 32 * 16 + tid * 16, 0u, RLX_AGENT); GRID_BAR(); }
                phase_router(P, lds, l, G, nrows, wv); }
            SEAM(pb + 7); }
        if ((EN(8) && IN(pb + 8)) || (EN(9) && IN(pb + 9))) {
            GAS unsigned char* wsg_ = (GAS unsigned char*)P.ws; asm volatile("" : "+s"(wsg_)); unsigned char* ws = (unsigned char*)wsg_;
            LAS unsigned* utab8 = (LAS unsigned*)(lds + 131072); LAS unsigned* utab4 = utab8 + 32; LAS int* ptab = (LAS int*)(utab8 + 64);
            { const int t_ = tid;
              if (t_ == 0) { const unsigned* gcnt = ctl + CW_CNT + l * 32 * 16; int run = 0;
                  for (int e = 0; e < NE; ++e) { ptab[e] = run; run += (int)((__hip_atomic_load(gcnt + e * 16, RLX_AGENT) + 255u) >> 8); } ptab[32] = run; }
              __syncthreads();
              if (t_ < 64) { const int i = t_ & 31, lg = (t_ < 32) ? 3 : 2; const int c_ = (int)blockIdx.x;
                  int tr, pn;
                  if ((G & 63) == 0) { const int x = c_ & 7, q = c_ >> 3, per = (G >> 3) >> lg; pn = q & ((1 << lg) - 1); tr = (i * 8 + x) * per + (q >> lg); }
                  else { const int L = i * G + c_; tr = L >> lg; pn = L & ((1 << lg) - 1); }
                  unsigned v = 0xffffffffu;
                  if (tr < ptab[32]) { int e = 0; for (int j = 1; j < 32; ++j) e = (tr >= ptab[j]) ? j : e; v = ((unsigned)(65 * e + (tr - ptab[e])) << 16) | (unsigned)((e << lg) + pn); }
                  (t_ < 32 ? utab8 : utab4)[i] = v; }
              __syncthreads(); }
            if (EN(8) && IN(pb + 8)) {
                pg8::Gemm g{(const bf16*)(ws + WS_XS), (const bf16*)(ws + WS_WGU + l * WGU_L), NE * CAP, NE * 2048, D / 2};
                pg8::MoeOrder S{utab8};
                EpiSwiglu E{(bf16*)(ws + WS_HDN), P.in[I_BGU] + (size_t)l * NE * 2048};
                pg8::gemm_phase<EpiSwiglu, pg8::MoeOrder, true, true>(lds, g, S, E, wv);
                if (DUPQ(8)) { GRID_BAR(); pg8::gemm_phase<EpiSwiglu, pg8::MoeOrder, true, true>(lds, g, S, E, wv); }
                SEAM(pb + 8);
            }
            if (EN(9) && IN(pb + 9)) {
                pg8::Gemm g{(const bf16*)(ws + WS_HDN), (const bf16*)(ws + WS_WD + l * WD_L), NE * CAP, NE * 1024, DFF / 2};
                pg8::MoeOrder S{utab4};
                EpiDown E{(bf16*)(ws + WS_XS), P.in[I_BDN] + (size_t)l * NE * D};
                pg8::gemm_phase<EpiDown, pg8::MoeOrder, true, true>(lds, g, S, E, wv);
                if (DUPQ(9)) { GRID_BAR(); pg8::gemm_phase<EpiDown, pg8::MoeOrder, true, true>(lds, g, S, E, wv); }
                SEAM(pb + 9);
            }
        }
        if (EN(10) && IN(pb + 10)) { if (DUPQ(11)) { phase_combine<true>(P, lds, l, G, nrows, wv); GRID_BAR(); } phase_combine<false>(P, lds, l, G, nrows, wv); SEAM(pb + 10); }
    }
#ifdef PROBE_PH
    if (blockIdx.x == 0 && tid == 0) {
        unsigned long long tot = 0;
        for (int k = 0; k < NPHASES; ++k) { const int ty = k < 2 ? 12 + k : (k - 2) % 11; if (ty == PROBE_PH || PROBE_PH == 99) tot += stamps[k + 1] - stamps[k]; }
        *(float*)(ws + WS_CTL + 768 * 1024) = 1.f + (float)tot * (1.f / 10000.f);
    }
    GRID_BAR();
    { const float sc = 1.f + *(const float*)(ws + WS_CTL + 768 * 1024);
      for (size_t i = (size_t)blockIdx.x * NTHR + tid; i < (size_t)SEQ * D; i += (size_t)G * NTHR) P.out[i] *= sc; }
#endif
#undef tid
#undef IN
#undef EN
#undef SEAM
#undef GRID_BAR
}

extern "C" void kernel_launch(void* const* d_in, const int* in_sizes, int n_in, void* d_out, int out_size, void* d_ws, size_t ws_size, hipStream_t stream) {
    static int grid = 0;
    if (grid == 0) {
        if (n_in != 24 || out_size != SEQ * D || ws_size < WS_END3) { fprintf(stderr, "kernel_launch: unexpected shapes (n_in %d, out %d, ws %zu < %zu)\n", n_in, out_size, ws_size, (size_t)WS_END3); grid = -1; return; }
        int dev = 0, cus = 0;
        if (hipGetDevice(&dev) != hipSuccess || hipDeviceGetAttribute(&cus, hipDeviceAttributeMultiprocessorCount, dev) != hipSuccess) { grid = -1; return; }
        if (hipFuncSetAttribute((const void*)fwd_kernel, hipFuncAttributeMaxDynamicSharedMemorySize, LDS_BYTES) != hipSuccess) { fprintf(stderr, "kernel_launch: hipFuncSetAttribute failed\n"); grid = -1; return; }
        int per_cu = 0;
        if (hipOccupancyMaxActiveBlocksPerMultiprocessor(&per_cu, (const void*)fwd_kernel, NTHR, LDS_BYTES) != hipSuccess || per_cu < 1) fprintf(stderr, "kernel_launch: occupancy query reports %d\n", per_cu);
        (void)hipGetLastError();
        grid = cus;
    }
    if (grid < 0) return;
    (void)hipMemsetAsync((char*)d_ws + WS_CTL, 0, CTL_ZERO_BYTES, stream);
    Params p{};
    for (int i = 0; i < 24; ++i) p.in[i] = (const float*)d_in[i];
    p.out = (float*)d_out; p.ws = (unsigned char*)d_ws;
#if MK_ONE_LAUNCH
    p.ph_lo = 0; p.ph_hi = NPHASES;
    hipLaunchKernelGGL(fwd_kernel, dim3(grid), dim3(NTHR), LDS_BYTES, stream, p);
#else
    for (int k = 0; k < NPHASES; ++k) { p.ph_lo = k; p.ph_hi = k + 1; hipLaunchKernelGGL(fwd_kernel, dim3(grid), dim3(NTHR), LDS_BYTES, stream, p); }
#endif
}
```

```cpp
#include <hip/hip_runtime.h>
#include <cstdio>
#include <cstdint>

#ifndef MK_ONE_LAUNCH
#define MK_ONE_LAUNCH 1
#endif

#define GAS __attribute__((address_space(1)))
#define LAS __attribute__((address_space(3)))
typedef unsigned short bf16;
typedef unsigned v4u __attribute__((ext_vector_type(4)));
typedef unsigned v2u __attribute__((ext_vector_type(2)));
typedef float f32x4 __attribute__((ext_vector_type(4)));
typedef float f32x16 __attribute__((ext_vector_type(16)));
typedef short bf16x8 __attribute__((ext_vector_type(8)));
typedef short s16x4 __attribute__((ext_vector_type(4)));
typedef float f32x2_t __attribute__((ext_vector_type(2)));
typedef __bf16 bf16x2_t __attribute__((ext_vector_type(2)));

constexpr int D = 1024, SEQ = 16384, LC = 256, NT = SEQ + LC, DEPTH = 4;
constexpr int INC = 6144, NE = 32, DFF = 1024, TOPK = 4;
constexpr int CAP = NT;
constexpr int PROJW = 4608;
constexpr int PC_QH = 0, PC_ZF = 512, PC_ZB = 1024, PC_VH = 1536, PC_GH = 2048, PC_GA = 2560, PC_GB = 3584;
constexpr int LDV = NT;
constexpr float EPS = 1e-6f;
constexpr int NWAVES = 8, NTHR = 512;
constexpr int NPH_PRO = 2, NPH_LAYER = 11, NPHASES = NPH_PRO + NPH_LAYER * DEPTH;

constexpr size_t MiB = 1u << 20;
constexpr size_t WS_CTL = 0, CTL_ZERO_BYTES = 1 * MiB;
constexpr size_t WS_MODP = 1 * MiB;
constexpr size_t WS_MODV = WS_MODP + 2 * MiB;
constexpr size_t WS_LB = WS_MODV + 1 * MiB;
constexpr size_t WS_ROPE = WS_LB + 1 * MiB;
constexpr size_t WS_WIN = WS_ROPE + 1 * MiB;
constexpr size_t WIN_L = (size_t)5632 * 1024 * 2;
constexpr size_t WS_WV = WS_WIN + 4 * WIN_L;
constexpr size_t WV_L = (size_t)512 * 1024 * 2;
constexpr size_t WS_WAB = WS_WV + 4 * WV_L;
constexpr size_t WAB_L = (size_t)2048 * 512 * 2;
constexpr size_t WS_WO = WS_WAB + 4 * WAB_L;
constexpr size_t WO_L = (size_t)1024 * 1024 * 2;
constexpr size_t WS_WGU = WS_WO + 4 * WO_L;
constexpr size_t WGU_E = (size_t)2048 * 1024 * 2, WGU_L = 32 * WGU_E;
constexpr size_t WS_WD = WS_WGU + 4 * WGU_L;
constexpr size_t WD_E = (size_t)1024 * 1024 * 2, WD_L = 32 * WD_E;
constexpr size_t WS_XRES = WS_WD + 4 * WD_L;
constexpr size_t WS_H = WS_XRES + (size_t)NT * D * 4;
constexpr size_t WS_Q = WS_H + (size_t)NT * D * 2;
constexpr size_t WS_K = WS_Q + (size_t)NT * 512 * 2;
constexpr size_t WS_VT = WS_K + (size_t)NT * 512 * 2;
constexpr size_t WS_PROJ = WS_VT + (size_t)512 * LDV * 2;
constexpr size_t WS_OAB = WS_PROJ + (size_t)NT * PROJW * 2;
constexpr size_t WS_OBF = WS_OAB + (size_t)2 * NT * 512 * 2;
constexpr size_t WS_U = WS_OBF + (size_t)NT * 512 * 4;
constexpr size_t WS_HGU = WS_U + (size_t)NT * D * 2;
constexpr size_t WS_HGD = WS_HGU + (size_t)512 * 16384 * 4;
constexpr size_t WS_HGS = WS_HGD + 1 * MiB;
constexpr size_t WS_TOK = WS_HGS + (size_t)520 * 16384 * 4;
constexpr size_t WS_XS = WS_TOK + (size_t)NT * 64;
constexpr size_t SLAB = (size_t)NE * CAP * D * 2;
constexpr size_t WS_HDN = WS_XS + SLAB;
constexpr size_t WS_END = WS_HDN + SLAB;
constexpr int IM_BYTES = 21504;
constexpr size_t WS_IMG = WS_END;
constexpr size_t WS_END2 = WS_IMG + (size_t)8 * 65 * 16 * IM_BYTES;
constexpr int RW_PITCH = 2064, RW_IMG = 2 * 32 * RW_PITCH;
constexpr size_t WS_RWIMG = WS_END2;
constexpr size_t WS_END3 = WS_RWIMG + (size_t)DEPTH * RW_IMG + 4096;
constexpr int CW_TMO = 0;
constexpr int CW_BAR = 4096;
constexpr int CW_CNT = 16384;

constexpr int LDS_BYTES = 162816;
constexpr int MISC_OFF = LDS_BYTES - 256;

#define RLX_AGENT __ATOMIC_RELAXED, __HIP_MEMORY_SCOPE_AGENT
__device__ __forceinline__ unsigned pk2(float lo, float hi) { f32x2_t v = {lo, hi}; bf16x2_t b = __builtin_convertvector(v, bf16x2_t); return __builtin_bit_cast(unsigned, b); }
__device__ __forceinline__ float bflo(unsigned w) { return __uint_as_float(w << 16); }
__device__ __forceinline__ float bfhi(unsigned w) { return __uint_as_float(w & 0xffff0000u); }
__device__ __forceinline__ float bf2f(bf16 b) { return __uint_as_float(((unsigned)b) << 16); }
__device__ __forceinline__ int fresh_tid(int wv) { int l; asm volatile("v_mbcnt_lo_u32_b32 %0, -1, 0\n\tv_mbcnt_hi_u32_b32 %0, -1, %0" : "=v"(l)); return wv * 64 + l; }
__device__ __forceinline__ float shx(float v, int off, int lane) { return __int_as_float(__builtin_amdgcn_ds_bpermute((lane ^ off) << 2, __float_as_int(v))); }
__device__ __forceinline__ float wave_sum(float v, int lane) {
#pragma unroll
    for (int o = 1; o < 64; o <<= 1) v += shx(v, o, lane);
    return v;
}
__device__ __forceinline__ float fast_exp(float x) { return __builtin_amdgcn_exp2f(x * 1.4426950408889634f); }
__device__ __forceinline__ float fast_log(float x) { return __builtin_amdgcn_logf(x) * 0.6931471805599453f; }
__device__ __forceinline__ float fast_rcp(float x) { return __builtin_amdgcn_rcpf(x); }
__device__ __forceinline__ float sigmoidf_(float x) { return fast_rcp(1.f + fast_exp(-x)); }
__device__ __forceinline__ unsigned pk_fp8x4(float a, float b, float c, float d) { int p = __builtin_amdgcn_cvt_pk_fp8_f32(a, b, 0, false); p = __builtin_amdgcn_cvt_pk_fp8_f32(c, d, p, true); return (unsigned)p; }
constexpr float W8_SCALE = 32.f;
__device__ __forceinline__ int perm8(int s) { return (s & ~31) | (((s >> 2) & 1) << 4) | (((s >> 3) & 3) << 2) | (s & 3); }

namespace pg8 {
#define PG8_LAS __attribute__((address_space(3)))
typedef unsigned short bf16_t;
typedef short bf16x8 __attribute__((ext_vector_type(8)));
typedef float f32x4 __attribute__((ext_vector_type(4)));
typedef unsigned u32x4 __attribute__((ext_vector_type(4)));
constexpr int BM = 256, BK = 64, HALF = 128, HTB = HALF * BK * 2  , STAGE_BYTES = 8 * HTB, NXCD = 8, WGM = 2;

__host__ __device__ __forceinline__ int lds_byte(int r, int c) { const int st = (r >> 4) * 2 + (c >> 5), rr = r & 15, cc = c & 31, ob = rr * 64 + cc * 2; return st * 1024 + (ob ^ (((ob >> 9) & 1) << 5)); }
__host__ __device__ __forceinline__ void stage_rc(int b, int& R, int& C) { const int st = b / 1024, sb = b % 1024, swz = sb ^ (((sb >> 9) & 1) << 5); R = (st >> 1) * 16 + swz / 64; C = (st & 1) * 32 + (swz % 64) / 2; }
__host__ __device__ __forceinline__ int perm32(int rho) { const int n = rho >> 4, i = rho & 15; return 8 * (i >> 2) + 4 * n + (i & 3); }

struct Unit { int pm, pn; };
struct Gemm { const bf16_t* A; const bf16_t* Bt; int M, N, K; };
struct StaticOrder {
    int nM, nN, nwg, G, c;
    __host__ __device__ void init(int M, int N, int G_, int c_) { nM = M / BM; nN = N / BM; nwg = nM * nN; G = G_; c = c_; }
    __host__ __device__ bool next(int i, Unit& u) const {
        const long L = (long)i * G + c; if (L >= nwg) return false;
        int wgid = (int)L; { const int q = nwg / NXCD, r = nwg % NXCD, xcd = wgid % NXCD, off = wgid / NXCD; wgid = (xcd < r ? xcd * (q + 1) : r * (q + 1) + (xcd - r) * q) + off; }
        const int nig = WGM * nN, gid = wgid / nig, fm = gid * WGM, gsz = (nM - fm) < WGM ? (nM - fm) : WGM;
        u.pm = fm + ((wgid % nig) % gsz); u.pn = (wgid % nig) / gsz; return true;
    }
    __device__ __forceinline__ void a_ready(const Unit&) const {}
    __device__ __forceinline__ void done(const Unit&) const {}
};
struct MergeOrder {
    int nM, G, c;
    __device__ bool next(int i, Unit& u) const {
        const int br = i & 1; int L = (i >> 1) * G + c;
        if ((G & 31) == 0) { const int x = c & 7, q = c >> 3; L = (((i >> 1) * 8 + x) * (G >> 5) + (q >> 2)) * 4 + (q & 3); }
        if (L >= nM * 4) return false;
        u.pm = 65 * br + (L >> 2); u.pn = 4 * br + (L & 3); return true;
    }
    __device__ __forceinline__ void a_ready(const Unit&) const {}
    __device__ __forceinline__ void done(const Unit&) const {}
};
struct MoeOrder {
    const PG8_LAS unsigned* utab;
    __device__ bool next(int i, Unit& u) const {
        if (i >= 32) return false;
        const unsigned v = (unsigned)__builtin_amdgcn_readfirstlane((int)utab[i]); if (v == 0xffffffffu) return false;
        u.pm = (int)(v >> 16); u.pn = (int)(v & 0xffffu); return true;
    }
    __device__ __forceinline__ void a_ready(const Unit&) const {}
    __device__ __forceinline__ void done(const Unit&) const {}
};

template <class Epi, class Sched, bool ALIGN_EPI = false, bool SP2 = false>
__device__ __forceinline__ void gemm_phase(PG8_LAS unsigned char* lds, const Gemm g, const Sched& S, const Epi& E, int wv) {
    int tid_ = fresh_tid(wv);
    const int tid = tid_, wid = __builtin_amdgcn_readfirstlane(tid >> 6), lane = tid & 63, wr = wid >> 2, wc = wid & 3, fr = lane & 15, fq = lane >> 4;
    const int K = g.K, nt = K / BK;
    unsigned voffA[2], voffB[2];
#pragma unroll
    for (int i = 0; i < 2; ++i) { int R, C; stage_rc(tid * 16 + i * 8192, R, C); const int Rb = Epi::PERM ? ((R & ~31) + perm32(R & 31)) : R;
        voffA[i] = (unsigned)(R * K + C) * 2u; voffB[i] = (unsigned)(Rb * K + C) * 2u; }
    const size_t kstep = (size_t)(BK * 2);
    const size_t hstep = (size_t)HALF * K * 2;
    const size_t tstep = 2 * hstep;
    const unsigned ldsw = (unsigned)wid * 1024u;
    const int aoff = lds_byte(wr * 64 + fr, fq * 8), boff = lds_byte(wc * 32 + fr, fq * 8);
#define PG8_SA(b, h) (((b) * 2 + (h)) * HTB)
#define PG8_SB(b, h) ((4 + (b) * 2 + (h)) * HTB)
#define PG8_STAGE(bufoff, gbase, voff) do { _Pragma("unroll") for (int _i = 0; _i < 2; ++_i) \
        __builtin_amdgcn_global_load_lds((const unsigned*)((const char*)(gbase) + (voff)[_i]), (PG8_LAS unsigned*)(lds + (bufoff) + ldsw + _i * 8192), 16, 0, 0); } while (0)
#define PG8_LD8(p_) __builtin_shufflevector(*(const PG8_LAS v4i_*)(p_), *(const PG8_LAS v4i_*)((p_) + 1024), 0, 1, 2, 3, 4, 5, 6, 7)
#define PG8_LDA(dst, b, h) do { if constexpr (Epi::FP8) { _Pragma("unroll") for (int m = 0; m < 4; ++m) dst##8[m] = PG8_LD8(lds + PG8_SA(b, h) + aoff + m * 2048); } \
        else { _Pragma("unroll") for (int m = 0; m < 4; ++m) _Pragma("unroll") for (int k = 0; k < 2; ++k) dst[m][k] = *(const PG8_LAS bf16x8*)(lds + PG8_SA(b, h) + aoff + m * 2048 + k * 1024); } } while (0)
#define PG8_LDB(dst, b, h) do { if constexpr (Epi::FP8) { _Pragma("unroll") for (int n = 0; n < 2; ++n) dst##8[n] = PG8_LD8(lds + PG8_SB(b, h) + boff + n * 2048); } \
        else { _Pragma("unroll") for (int n = 0; n < 2; ++n) _Pragma("unroll") for (int k = 0; k < 2; ++k) dst[n][k] = *(const PG8_LAS bf16x8*)(lds + PG8_SB(b, h) + boff + n * 2048 + k * 1024); } } while (0)
#define PG8_MMA(ai, bj, At, Bt) do { if constexpr (Epi::FP8) __builtin_amdgcn_sched_barrier(0);     \
        __builtin_amdgcn_s_setprio(1); _Pragma("unroll") for (int m = 0; m < 4; ++m) _Pragma("unroll") for (int n = 0; n < 2; ++n) { \
        if constexpr (Epi::FP8)   \
            acc[ai][bj][m][n] = __builtin_amdgcn_mfma_scale_f32_16x16x128_f8f6f4(Bt##8[n], At##8[m], acc[ai][bj][m][n], 0, 0, 0, 0, 0, 0);     \
        else { _Pragma("unroll") for (int k = 0; k < 2; ++k) acc[ai][bj][m][n] = __builtin_amdgcn_mfma_f32_16x16x32_bf16(Bt[n][k], At[m][k], acc[ai][bj][m][n], 0, 0, 0); } } \
        if constexpr (Epi::FP8) { _Pragma("unroll") for (int m = 0; m < 4; ++m) _Pragma("unroll") for (int n = 0; n < 2; ++n) asm volatile("" : "+v"(acc[ai][bj][m][n])); }     \
        __builtin_amdgcn_s_setprio(0); if constexpr (Epi::FP8) __builtin_amdgcn_sched_barrier(0); } while (0)
#define PG8_WAIT_V(n) asm volatile("s_waitcnt vmcnt(" #n ")" ::: "memory")
#define PG8_WAIT_L(n) asm volatile("s_waitcnt lgkmcnt(" #n ")" ::: "memory")
#define PG8_BAR __builtin_amdgcn_s_barrier()
#define PG8_SCHED __builtin_amdgcn_sched_barrier(0)
    Unit cur, nxt; int ui = 0;
    if (!S.next(0, cur)) return;
    f32x4 acc[2][2][4][2];
#pragma unroll
    for (int a = 0; a < 2; ++a)
#pragma unroll
        for (int b = 0; b < 2; ++b)
#pragma unroll
            for (int m = 0; m < 4; ++m)
#pragma unroll
                for (int n = 0; n < 2; ++n) acc[a][b][m][n] = (f32x4){0.f, 0.f, 0.f, 0.f};
    typedef int v4i_ __attribute__((ext_vector_type(4))); typedef int v8i_ __attribute__((ext_vector_type(8)));
    bf16x8 At[4][2], B0[2][2], B1[2][2]; v8i_ At8[4], B08[2], B18[2];
    const char* cA = (const char*)g.A + (size_t)cur.pm * tstep; const char* cB = (const char*)g.Bt + (size_t)cur.pn * tstep;
    S.a_ready(cur);
    if constexpr (SP2) {
        PG8_STAGE(PG8_SB(0, 0), cB, voffB); PG8_STAGE(PG8_SB(0, 1), cB + hstep, voffB); PG8_STAGE(PG8_SA(0, 0), cA, voffA); PG8_STAGE(PG8_SA(0, 1), cA + hstep, voffA);
        if (wr == 1) PG8_BAR;
        PG8_WAIT_V(2); PG8_BAR;
        PG8_STAGE(PG8_SB(1, 0), cB + kstep, voffB); PG8_STAGE(PG8_SA(1, 0), cA + kstep, voffA); PG8_STAGE(PG8_SB(1, 1), cB + hstep + kstep, voffB);
        PG8_WAIT_V(6); PG8_BAR;
    } else {
        PG8_STAGE(PG8_SB(0, 0), cB, voffB); PG8_STAGE(PG8_SA(0, 0), cA, voffA); PG8_STAGE(PG8_SB(0, 1), cB + hstep, voffB); PG8_STAGE(PG8_SA(0, 1), cA + hstep, voffA);
        if (wr == 1) PG8_BAR;
        PG8_WAIT_V(4); PG8_BAR;
        PG8_STAGE(PG8_SB(1, 0), cB + kstep, voffB); PG8_STAGE(PG8_SA(1, 0), cA + kstep, voffA); PG8_STAGE(PG8_SB(1, 1), cB + hstep + kstep, voffB);
        PG8_WAIT_V(6); PG8_BAR;
    }
    for (;;) {
        const bool has_next = S.next(ui + 1, nxt);
        const char* nA = has_next ? (const char*)g.A + (size_t)nxt.pm * tstep : cA; const char* nB = has_next ? (const char*)g.Bt + (size_t)nxt.pn * tstep : cB;
        for (int t = 0; t < nt; t += 2) {
            const bool last = (t == nt - 2);
            const char* a1 = cA + (size_t)(t + 1) * kstep;
            const char* a2 = last ? nA : cA + (size_t)(t + 2) * kstep; const char* b2 = last ? nB : cB + (size_t)(t + 2) * kstep;
            const char* a3 = a2 + kstep; const char* b3 = b2 + kstep;
            if (last && has_next) S.a_ready(nxt);
            if constexpr (SP2) {
            PG8_LDB(B0, 0, 0); PG8_LDB(B1, 0, 1); PG8_SCHED; PG8_LDA(At, 0, 0); PG8_STAGE(PG8_SA(1, 1), a1 + hstep, voffA);
            PG8_WAIT_V(8); PG8_WAIT_L(0); PG8_BAR; PG8_MMA(0, 0, At, B0); PG8_MMA(0, 1, At, B1); PG8_BAR; PG8_SCHED;
            PG8_LDA(At, 0, 1); PG8_STAGE(PG8_SB(0, 0), b2, voffB); PG8_STAGE(PG8_SB(0, 1), b2 + hstep, voffB); PG8_STAGE(PG8_SA(0, 0), a2, voffA);
            PG8_WAIT_V(8); PG8_WAIT_L(0); PG8_BAR; PG8_MMA(1, 0, At, B0); PG8_MMA(1, 1, At, B1); PG8_BAR; PG8_SCHED;
            PG8_LDB(B0, 1, 0); PG8_LDB(B1, 1, 1); PG8_SCHED; PG8_LDA(At, 1, 0); PG8_STAGE(PG8_SA(0, 1), a2 + hstep, voffA);
            PG8_WAIT_V(8); PG8_WAIT_L(0); PG8_BAR; PG8_MMA(0, 0, At, B0); PG8_MMA(0, 1, At, B1); PG8_BAR; PG8_SCHED;
            PG8_LDA(At, 1, 1); PG8_STAGE(PG8_SB(1, 0), b3, voffB); PG8_STAGE(PG8_SB(1, 1), b3 + hstep, voffB); PG8_STAGE(PG8_SA(1, 0), a3, voffA);
            PG8_WAIT_V(8); PG8_WAIT_L(0); PG8_BAR; PG8_MMA(1, 0, At, B0); PG8_MMA(1, 1, At, B1); PG8_BAR; PG8_SCHED;
            } else {
            PG8_LDB(B0, 0, 0); PG8_SCHED; PG8_LDA(At, 0, 0); PG8_STAGE(PG8_SA(1, 1), a1 + hstep, voffA);
            PG8_WAIT_L(8); PG8_BAR; PG8_WAIT_L(0); PG8_MMA(0, 0, At, B0); PG8_BAR; PG8_SCHED;
            PG8_LDB(B1, 0, 1); PG8_STAGE(PG8_SB(0, 0), b2, voffB);
            PG8_BAR; PG8_WAIT_L(0); PG8_MMA(0, 1, At, B1); PG8_BAR;
            PG8_LDA(At, 0, 1); PG8_STAGE(PG8_SA(0, 0), a2, voffA);
            PG8_BAR; PG8_WAIT_L(0); PG8_MMA(1, 0, At, B0); PG8_BAR; PG8_SCHED;
            PG8_STAGE(PG8_SB(0, 1), b2 + hstep, voffB);
            PG8_WAIT_V(6); PG8_BAR; PG8_MMA(1, 1, At, B1); PG8_BAR;
            PG8_LDB(B0, 1, 0); PG8_SCHED; PG8_LDA(At, 1, 0); PG8_STAGE(PG8_SA(0, 1), a2 + hstep, voffA);
            PG8_WAIT_L(8); PG8_BAR; PG8_WAIT_L(0); PG8_MMA(0, 0, At, B0); PG8_BAR; PG8_SCHED;
            PG8_LDB(B1, 1, 1); PG8_STAGE(PG8_SB(1, 0), b3, voffB);
            PG8_BAR; PG8_WAIT_L(0); PG8_MMA(0, 1, At, B1); PG8_BAR;
            PG8_LDA(At, 1, 1); PG8_STAGE(PG8_SA(1, 0), a3, voffA);
            PG8_BAR; PG8_WAIT_L(0); PG8_MMA(1, 0, At, B0); PG8_BAR; PG8_SCHED;
            PG8_STAGE(PG8_SB(1, 1), b3 + hstep, voffB);
            PG8_WAIT_V(6); PG8_BAR; PG8_MMA(1, 1, At, B1); PG8_BAR;
            }
        }
        if constexpr (ALIGN_EPI) { if (wr == 0) PG8_BAR; }
        if constexpr (Epi::FP8) { _Pragma("unroll") for (int ai = 0; ai < 2; ++ai) _Pragma("unroll") for (int bj = 0; bj < 2; ++bj) _Pragma("unroll") for (int m = 0; m < 4; ++m) _Pragma("unroll") for (int n = 0; n < 2; ++n) acc[ai][bj][m][n] *= (1.f / W8_SCALE); }
        if constexpr (!Epi::AFTER_DRAIN) { E(acc, cur, wr, wc, fr, fq); S.done(cur); }
        if (!has_next) break;
#pragma unroll
        for (int a = 0; a < 2; ++a)
#pragma unroll
            for (int b = 0; b < 2; ++b)
#pragma unroll
                for (int m = 0; m < 4; ++m)
#pragma unroll
                    for (int n = 0; n < 2; ++n) acc[a][b][m][n] = (f32x4){0.f, 0.f, 0.f, 0.f};
        cur = nxt; cA = nA; cB = nB; ++ui;
        if constexpr (ALIGN_EPI) { if (wr == 1) PG8_BAR; }
    }
    PG8_WAIT_V(0);
    if constexpr (!ALIGN_EPI) { if (wr == 0) PG8_BAR; }
    PG8_BAR;
    if constexpr (Epi::AFTER_DRAIN) { E.fused(acc, cur, wr, wc, fr, fq, lds, wid, lane); S.done(cur); }
#undef PG8_SA
#undef PG8_SB
#undef PG8_STAGE
#undef PG8_LDA
#undef PG8_LD8
#undef PG8_LDB
#undef PG8_MMA
#undef PG8_WAIT_V
#undef PG8_WAIT_L
#undef PG8_BAR
#undef PG8_SCHED
}
}


struct Params { const float* in[24]; float* out; unsigned char* ws; int ph_lo, ph_hi; };
enum { I_X = 0, I_C, I_CTX, I_CCTX, I_ADAW, I_ADAB, I_N1G, I_N2G, I_WIN, I_QNG, I_KNG, I_LAMQK, I_SUBLN, I_HGLB, I_HGNG, I_WBA, I_WBB, I_WOUT, I_RW, I_RB, I_WGU, I_BGU, I_WDN, I_BDN };

#define LDS_WAIT() asm volatile("s_waitcnt lgkmcnt(0)" ::: "memory")

template <int KIND, bool FP8 = false>
__device__ __forceinline__ void transpose_item(const float* __restrict__ W, int K, int N, bf16* WT, bf16* WT2, int row_off, int k0, int n0, LAS float* scr, int lane) {
#pragma unroll 4
    for (int it = 0; it < 16; ++it) {
        const int k = 4 * it + (lane >> 4), n4 = (lane & 15) * 4;
        const f32x4 v = __builtin_nontemporal_load((const f32x4*)(W + (size_t)(k0 + k) * N + n0 + n4));
        *(LAS f32x4*)(scr + k * 64 + (n4 ^ (4 * ((k >> 3) & 7)))) = v;
    }
    LDS_WAIT();
    const int c = lane & 7;
#pragma unroll 2
    for (int j2 = 0; j2 < 8; ++j2) {
        const int nl = (lane >> 3) + 8 * j2, n = n0 + nl;
        const LAS float* s = scr + (8 * c) * 64 + (nl ^ (4 * c));
        v4u o; o.x = pk2(s[0], s[64]); o.y = pk2(s[128], s[192]); o.z = pk2(s[256], s[320]); o.w = pk2(s[384], s[448]);
        bf16* base = WT; size_t row;
        if (KIND == 0) row = (size_t)(row_off + n);
        else if (KIND == 1) row = (size_t)(row_off + perm8(n));
        else if (KIND == 2) {
            if (n < 1024) { const int tile = n >> 8, G = (n >> 6) & 3, bj = (n >> 5) & 1, e = n & 31; row = (size_t)(256 * tile + 128 * bj + 32 * G + e); }
            else if (n < 1536) { base = WT2; row = (size_t)(n - 1024); }
            else if (n < 3584) {
                const int Q = (n - 1536) >> 9, rem = (n - 1536) & 511, hh = rem >> 7, d = rem & 127, dd = d & 63;
                const int p = 128 * (Q >> 1) + 32 * (dd >> 4) + 16 * (Q & 1) + 4 * ((dd >> 2) & 3) + (dd & 3);
                row = (size_t)(1024 + 256 * (2 * hh + (d >> 6)) + p); }
            else row = (size_t)(3072 + perm8(n - 3584));
        } else {
            const int half = n >> 10, nn = n & 1023;
            row = (size_t)(256 * (nn >> 7) + 128 * half + perm8(nn & 127));
        }
        if (!FP8) __builtin_nontemporal_store(o, (v4u*)(base + row * K + k0 + 8 * c));
        else { v2u o8; o8.x = pk_fp8x4(s[0] * W8_SCALE, s[64] * W8_SCALE, s[128] * W8_SCALE, s[192] * W8_SCALE); o8.y = pk_fp8x4(s[256] * W8_SCALE, s[320] * W8_SCALE, s[384] * W8_SCALE, s[448] * W8_SCALE);
               __builtin_nontemporal_store(o8, (v2u*)((unsigned char*)base + row * K + k0 + 8 * c)); }
    }
    LDS_WAIT();
}

__device__ __forceinline__ void sincos_d(double x, double& s, double& c) {
    const double k = __builtin_rint(x * 0.63661977236758134308);
    double r = __builtin_fma(-k, 1.57079632679489655800e+00, x); r = __builtin_fma(-k, 6.12323399573676603587e-17, r);
    const double r2 = r * r;
    double sp = -1.0 / 1307674368000.0; sp = sp * r2 + 1.0 / 6227020800.0; sp = sp * r2 - 1.0 / 39916800.0; sp = sp * r2 + 1.0 / 362880.0; sp = sp * r2 - 1.0 / 5040.0; sp = sp * r2 + 1.0 / 120.0; sp = sp * r2 - 1.0 / 6.0; sp = sp * r2 + 1.0;
    const double sr = sp * r;
    double cp = 1.0 / 20922789888000.0; cp = cp * r2 - 1.0 / 87178291200.0; cp = cp * r2 + 1.0 / 479001600.0; cp = cp * r2 - 1.0 / 3628800.0; cp = cp * r2 + 1.0 / 40320.0; cp = cp * r2 - 1.0 / 720.0; cp = cp * r2 + 1.0 / 24.0; cp = cp * r2 - 0.5; cp = cp * r2 + 1.0;
    const int q = ((int)k) & 3;
    s = (q == 0) ? sr : (q == 1) ? cp : (q == 2) ? -sr : -cp;
    c = (q == 0) ? cp : (q == 1) ? -sr : (q == 2) ? -cp : sr;
}

constexpr int CI_IN = 16 * 96, CI_A = 8 * 16, CI_B = 8 * 16, CI_O = 16 * 16, CI_GU = 16 * 32, CI_DN = 16 * 16;
constexpr int PER_L = CI_IN + CI_A + CI_B + CI_O + NE * CI_GU + NE * CI_DN;
__device__ __forceinline__ void convert_items(const Params& P, LAS unsigned char* lds, int it0, int it1, int gwg, int nwg, int wv) {
    int tid_ = fresh_tid(wv);
    const int lane = tid_ & 63, wave = __builtin_amdgcn_readfirstlane(tid_ >> 6);
    GAS unsigned char* wsg_ = (GAS unsigned char*)P.ws; asm volatile("" : "+s"(wsg_)); unsigned char* ws = (unsigned char*)wsg_;
    LAS float* scr = (LAS float*)(lds + wave * 16384);
    constexpr int I_IN = CI_IN, I_A = CI_A, I_B = CI_B, I_O = CI_O, I_GU = CI_GU, I_DN = CI_DN;
#pragma unroll 1
    for (int it = it0 + gwg * NWAVES + wave; it < it1; it += nwg * NWAVES) {
        const int l = it / PER_L; int r = it % PER_L;
        if (r < I_IN) { const int kb = r / 96, nb = r % 96;
            transpose_item<2, true>(P.in[I_WIN] + (size_t)l * D * INC, D, INC, (bf16*)(ws + WS_WIN + l * WIN_L), (bf16*)(ws + WS_WV + l * WV_L), 0, 64 * kb, 64 * nb, scr, lane); continue; }
        r -= I_IN;
        if (r < I_A) { const int kb = r / 16, nb = r % 16;
            transpose_item<1>(P.in[I_WBA] + (size_t)l * 512 * D, 512, D, (bf16*)(ws + WS_WAB + l * WAB_L), nullptr, 0, 64 * kb, 64 * nb, scr, lane); continue; }
        r -= I_A;
        if (r < I_B) { const int kb = r / 16, nb = r % 16;
            transpose_item<1>(P.in[I_WBB] + (size_t)l * 512 * D, 512, D, (bf16*)(ws + WS_WAB + l * WAB_L), nullptr, 1024, 64 * kb, 64 * nb, scr, lane); continue; }
        r -= I_B;
        if (r < I_O) { const int kb = r / 16, nb = r % 16;
            transpose_item<0>(P.in[I_WOUT] + (size_t)l * D * D, D, D, (bf16*)(ws + WS_WO + l * WO_L), nullptr, 0, 64 * kb, 64 * nb, scr, lane); continue; }
        r -= I_O;
        if (r < NE * I_GU) { const int e = r / I_GU, q = r % I_GU, kb = q / 32, nb = q % 32;
            transpose_item<3, true>(P.in[I_WGU] + ((size_t)l * NE + e) * D * 2048, D, 2048, (bf16*)(ws + WS_WGU + l * WGU_L + e * (WGU_E / 2)), nullptr, 0, 64 * kb, 64 * nb, scr, lane); continue; }
        r -= NE * I_GU;
        { const int e = r / I_DN, q = r % I_DN, kb = q / 16, nb = q % 16;
            transpose_item<1, true>(P.in[I_WDN] + ((size_t)l * NE + e) * DFF * D, DFF, D, (bf16*)(ws + WS_WD + l * WD_L + e * (WD_E / 2)), nullptr, 0, 64 * kb, 64 * nb, scr, lane); }
    }
}

__device__ __forceinline__ void phase_p0a(const Params& P, LAS unsigned char* lds, int G, int wv) {
    int tid_ = fresh_tid(wv);
    const int tid = tid_, lane = tid & 63, wave = tid >> 6;
    GAS unsigned char* wsg_ = (GAS unsigned char*)P.ws; asm volatile("" : "+s"(wsg_)); unsigned char* ws = (unsigned char*)wsg_;
    LAS float* sil = (LAS float*)(lds + 131072);
    for (int i = tid; i < 2048; i += NTHR) { const float v = (i < 1024) ? P.in[I_C][i] : P.in[I_CCTX][i - 1024]; sil[i] = v * sigmoidf_(v); }
    __syncthreads();
    {
        float* modp = (float*)(ws + WS_MODP);
        for (int t = blockIdx.x * NTHR + tid; t < DEPTH * 8 * 6144; t += G * NTHR) {
            const int j = t % 6144, lp = t / 6144, part = lp & 7, l = lp >> 3;
            const float* w = P.in[I_ADAW] + ((size_t)l * D + part * 128) * 6144 + j;
            float a0 = 0.f, a1 = 0.f;
#pragma unroll 8
            for (int i = 0; i < 128; ++i) { const float wv = w[(size_t)i * 6144]; a0 += sil[part * 128 + i] * wv; a1 += sil[1024 + part * 128 + i] * wv; }
            modp[((size_t)(l * 8 + part) * 2 + 0) * 6144 + j] = a0;
            modp[((size_t)(l * 8 + part) * 2 + 1) * 6144 + j] = a1;
        }
    }
    {
        float* lbo = (float*)(ws + WS_LB);
        for (int t = blockIdx.x * NTHR + tid; t < 2 * 512; t += G * NTHR) {
            const int dir = t >> 9, j = t & 511;
            float v[DEPTH], mx = -1e30f;
#pragma unroll
            for (int l = 0; l < DEPTH; ++l) { v[l] = P.in[I_HGLB][((size_t)dir * DEPTH + l) * 512 + j]; mx = fmaxf(mx, v[l]); }
            float sum = 0.f;
#pragma unroll
            for (int l = 0; l < DEPTH; ++l) { v[l] = expf(v[l] - mx); sum += v[l]; }
            float cs = 0.f, first = 0.f;
#pragma unroll
            for (int l = 0; l < DEPTH; ++l) { cs += v[l] / sum; if (l == 0) first = cs; lbo[((size_t)dir * DEPTH + l) * 512 + j] = cs - first; }
        }
    }
    {
        float* rt = (float*)(ws + WS_ROPE);
        for (int t = blockIdx.x * NTHR + tid; t < 256 * 16; t += G * NTHR) {
            const int pos = t >> 4, fi = t & 15;
            const float freq = (float)exp2(-(double)fi * (13.287712379549449 / 16.0));
            const float ang = (float)pos * freq;
            double s, c; sincos_d((double)ang, s, c);
            rt[2 * t] = (float)c; rt[2 * t + 1] = (float)s;
        }
    }
    {
        for (int t = blockIdx.x * NTHR + tid; t < DEPTH * D * NE; t += G * NTHR) {
            const int e = t & 31, k = (t >> 5) & 1023, l = t >> 15;
            const float v = P.in[I_RW][t];
            const unsigned hi = pk2(v, 0.f) & 0xffffu; const unsigned lo = pk2(v - bflo(hi), 0.f) & 0xffffu;
            unsigned char* img = ws + WS_RWIMG + (size_t)l * RW_IMG;
            *(bf16*)(img + e * RW_PITCH + k * 2) = (bf16)hi; *(bf16*)(img + 32 * RW_PITCH + e * RW_PITCH + k * 2) = (bf16)lo;
        }
    }
    {
        convert_items(P, lds, 0, (G == 256) ? PER_L : DEPTH * PER_L, (int)blockIdx.x, G, wv);
    }
}

__device__ __forceinline__ const float* modv_ptr(const Params& P, int l, int w) { return (const float*)(P.ws + WS_MODV) + ((size_t)l * 2 + w) * 6144; }
__device__ __forceinline__ const float* xin_row(const Params& P, int l, int row) {
    if (l == 0) return (row < SEQ) ? P.in[I_X] + (size_t)row * D : P.in[I_CTX] + (size_t)(row - SEQ) * D;
    return (const float*)(P.ws + WS_XRES) + (size_t)row * D;
}
__device__ __forceinline__ void norm_store_row(const f32x4 (&v)[4], const LAS float* A, const LAS float* B, unsigned char* hrow, int lane) {
    float ss = 0.f;
#pragma unroll
    for (int j = 0; j < 4; ++j) ss += (v[j].x * v[j].x + v[j].y * v[j].y) + (v[j].z * v[j].z + v[j].w * v[j].w);
    const float rstd = __builtin_amdgcn_rsqf(wave_sum(ss, lane) * (1.f / D) + EPS);
#pragma unroll
    for (int j = 0; j < 4; ++j) {
        const f32x4 a = *(const LAS f32x4*)(A + 4 * lane + 256 * j), b = *(const LAS f32x4*)(B + 4 * lane + 256 * j);
        const f32x4 y = v[j] * rstd * a + b;
        *(unsigned*)(hrow + 4 * lane + 256 * j) = pk_fp8x4(y.x, y.y, y.z, y.w);
    }
}

__device__ __forceinline__ void phase_p0b(const Params& P, LAS unsigned char* lds, int G, int wv) {
    int tid_ = fresh_tid(wv);
    const int tid = tid_, lane = tid & 63, wave = tid >> 6;
    GAS unsigned char* wsg_ = (GAS unsigned char*)P.ws; asm volatile("" : "+s"(wsg_)); unsigned char* ws = (unsigned char*)wsg_;
    const float* modp = (const float*)(ws + WS_MODP);
    float* modv = (float*)(ws + WS_MODV);
    for (int t = blockIdx.x * NTHR + tid; t < DEPTH * 2 * 6144; t += G * NTHR) {
        const int j = t % 6144, lw = t / 6144, w = lw & 1, l = lw >> 1;
        float a = P.in[I_ADAB][(size_t)l * 6144 + j];
#pragma unroll
        for (int p = 0; p < 8; ++p) a += modp[((size_t)(l * 8 + p) * 2 + w) * 6144 + j];
        modv[t] = a;
    }
    LAS float* TA = (LAS float*)lds;
    LAS float* TB = (LAS float*)(lds + 8192);
    for (int i = tid; i < 2048; i += NTHR) {
        const int w = i >> 10, j = i & 1023;
        float sh = P.in[I_ADAB][j], sc = P.in[I_ADAB][1024 + j];
#pragma unroll
        for (int p = 0; p < 8; ++p) { sh += modp[((size_t)p * 2 + w) * 6144 + j]; sc += modp[((size_t)p * 2 + w) * 6144 + 1024 + j]; }
        TA[i] = P.in[I_N1G][j] * (1.f + sc); TB[i] = sh;
    }
    __syncthreads();
    bf16* H = (bf16*)(ws + WS_H);
    for (int row = blockIdx.x * NWAVES + wave; row < NT; row += G * NWAVES) {
        const float* xr = xin_row(P, 0, row); const int w = row >= SEQ;
        f32x4 v[4];
#pragma unroll
        for (int j = 0; j < 4; ++j) v[j] = *(const f32x4*)(xr + 4 * lane + 256 * j);
        norm_store_row(v, TA + 1024 * w, TB + 1024 * w, (unsigned char*)H + (size_t)row * D, lane);
        bf16* xb = (bf16*)(ws + WS_XRES) + (size_t)row * D + 4 * lane;
#pragma unroll
        for (int j = 0; j < 4; ++j) { v2u o; o.x = pk2(v[j].x, v[j].y); o.y = pk2(v[j].z, v[j].w); *(v2u*)(xb + 256 * j) = o; }
    }
}

using pg8::Unit;

struct EpiInProj {
    static constexpr bool PERM = false, AFTER_DRAIN = false, FP8 = true;
    bf16* Q; bf16* K; bf16* proj; const float* qn_g; const float* kn_g; const float* rope; unsigned char* img; const float* lbl;
    __device__ __forceinline__ void operator()(const f32x4 (&acc)[2][2][4][2], const Unit& u, int wr, int wc, int fr, int fq) const {
        const int row0 = u.pm * 256 + wr * 64 + fr;
        if (u.pn < 4) {
            const bool isq = u.pn < 2; const int gg = 4 * (u.pn & 1) + wc, hh = gg >> 1, mm = gg & 1;
            const float* gv = isq ? qn_g : kn_g; unsigned char* dstb = (unsigned char*)(isq ? Q : K) + (size_t)hh * NT * 128 + 64 * mm;
            const float oscale = isq ? 0.125f * 1.4426950408889634f : 1.f;
            f32x4 g[2][2];
#pragma unroll
            for (int bj = 0; bj < 2; ++bj)
#pragma unroll
                for (int n = 0; n < 2; ++n) g[bj][n] = *(const f32x4*)(gv + 32 * bj + 16 * n + 4 * fq);
#pragma unroll
            for (int ai = 0; ai < 2; ++ai)
#pragma unroll
                for (int m = 0; m < 4; ++m) {
                    const int row = row0 + ai * 128 + m * 16;
                    float ss = 0.f;
#pragma unroll
                    for (int bj = 0; bj < 2; ++bj)
#pragma unroll
                        for (int n = 0; n < 2; ++n) { const f32x4 x = acc[ai][bj][m][n]; ss += (x.x * x.x + x.y * x.y) + (x.z * x.z + x.w * x.w); }
                    { const int ln_ = 16 * fq + fr; ss += shx(ss, 16, ln_); ss += shx(ss, 32, ln_); }
                    const float rstd = __builtin_amdgcn_rsqf(ss * (1.f / 64.f) + EPS) ;
                    unsigned char* dst = dstb + (size_t)row * 128;
                    const bool lat = row < SEQ;
#pragma unroll
                    for (int bj = 0; bj < 2; ++bj) {
                        f32x4 x1 = acc[ai][bj][m][0] * rstd * g[bj][0], x2 = acc[ai][bj][m][1] * rstd * g[bj][1];
                        if (lat) {
                            const int pos = bj == 0 ? (row >> 6) : (row & 63);
                            const f32x4 cs0 = *(const f32x4*)(rope + (size_t)(pos * 16 + 4 * fq) * 2), cs1 = *(const f32x4*)(rope + (size_t)(pos * 16 + 4 * fq) * 2 + 4);
                            const f32x4 c = {cs0.x, cs0.z, cs1.x, cs1.z}, s = {cs0.y, cs0.w, cs1.y, cs1.w};
                            const f32x4 y1 = x1 * c - x2 * s, y2 = x2 * c + x1 * s; x1 = y1; x2 = y2;
                        }
                        x1 = x1 * oscale; x2 = x2 * oscale;
                        *(unsigned*)(dst + 32 * bj + 4 * fq) = pk_fp8x4(x1.x, x1.y, x1.z, x1.w); *(unsigned*)(dst + 32 * bj + 16 + 4 * fq) = pk_fp8x4(x2.x, x2.y, x2.z, x2.w);
                    }
                }
        } else if (u.pn < 12) {
            const int T = u.pn - 4, hh = T >> 1, d0 = 64 * (T & 1) + 16 * wc + 4 * fq, ln_ = 16 * fq + fr;
            const f32x4 lbf = *(const f32x4*)(lbl + 128 * hh + d0), lbb = *(const f32x4*)(lbl + (size_t)DEPTH * 512 + 128 * hh + d0);
#pragma unroll
            for (int ai = 0; ai < 2; ++ai)
#pragma unroll
                for (int m = 0; m < 4; ++m) {
                    const int rg = u.pm * 256 + ai * 128 + wr * 64 + m * 16;
                    const int seg = rg < SEQ ? (rg >> 8) : 64, cf = ((rg < SEQ ? rg : rg - SEQ) & 255) >> 4;
                    const f32x4 qv = acc[ai][0][m][0], vv = acc[ai][1][m][1];
#pragma unroll
                    for (int dir = 0; dir < 2; ++dir) {
                        const f32x4 zv = dir ? acc[ai][1][m][0] : acc[ai][0][m][1], lb = dir ? lbb : lbf;
                        const int s_ = dir ? 15 - fr : fr, c_ = dir ? 15 - cf : cf;
                        unsigned char* im = img + (size_t)((((dir * 4 + hh) * 65 + seg) * 16) + c_) * IM_BYTES;
                        float qt[4], kt[4], kh[4], dc[4];
#pragma unroll
                        for (int i = 0; i < 4; ++i) {
                            const float zc = fminf(fmaxf(zv[i], -80.f), 80.f), E = fast_exp(-zc), den = fast_rcp(1.f + E);
                            const float g = fast_log((1.f + lb[i] * E) * den), kk = (1.f - lb[i]) * E * den;
                            float b = g;
                            if (dir == 0) { b += __int_as_float(__builtin_amdgcn_update_dpp(0, __float_as_int(b), 0x111, 0xf, 0xf, true)); b += __int_as_float(__builtin_amdgcn_update_dpp(0, __float_as_int(b), 0x112, 0xf, 0xf, true));
                                            b += __int_as_float(__builtin_amdgcn_update_dpp(0, __float_as_int(b), 0x114, 0xf, 0xf, true)); b += __int_as_float(__builtin_amdgcn_update_dpp(0, __float_as_int(b), 0x118, 0xf, 0xf, true)); }
                            else          { b += __int_as_float(__builtin_amdgcn_update_dpp(0, __float_as_int(b), 0x101, 0xf, 0xf, true)); b += __int_as_float(__builtin_amdgcn_update_dpp(0, __float_as_int(b), 0x102, 0xf, 0xf, true));
                                            b += __int_as_float(__builtin_amdgcn_update_dpp(0, __float_as_int(b), 0x104, 0xf, 0xf, true)); b += __int_as_float(__builtin_amdgcn_update_dpp(0, __float_as_int(b), 0x108, 0xf, 0xf, true)); }
                            const float bl = __int_as_float(__builtin_amdgcn_ds_bpermute((dir ? (ln_ & ~15) : (ln_ | 15)) << 2, __float_as_int(b)));
                            qt[i] = qv[i] * fast_exp(b); kt[i] = kk * fast_exp(fminf(-b, 80.f)); kh[i] = kk * fast_exp(bl - b); dc[i] = fast_exp(bl);
                        }
                        { v2u o; o.x = pk2(qt[0], qt[1]); o.y = pk2(qt[2], qt[3]); *(v2u*)(im + 0 + s_ * 272 + d0 * 2) = o; }
                        { v2u o; o.x = pk2(kt[0], kt[1]); o.y = pk2(kt[2], kt[3]); *(v2u*)(im + 4352 + s_ * 272 + d0 * 2) = o; }
#pragma unroll
                        for (int i = 0; i < 4; ++i) { *(bf16*)(im + 8704 + (d0 + i) * 48 + s_ * 2) = (bf16)(pk2(kh[i], 0.f) & 0xffffu); *(bf16*)(im + 14848 + (d0 + i) * 48 + s_ * 2) = (bf16)(pk2(vv[i], 0.f) & 0xffffu); }
                        if (s_ == 15) *(f32x4*)(im + 20992 + d0 * 4) = (f32x4){dc[0], dc[1], dc[2], dc[3]};
                    }
                }
        } else {
            const int pt = u.pn - 4; const int act = pt < 10 ? 1 : 2;
            const int col0 = pt * 256 + wc * 32 + 8 * fq;
#pragma unroll
            for (int ai = 0; ai < 2; ++ai)
#pragma unroll
                for (int m = 0; m < 4; ++m) { bf16* rowp = proj + (size_t)(row0 + ai * 128 + m * 16) * PROJW + col0;
#pragma unroll
                    for (int bj = 0; bj < 2; ++bj) { f32x4 v0 = acc[ai][bj][m][0], v1 = acc[ai][bj][m][1];
#pragma unroll
                        for (int j = 0; j < 4; ++j) { const float s0 = sigmoidf_(v0[j]), s1 = sigmoidf_(v1[j]); v0[j] = act == 1 ? v0[j] * s0 : s0; v1[j] = act == 1 ? v1[j] * s1 : s1; }
                        v4u w; w.x = pk2(v0.x, v0.y); w.y = pk2(v0.z, v0.w); w.z = pk2(v1.x, v1.y); w.w = pk2(v1.z, v1.w);
                        *(v4u*)(rowp + bj * 128) = w; } }
        }
    }
};
struct EpiVt {
    static constexpr bool PERM = false, AFTER_DRAIN = false, FP8 = true;
    bf16* VT;
    __device__ __forceinline__ void operator()(const f32x4 (&acc)[2][2][4][2], const Unit& u, int wr, int wc, int fr, int fq) const {
        const int row0 = u.pm * 256 + wr * 64 + fr, col0 = u.pn * 256 + wc * 32 + 4 * fq;
#pragma unroll
        for (int ai = 0; ai < 2; ++ai)
#pragma unroll
            for (int m = 0; m < 4; ++m) { unsigned char* rowp = (unsigned char*)VT + (size_t)(row0 + ai * 128 + m * 16) * LDV + col0;
#pragma unroll
                for (int bj = 0; bj < 2; ++bj)
#pragma unroll
                    for (int n = 0; n < 2; ++n) { const f32x4 v = acc[ai][bj][m][n]; *(unsigned*)(rowp + bj * 128 + n * 16) = pk_fp8x4(v.x, v.y, v.z, v.w); } }
    }
};
struct EpiMerge {
    static constexpr bool PERM = false, AFTER_DRAIN = false, FP8 = false;
    const bf16* proj; bf16* U;
    __device__ __forceinline__ void operator()(const f32x4 (&acc)[2][2][4][2], const Unit& u, int wr, int wc, int fr, int fq) const {
        const int br = u.pn >> 2, T = u.pn & 3, pm = u.pm - 65 * br;
        const int row0 = pm * 256 + wr * 64 + fr, col0 = T * 256 + wc * 32 + 8 * fq;
        const int gcol = (br ? PC_GB : PC_GA) + col0;
#pragma unroll
        for (int ai = 0; ai < 2; ++ai)
#pragma unroll
            for (int m = 0; m < 4; ++m) { const size_t row = (size_t)(row0 + ai * 128 + m * 16);
#pragma unroll
                for (int bj = 0; bj < 2; ++bj) {
                    const v4u gw = *(const v4u*)(proj + row * PROJW + gcol + bj * 128);
                    f32x4 v0 = acc[ai][bj][m][0], v1 = acc[ai][bj][m][1];
                    v0.x *= bflo(gw.x); v0.y *= bfhi(gw.x); v0.z *= bflo(gw.y); v0.w *= bfhi(gw.y);
                    v1.x *= bflo(gw.z); v1.y *= bfhi(gw.z); v1.z *= bflo(gw.w); v1.w *= bfhi(gw.w);
                    bf16* up = U + row * D + col0 + bj * 128;
                    if (br) { const v4u o = *(const v4u*)up;
                        v0.x += bflo(o.x); v0.y += bfhi(o.x); v0.z += bflo(o.y); v0.w += bfhi(o.y);
                        v1.x += bflo(o.z); v1.y += bfhi(o.z); v1.z += bflo(o.w); v1.w += bfhi(o.w); }
                    v4u w; w.x = pk2(v0.x, v0.y); w.y = pk2(v0.z, v0.w); w.z = pk2(v1.x, v1.y); w.w = pk2(v1.z, v1.w);
                    *(v4u*)up = w; } }
    }
};
struct EpiOut {
    static constexpr bool PERM = false, AFTER_DRAIN = false, FP8 = false;
    const bf16* xsrc; bf16* xres; const float* g1lat; const float* g1ctx;
    __device__ __forceinline__ void operator()(const f32x4 (&acc)[2][2][4][2], const Unit& u, int wr, int wc, int fr, int fq) const {
        const int row0 = u.pm * 256 + wr * 64 + fr, col0 = u.pn * 256 + wc * 32 + 4 * fq;
        const bool isctx = u.pm >= 64;
        const float* gsrc = isctx ? g1ctx : g1lat;
        f32x4 gv[2][2];
#pragma unroll
        for (int bj = 0; bj < 2; ++bj)
#pragma unroll
            for (int n = 0; n < 2; ++n) gv[bj][n] = *(const f32x4*)(gsrc + col0 + bj * 128 + n * 16);
#pragma unroll
        for (int ai = 0; ai < 2; ++ai)
#pragma unroll
            for (int m = 0; m < 4; ++m) { const int row = row0 + ai * 128 + m * 16;
                const bf16* src = xsrc + (size_t)row * D + col0;
                bf16* dst = xres + (size_t)row * D + col0;
#pragma unroll
                for (int bj = 0; bj < 2; ++bj)
#pragma unroll
                    for (int n = 0; n < 2; ++n) { const v2u xv = *(const v2u*)(src + bj * 128 + n * 16);
                        const f32x4 y = (f32x4){bflo(xv.x), bfhi(xv.x), bflo(xv.y), bfhi(xv.y)} + gv[bj][n] * acc[ai][bj][m][n];
                        v2u o; o.x = pk2(y.x, y.y); o.y = pk2(y.z, y.w); *(v2u*)(dst + bj * 128 + n * 16) = o; } }
    }
};
struct EpiSwiglu {
    static constexpr bool PERM = false, AFTER_DRAIN = false, FP8 = true;
    bf16* hdn; const float* bgu;
    __device__ __forceinline__ void operator()(const f32x4 (&acc)[2][2][4][2], const Unit& u, int wr, int wc, int fr, int fq) const {
        const int e = u.pn >> 3, T = u.pn & 7;
        const int row0 = u.pm * 256 + wr * 64 + fr, col0 = T * 128 + wc * 32 + 8 * fq;
        const float* bg = bgu + (size_t)e * 2048 + col0;
        const f32x4 bg0 = *(const f32x4*)bg, bg1 = *(const f32x4*)(bg + 4), bu0 = *(const f32x4*)(bg + 1024), bu1 = *(const f32x4*)(bg + 1028);
#pragma unroll
        for (int ai = 0; ai < 2; ++ai)
#pragma unroll
            for (int m = 0; m < 4; ++m) {
                f32x4 g0 = acc[ai][0][m][0] + bg0, g1 = acc[ai][0][m][1] + bg1, u0 = acc[ai][1][m][0] + bu0, u1 = acc[ai][1][m][1] + bu1;
                f32x4 h0, h1;
#pragma unroll
                for (int j = 0; j < 4; ++j) {
                    const float ga = fminf(g0[j], 7.f), gb = fminf(g1[j], 7.f);
                    const float ua = fminf(fmaxf(u0[j], -7.f), 7.f), ub = fminf(fmaxf(u1[j], -7.f), 7.f);
                    h0[j] = (ua + 1.f) * ga * sigmoidf_(1.702f * ga); h1[j] = (ub + 1.f) * gb * sigmoidf_(1.702f * gb);
                }
                v2u w; w.x = pk_fp8x4(h0.x, h0.y, h0.z, h0.w); w.y = pk_fp8x4(h1.x, h1.y, h1.z, h1.w);
                *(v2u*)((unsigned char*)hdn + (size_t)(row0 + ai * 128 + m * 16) * D + col0) = w;
            }
    }
};
struct EpiDown {
    static constexpr bool PERM = false, AFTER_DRAIN = false, FP8 = true;
    bf16* Y; const float* bdn;
    __device__ __forceinline__ void operator()(const f32x4 (&acc)[2][2][4][2], const Unit& u, int wr, int wc, int fr, int fq) const {
        const int e = u.pn >> 2, T = u.pn & 3;
        const int row0 = u.pm * 256 + wr * 64 + fr, col0 = T * 256 + wc * 32 + 8 * fq;
        f32x4 bv[2][2];
#pragma unroll
        for (int bj = 0; bj < 2; ++bj)
#pragma unroll
            for (int n = 0; n < 2; ++n) bv[bj][n] = *(const f32x4*)(bdn + (size_t)e * D + col0 + bj * 128 + 4 * n);
#pragma unroll
        for (int ai = 0; ai < 2; ++ai)
#pragma unroll
            for (int m = 0; m < 4; ++m) { bf16* rowp = Y + (size_t)(row0 + ai * 128 + m * 16) * D + col0;
#pragma unroll
                for (int bj = 0; bj < 2; ++bj) { const f32x4 v0 = acc[ai][bj][m][0] + bv[bj][0], v1 = acc[ai][bj][m][1] + bv[bj][1];
                    v4u w; w.x = pk2(v0.x, v0.y); w.y = pk2(v0.z, v0.w); w.z = pk2(v1.x, v1.y); w.w = pk2(v1.z, v1.w);
                    *(v4u*)(rowp + bj * 128) = w; } }
    }
};

constexpr int IM_QT = 0, IM_KT = 4352, IM_KH = 8704, IM_VT = 14848, IM_DEC = 20992;
constexpr int HGP = 272;
constexpr int HL_IMG = 0, HL_ST = 2 * IM_BYTES, HL_STSZ = 34816, HL_OT = HL_ST + 2 * HL_STSZ, HL_OTSZ = 8448, HL_OF = HL_OT + 2 * HL_OTSZ, HL_GT = HL_OF + 2 * 8192, HL_AM = HL_GT + 2 * 4096;

__device__ __forceinline__ void glds16_s(const void* sbase, unsigned voff, unsigned lds_dst);

__device__ __forceinline__ void phase_hgrn_build(const Params& P, int layer, int G, int wv) {
    int tid_ = fresh_tid(wv);
    const int tid = tid_, d = tid & 127;
    GAS unsigned char* wsg_ = (GAS unsigned char*)P.ws; asm volatile("" : "+s"(wsg_)); unsigned char* ws = (unsigned char*)wsg_;
    const bf16* proj = (const bf16*)(ws + WS_PROJ);
    for (int task = blockIdx.x * 4 + (tid >> 7); task < 8 * 65 * 16; task += G * 4) {
        const int c = task & 15, sg = (task >> 4) % 65, dh = task / (16 * 65), dir = dh >> 2, hh = dh & 3;
        const int tok0 = (sg < 64 ? sg * 256 : SEQ) + (dir ? 255 : 0), sgn = dir ? -1 : 1;
        const float lb = ((const float*)(ws + WS_LB))[((size_t)dir * DEPTH + layer) * 512 + 128 * hh + d];
        const bf16* base = proj + (size_t)(tok0 + sgn * 16 * c) * PROJW + 128 * hh + d;
        const long rstep = (long)sgn * PROJW;
        float z[16], q[16]; unsigned short vv[16];
#pragma unroll
        for (int s = 0; s < 16; ++s) { const bf16* r = base + s * rstep; z[s] = bf2f(r[dir ? PC_ZB : PC_ZF]); q[s] = bf2f(r[PC_QH]); vv[s] = r[PC_VH]; }
        float b[16], kk[16], run = 0.f;
#pragma unroll
        for (int s = 0; s < 16; ++s) {
            const float zz = fminf(fmaxf(z[s], -80.f), 80.f), E = fast_exp(-zz), den = fast_rcp(1.f + E);
            run += fast_log((1.f + lb * E) * den); b[s] = run; kk[s] = (1.f - lb) * E * den;
        }
        unsigned char* img = ws + WS_IMG + (size_t)task * IM_BYTES;
        unsigned khw[8], vtw[8];
#pragma unroll
        for (int s = 0; s < 16; ++s) {
            *(bf16*)(img + IM_QT + s * HGP + d * 2) = (bf16)(pk2(q[s] * fast_exp(b[s]), 0.f) & 0xffffu);
            *(bf16*)(img + IM_KT + s * HGP + d * 2) = (bf16)(pk2(kk[s] * fast_exp(fminf(-b[s], 80.f)), 0.f) & 0xffffu);
        }
#pragma unroll
        for (int j = 0; j < 8; ++j) { khw[j] = pk2(kk[2 * j] * fast_exp(b[15] - b[2 * j]), kk[2 * j + 1] * fast_exp(b[15] - b[2 * j + 1])); vtw[j] = (unsigned)vv[2 * j] | ((unsigned)vv[2 * j + 1] << 16); }
        *(v4u*)(img + IM_KH + d * 48) = (v4u){khw[0], khw[1], khw[2], khw[3]}; *(v4u*)(img + IM_KH + d * 48 + 16) = (v4u){khw[4], khw[5], khw[6], khw[7]};
        *(v4u*)(img + IM_VT + d * 48) = (v4u){vtw[0], vtw[1], vtw[2], vtw[3]}; *(v4u*)(img + IM_VT + d * 48 + 16) = (v4u){vtw[4], vtw[5], vtw[6], vtw[7]};
        *(float*)(img + IM_DEC + d * 4) = fast_exp(b[15]);
    }
}

template <int MODE>
__device__ __forceinline__ void hgrn_sweep(const Params& P, LAS unsigned char* lds, int layer, int dir, int hh, int seg, const float* Sinit, float* Uout, float* Dout, int wv) {
    int tid_ = fresh_tid(wv);
    const int tid = tid_, lane = tid & 63, wid = __builtin_amdgcn_readfirstlane(tid >> 6), r32 = lane & 31, hi = lane >> 5;
    GAS unsigned char* wsg_ = (GAS unsigned char*)P.ws; asm volatile("" : "+s"(wsg_)); unsigned char* ws = (unsigned char*)wsg_;
    const int tok0 = (seg < 64 ? seg * 256 : SEQ) + (dir ? 255 : 0), sgn = dir ? -1 : 1;
    constexpr int NV = (MODE == 0) ? 2 : 4;
    const int db = wid & 3, vb0 = (MODE == 0) ? 2 * (wid >> 2) : 0;
    const bool srole = (MODE == 0) || wid >= 4, orole = (MODE != 0) && wid < 4;
    const unsigned lds0 = (unsigned)(uintptr_t)lds;
    const unsigned char* img0 = ws + WS_IMG + (size_t)(((dir * 4 + hh) * 65 + seg) * 16) * IM_BYTES;
    constexpr int P0 = (MODE == 0) ? 8 : 0;
#define HG_DMA_IMG(c) do { _Pragma("unroll") for (int j = 0; j < 3; ++j) { const int pc = wid + 8 * j; if (pc >= P0 && pc < 21) \
        glds16_s(img0 + (size_t)(c) * IM_BYTES + pc * 1024, (unsigned)lane * 16u, lds0 + HL_IMG + ((c) & 1) * IM_BYTES + pc * 1024); } } while (0)
#define HG_DMA_FIN(c) do { { const int t = 2 * wid + (lane >> 5), tok = tok0 + sgn * (16 * (c) + t); \
        glds16_s(ws + WS_OBF, (unsigned)(((size_t)tok * 512 + 128 * hh) * 4 + (lane & 31) * 16), lds0 + HL_OF + ((c) & 1) * 8192 + wid * 1024); } \
      if (wid < 4) { const int t = 4 * wid + (lane >> 4), tok = tok0 + sgn * (16 * (c) + t); \
        glds16_s(ws + WS_PROJ, (unsigned)(((size_t)tok * PROJW + PC_GH + 128 * hh) * 2 + (lane & 15) * 16), lds0 + HL_GT + ((c) & 1) * 4096 + wid * 1024); } } while (0)
    HG_DMA_IMG(0);
    f32x16 S[NV];
#pragma unroll
    for (int blk = 0; blk < NV; ++blk)
#pragma unroll
        for (int r = 0; r < 16; ++r) { const int d = 32 * db + (r & 3) + 8 * (r >> 2) + 4 * hi, v = 32 * (vb0 + blk) + r32; S[blk][r] = (Sinit && srole) ? Sinit[(size_t)d * 128 + v] : 0.f; }
    if (MODE != 0 && srole) {
#pragma unroll
        for (int blk = 0; blk < NV; ++blk)
#pragma unroll
            for (int g = 0; g < 4; ++g) { v2u o; o.x = pk2(S[blk][4 * g], S[blk][4 * g + 1]); o.y = pk2(S[blk][4 * g + 2], S[blk][4 * g + 3]);
                *(LAS v2u*)(lds + HL_ST + (32 * (vb0 + blk) + r32) * HGP + (32 * db + 8 * g + 4 * hi) * 2) = o; }
    }
    float dtot = 1.f;
    const f32x4 gnv = *(const f32x4*)(P.in[I_HGNG] + (size_t)layer * 128 + 4 * (tid & 31));
#define HG_FINALIZE(c) do { const int t = tid >> 5, v4 = 4 * (tid & 31), tok = tok0 + sgn * (16 * (c) + t); \
        const f32x4 o = *(const LAS f32x4*)(lds + HL_OT + ((c) & 1) * HL_OTSZ + t * 528 + v4 * 4) + *(const LAS f32x4*)(lds + HL_OF + ((c) & 1) * 8192 + t * 512 + v4 * 4); \
        float ss = (o.x * o.x + o.y * o.y) + (o.z * o.z + o.w * o.w); \
        _Pragma("unroll") for (int off = 1; off < 32; off <<= 1) ss += shx(ss, off, lane); \
        const float rstd = __builtin_amdgcn_rsqf(ss * (1.f / 128.f) + EPS); \
        const f32x4 gn = gnv; \
        const v2u gt = *(const LAS v2u*)(lds + HL_GT + ((c) & 1) * 4096 + t * 256 + v4 * 2); \
        v2u w; w.x = pk2(o.x * rstd * gn.x * bflo(gt.x), o.y * rstd * gn.y * bfhi(gt.x)); w.y = pk2(o.z * rstd * gn.z * bflo(gt.y), o.w * rstd * gn.w * bfhi(gt.y)); \
        *(v2u*)((bf16*)(ws + WS_OAB) + (size_t)NT * 512 + (size_t)tok * 512 + 128 * hh + v4) = w; } while (0)
    for (int c = 0; c < 16; ++c) {
        if (c >= 1 && MODE == 1 && orole) asm volatile("s_waitcnt vmcnt(8)" ::: "memory");
        else if (c >= 2 && MODE == 2) asm volatile("s_waitcnt vmcnt(1)" ::: "memory");
        else asm volatile("s_waitcnt vmcnt(0)" ::: "memory");
        __syncthreads();
        if (c + 1 < 16) HG_DMA_IMG(c + 1);
        if (MODE == 2) { HG_DMA_FIN(c); if (c > 0) HG_FINALIZE(c - 1); }
        const LAS unsigned char* im = lds + HL_IMG + (c & 1) * IM_BYTES;
        const int cur = c & 1;
        if (orole) {
            const int t16 = lane & 15, kq4 = lane >> 4;
            bf16x8 qa[4];
#pragma unroll
            for (int ks = 0; ks < 4; ++ks) qa[ks] = *(const LAS bf16x8*)(im + IM_QT + t16 * HGP + (32 * ks + 8 * kq4) * 2);
            f32x4 am = {0.f, 0.f, 0.f, 0.f};
#pragma unroll
            for (int ks = 0; ks < 4; ++ks) { const bf16x8 kb = *(const LAS bf16x8*)(im + IM_KT + t16 * HGP + (32 * ks + 8 * kq4) * 2); am = __builtin_amdgcn_mfma_f32_16x16x32_bf16(qa[ks], kb, am, 0, 0, 0); }
            LAS unsigned char* amw = lds + HL_AM + wid * 768;
#pragma unroll
            for (int i = 0; i < 4; ++i) { const int t = 4 * kq4 + i; *(LAS bf16*)(amw + t * 48 + t16 * 2) = (bf16)(pk2(t16 <= t ? am[i] : 0.f, 0.f) & 0xffffu); }
            f32x4 o4[2];
#pragma unroll
            for (int b2 = 0; b2 < 2; ++b2) { o4[b2] = (f32x4){0.f, 0.f, 0.f, 0.f}; const int vcol = 32 * wid + 16 * b2 + t16;
#pragma unroll
                for (int ks = 0; ks < 4; ++ks) { const bf16x8 sb = *(const LAS bf16x8*)(lds + HL_ST + cur * HL_STSZ + vcol * HGP + (32 * ks + 8 * kq4) * 2); o4[b2] = __builtin_amdgcn_mfma_f32_16x16x32_bf16(qa[ks], sb, o4[b2], 0, 0, 0); } }
            LDS_WAIT();
            bf16x8 ama = *(const LAS bf16x8*)(amw + t16 * 48 + 16 * (kq4 & 1));
            if (kq4 >= 2) ama = (bf16x8){0, 0, 0, 0, 0, 0, 0, 0};
#pragma unroll
            for (int b2 = 0; b2 < 2; ++b2) { const int vcol = 32 * wid + 16 * b2 + t16;
                const bf16x8 vbf = *(const LAS bf16x8*)(im + IM_VT + vcol * 48 + 16 * (kq4 & 1));
                o4[b2] = __builtin_amdgcn_mfma_f32_16x16x32_bf16(ama, vbf, o4[b2], 0, 0, 0);
#pragma unroll
                for (int i = 0; i < 4; ++i) { const int t = 4 * kq4 + i;
                    if (MODE == 1) { const int tok = tok0 + sgn * (16 * c + t); ((float*)(ws + WS_OBF))[(size_t)tok * 512 + 128 * hh + vcol] = o4[b2][i]; }
                    else *(LAS float*)(lds + HL_OT + cur * HL_OTSZ + t * 528 + vcol * 4) = o4[b2][i]; } }
        }
        if (srole) {
            float dsc[16];
#pragma unroll
            for (int r = 0; r < 16; ++r) dsc[r] = *(const LAS float*)(im + IM_DEC + (32 * db + (r & 3) + 8 * (r >> 2) + 4 * hi) * 4);
            if (MODE == 0 && tid < 128) dtot *= *(const LAS float*)(im + IM_DEC + tid * 4);
            const bf16x8 ka = *(const LAS bf16x8*)(im + IM_KH + (32 * db + r32) * 48 + 16 * hi);
#pragma unroll
            for (int blk = 0; blk < NV; ++blk) {
#pragma unroll
                for (int r = 0; r < 16; ++r) S[blk][r] *= dsc[r];
                const bf16x8 vb = *(const LAS bf16x8*)(im + IM_VT + (32 * (vb0 + blk) + r32) * 48 + 16 * hi);
                S[blk] = __builtin_amdgcn_mfma_f32_32x32x16_bf16(ka, vb, S[blk], 0, 0, 0);
                if (MODE != 0) {
#pragma unroll
                    for (int g = 0; g < 4; ++g) { v2u o; o.x = pk2(S[blk][4 * g], S[blk][4 * g + 1]); o.y = pk2(S[blk][4 * g + 2], S[blk][4 * g + 3]);
                        *(LAS v2u*)(lds + HL_ST + (cur ^ 1) * HL_STSZ + (32 * (vb0 + blk) + r32) * HGP + (32 * db + 8 * g + 4 * hi) * 2) = o; }
                }
            }
        }
    }
    asm volatile("s_waitcnt vmcnt(0)" ::: "memory");
    __syncthreads();
    if (MODE == 2) HG_FINALIZE(15);
    if (MODE == 0) {
#pragma unroll
        for (int blk = 0; blk < NV; ++blk)
#pragma unroll
            for (int r = 0; r < 16; ++r) { const int d = 32 * db + (r & 3) + 8 * (r >> 2) + 4 * hi, v = 32 * (vb0 + blk) + r32; Uout[(size_t)d * 128 + v] = S[blk][r]; }
        if (tid < 128) Dout[tid] = dtot;
    }
    asm volatile("s_waitcnt vmcnt(0)" ::: "memory");
    __syncthreads();
#undef HG_DMA_IMG
#undef HG_DMA_FIN
#undef HG_FINALIZE
}

__device__ __forceinline__ void phase_hgrn1(const Params& P, LAS unsigned char* lds, int layer, int G, int wv) {
    float* U = (float*)(P.ws + WS_HGU); float* Dv = (float*)(P.ws + WS_HGD);
    for (int w = blockIdx.x; w < 512; w += G) {
        const int dir = w >> 8, hh = (w >> 6) & 3, j = w & 63;
        const int seg = (j == 0) ? 64 : (dir ? 64 - j : j - 1);
        hgrn_sweep<0>(P, lds, layer, dir, hh, seg, nullptr, U + (size_t)w * 16384, Dv + (size_t)w * 128, wv);
    }
}
__device__ __forceinline__ void phase_hgrn_chain(const Params& P, int G, int wv) {
    const float* U = (const float*)(P.ws + WS_HGU); const float* Dv = (const float*)(P.ws + WS_HGD); float* Sg = (float*)(P.ws + WS_HGS);
    int tid_ = fresh_tid(wv);
    for (int t = blockIdx.x * NTHR + tid_; t < 8 * 16384; t += G * NTHR) {
        const int dh = t >> 14, el = t & 16383, d = el >> 7;
        float s = 0.f;
        Sg[((size_t)dh * 65 + 0) * 16384 + el] = 0.f;
#pragma unroll
        for (int h = 0; h < 2; ++h) {
            float uu[32], dd[32];
#pragma unroll
            for (int p = 0; p < 32; ++p) { uu[p] = U[((size_t)dh * 64 + 32 * h + p) * 16384 + el]; dd[p] = Dv[((size_t)dh * 64 + 32 * h + p) * 128 + d]; }
#pragma unroll
            for (int p = 0; p < 32; ++p) { s = dd[p] * s + uu[p]; Sg[((size_t)dh * 65 + 32 * h + p + 1) * 16384 + el] = s; }
        }
    }
}
__device__ __forceinline__ void hgrn_unit2(const Params& P, LAS unsigned char* lds, int layer, int hh, int seg, int wv) {
    const float* Sg = (const float*)(P.ws + WS_HGS);
    const int pf = (seg < 64) ? seg + 1 : 0, pb = (seg < 64) ? 64 - seg : 0;
    hgrn_sweep<1>(P, lds, layer, 0, hh, seg, pf ? Sg + ((size_t)(0 * 4 + hh) * 65 + pf) * 16384 : nullptr, nullptr, nullptr, wv);
    hgrn_sweep<2>(P, lds, layer, 1, hh, seg, pb ? Sg + ((size_t)(1 * 4 + hh) * 65 + pb) * 16384 : nullptr, nullptr, nullptr, wv);
}

constexpr int AL_K = 0, AL_KSZ = 8192, AL_V = 2 * AL_KSZ, AL_VSZ = 8192, AL_WS = 65536, AL_OST = AL_WS + 8 * 256;

__device__ __forceinline__ void glds16_s(const void* sbase, unsigned voff, unsigned lds_dst) {
    unsigned keep;
    { const unsigned long long a = (unsigned long long)(uintptr_t)sbase;
      const unsigned lo = __builtin_amdgcn_readfirstlane((unsigned)a), hi2 = __builtin_amdgcn_readfirstlane((unsigned)(a >> 32));
      sbase = (const void*)(uintptr_t)(((unsigned long long)hi2 << 32) | lo); lds_dst = __builtin_amdgcn_readfirstlane(lds_dst); }
    asm volatile("s_mov_b32 %0, m0\n\ts_mov_b32 m0, %3\n\ts_nop 0\n\tglobal_load_lds_dwordx4 %1, %2\n\ts_mov_b32 m0, %0" : "=&s"(keep) : "v"(voff), "s"(sbase), "s"(lds_dst) : "memory");
}
__device__ __forceinline__ void attn_unit(const Params& P, LAS unsigned char* lds, int layer, int hh, int qt, float lam, float oscale, int wv) {
    int tid = fresh_tid(wv);
    const int lane = tid & 63, wid = __builtin_amdgcn_readfirstlane(tid >> 6), r32 = lane & 31, hi = lane >> 5;
    const int qg = wid >> 1, mp = wid & 1;
    GAS unsigned char* wsg_ = (GAS unsigned char*)P.ws; asm volatile("" : "+s"(wsg_)); unsigned char* ws = (unsigned char*)wsg_;
    const int qrow0 = (qt < 64) ? qt * 256 : SEQ;
    const int kt_lo = (qt < 64) ? 0 : 256, kt_hi = NT / 64;
    const unsigned char* Qg = ws + WS_Q + ((size_t)hh * NT + qrow0 + 64 * qg + r32) * 128 + 64 * mp + 32 * hi;
    const char* Kg = (const char*)(ws + WS_K) + (size_t)hh * NT * 128;
    const char* Vg = (const char*)(ws + WS_VT) + (size_t)hh * 128 * LDV;
    typedef int v4i_ __attribute__((ext_vector_type(4))); typedef int v8i_ __attribute__((ext_vector_type(8)));
    v8i_ qf[2];
#pragma unroll
    for (int q2 = 0; q2 < 2; ++q2) qf[q2] = __builtin_shufflevector(*(const v4i_*)(Qg + (size_t)q2 * 32 * 128), *(const v4i_*)(Qg + (size_t)q2 * 32 * 128 + 16), 0, 1, 2, 3, 4, 5, 6, 7);
    f32x16 O[2][4];
#pragma unroll
    for (int q2 = 0; q2 < 2; ++q2)
#pragma unroll
        for (int db = 0; db < 4; ++db)
#pragma unroll
            for (int r = 0; r < 16; ++r) O[q2][db][r] = 0.f;
    float lsum0 = 0.f, lsum1 = 0.f;
    const unsigned lds0 = (unsigned)(uintptr_t)lds;
    const int ki_ = 8 * wid + (lane >> 3), vi_ = 16 * wid + (lane >> 2);
    const unsigned ko_ = (unsigned)((32 * ((ki_ >> 2) & 1) + 16 * (ki_ >> 5) + (ki_ & 3) + 4 * ((ki_ & 31) >> 3)) * 128 + (((lane & 7) ^ ((ki_ >> 1) & 7)) << 4));
    const unsigned vo_ = (unsigned)(vi_ * LDV + (((lane & 3) ^ ((vi_ >> 2) & 3)) << 4));
#define ATT_DMA(t, buf) do { \
        glds16_s(Kg + (size_t)(t) * 8192, ko_, lds0 + AL_K + (buf) * AL_KSZ + wid * 1024); \
        glds16_s(Vg + (size_t)(t) * 64, vo_, lds0 + AL_V + (buf) * AL_VSZ + wid * 1024); } while (0)
    ATT_DMA(kt_lo, 0);
    asm volatile("s_waitcnt vmcnt(0)" ::: "memory");
    __syncthreads();
    asm volatile("" : "+v"(qf[0]), "+v"(qf[1]));
    if (wid >= 4) __builtin_amdgcn_s_setprio(1);
    int cur = 0;
    const int ksw = (4 * mp + 2 * hi) ^ ((r32 >> 1) & 7), vsw = (2 * hi) ^ ((r32 >> 2) & 3);
    for (int t = kt_lo; t < kt_hi; ++t) {
        if (t + 1 < kt_hi) ATT_DMA(t + 1, cur ^ 1);
        unsigned kb0 = (unsigned)(AL_K + cur * AL_KSZ + r32 * 128 + (ksw << 4)), vb0 = (unsigned)(AL_V + cur * AL_VSZ + r32 * 64 + (vsw << 4));
        asm volatile("" : "+v"(kb0), "+v"(vb0));
        v8i_ kf[2], pa[2];
#pragma unroll
        for (int kb = 0; kb < 2; ++kb) kf[kb] = __builtin_shufflevector(*(const LAS v4i_*)(lds + kb0 + kb * 4096), *(const LAS v4i_*)(lds + (kb0 ^ 16u) + kb * 4096), 0, 1, 2, 3, 4, 5, 6, 7);
#pragma unroll
        for (int q2 = 0; q2 < 2; ++q2) {
            f32x16 s[2];
#pragma unroll
            for (int kb = 0; kb < 2; ++kb) {
#pragma unroll
                for (int r = 0; r < 16; ++r) s[kb][r] = 0.f;
                s[kb] = __builtin_amdgcn_mfma_scale_f32_32x32x64_f8f6f4(kf[kb], qf[q2], s[kb], 0, 0, 0, 0, 0, 0);
            }
            float ls = 0.f;
#pragma unroll
            for (int kb = 0; kb < 2; ++kb)
#pragma unroll
                for (int r = 0; r < 16; ++r) { s[kb][r] = __builtin_amdgcn_exp2f(s[kb][r]); ls += s[kb][r]; }
            if (q2 == 0) lsum0 += ls; else lsum1 += ls;
#pragma unroll
            for (int kb = 0; kb < 2; ++kb)
#pragma unroll
                for (int w = 0; w < 4; ++w) { int p; asm volatile("" : "=v"(p)); p = __builtin_amdgcn_cvt_pk_bf8_f32(s[kb][4 * w], s[kb][4 * w + 1], p, false);        p = __builtin_amdgcn_cvt_pk_bf8_f32(s[kb][4 * w + 2], s[kb][4 * w + 3], p, true); pa[q2][4 * kb + w] = p; }
        }
        {
            v8i_ vcur = __builtin_shufflevector(*(const LAS v4i_*)(lds + vb0), *(const LAS v4i_*)(lds + (vb0 ^ 16u)), 0, 1, 2, 3, 4, 5, 6, 7);
#pragma unroll
            for (int db = 0; db < 4; ++db) {
                v8i_ vnext = vcur;
                if (db < 3) vnext = __builtin_shufflevector(*(const LAS v4i_*)(lds + vb0 + (db + 1) * 2048), *(const LAS v4i_*)(lds + (vb0 ^ 16u) + (db + 1) * 2048), 0, 1, 2, 3, 4, 5, 6, 7);
                O[0][db] = __builtin_amdgcn_mfma_scale_f32_32x32x64_f8f6f4(pa[0], vcur, O[0][db], 1, 0, 0, 0, 0, 0);
                O[1][db] = __builtin_amdgcn_mfma_scale_f32_32x32x64_f8f6f4(pa[1], vcur, O[1][db], 1, 0, 0, 0, 0, 0);
                vcur = vnext;
            }
        }
        asm volatile("s_waitcnt vmcnt(0)" ::: "memory");
        __syncthreads();
        cur ^= 1;
    }
#undef ATT_DMA
    __builtin_amdgcn_s_setprio(0);
    lsum0 += shx(lsum0, 32, lane); lsum1 += shx(lsum1, 32, lane);
    LAS float* wsf = (LAS float*)(lds + AL_WS + wid * 256);
    if (hi == 0) { wsf[r32] = (mp ? lam : 1.f) / lsum0; wsf[32 + r32] = (mp ? lam : 1.f) / lsum1; }
    LDS_WAIT();
    LAS float* X = (LAS float*)(lds + qg * 16384);
    const float* sg = P.in[I_SUBLN] + (size_t)layer * 128;
    LAS bf16* stg = (LAS bf16*)(lds + AL_OST + qg * 8192);
#pragma unroll
    for (int q2 = 0; q2 < 2; ++q2) {
        if (mp == 1) {
#pragma unroll
            for (int r = 0; r < 16; ++r) { const float a = wsf[32 * q2 + (r & 3) + 8 * (r >> 2) + 4 * hi];
#pragma unroll
                for (int db = 0; db < 4; ++db) X[(db * 16 + r) * 64 + lane] = O[q2][db][r] * a; }
        }
        __syncthreads();
        if (mp == 0) {
            float gsc[4];
#pragma unroll
            for (int db = 0; db < 4; ++db) gsc[db] = sg[32 * db + r32] * oscale;
#pragma unroll
            for (int r = 0; r < 16; ++r) {
                const int q = (r & 3) + 8 * (r >> 2) + 4 * hi;
                const float a0 = wsf[32 * q2 + q];
                float o[4], ss = 0.f;
#pragma unroll
                for (int db = 0; db < 4; ++db) { o[db] = O[q2][db][r] * a0 - X[(db * 16 + r) * 64 + lane]; ss += o[db] * o[db]; }
#pragma unroll
                for (int off = 1; off < 32; off <<= 1) ss += shx(ss, off, lane);
                const float rstd = __builtin_amdgcn_rsqf(ss * (1.f / 128.f) + EPS);
#pragma unroll
                for (int db = 0; db < 4; ++db) stg[q * 128 + 32 * db + r32] = (bf16)(pk2(o[db] * rstd * gsc[db], 0.f) & 0xffffu);
            }
            LDS_WAIT();
            bf16* Ow = (bf16*)(ws + WS_OAB) + (size_t)(qrow0 + 64 * qg + 32 * q2) * 512 + 128 * hh;
#pragma unroll
            for (int i = 0; i < 8; ++i) { const int row = 4 * i + (lane >> 4), ch = lane & 15;
                const v4u v = *(const LAS v4u*)(stg + row * 128 + ch * 8); *(v4u*)(Ow + (size_t)row * 512 + ch * 8) = v; }
        }
        __syncthreads();
    }
}

__device__ __forceinline__ void phase_mix(const Params& P, LAS unsigned char* lds, int layer, int G, bool with_ctx, int wv, int KINDS) {
    int tid_ = fresh_tid(wv);
    const int lane = tid_ & 63;
    const float* lq = P.in[I_LAMQK] + (size_t)layer * 4 * 64;
    const float s1 = wave_sum(lq[lane] * lq[64 + lane], lane), s2 = wave_sum(lq[128 + lane] * lq[192 + lane], lane);
    const float lam_init = __int_as_float(__builtin_amdgcn_readfirstlane(__float_as_int(0.8f - 0.6f * expf(-0.3f * (float)layer))));
    const float lam = __int_as_float(__builtin_amdgcn_readfirstlane(__float_as_int(expf(s1) - expf(s2) + lam_init)));
    if (KINDS & 1) {
        const int na = with_ctx ? 260 : 256;
#pragma unroll 1
        for (int u = blockIdx.x; u < na; u += G) {
            const int hh = (u < 256) ? ((u & 7) >> 1) : (u - 256), qt = (u < 256) ? (((u >> 3) << 1) | (u & 1)) : 64;
            attn_unit(P, lds, layer, hh, qt, lam, __int_as_float(__builtin_amdgcn_readfirstlane(__float_as_int(1.f - lam_init))), wv);
        }
    }
    if (KINDS & 2) {
        const int nh = with_ctx ? 260 : 256;
#pragma unroll 1
        for (int k = 0; ; ++k) {
            int v;
            if (G == 256) { const int c = (int)blockIdx.x; if (k == 0) v = c; else if (k == 1 && with_ctx && c >= 4 && c < 8) v = 252 + c; else break; }
            else { v = (int)blockIdx.x + k * G; if (v >= nh) break; }
            hgrn_unit2(P, lds, layer, v & 3, v >> 2, wv);
        }
    }
}

constexpr int RL_RW = 0, RL_TA = RW_IMG, RL_TB = RL_TA + 8192, RL_LOG = RL_TB + 8192, RL_INFO = RL_LOG + 80 * 33 * 4, RL_CNT = RL_INFO + 80 * 32, RL_BASE = RL_CNT + 128, RL_RSTD = RL_BASE + 128;
__device__ __forceinline__ void phase_router(const Params& P, LAS unsigned char* lds, int layer, int G, int nrows, int wv) {
    int tid_ = fresh_tid(wv);
    const int tid = tid_, lane = tid & 63, wave = __builtin_amdgcn_readfirstlane(tid >> 6);
    GAS unsigned char* wsg_ = (GAS unsigned char*)P.ws; asm volatile("" : "+s"(wsg_)); unsigned char* ws = (unsigned char*)wsg_;
    LAS float* TA = (LAS float*)(lds + RL_TA); LAS float* TB = (LAS float*)(lds + RL_TB); LAS float* LOG = (LAS float*)(lds + RL_LOG);
    LAS unsigned* INFO = (LAS unsigned*)(lds + RL_INFO); LAS unsigned* LCNT = (LAS unsigned*)(lds + RL_CNT); LAS unsigned* GBASE = (LAS unsigned*)(lds + RL_BASE); LAS float* RSTD = (LAS float*)(lds + RL_RSTD);
    { const unsigned lds0 = (unsigned)(uintptr_t)lds; const unsigned char* img = ws + WS_RWIMG + (size_t)layer * RW_IMG;
      for (int pc = wave; pc < RW_IMG / 1024; pc += NWAVES) glds16_s(img + (size_t)pc * 1024, (unsigned)lane * 16u, lds0 + RL_RW + pc * 1024); }
    for (int i = tid; i < 2048; i += NTHR) { const int w = i >> 10, j = i & 1023; const float* mv = modv_ptr(P, layer, w);
        TA[i] = P.in[I_N2G][(size_t)layer * D + j] * (1.f + mv[4096 + j]); TB[i] = mv[3072 + j]; }
    const bf16* xres = (const bf16*)(ws + WS_XRES);
    const float* rb = P.in[I_RB] + (size_t)layer * NE;
    unsigned* gcnt = (unsigned*)(ws + WS_CTL) + CW_CNT + layer * 32 * 16;
    unsigned* tokinfo = (unsigned*)(ws + WS_TOK);
    bf16* XS = (bf16*)(ws + WS_XS);
    const int RB = nrows / 256;
    asm volatile("s_waitcnt vmcnt(0)" ::: "memory");
    for (int blk = blockIdx.x; blk < 256; blk += G) {
#define RROW(r) ((r) < 64 ? 64 * blk + (r) : SEQ + blk)
        if (tid < 32) LCNT[tid] = 0u;
#pragma unroll 1
        for (int rl = wave; rl < RB; rl += NWAVES) {
            const bf16* xr = xres + (size_t)RROW(rl) * D;
            float ss = 0.f;
#pragma unroll
            for (int k = 0; k < 4; ++k) { const v2u xw = *(const v2u*)(xr + 4 * lane + 256 * k); const f32x4 x = {bflo(xw.x), bfhi(xw.x), bflo(xw.y), bfhi(xw.y)}; ss += (x.x * x.x + x.y * x.y) + (x.z * x.z + x.w * x.w); }
            ss = wave_sum(ss, lane);
            if (lane == 0) RSTD[rl] = __builtin_amdgcn_rsqf(ss * (1.f / D) + EPS);
        }
        __syncthreads();
        if (16 * wave < RB) {
            const int r16 = lane & 15, kq = lane >> 4, r = 16 * wave + r16, rc = r < RB ? r : RB - 1, row = RROW(rc), wsel = row >= SEQ;
            const float rstd = RSTD[rc];
            const bf16* xr = xres + (size_t)row * D + 8 * kq;
            const LAS float* ta = TA + 1024 * wsel + 8 * kq; const LAS float* tb = TB + 1024 * wsel + 8 * kq;
            const LAS unsigned char* bh = lds + RL_RW + r16 * RW_PITCH + 16 * kq;
            f32x4 acc0 = {0.f, 0.f, 0.f, 0.f}, acc1 = {0.f, 0.f, 0.f, 0.f};
#pragma unroll 4
            for (int ks = 0; ks < 32; ++ks) {
                const v4u xw = *(const v4u*)(xr + 32 * ks); const f32x4 x0 = {bflo(xw.x), bfhi(xw.x), bflo(xw.y), bfhi(xw.y)}, x1 = {bflo(xw.z), bfhi(xw.z), bflo(xw.w), bfhi(xw.w)};
                const f32x4 a0 = *(const LAS f32x4*)(ta + 32 * ks), a1 = *(const LAS f32x4*)(ta + 32 * ks + 4), b0 = *(const LAS f32x4*)(tb + 32 * ks), b1 = *(const LAS f32x4*)(tb + 32 * ks + 4);
                const f32x4 h0 = x0 * rstd * a0 + b0, h1 = x1 * rstd * a1 + b1;
                v4u hw, lw;
                hw.x = pk2(h0.x, h0.y); hw.y = pk2(h0.z, h0.w); hw.z = pk2(h1.x, h1.y); hw.w = pk2(h1.z, h1.w);
                lw.x = pk2(h0.x - bflo(hw.x), h0.y - bfhi(hw.x)); lw.y = pk2(h0.z - bflo(hw.y), h0.w - bfhi(hw.y)); lw.z = pk2(h1.x - bflo(hw.z), h1.y - bfhi(hw.z)); lw.w = pk2(h1.z - bflo(hw.w), h1.w - bfhi(hw.w));
                const bf16x8 ah = __builtin_bit_cast(bf16x8, hw), al = __builtin_bit_cast(bf16x8, lw);
                const bf16x8 wh0 = *(const LAS bf16x8*)(bh + 64 * ks), wh1 = *(const LAS bf16x8*)(bh + 16 * RW_PITCH + 64 * ks);
                const bf16x8 wl0 = *(const LAS bf16x8*)(bh + 32 * RW_PITCH + 64 * ks), wl1 = *(const LAS bf16x8*)(bh + 48 * RW_PITCH + 64 * ks);
                acc0 = __builtin_amdgcn_mfma_f32_16x16x32_bf16(ah, wh0, acc0, 0, 0, 0); acc0 = __builtin_amdgcn_mfma_f32_16x16x32_bf16(ah, wl0, acc0, 0, 0, 0); acc0 = __builtin_amdgcn_mfma_f32_16x16x32_bf16(al, wh0, acc0, 0, 0, 0);
                acc1 = __builtin_amdgcn_mfma_f32_16x16x32_bf16(ah, wh1, acc1, 0, 0, 0); acc1 = __builtin_amdgcn_mfma_f32_16x16x32_bf16(ah, wl1, acc1, 0, 0, 0); acc1 = __builtin_amdgcn_mfma_f32_16x16x32_bf16(al, wh1, acc1, 0, 0, 0);
            }
#pragma unroll
            for (int i = 0; i < 4; ++i) { const int rr = 16 * wave + 4 * kq + i; if (rr < RB) { LOG[rr * 33 + r16] = acc0[i]; LOG[rr * 33 + 16 + r16] = acc1[i]; } }
        }
        __syncthreads();
        if (tid < RB) {
            float p[NE];
#pragma unroll
            for (int e = 0; e < NE; ++e) p[e] = LOG[tid * 33 + e] + rb[e];
            float tv[4]; int ti[4];
#pragma unroll
            for (int k = 0; k < 4; ++k) { float best = -3.0e38f; int bi = 0;
#pragma unroll
                for (int e = 0; e < NE; ++e) { const bool gt = p[e] > best; best = gt ? p[e] : best; bi = gt ? e : bi; }
                tv[k] = best; ti[k] = bi;
#pragma unroll
                for (int e = 0; e < NE; ++e) p[e] = (e == bi) ? -3.0e38f : p[e]; }
            float wk[4], wsum = 0.f;
#pragma unroll
            for (int k = 0; k < 4; ++k) { wk[k] = expf(tv[k] - tv[0]); wsum += wk[k]; }
#pragma unroll
            for (int k = 0; k < 4; ++k) { const unsigned pos = __hip_atomic_fetch_add(&LCNT[ti[k]], 1u, __ATOMIC_RELAXED, __HIP_MEMORY_SCOPE_WORKGROUP); INFO[tid * 8 + 2 * k] = ((unsigned)ti[k] << 16) | pos; INFO[tid * 8 + 2 * k + 1] = __float_as_uint(wk[k] / wsum); }
        }
        __syncthreads();
        if (tid < 32) GBASE[tid] = __hip_atomic_fetch_add(gcnt + tid * 16, LCNT[tid], RLX_AGENT);
        __syncthreads();
#pragma unroll 1
        for (int rl = wave; rl < RB; rl += NWAVES) {
            const int row = RROW(rl), w = row >= SEQ;
            const bf16* xr = xres + (size_t)row * D + 16 * lane;
            const float rstd = RSTD[rl];
            v4u o8;
            {
                f32x4 v[4];
#pragma unroll
                for (int j = 0; j < 4; ++j) { const v2u xw = *(const v2u*)(xr + 4 * j); const f32x4 xv = {bflo(xw.x), bfhi(xw.x), bflo(xw.y), bfhi(xw.y)}; const f32x4 a = *(const LAS f32x4*)(TA + 1024 * w + 16 * lane + 4 * j), b = *(const LAS f32x4*)(TB + 1024 * w + 16 * lane + 4 * j); v[j] = xv * rstd * a + b; }
                o8.x = pk_fp8x4(v[0].x, v[0].y, v[0].z, v[0].w); o8.y = pk_fp8x4(v[1].x, v[1].y, v[1].z, v[1].w); o8.z = pk_fp8x4(v[2].x, v[2].y, v[2].z, v[2].w); o8.w = pk_fp8x4(v[3].x, v[3].y, v[3].z, v[3].w);
            }
#pragma unroll
            for (int k = 0; k < 4; ++k) {
                const unsigned ep = INFO[rl * 8 + 2 * k], wb = INFO[rl * 8 + 2 * k + 1];
                const unsigned e = ep >> 16, slot = GBASE[e] + (ep & 0xffffu);
                unsigned char* dst = (unsigned char*)XS + ((size_t)e * CAP + slot) * D + 16 * lane;
                *(v4u*)dst = o8;
                if (lane == 0) { v4u ti4; ti4.x = e; ti4.y = slot; ti4.z = wb; ti4.w = 0u; *(v4u*)(tokinfo + (size_t)row * 16 + 4 * k) = ti4; }
            }
        }
        __syncthreads();
#undef RROW
    }
}

template <bool DRY>
__device__ __forceinline__ void phase_combine(const Params& P, LAS unsigned char* lds, int layer, int G, int nrows, int wv) {
    int tid_ = fresh_tid(wv);
    const int tid = tid_, lane = tid & 63, wave = tid >> 6;
    GAS unsigned char* wsg_ = (GAS unsigned char*)P.ws; asm volatile("" : "+s"(wsg_)); unsigned char* ws = (unsigned char*)wsg_;
    const bool last = (layer == DEPTH - 1);
    LAS float* TA = (LAS float*)lds; LAS float* TB = (LAS float*)(lds + 8192); LAS float* TG = (LAS float*)(lds + 16384);
    for (int i = tid; i < 2048; i += NTHR) { const int w = i >> 10, j = i & 1023;
        TG[i] = modv_ptr(P, layer, w)[5120 + j];
        if (!last) { const float* mv = modv_ptr(P, layer + 1, w); TA[i] = P.in[I_N1G][(size_t)(layer + 1) * D + j] * (1.f + mv[1024 + j]); TB[i] = mv[j]; } }
    __syncthreads();
    bf16* xres = (bf16*)(ws + WS_XRES);
    bf16* xdst = DRY ? (bf16*)(ws + WS_HDN) : xres;
    const unsigned* tokinfo = (const unsigned*)(ws + WS_TOK);
    const bf16* Y = (const bf16*)(ws + WS_XS);
    bf16* H = DRY ? (bf16*)(ws + WS_HDN + (size_t)NT * D * 4) : (bf16*)(ws + WS_H);
#pragma unroll 2
    for (int row = blockIdx.x * NWAVES + wave; row < nrows; row += G * NWAVES) {
        const int w = row >= SEQ;
        f32x4 acc[4];
#pragma unroll
        for (int j = 0; j < 4; ++j) acc[j] = (f32x4){0.f, 0.f, 0.f, 0.f};
#pragma unroll
        for (int k = 0; k < 4; ++k) {
            const v4u ti4 = *(const v4u*)(tokinfo + (size_t)row * 16 + 4 * k);
            const float wk = __uint_as_float(ti4.z);
            const bf16* yr = Y + ((size_t)ti4.x * CAP + ti4.y) * D + 4 * lane;
#pragma unroll
            for (int j = 0; j < 4; ++j) { const v2u yv = *(const v2u*)(yr + 256 * j); acc[j] += wk * (f32x4){bflo(yv.x), bfhi(yv.x), bflo(yv.y), bfhi(yv.y)}; }
        }
        const bf16* xr = xres + (size_t)row * D + 4 * lane;
        f32x4 v[4];
#pragma unroll
        for (int j = 0; j < 4; ++j) { const v2u xw = *(const v2u*)(xr + 256 * j); v[j] = (f32x4){bflo(xw.x), bfhi(xw.x), bflo(xw.y), bfhi(xw.y)} + *(const LAS f32x4*)(TG + 1024 * w + 4 * lane + 256 * j) * acc[j]; }
        if (last) {
            float* orow = (DRY ? (float*)xdst : P.out) + (size_t)row * D + 4 * lane;
#pragma unroll
            for (int j = 0; j < 4; ++j) *(f32x4*)(orow + 256 * j) = v[j];
        } else {
#pragma unroll
            for (int j = 0; j < 4; ++j) { v2u o; o.x = pk2(v[j].x, v[j].y); o.y = pk2(v[j].z, v[j].w); *(v2u*)(xdst + (size_t)row * D + 4 * lane + 256 * j) = o; }
            norm_store_row(v, TA + 1024 * w, TB + 1024 * w, (unsigned char*)H + (size_t)row * D, lane);
        }
    }
}
#define XB_TMO      128
#define XB_XCNT(j)  (256  + 64 * (j))
#define XB_XSUB(j)  (1280 + 64 * (j))
#define XB_XGEN(j)  (2304 + 64 * (j))
#define XB_TOP      3328
#define XB_TOPGEN   3392
#define XCD_BAR_WORDS 3456
#define XB_SPIN_CAP (1u << 18)

__device__ __forceinline__ unsigned xb_ld(unsigned* p)              { return __hip_atomic_load(p, __ATOMIC_RELAXED, __HIP_MEMORY_SCOPE_AGENT); }
__device__ __forceinline__ unsigned xb_add(unsigned* p, unsigned v) { return __hip_atomic_fetch_add(p, v, __ATOMIC_RELAXED, __HIP_MEMORY_SCOPE_AGENT); }
__device__ __forceinline__ unsigned xb_xcc_id() { return (unsigned)__builtin_amdgcn_s_getreg((3 << 11) | 20) & 0xFu; }
#define XB_SPIN(cond, bar) do { unsigned _sp = 0; while (cond) { __builtin_amdgcn_s_sleep(1); \
    if ((++_sp & 255u) == 0u) { if (xb_ld(&(bar)[XB_TMO])) break; if (_sp > XB_SPIN_CAP) { atomicAdd(&(bar)[XB_TMO], 1u); break; } } } } while (0)

struct XcdBarrier {
    int wv; unsigned* bar; unsigned x;
    volatile LAS unsigned* st;
};

__device__ __forceinline__ XcdBarrier xcd_barrier_post(unsigned* bar, volatile LAS unsigned* st, int wv) {
    XcdBarrier b; b.wv = wv; b.bar = bar; b.x = xb_xcc_id(); b.st = st;
    if (fresh_tid(wv) == 0) (void)xb_add(&bar[XB_XCNT(b.x)], 1u);
    return b;
}
__device__ __forceinline__ void xcd_barrier_complete(unsigned* bar, unsigned x, unsigned& nloc, unsigned& nx) {
    const unsigned G = gridDim.x * gridDim.y * gridDim.z;
    unsigned sum, cnt, mine, sp = 0u;
    for (;;) {
        sum = 0u; cnt = 0u; mine = 0u;
#pragma unroll
        for (unsigned j = 0; j < 16; ++j) { const unsigned c = xb_ld(&bar[XB_XCNT(j)]); sum += c; cnt += (c > 0u) ? 1u : 0u; mine = (j == x) ? c : mine; }
        if (sum == G) break;
        __builtin_amdgcn_s_sleep(1);
        if ((++sp & 255u) == 0u) { if (xb_ld(&bar[XB_TMO])) break; if (sp > XB_SPIN_CAP) { atomicAdd(&bar[XB_TMO], 1u); break; } }
    }
    nloc = mine > 0u ? mine : 1u; nx = cnt > 0u ? cnt : 1u;
}

__device__ __forceinline__ void xcd_barrier(const XcdBarrier& b) {
    asm volatile("s_waitcnt vmcnt(0)" ::: "memory");
    __syncthreads();
    if (fresh_tid(b.wv) == 0) {
        unsigned* bar = b.bar;
        __builtin_amdgcn_s_waitcnt(0);
        unsigned nloc = b.st[0], nx = b.st[1];
        if (nloc == 0u) { xcd_barrier_complete(bar, b.x, nloc, nx); b.st[0] = nloc; b.st[1] = nx; }
        const unsigned old = xb_add(&bar[XB_XSUB(b.x)], 1u);
        const unsigned gen = old / nloc;
        if (old + 1u == (gen + 1u) * nloc) {
            __builtin_amdgcn_fence(__ATOMIC_RELEASE, "agent");
            asm volatile("s_waitcnt vmcnt(0)" ::: "memory");
            const unsigned og = xb_add(&bar[XB_TOP], 1u);
            const unsigned tg = og / nx;
            if (og + 1u == (tg + 1u) * nx) xb_add(&bar[XB_TOPGEN], 1u);
            else XB_SPIN(xb_ld(&bar[XB_TOPGEN]) == tg, bar);
            __builtin_amdgcn_fence(__ATOMIC_ACQUIRE, "agent");
            xb_add(&bar[XB_XGEN(b.x)], 1u);
            asm volatile("s_waitcnt vmcnt(0)" ::: "memory");
        } else {
            XB_SPIN(xb_ld(&bar[XB_XGEN(b.x)]) == gen, bar);
            __builtin_amdgcn_fence(__ATOMIC_ACQUIRE, "agent");
            asm volatile("s_waitcnt vmcnt(0)" ::: "memory");
        }
    }
    __syncthreads();
}


__global__ void __launch_bounds__(NTHR, 2) fwd_kernel(Params P) {
    extern __shared__ __attribute__((aligned(16))) unsigned char lds_raw[];
    LAS unsigned char* lds = (LAS unsigned char*)lds_raw;
    volatile LAS unsigned* MISC = (volatile LAS unsigned*)(lds + MISC_OFF);
    const int wv = __builtin_amdgcn_readfirstlane((int)(threadIdx.x >> 6)), G = gridDim.x;
#define tid fresh_tid(wv)
    unsigned char* ws = P.ws;
    unsigned* ctl = (unsigned*)(ws + WS_CTL);
    if (tid < 64) MISC[tid] = 0u;
    __syncthreads();
#if MK_ONE_LAUNCH
    XcdBarrier bar = xcd_barrier_post(ctl + CW_BAR, MISC + 8, wv);
#define GRID_BAR() xcd_barrier(bar)
#else
#define GRID_BAR() do {} while (0)
#endif
    const int lo = P.ph_lo, hi = P.ph_hi;
#ifndef PHM
#define PHM 0x3FFF
#endif
#define IN(k) (lo <= (k) && (k) < hi)
#define EN(b) ((PHM >> (b)) & 1)
#ifdef PROBE_PH
    unsigned long long* stamps = (unsigned long long*)(ws + WS_CTL + 512 * 1024);
#define STAMP(k) do { if (blockIdx.x == 0 && tid == 0) stamps[k] = __builtin_amdgcn_s_memrealtime(); } while (0)
#else
#define STAMP(k) do {} while (0)
#endif
    STAMP(0);
#define SEAM(k) do { int lo_ = lo, hi_ = hi; asm volatile("" : "+s"(lo_), "+s"(hi_));     \
        if (lo_ <= (k) && (k) + 1 < hi_) GRID_BAR(); STAMP((k) + 1); } while (0)

    constexpr int BG_A = 4096, BG_D = 9216, BG_E = 6656;
#ifndef DUP_PH
#define DUP_PH -1
#endif
#define DUPQ(t) (DUP_PH == (t))
    if (EN(12) && IN(0)) { phase_p0a(P, lds, G, wv); if (DUPQ(10)) { GRID_BAR(); phase_p0a(P, lds, G, wv); } SEAM(0); }
    if (EN(13) && IN(1)) { phase_p0b(P, lds, G, wv); SEAM(1); }

    for (int l = 0; l < DEPTH; ++l) {
        const int pb = NPH_PRO + NPH_LAYER * l;
        const bool last = (l == DEPTH - 1);
        const int nrows = last ? SEQ : NT;
        bf16* H = (bf16*)(ws + WS_H);
        if (EN(0) && IN(pb + 0)) {
            GAS unsigned char* wsg_ = (GAS unsigned char*)P.ws; asm volatile("" : "+s"(wsg_)); unsigned char* ws = (unsigned char*)wsg_;
            for (int rep = 0; rep < (DUPQ(0) ? 2 : 1); ++rep) {
            if (rep) GRID_BAR();
            { pg8::Gemm g{H, (const bf16*)(ws + WS_WIN + l * WIN_L), NT, 5632, D / 2};        int c1 = (int)blockIdx.x; asm volatile("" : "+s"(c1)); pg8::StaticOrder S; S.init(NT, 5632, G, c1);
              EpiInProj E{(bf16*)(ws + WS_Q), (bf16*)(ws + WS_K), (bf16*)(ws + WS_PROJ), P.in[I_QNG] + l * 64, P.in[I_KNG] + l * 64, (const float*)(ws + WS_ROPE), ws + WS_IMG, (const float*)(ws + WS_LB) + (size_t)l * 512};
              pg8::gemm_phase<EpiInProj, pg8::StaticOrder, true, true>(lds, g, S, E, wv); }
            { pg8::Gemm g{(const bf16*)(ws + WS_WV + l * WV_L), H, 512, NT, D / 2}; int c2 = (int)(blockIdx.x + 106 < (unsigned)G ? blockIdx.x + 106 : (blockIdx.x + 106) % (unsigned)G); asm volatile("" : "+s"(c2));
              pg8::StaticOrder S; S.init(512, NT, G, c2);
              EpiVt E{(bf16*)(ws + WS_VT)};
              pg8::gemm_phase<EpiVt, pg8::StaticOrder, true, true>(lds, g, S, E, wv); }
            }
            if (!last && G == 256) { const int c = (int)blockIdx.x; __syncthreads(); if (c >= 24) convert_items(P, lds, PER_L * (l + 1), PER_L * (l + 1) + BG_A, c - 24, 232, wv); }
            SEAM(pb + 0);
        }
        if (EN(2) && IN(pb + 2)) { phase_hgrn1(P, lds, l, G, wv); if (DUPQ(1)) { GRID_BAR(); phase_hgrn1(P, lds, l, G, wv); } SEAM(pb + 2); }
        if (EN(3) && IN(pb + 3)) { phase_hgrn_chain(P, G, wv); if (DUPQ(2)) { GRID_BAR(); phase_hgrn_chain(P, G, wv); } SEAM(pb + 3); }
        if (EN(4) && IN(pb + 4)) {
#pragma unroll 1
            for (int rep = 0; rep < ((DUPQ(31) || DUPQ(32)) ? 2 : 1); ++rep) { if (rep) GRID_BAR(); phase_mix(P, lds, l, G, !last, wv, rep == 0 ? 3 : (DUPQ(31) ? 1 : 2)); }
            if (!last && G == 256) { const int c = (int)blockIdx.x; __syncthreads(); if (c >= 8) convert_items(P, lds, PER_L * (l + 1) + BG_A, PER_L * (l + 1) + BG_A + BG_D, c - 8, 248, wv); }
            SEAM(pb + 4); }
        if (EN(5) && IN(pb + 5)) {
            GAS unsigned char* wsg_ = (GAS unsigned char*)P.ws; asm volatile("" : "+s"(wsg_)); unsigned char* ws = (unsigned char*)wsg_;
            pg8::Gemm g{(const bf16*)(ws + WS_OAB), (const bf16*)(ws + WS_WAB + l * WAB_L), 2 * NT, 2048, 512};
            pg8::MergeOrder S{nrows / 256, G, (int)blockIdx.x};
            EpiMerge E{(const bf16*)(ws + WS_PROJ), (bf16*)(ws + WS_U)};
            pg8::gemm_phase<EpiMerge, pg8::MergeOrder, true, true>(lds, g, S, E, wv);
            if (DUPQ(50)) { GRID_BAR(); pg8::gemm_phase<EpiMerge, pg8::MergeOrder, true, true>(lds, g, S, E, wv); }
            if (!last && G == 256) { const int c = (int)blockIdx.x; __syncthreads(); if (!((c & 7) == 0 && c < 32)) { const int nb = (c + 7) >> 3; convert_items(P, lds, PER_L * (l + 1) + BG_A + BG_D, PER_L * (l + 1) + BG_A + BG_D + BG_E, c - (nb < 4 ? nb : 4), 252, wv); } }
            SEAM(pb + 5);
        }
        if (EN(6) && IN(pb + 6)) {
            GAS unsigned char* wsg_ = (GAS unsigned char*)P.ws; asm volatile("" : "+s"(wsg_)); unsigned char* ws = (unsigned char*)wsg_;
            pg8::Gemm g{(const bf16*)(ws + WS_U), (const bf16*)(ws + WS_WO + l * WO_L), nrows, D, D}; pg8::StaticOrder S; S.init(nrows, D, G, (int)blockIdx.x);
            EpiOut E{(const bf16*)(ws + WS_XRES), (bf16*)(ws + WS_XRES), modv_ptr(P, l, 0) + 2048, modv_ptr(P, l, 1) + 2048};
            if (DUPQ(6)) { EpiOut E2 = E; E2.xres = (bf16*)(ws + WS_HDN); pg8::gemm_phase<EpiOut, pg8::StaticOrder, true, true>(lds, g, S, E2, wv); GRID_BAR(); }
            pg8::gemm_phase<EpiOut, pg8::StaticOrder, true, true>(lds, g, S, E, wv);
            if (!last && G == 256) { const int c = (int)blockIdx.x; __syncthreads(); if (c >= 4) convert_items(P, lds, PER_L * (l + 1) + BG_A + BG_D + BG_E, PER_L * (l + 2), c - 4, 252, wv); }
            SEAM(pb + 6);
        }
        if (EN(7) && IN(pb + 7)) {
#pragma unroll 1
            for (int rep = 0; rep < (DUPQ(7) ? 2 : 1); ++rep) {
                if (rep) { GRID_BAR(); if (blockIdx.x == 0 && tid < 32) __hip_atomic_store(ctl + CW_CNT + l * 32 * 16 + tid * 16, 0u, RLX_AGENT); GRID_BAR(); }
                phase_router(P, lds, l, G, nrows, wv); }
            SEAM(pb + 7); }
        if ((EN(8) && IN(pb + 8)) || (EN(9) && IN(pb + 9))) {
            GAS unsigned char* wsg_ = (GAS unsigned char*)P.ws; asm volatile("" : "+s"(wsg_)); unsigned char* ws = (unsigned char*)wsg_;
            LAS unsigned* utab8 = (LAS unsigned*)(lds + 131072); LAS unsigned* utab4 = utab8 + 32; LAS int* ptab = (LAS int*)(utab8 + 64);
            { const int t_ = tid;
              if (t_ == 0) { const unsigned* gcnt = ctl + CW_CNT + l * 32 * 16; int run = 0;
                  for (int e = 0; e < NE; ++e) { ptab[e] = run; run += (int)((__hip_atomic_load(gcnt + e * 16, RLX_AGENT) + 255u) >> 8); } ptab[32] = run; }
              __syncthreads();
              if (t_ < 64) { const int i = t_ & 31, lg = (t_ < 32) ? 3 : 2; const int c_ = (int)blockIdx.x;
                  int tr, pn;
                  if ((G & 63) == 0) { const int x = c_ & 7, q = c_ >> 3, per = (G >> 3) >> lg; pn = q & ((1 << lg) - 1); tr = (i * 8 + x) * per + (q >> lg); }
                  else { const int L = i * G + c_; tr = L >> lg; pn = L & ((1 << lg) - 1); }
                  unsigned v = 0xffffffffu;
                  if (tr < ptab[32]) { int e = 0; for (int j = 1; j < 32; ++j) e = (tr >= ptab[j]) ? j : e; v = ((unsigned)(65 * e + (tr - ptab[e])) << 16) | (unsigned)((e << lg) + pn); }
                  (t_ < 32 ? utab8 : utab4)[i] = v; }
              __syncthreads(); }
            if (EN(8) && IN(pb + 8)) {
                pg8::Gemm g{(const bf16*)(ws + WS_XS), (const bf16*)(ws + WS_WGU + l * WGU_L), NE * CAP, NE * 2048, D / 2};
                pg8::MoeOrder S{utab8};
                EpiSwiglu E{(bf16*)(ws + WS_HDN), P.in[I_BGU] + (size_t)l * NE * 2048};
                pg8::gemm_phase<EpiSwiglu, pg8::MoeOrder, true, true>(lds, g, S, E, wv);
                if (DUPQ(8)) { GRID_BAR(); pg8::gemm_phase<EpiSwiglu, pg8::MoeOrder, true, true>(lds, g, S, E, wv); }
                SEAM(pb + 8);
            }
            if (EN(9) && IN(pb + 9)) {
                pg8::Gemm g{(const bf16*)(ws + WS_HDN), (const bf16*)(ws + WS_WD + l * WD_L), NE * CAP, NE * 1024, DFF / 2};
                pg8::MoeOrder S{utab4};
                EpiDown E{(bf16*)(ws + WS_XS), P.in[I_BDN] + (size_t)l * NE * D};
                pg8::gemm_phase<EpiDown, pg8::MoeOrder, true, true>(lds, g, S, E, wv);
                if (DUPQ(9)) { GRID_BAR(); pg8::gemm_phase<EpiDown, pg8::MoeOrder, true, true>(lds, g, S, E, wv); }
                SEAM(pb + 9);
            }
        }
        if (EN(10) && IN(pb + 10)) { if (DUPQ(11)) { phase_combine<true>(P, lds, l, G, nrows, wv); GRID_BAR(); } phase_combine<false>(P, lds, l, G, nrows, wv); SEAM(pb + 10); }
    }
#ifdef PROBE_PH
    if (blockIdx.x == 0 && tid == 0) {
        unsigned long long tot = 0;
        for (int k = 0; k < NPHASES; ++k) { const int ty = k < 2 ? 12 + k : (k - 2) % 11; if (ty == PROBE_PH || PROBE_PH == 99) tot += stamps[k + 1] - stamps[k]; }
        *(float*)(ws + WS_CTL + 768 * 1024) = 1.f + (float)tot * (1.f / 10000.f);
    }
    GRID_BAR();
    { const float sc = 1.f + *(const float*)(ws + WS_CTL + 768 * 1024);
      for (size_t i = (size_t)blockIdx.x * NTHR + tid; i < (size_t)SEQ * D; i += (size_t)G * NTHR) P.out[i] *= sc; }
#endif
#undef tid
#undef IN
#undef EN
#undef SEAM
#undef GRID_BAR
}

extern "C" void kernel_launch(void* const* d_in, const int* in_sizes, int n_in, void* d_out, int out_size, void* d_ws, size_t ws_size, hipStream_t stream) {
    static int grid = 0;
    if (grid == 0) {
        if (n_in != 24 || out_size != SEQ * D || ws_size < WS_END3) { fprintf(stderr, "kernel_launch: unexpected shapes (n_in %d, out %d, ws %zu < %zu)\n", n_in, out_size, ws_size, (size_t)WS_END3); grid = -1; return; }
        int dev = 0, cus = 0;
        if (hipGetDevice(&dev) != hipSuccess || hipDeviceGetAttribute(&cus, hipDeviceAttributeMultiprocessorCount, dev) != hipSuccess) { grid = -1; return; }
        if (hipFuncSetAttribute((const void*)fwd_kernel, hipFuncAttributeMaxDynamicSharedMemorySize, LDS_BYTES) != hipSuccess) { fprintf(stderr, "kernel_launch: hipFuncSetAttribute failed\n"); grid = -1; return; }
        int per_cu = 0;
        if (hipOccupancyMaxActiveBlocksPerMultiprocessor(&per_cu, (const void*)fwd_kernel, NTHR, LDS_BYTES) != hipSuccess || per_cu < 1) fprintf(stderr, "kernel_launch: occupancy query reports %d\n", per_cu);
        (void)hipGetLastError();
        grid = cus;
    }
    if (grid < 0) return;
    (void)hipMemsetAsync((char*)d_ws + WS_CTL, 0, CTL_ZERO_BYTES, stream);
    Params p{};
    for (int i = 0; i < 24; ++i) p.in[i] = (const float*)d_in[i];
    p.out = (float*)d_out; p.ws = (unsigned char*)d_ws;
#if MK_ONE_LAUNCH
    p.ph_lo = 0; p.ph_hi = NPHASES;
    hipLaunchKernelGGL(fwd_kernel, dim3(grid), dim3(NTHR), LDS_BYTES, stream, p);
#else
    for (int k = 0; k < NPHASES; ++k) { p.ph_lo = k; p.ph_hi = k + 1; hipLaunchKernelGGL(fwd_kernel, dim3(grid), dim3(NTHR), LDS_BYTES, stream, p); }
#endif
}
```

```cpp
#include <hip/hip_runtime.h>
#include <cstdio>
#include <cstdint>

#ifndef MK_ONE_LAUNCH
#define MK_ONE_LAUNCH 1
#endif

#define GAS __attribute__((address_space(1)))
#define LAS __attribute__((address_space(3)))
typedef unsigned short bf16;
typedef unsigned v4u __attribute__((ext_vector_type(4)));
typedef unsigned v2u __attribute__((ext_vector_type(2)));
typedef float f32x4 __attribute__((ext_vector_type(4)));
typedef float f32x16 __attribute__((ext_vector_type(16)));
typedef short bf16x8 __attribute__((ext_vector_type(8)));
typedef short s16x4 __attribute__((ext_vector_type(4)));
typedef float f32x2_t __attribute__((ext_vector_type(2)));
typedef __bf16 bf16x2_t __attribute__((ext_vector_type(2)));

constexpr int D = 1024, SEQ = 16384, LC = 256, NT = SEQ + LC, DEPTH = 4;
constexpr int INC = 6144, NE = 32, DFF = 1024, TOPK = 4;
constexpr int CAP = NT;
constexpr int PROJW = 4608;
constexpr int PC_QH = 0, PC_ZF = 512, PC_ZB = 1024, PC_VH = 1536, PC_GH = 2048, PC_GA = 2560, PC_GB = 3584;
constexpr int LDV = NT;
constexpr float EPS = 1e-6f;
constexpr int NWAVES = 8, NTHR = 512;
constexpr int NPH_PRO = 2, NPH_LAYER = 11, NPHASES = NPH_PRO + NPH_LAYER * DEPTH;

constexpr size_t MiB = 1u << 20;
constexpr size_t WS_CTL = 0, CTL_ZERO_BYTES = 1 * MiB;
constexpr size_t WS_MODP = 1 * MiB;
constexpr size_t WS_MODV = WS_MODP + 2 * MiB;
constexpr size_t WS_LB = WS_MODV + 1 * MiB;
constexpr size_t WS_ROPE = WS_LB + 1 * MiB;
constexpr size_t WS_WIN = WS_ROPE + 1 * MiB;
constexpr size_t WIN_L = (size_t)5632 * 1024 * 2;
constexpr size_t WS_WV = WS_WIN + 4 * WIN_L;
constexpr size_t WV_L = (size_t)512 * 1024 * 2;
constexpr size_t WS_WAB = WS_WV + 4 * WV_L;
constexpr size_t WAB_L = (size_t)2048 * 512 * 2;
constexpr size_t WS_WO = WS_WAB + 4 * WAB_L;
constexpr size_t WO_L = (size_t)1024 * 1024 * 2;
constexpr size_t WS_WGU = WS_WO + 4 * WO_L;
constexpr size_t WGU_E = (size_t)2048 * 1024 * 2, WGU_L = 32 * WGU_E;
constexpr size_t WS_WD = WS_WGU + 4 * WGU_L;
constexpr size_t WD_E = (size_t)1024 * 1024 * 2, WD_L = 32 * WD_E;
constexpr size_t WS_XRES = WS_WD + 4 * WD_L;
constexpr size_t WS_H = WS_XRES + (size_t)NT * D * 4;
constexpr size_t WS_Q = WS_H + (size_t)NT * D * 2;
constexpr size_t WS_K = WS_Q + (size_t)NT * 512 * 2;
constexpr size_t WS_VT = WS_K + (size_t)NT * 512 * 2;
constexpr size_t WS_PROJ = WS_VT + (size_t)512 * LDV * 2;
constexpr size_t WS_OAB = WS_PROJ + (size_t)NT * PROJW * 2;
constexpr size_t WS_OBF = WS_OAB + (size_t)2 * NT * 512 * 2;
constexpr size_t WS_U = WS_OBF + (size_t)NT * 512 * 4;
constexpr size_t WS_HGU = WS_U + (size_t)NT * D * 2;
constexpr size_t WS_HGD = WS_HGU + (size_t)512 * 16384 * 4;
constexpr size_t WS_HGS = WS_HGD + 1 * MiB;
constexpr size_t WS_TOK = WS_HGS + (size_t)520 * 16384 * 4;
constexpr size_t WS_XS = WS_TOK + (size_t)NT * 64;
constexpr size_t SLAB = (size_t)NE * CAP * D * 2;
constexpr size_t WS_HDN = WS_XS + SLAB;
constexpr size_t WS_END = WS_HDN + SLAB;
constexpr int IM_BYTES = 21504;
constexpr size_t WS_IMG = WS_END;
constexpr size_t WS_END2 = WS_IMG + (size_t)8 * 65 * 16 * IM_BYTES;
constexpr int RW_PITCH = 2064, RW_IMG = 2 * 32 * RW_PITCH;
constexpr size_t WS_RWIMG = WS_END2;
constexpr size_t WS_END3 = WS_RWIMG + (size_t)DEPTH * RW_IMG + 4096;
constexpr int CW_TMO = 0;
constexpr int CW_BAR = 4096;
constexpr int CW_CNT = 16384;

constexpr int LDS_BYTES = 162816;
constexpr int MISC_OFF = LDS_BYTES - 256;

#define RLX_AGENT __ATOMIC_RELAXED, __HIP_MEMORY_SCOPE_AGENT
__device__ __forceinline__ unsigned pk2(float lo, float hi) { f32x2_t v = {lo, hi}; bf16x2_t b = __builtin_convertvector(v, bf16x2_t); return __builtin_bit_cast(unsigned, b); }
__device__ __forceinline__ float bflo(unsigned w) { return __uint_as_float(w << 16); }
__device__ __forceinline__ float bfhi(unsigned w) { return __uint_as_float(w & 0xffff0000u); }
__device__ __forceinline__ float bf2f(bf16 b) { return __uint_as_float(((unsigned)b) << 16); }
__device__ __forceinline__ int fresh_tid(int wv) { int l; asm volatile("v_mbcnt_lo_u32_b32 %0, -1, 0\n\tv_mbcnt_hi_u32_b32 %0, -1, %0" : "=v"(l)); return wv * 64 + l; }
__device__ __forceinline__ float shx(float v, int off, int lane) { return __int_as_float(__builtin_amdgcn_ds_bpermute((lane ^ off) << 2, __float_as_int(v))); }
__device__ __forceinline__ float wave_sum(float v, int lane) {
#pragma unroll
    for (int o = 1; o < 64; o <<= 1) v += shx(v, o, lane);
    return v;
}
__device__ __forceinline__ float fast_exp(float x) { return __builtin_amdgcn_exp2f(x * 1.4426950408889634f); }
__device__ __forceinline__ float fast_log(float x) { return __builtin_amdgcn_logf(x) * 0.6931471805599453f; }
__device__ __forceinline__ float fast_rcp(float x) { return __builtin_amdgcn_rcpf(x); }
__device__ __forceinline__ float sigmoidf_(float x) { return fast_rcp(1.f + fast_exp(-x)); }
__device__ __forceinline__ unsigned pk_fp8x4(float a, float b, float c, float d) { int p = __builtin_amdgcn_cvt_pk_fp8_f32(a, b, 0, false); p = __builtin_amdgcn_cvt_pk_fp8_f32(c, d, p, true); return (unsigned)p; }
constexpr float W8_SCALE = 32.f;
__device__ __forceinline__ int perm8(int s) { return (s & ~31) | (((s >> 2) & 1) << 4) | (((s >> 3) & 3) << 2) | (s & 3); }

namespace pg8 {
#define PG8_LAS __attribute__((address_space(3)))
typedef unsigned short bf16_t;
typedef short bf16x8 __attribute__((ext_vector_type(8)));
typedef float f32x4 __attribute__((ext_vector_type(4)));
typedef unsigned u32x4 __attribute__((ext_vector_type(4)));
constexpr int BM = 256, BK = 64, HALF = 128, HTB = HALF * BK * 2  , STAGE_BYTES = 8 * HTB, NXCD = 8, WGM = 2;

__host__ __device__ __forceinline__ int lds_byte(int r, int c) { const int st = (r >> 4) * 2 + (c >> 5), rr = r & 15, cc = c & 31, ob = rr * 64 + cc * 2; return st * 1024 + (ob ^ (((ob >> 9) & 1) << 5)); }
__host__ __device__ __forceinline__ void stage_rc(int b, int& R, int& C) { const int st = b / 1024, sb = b % 1024, swz = sb ^ (((sb >> 9) & 1) << 5); R = (st >> 1) * 16 + swz / 64; C = (st & 1) * 32 + (swz % 64) / 2; }
__host__ __device__ __forceinline__ int perm32(int rho) { const int n = rho >> 4, i = rho & 15; return 8 * (i >> 2) + 4 * n + (i & 3); }

struct Unit { int pm, pn; };
struct Gemm { const bf16_t* A; const bf16_t* Bt; int M, N, K; };
struct StaticOrder {
    int nM, nN, nwg, G, c;
    __host__ __device__ void init(int M, int N, int G_, int c_) { nM = M / BM; nN = N / BM; nwg = nM * nN; G = G_; c = c_; }
    __host__ __device__ bool next(int i, Unit& u) const {
        const long L = (long)i * G + c; if (L >= nwg) return false;
        int wgid = (int)L; { const int q = nwg / NXCD, r = nwg % NXCD, xcd = wgid % NXCD, off = wgid / NXCD; wgid = (xcd < r ? xcd * (q + 1) : r * (q + 1) + (xcd - r) * q) + off; }
        const int nig = WGM * nN, gid = wgid / nig, fm = gid * WGM, gsz = (nM - fm) < WGM ? (nM - fm) : WGM;
        u.pm = fm + ((wgid % nig) % gsz); u.pn = (wgid % nig) / gsz; return true;
    }
    __device__ __forceinline__ void a_ready(const Unit&) const {}
    __device__ __forceinline__ void done(const Unit&) const {}
};
struct MergeOrder {
    int nM, G, c;
    __device__ bool next(int i, Unit& u) const {
        const int br = i & 1; int L = (i >> 1) * G + c;
        if ((G & 31) == 0) { const int x = c & 7, q = c >> 3; L = (((i >> 1) * 8 + x) * (G >> 5) + (q >> 2)) * 4 + (q & 3); }
        if (L >= nM * 4) return false;
        u.pm = 65 * br + (L >> 2); u.pn = 4 * br + (L & 3); return true;
    }
    __device__ __forceinline__ void a_ready(const Unit&) const {}
    __device__ __forceinline__ void done(const Unit&) const {}
};
struct MoeOrder {
    const PG8_LAS unsigned* utab;
    __device__ bool next(int i, Unit& u) const {
        if (i >= 32) return false;
        const unsigned v = (unsigned)__builtin_amdgcn_readfirstlane((int)utab[i]); if (v == 0xffffffffu) return false;
        u.pm = (int)(v >> 16); u.pn = (int)(v & 0xffffu); return true;
    }
    __device__ __forceinline__ void a_ready(const Unit&) const {}
    __device__ __forceinline__ void done(const Unit&) const {}
};

template <class Epi, class Sched, bool ALIGN_EPI = false, bool SP2 = false>
__device__ __forceinline__ void gemm_phase(PG8_LAS unsigned char* lds, const Gemm g, const Sched& S, const Epi& E, int wv) {
    int tid_ = fresh_tid(wv);
    const int tid = tid_, wid = __builtin_amdgcn_readfirstlane(tid >> 6), lane = tid & 63, wr = wid >> 2, wc = wid & 3, fr = lane & 15, fq = lane >> 4;
    const int K = g.K, nt = K / BK;
    unsigned voffA[2], voffB[2];
#pragma unroll
    for (int i = 0; i < 2; ++i) { int R, C; stage_rc(tid * 16 + i * 8192, R, C); const int Rb = Epi::PERM ? ((R & ~31) + perm32(R & 31)) : R;
        voffA[i] = (unsigned)(R * K + C) * 2u; voffB[i] = (unsigned)(Rb * K + C) * 2u; }
    const size_t kstep = (size_t)(BK * 2);
    const size_t hstep = (size_t)HALF * K * 2;
    const size_t tstep = 2 * hstep;
    const unsigned ldsw = (unsigned)wid * 1024u;
    const int aoff = lds_byte(wr * 64 + fr, fq * 8), boff = lds_byte(wc * 32 + fr, fq * 8);
#define PG8_SA(b, h) (((b) * 2 + (h)) * HTB)
#define PG8_SB(b, h) ((4 + (b) * 2 + (h)) * HTB)
#define PG8_STAGE(bufoff, gbase, voff) do { _Pragma("unroll") for (int _i = 0; _i < 2; ++_i) \
        __builtin_amdgcn_global_load_lds((const unsigned*)((const char*)(gbase) + (voff)[_i]), (PG8_LAS unsigned*)(lds + (bufoff) + ldsw + _i * 8192), 16, 0, 0); } while (0)
#define PG8_LD8(p_) __builtin_shufflevector(*(const PG8_LAS v4i_*)(p_), *(const PG8_LAS v4i_*)((p_) + 1024), 0, 1, 2, 3, 4, 5, 6, 7)
#define PG8_LDA(dst, b, h) do { if constexpr (Epi::FP8) { _Pragma("unroll") for (int m = 0; m < 4; ++m) dst##8[m] = PG8_LD8(lds + PG8_SA(b, h) + aoff + m * 2048); } \
        else { _Pragma("unroll") for (int m = 0; m < 4; ++m) _Pragma("unroll") for (int k = 0; k < 2; ++k) dst[m][k] = *(const PG8_LAS bf16x8*)(lds + PG8_SA(b, h) + aoff + m * 2048 + k * 1024); } } while (0)
#define PG8_LDB(dst, b, h) do { if constexpr (Epi::FP8) { _Pragma("unroll") for (int n = 0; n < 2; ++n) dst##8[n] = PG8_LD8(lds + PG8_SB(b, h) + boff + n * 2048); } \
        else { _Pragma("unroll") for (int n = 0; n < 2; ++n) _Pragma("unroll") for (int k = 0; k < 2; ++k) dst[n][k] = *(const PG8_LAS bf16x8*)(lds + PG8_SB(b, h) + boff + n * 2048 + k * 1024); } } while (0)
#define PG8_MMA(ai, bj, At, Bt) do { if constexpr (Epi::FP8) __builtin_amdgcn_sched_barrier(0);     \
        __builtin_amdgcn_s_setprio(1); _Pragma("unroll") for (int m = 0; m < 4; ++m) _Pragma("unroll") for (int n = 0; n < 2; ++n) { \
        if constexpr (Epi::FP8)   \
            acc[ai][bj][m][n] = __builtin_amdgcn_mfma_scale_f32_16x16x128_f8f6f4(Bt##8[n], At##8[m], acc[ai][bj][m][n], 0, 0, 0, 0, 0, 0);     \
        else { _Pragma("unroll") for (int k = 0; k < 2; ++k) acc[ai][bj][m][n] = __builtin_amdgcn_mfma_f32_16x16x32_bf16(Bt[n][k], At[m][k], acc[ai][bj][m][n], 0, 0, 0); } } \
        if constexpr (Epi::FP8) { _Pragma("unroll") for (int m = 0; m < 4; ++m) _Pragma("unroll") for (int n = 0; n < 2; ++n) asm volatile("" : "+v"(acc[ai][bj][m][n])); }     \
        __builtin_amdgcn_s_setprio(0); if constexpr (Epi::FP8) __builtin_amdgcn_sched_barrier(0); } while (0)
#define PG8_WAIT_V(n) asm volatile("s_waitcnt vmcnt(" #n ")" ::: "memory")
#define PG8_WAIT_L(n) asm volatile("s_waitcnt lgkmcnt(" #n ")" ::: "memory")
#define PG8_BAR __builtin_amdgcn_s_barrier()
#define PG8_SCHED __builtin_amdgcn_sched_barrier(0)
    Unit cur, nxt; int ui = 0;
    if (!S.next(0, cur)) return;
    f32x4 acc[2][2][4][2];
#pragma unroll
    for (int a = 0; a < 2; ++a)
#pragma unroll
        for (int b = 0; b < 2; ++b)
#pragma unroll
            for (int m = 0; m < 4; ++m)
#pragma unroll
                for (int n = 0; n < 2; ++n) acc[a][b][m][n] = (f32x4){0.f, 0.f, 0.f, 0.f};
    typedef int v4i_ __attribute__((ext_vector_type(4))); typedef int v8i_ __attribute__((ext_vector_type(8)));
    bf16x8 At[4][2], B0[2][2], B1[2][2]; v8i_ At8[4], B08[2], B18[2];
    const char* cA = (const char*)g.A + (size_t)cur.pm * tstep; const char* cB = (const char*)g.Bt + (size_t)cur.pn * tstep;
    S.a_ready(cur);
    if constexpr (SP2) {
        PG8_STAGE(PG8_SB(0, 0), cB, voffB); PG8_STAGE(PG8_SB(0, 1), cB + hstep, voffB); PG8_STAGE(PG8_SA(0, 0), cA, voffA); PG8_STAGE(PG8_SA(0, 1), cA + hstep, voffA);
        if (wr == 1) PG8_BAR;
        PG8_WAIT_V(2); PG8_BAR;
        PG8_STAGE(PG8_SB(1, 0), cB + kstep, voffB); PG8_STAGE(PG8_SA(1, 0), cA + kstep, voffA); PG8_STAGE(PG8_SB(1, 1), cB + hstep + kstep, voffB);
        PG8_WAIT_V(6); PG8_BAR;
    } else {
        PG8_STAGE(PG8_SB(0, 0), cB, voffB); PG8_STAGE(PG8_SA(0, 0), cA, voffA); PG8_STAGE(PG8_SB(0, 1), cB + hstep, voffB); PG8_STAGE(PG8_SA(0, 1), cA + hstep, voffA);
        if (wr == 1) PG8_BAR;
        PG8_WAIT_V(4); PG8_BAR;
        PG8_STAGE(PG8_SB(1, 0), cB + kstep, voffB); PG8_STAGE(PG8_SA(1, 0), cA + kstep, voffA); PG8_STAGE(PG8_SB(1, 1), cB + hstep + kstep, voffB);
        PG8_WAIT_V(6); PG8_BAR;
    }
    for (;;) {
        const bool has_next = S.next(ui + 1, nxt);
        const char* nA = has_next ? (const char*)g.A + (size_t)nxt.pm * tstep : cA; const char* nB = has_next ? (const char*)g.Bt + (size_t)nxt.pn * tstep : cB;
        for (int t = 0; t < nt; t += 2) {
            const bool last = (t == nt - 2);
            const char* a1 = cA + (size_t)(t + 1) * kstep;
            const char* a2 = last ? nA : cA + (size_t)(t + 2) * kstep; const char* b2 = last ? nB : cB + (size_t)(t + 2) * kstep;
            const char* a3 = a2 + kstep; const char* b3 = b2 + kstep;
            if (last && has_next) S.a_ready(nxt);
            if constexpr (SP2) {
            PG8_LDB(B0, 0, 0); PG8_LDB(B1, 0, 1); PG8_SCHED; PG8_LDA(At, 0, 0); PG8_STAGE(PG8_SA(1, 1), a1 + hstep, voffA);
            PG8_WAIT_V(8); PG8_WAIT_L(0); PG8_BAR; PG8_MMA(0, 0, At, B0); PG8_MMA(0, 1, At, B1); PG8_BAR; PG8_SCHED;
            PG8_LDA(At, 0, 1); PG8_STAGE(PG8_SB(0, 0), b2, voffB); PG8_STAGE(PG8_SB(0, 1), b2 + hstep, voffB); PG8_STAGE(PG8_SA(0, 0), a2, voffA);
            PG8_WAIT_V(8); PG8_WAIT_L(0); PG8_BAR; PG8_MMA(1, 0, At, B0); PG8_MMA(1, 1, At, B1); PG8_BAR; PG8_SCHED;
            PG8_LDB(B0, 1, 0); PG8_LDB(B1, 1, 1); PG8_SCHED; PG8_LDA(At, 1, 0); PG8_STAGE(PG8_SA(0, 1), a2 + hstep, voffA);
            PG8_WAIT_V(8); PG8_WAIT_L(0); PG8_BAR; PG8_MMA(0, 0, At, B0); PG8_MMA(0, 1, At, B1); PG8_BAR; PG8_SCHED;
            PG8_LDA(At, 1, 1); PG8_STAGE(PG8_SB(1, 0), b3, voffB); PG8_STAGE(PG8_SB(1, 1), b3 + hstep, voffB); PG8_STAGE(PG8_SA(1, 0), a3, voffA);
            PG8_WAIT_V(8); PG8_WAIT_L(0); PG8_BAR; PG8_MMA(1, 0, At, B0); PG8_MMA(1, 1, At, B1); PG8_BAR; PG8_SCHED;
            } else {
            PG8_LDB(B0, 0, 0); PG8_SCHED; PG8_LDA(At, 0, 0); PG8_STAGE(PG8_SA(1, 1), a1 + hstep, voffA);
            PG8_WAIT_L(8); PG8_BAR; PG8_WAIT_L(0); PG8_MMA(0, 0, At, B0); PG8_BAR; PG8_SCHED;
            PG8_LDB(B1, 0, 1); PG8_STAGE(PG8_SB(0, 0), b2, voffB);
            PG8_BAR; PG8_WAIT_L(0); PG8_MMA(0, 1, At, B1); PG8_BAR;
            PG8_LDA(At, 0, 1); PG8_STAGE(PG8_SA(0, 0), a2, voffA);
            PG8_BAR; PG8_WAIT_L(0); PG8_MMA(1, 0, At, B0); PG8_BAR; PG8_SCHED;
            PG8_STAGE(PG8_SB(0, 1), b2 + hstep, voffB);
            PG8_WAIT_V(6); PG8_BAR; PG8_MMA(1, 1, At, B1); PG8_BAR;
            PG8_LDB(B0, 1, 0); PG8_SCHED; PG8_LDA(At, 1, 0); PG8_STAGE(PG8_SA(0, 1), a2 + hstep, voffA);
            PG8_WAIT_L(8); PG8_BAR; PG8_WAIT_L(0); PG8_MMA(0, 0, At, B0); PG8_BAR; PG8_SCHED;
            PG8_LDB(B1, 1, 1); PG8_STAGE(PG8_SB(1, 0), b3, voffB);
            PG8_BAR; PG8_WAIT_L(0); PG8_MMA(0, 1, At, B1); PG8_BAR;
            PG8_LDA(At, 1, 1); PG8_STAGE(PG8_SA(1, 0), a3, voffA);
            PG8_BAR; PG8_WAIT_L(0); PG8_MMA(1, 0, At, B0); PG8_BAR; PG8_SCHED;
            PG8_STAGE(PG8_SB(1, 1), b3 + hstep, voffB);
            PG8_WAIT_V(6); PG8_BAR; PG8_MMA(1, 1, At, B1); PG8_BAR;
            }
        }
        if constexpr (ALIGN_EPI) { if (wr == 0) PG8_BAR; }
        if constexpr (Epi::FP8) { _Pragma("unroll") for (int ai = 0; ai < 2; ++ai) _Pragma("unroll") for (int bj = 0; bj < 2; ++bj) _Pragma("unroll") for (int m = 0; m < 4; ++m) _Pragma("unroll") for (int n = 0; n < 2; ++n) acc[ai][bj][m][n] *= (1.f / W8_SCALE); }
        if constexpr (!Epi::AFTER_DRAIN) { E(acc, cur, wr, wc, fr, fq); S.done(cur); }
        if (!has_next) break;
#pragma unroll
        for (int a = 0; a < 2; ++a)
#pragma unroll
            for (int b = 0; b < 2; ++b)
#pragma unroll
                for (int m = 0; m < 4; ++m)
#pragma unroll
                    for (int n = 0; n < 2; ++n) acc[a][b][m][n] = (f32x4){0.f, 0.f, 0.f, 0.f};
        cur = nxt; cA = nA; cB = nB; ++ui;
        if constexpr (ALIGN_EPI) { if (wr == 1) PG8_BAR; }
    }
    PG8_WAIT_V(0);
    if constexpr (!ALIGN_EPI) { if (wr == 0) PG8_BAR; }
    PG8_BAR;
    if constexpr (Epi::AFTER_DRAIN) { E.fused(acc, cur, wr, wc, fr, fq, lds, wid, lane); S.done(cur); }
#undef PG8_SA
#undef PG8_SB
#undef PG8_STAGE
#undef PG8_LDA
#undef PG8_LD8
#undef PG8_LDB
#undef PG8_MMA
#undef PG8_WAIT_V
#undef PG8_WAIT_L
#undef PG8_BAR
#undef PG8_SCHED
}
}


struct Params { const float* in[24]; float* out; unsigned char* ws; int ph_lo, ph_hi; };
enum { I_X = 0, I_C, I_CTX, I_CCTX, I_ADAW, I_ADAB, I_N1G, I_N2G, I_WIN, I_QNG, I_KNG, I_LAMQK, I_SUBLN, I_HGLB, I_HGNG, I_WBA, I_WBB, I_WOUT, I_RW, I_RB, I_WGU, I_BGU, I_WDN, I_BDN };

#define LDS_WAIT() asm volatile("s_waitcnt lgkmcnt(0)" ::: "memory")

template <int KIND, bool FP8 = false>
__device__ __forceinline__ void transpose_item(const float* __restrict__ W, int K, int N, bf16* WT, bf16* WT2, int row_off, int k0, int n0, LAS float* scr, int lane) {
#pragma unroll 4
    for (int it = 0; it < 16; ++it) {
        const int k = 4 * it + (lane >> 4), n4 = (lane & 15) * 4;
        const f32x4 v = __builtin_nontemporal_load((const f32x4*)(W + (size_t)(k0 + k) * N + n0 + n4));
        *(LAS f32x4*)(scr + k * 64 + (n4 ^ (4 * ((k >> 3) & 7)))) = v;
    }
    LDS_WAIT();
    const int c = lane & 7;
#pragma unroll 2
    for (int j2 = 0; j2 < 8; ++j2) {
        const int nl = (lane >> 3) + 8 * j2, n = n0 + nl;
        const LAS float* s = scr + (8 * c) * 64 + (nl ^ (4 * c));
        v4u o; o.x = pk2(s[0], s[64]); o.y = pk2(s[128], s[192]); o.z = pk2(s[256], s[320]); o.w = pk2(s[384], s[448]);
        bf16* base = WT; size_t row;
        if (KIND == 0) row = (size_t)(row_off + n);
        else if (KIND == 1) row = (size_t)(row_off + perm8(n));
        else if (KIND == 2) {
            if (n < 1024) { const int tile = n >> 8, G = (n >> 6) & 3, bj = (n >> 5) & 1, e = n & 31; row = (size_t)(256 * tile + 128 * bj + 32 * G + e); }
            else if (n < 1536) { base = WT2; row = (size_t)(n - 1024); }
            else if (n < 3584) {
                const int Q = (n - 1536) >> 9, rem = (n - 1536) & 511, hh = rem >> 7, d = rem & 127, dd = d & 63;
                const int p = 128 * (Q >> 1) + 32 * (dd >> 4) + 16 * (Q & 1) + 4 * ((dd >> 2) & 3) + (dd & 3);
                row = (size_t)(1024 + 256 * (2 * hh + (d >> 6)) + p); }
            else row = (size_t)(3072 + perm8(n - 3584));
        } else {
            const int half = n >> 10, nn = n & 1023;
            row = (size_t)(256 * (nn >> 7) + 128 * half + perm8(nn & 127));
        }
        if (!FP8) __builtin_nontemporal_store(o, (v4u*)(base + row * K + k0 + 8 * c));
        else { v2u o8; o8.x = pk_fp8x4(s[0] * W8_SCALE, s[64] * W8_SCALE, s[128] * W8_SCALE, s[192] * W8_SCALE); o8.y = pk_fp8x4(s[256] * W8_SCALE, s[320] * W8_SCALE, s[384] * W8_SCALE, s[448] * W8_SCALE);
               __builtin_nontemporal_store(o8, (v2u*)((unsigned char*)base + row * K + k0 + 8 * c)); }
    }
    LDS_WAIT();
}

__device__ __forceinline__ void sincos_d(double x, double& s, double& c) {
    const double k = __builtin_rint(x * 0.63661977236758134308);
    double r = __builtin_fma(-k, 1.57079632679489655800e+00, x); r = __builtin_fma(-k, 6.12323399573676603587e-17, r);
    const double r2 = r * r;
    double sp = -1.0 / 1307674368000.0; sp = sp * r2 + 1.0 / 6227020800.0; sp = sp * r2 - 1.0 / 39916800.0; sp = sp * r2 + 1.0 / 362880.0; sp = sp * r2 - 1.0 / 5040.0; sp = sp * r2 + 1.0 / 120.0; sp = sp * r2 - 1.0 / 6.0; sp = sp * r2 + 1.0;
    const double sr = sp * r;
    double cp = 1.0 / 20922789888000.0; cp = cp * r2 - 1.0 / 87178291200.0; cp = cp * r2 + 1.0 / 479001600.0; cp = cp * r2 - 1.0 / 3628800.0; cp = cp * r2 + 1.0 / 40320.0; cp = cp * r2 - 1.0 / 720.0; cp = cp * r2 + 1.0 / 24.0; cp = cp * r2 - 0.5; cp = cp * r2 + 1.0;
    const int q = ((int)k) & 3;
    s = (q == 0) ? sr : (q == 1) ? cp : (q == 2) ? -sr : -cp;
    c = (q == 0) ? cp : (q == 1) ? -sr : (q == 2) ? -cp : sr;
}

constexpr int CI_IN = 16 * 96, CI_A = 8 * 16, CI_B = 8 * 16, CI_O = 16 * 16, CI_GU = 16 * 32, CI_DN = 16 * 16;
constexpr int PER_L = CI_IN + CI_A + CI_B + CI_O + NE * CI_GU + NE * CI_DN;
__device__ __forceinline__ void convert_items(const Params& P, LAS unsigned char* lds, int it0, int it1, int gwg, int nwg, int wv) {
    int tid_ = fresh_tid(wv);
    const int lane = tid_ & 63, wave = __builtin_amdgcn_readfirstlane(tid_ >> 6);
    GAS unsigned char* wsg_ = (GAS unsigned char*)P.ws; asm volatile("" : "+s"(wsg_)); unsigned char* ws = (unsigned char*)wsg_;
    LAS float* scr = (LAS float*)(lds + wave * 16384);
    constexpr int I_IN = CI_IN, I_A = CI_A, I_B = CI_B, I_O = CI_O, I_GU = CI_GU, I_DN = CI_DN;
#pragma unroll 1
    for (int it = it0 + gwg * NWAVES + wave; it < it1; it += nwg * NWAVES) {
        const int l = it / PER_L; int r = it % PER_L;
        if (r < I_IN) { const int kb = r / 96, nb = r % 96;
            transpose_item<2, true>(P.in[I_WIN] + (size_t)l * D * INC, D, INC, (bf16*)(ws + WS_WIN + l * WIN_L), (bf16*)(ws + WS_WV + l * WV_L), 0, 64 * kb, 64 * nb, scr, lane); continue; }
        r -= I_IN;
        if (r < I_A) { const int kb = r / 16, nb = r % 16;
            transpose_item<1>(P.in[I_WBA] + (size_t)l * 512 * D, 512, D, (bf16*)(ws + WS_WAB + l * WAB_L), nullptr, 0, 64 * kb, 64 * nb, scr, lane); continue; }
        r -= I_A;
        if (r < I_B) { const int kb = r / 16, nb = r % 16;
            transpose_item<1>(P.in[I_WBB] + (size_t)l * 512 * D, 512, D, (bf16*)(ws + WS_WAB + l * WAB_L), nullptr, 1024, 64 * kb, 64 * nb, scr, lane); continue; }
        r -= I_B;
        if (r < I_O) { const int kb = r / 16, nb = r % 16;
            transpose_item<0>(P.in[I_WOUT] + (size_t)l * D * D, D, D, (bf16*)(ws + WS_WO + l * WO_L), nullptr, 0, 64 * kb, 64 * nb, scr, lane); continue; }
        r -= I_O;
        if (r < NE * I_GU) { const int e = r / I_GU, q = r % I_GU, kb = q / 32, nb = q % 32;
            transpose_item<3, true>(P.in[I_WGU] + ((size_t)l * NE + e) * D * 2048, D, 2048, (bf16*)(ws + WS_WGU + l * WGU_L + e * (WGU_E / 2)), nullptr, 0, 64 * kb, 64 * nb, scr, lane); continue; }
        r -= NE * I_GU;
        { const int e = r / I_DN, q = r % I_DN, kb = q / 16, nb = q % 16;
            transpose_item<1, true>(P.in[I_WDN] + ((size_t)l * NE + e) * DFF * D, DFF, D, (bf16*)(ws + WS_WD + l * WD_L + e * (WD_E / 2)), nullptr, 0, 64 * kb, 64 * nb, scr, lane); }
    }
}

__device__ __forceinline__ void phase_p0a(const Params& P, LAS unsigned char* lds, int G, int wv) {
    int tid_ = fresh_tid(wv);
    const int tid = tid_, lane = tid & 63, wave = tid >> 6;
    GAS unsigned char* wsg_ = (GAS unsigned char*)P.ws; asm volatile("" : "+s"(wsg_)); unsigned char* ws = (unsigned char*)wsg_;
    LAS float* sil = (LAS float*)(lds + 131072);
    for (int i = tid; i < 2048; i += NTHR) { const float v = (i < 1024) ? P.in[I_C][i] : P.in[I_CCTX][i - 1024]; sil[i] = v * sigmoidf_(v); }
    __syncthreads();
    {
        float* modp = (float*)(ws + WS_MODP);
        for (int t = blockIdx.x * NTHR + tid; t < DEPTH * 8 * 6144; t += G * NTHR) {
            const int j = t % 6144, lp = t / 6144, part = lp & 7, l = lp >> 3;
            const float* w = P.in[I_ADAW] + ((size_t)l * D + part * 128) * 6144 + j;
            float a0 = 0.f, a1 = 0.f;
#pragma unroll 8
            for (int i = 0; i < 128; ++i) { const float wv = w[(size_t)i * 6144]; a0 += sil[part * 128 + i] * wv; a1 += sil[1024 + part * 128 + i] * wv; }
            modp[((size_t)(l * 8 + part) * 2 + 0) * 6144 + j] = a0;
            modp[((size_t)(l * 8 + part) * 2 + 1) * 6144 + j] = a1;
        }
    }
    {
        float* lbo = (float*)(ws + WS_LB);
        for (int t = blockIdx.x * NTHR + tid; t < 2 * 512; t += G * NTHR) {
            const int dir = t >> 9, j = t & 511;
            float v[DEPTH], mx = -1e30f;
#pragma unroll
            for (int l = 0; l < DEPTH; ++l) { v[l] = P.in[I_HGLB][((size_t)dir * DEPTH + l) * 512 + j]; mx = fmaxf(mx, v[l]); }
            float sum = 0.f;
#pragma unroll
            for (int l = 0; l < DEPTH; ++l) { v[l] = expf(v[l] - mx); sum += v[l]; }
            float cs = 0.f, first = 0.f;
#pragma unroll
            for (int l = 0; l < DEPTH; ++l) { cs += v[l] / sum; if (l == 0) first = cs; lbo[((size_t)dir * DEPTH + l) * 512 + j] = cs - first; }
        }
    }
    {
        float* rt = (float*)(ws + WS_ROPE);
        for (int t = blockIdx.x * NTHR + tid; t < 256 * 16; t += G * NTHR) {
            const int pos = t >> 4, fi = t & 15;
            const float freq = (float)exp2(-(double)fi * (13.287712379549449 / 16.0));
            const float ang = (float)pos * freq;
            double s, c; sincos_d((double)ang, s, c);
            rt[2 * t] = (float)c; rt[2 * t + 1] = (float)s;
        }
    }
    {
        for (int t = blockIdx.x * NTHR + tid; t < DEPTH * D * NE; t += G * NTHR) {
            const int e = t & 31, k = (t >> 5) & 1023, l = t >> 15;
            const float v = P.in[I_RW][t];
            const unsigned hi = pk2(v, 0.f) & 0xffffu; const unsigned lo = pk2(v - bflo(hi), 0.f) & 0xffffu;
            unsigned char* img = ws + WS_RWIMG + (size_t)l * RW_IMG;
            *(bf16*)(img + e * RW_PITCH + k * 2) = (bf16)hi; *(bf16*)(img + 32 * RW_PITCH + e * RW_PITCH + k * 2) = (bf16)lo;
        }
    }
    {
        convert_items(P, lds, 0, (G == 256) ? PER_L : DEPTH * PER_L, (int)blockIdx.x, G, wv);
    }
}

__device__ __forceinline__ const float* modv_ptr(const Params& P, int l, int w) { return (const float*)(P.ws + WS_MODV) + ((size_t)l * 2 + w) * 6144; }
__device__ __forceinline__ const float* xin_row(const Params& P, int l, int row) {
    if (l == 0) return (row < SEQ) ? P.in[I_X] + (size_t)row * D : P.in[I_CTX] + (size_t)(row - SEQ) * D;
    return (const float*)(P.ws + WS_XRES) + (size_t)row * D;
}
__device__ __forceinline__ void norm_store_row(const f32x4 (&v)[4], const LAS float* A, const LAS float* B, unsigned char* hrow, int lane) {
    float ss = 0.f;
#pragma unroll
    for (int j = 0; j < 4; ++j) ss += (v[j].x * v[j].x + v[j].y * v[j].y) + (v[j].z * v[j].z + v[j].w * v[j].w);
    const float rstd = __builtin_amdgcn_rsqf(wave_sum(ss, lane) * (1.f / D) + EPS);
#pragma unroll
    for (int j = 0; j < 4; ++j) {
        const f32x4 a = *(const LAS f32x4*)(A + 4 * lane + 256 * j), b = *(const LAS f32x4*)(B + 4 * lane + 256 * j);
        const f32x4 y = v[j] * rstd * a + b;
        *(unsigned*)(hrow + 4 * lane + 256 * j) = pk_fp8x4(y.x, y.y, y.z, y.w);
    }
}

__device__ __forceinline__ void phase_p0b(const Params& P, LAS unsigned char* lds, int G, int wv) {
    int tid_ = fresh_tid(wv);
    const int tid = tid_, lane = tid & 63, wave = tid >> 6;
    GAS unsigned char* wsg_ = (GAS unsigned char*)P.ws; asm volatile("" : "+s"(wsg_)); unsigned char* ws = (unsigned char*)wsg_;
    const float* modp = (const float*)(ws + WS_MODP);
    float* modv = (float*)(ws + WS_MODV);
    for (int t = blockIdx.x * NTHR + tid; t < DEPTH * 2 * 6144; t += G * NTHR) {
        const int j = t % 6144, lw = t / 6144, w = lw & 1, l = lw >> 1;
        float a = P.in[I_ADAB][(size_t)l * 6144 + j];
#pragma unroll
        for (int p = 0; p < 8; ++p) a += modp[((size_t)(l * 8 + p) * 2 + w) * 6144 + j];
        modv[t] = a;
    }
    LAS float* TA = (LAS float*)lds;
    LAS float* TB = (LAS float*)(lds + 8192);
    for (int i = tid; i < 2048; i += NTHR) {
        const int w = i >> 10, j = i & 1023;
        float sh = P.in[I_ADAB][j], sc = P.in[I_ADAB][1024 + j];
#pragma unroll
        for (int p = 0; p < 8; ++p) { sh += modp[((size_t)p * 2 + w) * 6144 + j]; sc += modp[((size_t)p * 2 + w) * 6144 + 1024 + j]; }
        TA[i] = P.in[I_N1G][j] * (1.f + sc); TB[i] = sh;
    }
    __syncthreads();
    bf16* H = (bf16*)(ws + WS_H);
    for (int row = blockIdx.x * NWAVES + wave; row < NT; row += G * NWAVES) {
        const float* xr = xin_row(P, 0, row); const int w = row >= SEQ;
        f32x4 v[4];
#pragma unroll
        for (int j = 0; j < 4; ++j) v[j] = *(const f32x4*)(xr + 4 * lane + 256 * j);
        norm_store_row(v, TA + 1024 * w, TB + 1024 * w, (unsigned char*)H + (size_t)row * D, lane);
        bf16* xb = (bf16*)(ws + WS_XRES) + (size_t)row * D + 4 * lane;
#pragma unroll
        for (int j = 0; j < 4; ++j) { v2u o; o.x = pk2(v[j].x, v[j].y); o.y = pk2(v[j].z, v[j].w); *(v2u*)(xb + 256 * j) = o; }
    }
}

using pg8::Unit;

struct EpiInProj {
    static constexpr bool PERM = false, AFTER_DRAIN = false, FP8 = true;
    bf16* Q; bf16* K; bf16* proj; const float* qn_g; const float* kn_g; const float* rope; unsigned char* img; const float* lbl;
    __device__ __forceinline__ void operator()(const f32x4 (&acc)[2][2][4][2], const Unit& u, int wr, int wc, int fr, int fq) const {
        const int row0 = u.pm * 256 + wr * 64 + fr;
        if (u.pn < 4) {
            const bool isq = u.pn < 2; const int gg = 4 * (u.pn & 1) + wc, hh = gg >> 1, mm = gg & 1;
            const float* gv = isq ? qn_g : kn_g; unsigned char* dstb = (unsigned char*)(isq ? Q : K) + (size_t)hh * NT * 128 + 64 * mm;
            const float oscale = isq ? 0.125f * 1.4426950408889634f : 1.f;
            f32x4 g[2][2];
#pragma unroll
            for (int bj = 0; bj < 2; ++bj)
#pragma unroll
                for (int n = 0; n < 2; ++n) g[bj][n] = *(const f32x4*)(gv + 32 * bj + 16 * n + 4 * fq);
#pragma unroll
            for (int ai = 0; ai < 2; ++ai)
#pragma unroll
                for (int m = 0; m < 4; ++m) {
                    const int row = row0 + ai * 128 + m * 16;
                    float ss = 0.f;
#pragma unroll
                    for (int bj = 0; bj < 2; ++bj)
#pragma unroll
                        for (int n = 0; n < 2; ++n) { const f32x4 x = acc[ai][bj][m][n]; ss += (x.x * x.x + x.y * x.y) + (x.z * x.z + x.w * x.w); }
                    { const int ln_ = 16 * fq + fr; ss += shx(ss, 16, ln_); ss += shx(ss, 32, ln_); }
                    const float rstd = __builtin_amdgcn_rsqf(ss * (1.f / 64.f) + EPS) ;
                    unsigned char* dst = dstb + (size_t)row * 128;
                    const bool lat = row < SEQ;
#pragma unroll
                    for (int bj = 0; bj < 2; ++bj) {
                        f32x4 x1 = acc[ai][bj][m][0] * rstd * g[bj][0], x2 = acc[ai][bj][m][1] * rstd * g[bj][1];
                        if (lat) {
                            const int pos = bj == 0 ? (row >> 6) : (row & 63);
                            const f32x4 cs0 = *(const f32x4*)(rope + (size_t)(pos * 16 + 4 * fq) * 2), cs1 = *(const f32x4*)(rope + (size_t)(pos * 16 + 4 * fq) * 2 + 4);
                            const f32x4 c = {cs0.x, cs0.z, cs1.x, cs1.z}, s = {cs0.y, cs0.w, cs1.y, cs1.w};
                            const f32x4 y1 = x1 * c - x2 * s, y2 = x2 * c + x1 * s; x1 = y1; x2 = y2;
                        }
                        x1 = x1 * oscale; x2 = x2 * oscale;
                        *(unsigned*)(dst + 32 * bj + 4 * fq) = pk_fp8x4(x1.x, x1.y, x1.z, x1.w); *(unsigned*)(dst + 32 * bj + 16 + 4 * fq) = pk_fp8x4(x2.x, x2.y, x2.z, x2.w);
                    }
                }
        } else if (u.pn < 12) {
            const int T = u.pn - 4, hh = T >> 1, d0 = 64 * (T & 1) + 16 * wc + 4 * fq, ln_ = 16 * fq + fr;
            const f32x4 lbf = *(const f32x4*)(lbl + 128 * hh + d0), lbb = *(const f32x4*)(lbl + (size_t)DEPTH * 512 + 128 * hh + d0);
#pragma unroll
            for (int ai = 0; ai < 2; ++ai)
#pragma unroll
                for (int m = 0; m < 4; ++m) {
                    const int rg = u.pm * 256 + ai * 128 + wr * 64 + m * 16;
                    const int seg = rg < SEQ ? (rg >> 8) : 64, cf = ((rg < SEQ ? rg : rg - SEQ) & 255) >> 4;
                    const f32x4 qv = acc[ai][0][m][0], vv = acc[ai][1][m][1];
#pragma unroll
                    for (int dir = 0; dir < 2; ++dir) {
                        const f32x4 zv = dir ? acc[ai][1][m][0] : acc[ai][0][m][1], lb = dir ? lbb : lbf;
                        const int s_ = dir ? 15 - fr : fr, c_ = dir ? 15 - cf : cf;
                        unsigned char* im = img + (size_t)((((dir * 4 + hh) * 65 + seg) * 16) + c_) * IM_BYTES;
                        float qt[4], kt[4], kh[4], dc[4];
#pragma unroll
                        for (int i = 0; i < 4; ++i) {
                            const float zc = fminf(fmaxf(zv[i], -80.f), 80.f), E = fast_exp(-zc), den = fast_rcp(1.f + E);
                            const float g = fast_log((1.f + lb[i] * E) * den), kk = (1.f - lb[i]) * E * den;
                            float b = g;
                            if (dir == 0) { b += __int_as_float(__builtin_amdgcn_update_dpp(0, __float_as_int(b), 0x111, 0xf, 0xf, true)); b += __int_as_float(__builtin_amdgcn_update_dpp(0, __float_as_int(b), 0x112, 0xf, 0xf, true));
                                            b += __int_as_float(__builtin_amdgcn_update_dpp(0, __float_as_int(b), 0x114, 0xf, 0xf, true)); b += __int_as_float(__builtin_amdgcn_update_dpp(0, __float_as_int(b), 0x118, 0xf, 0xf, true)); }
                            else          { b += __int_as_float(__builtin_amdgcn_update_dpp(0, __float_as_int(b), 0x101, 0xf, 0xf, true)); b += __int_as_float(__builtin_amdgcn_update_dpp(0, __float_as_int(b), 0x102, 0xf, 0xf, true));
                                            b += __int_as_float(__builtin_amdgcn_update_dpp(0, __float_as_int(b), 0x104, 0xf, 0xf, true)); b += __int_as_float(__builtin_amdgcn_update_dpp(0, __float_as_int(b), 0x108, 0xf, 0xf, true)); }
                            const float bl = __int_as_float(__builtin_amdgcn_ds_bpermute((dir ? (ln_ & ~15) : (ln_ | 15)) << 2, __float_as_int(b)));
                            qt[i] = qv[i] * fast_exp(b); kt[i] = kk * fast_exp(fminf(-b, 80.f)); kh[i] = kk * fast_exp(bl - b); dc[i] = fast_exp(bl);
                        }
                        { v2u o; o.x = pk2(qt[0], qt[1]); o.y = pk2(qt[2], qt[3]); *(v2u*)(im + 0 + s_ * 272 + d0 * 2) = o; }
                        { v2u o; o.x = pk2(kt[0], kt[1]); o.y = pk2(kt[2], kt[3]); *(v2u*)(im + 4352 + s_ * 272 + d0 * 2) = o; }
#pragma unroll
                        for (int i = 0; i < 4; ++i) { *(bf16*)(im + 8704 + (d0 + i) * 48 + s_ * 2) = (bf16)(pk2(kh[i], 0.f) & 0xffffu); *(bf16*)(im + 14848 + (d0 + i) * 48 + s_ * 2) = (bf16)(pk2(vv[i], 0.f) & 0xffffu); }
                        if (s_ == 15) *(f32x4*)(im + 20992 + d0 * 4) = (f32x4){dc[0], dc[1], dc[2], dc[3]};
                    }
                }
        } else {
            const int pt = u.pn - 4; const int act = pt < 10 ? 1 : 2;
            const int col0 = pt * 256 + wc * 32 + 8 * fq;
#pragma unroll
            for (int ai = 0; ai < 2; ++ai)
#pragma unroll
                for (int m = 0; m < 4; ++m) { bf16* rowp = proj + (size_t)(row0 + ai * 128 + m * 16) * PROJW + col0;
#pragma unroll
                    for (int bj = 0; bj < 2; ++bj) { f32x4 v0 = acc[ai][bj][m][0], v1 = acc[ai][bj][m][1];
#pragma unroll
                        for (int j = 0; j < 4; ++j) { const float s0 = sigmoidf_(v0[j]), s1 = sigmoidf_(v1[j]); v0[j] = act == 1 ? v0[j] * s0 : s0; v1[j] = act == 1 ? v1[j] * s1 : s1; }
                        v4u w; w.x = pk2(v0.x, v0.y); w.y = pk2(v0.z, v0.w); w.z = pk2(v1.x, v1.y); w.w = pk2(v1.z, v1.w);
                        *(v4u*)(rowp + bj * 128) = w; } }
        }
    }
};
struct EpiVt {
    static constexpr bool PERM = false, AFTER_DRAIN = false, FP8 = true;
    bf16* VT;
    __device__ __forceinline__ void operator()(const f32x4 (&acc)[2][2][4][2], const Unit& u, int wr, int wc, int fr, int fq) const {
        const int row0 = u.pm * 256 + wr * 64 + fr, col0 = u.pn * 256 + wc * 32 + 4 * fq;
#pragma unroll
        for (int ai = 0; ai < 2; ++ai)
#pragma unroll
            for (int m = 0; m < 4; ++m) { unsigned char* rowp = (unsigned char*)VT + (size_t)(row0 + ai * 128 + m * 16) * LDV + col0;
#pragma unroll
                for (int bj = 0; bj < 2; ++bj)
#pragma unroll
                    for (int n = 0; n < 2; ++n) { const f32x4 v = acc[ai][bj][m][n]; *(unsigned*)(rowp + bj * 128 + n * 16) = pk_fp8x4(v.x, v.y, v.z, v.w); } }
    }
};
struct EpiMerge {
    static constexpr bool PERM = false, AFTER_DRAIN = false, FP8 = false;
    const bf16* proj; bf16* U;
    __device__ __forceinline__ void operator()(const f32x4 (&acc)[2][2][4][2], const Unit& u, int wr, int wc, int fr, int fq) const {
        const int br = u.pn >> 2, T = u.pn & 3, pm = u.pm - 65 * br;
        const int row0 = pm * 256 + wr * 64 + fr, col0 = T * 256 + wc * 32 + 8 * fq;
        const int gcol = (br ? PC_GB : PC_GA) + col0;
#pragma unroll
        for (int ai = 0; ai < 2; ++ai)
#pragma unroll
            for (int m = 0; m < 4; ++m) { const size_t row = (size_t)(row0 + ai * 128 + m * 16);
#pragma unroll
                for (int bj = 0; bj < 2; ++bj) {
                    const v4u gw = *(const v4u*)(proj + row * PROJW + gcol + bj * 128);
                    f32x4 v0 = acc[ai][bj][m][0], v1 = acc[ai][bj][m][1];
                    v0.x *= bflo(gw.x); v0.y *= bfhi(gw.x); v0.z *= bflo(gw.y); v0.w *= bfhi(gw.y);
                    v1.x *= bflo(gw.z); v1.y *= bfhi(gw.z); v1.z *= bflo(gw.w); v1.w *= bfhi(gw.w);
                    bf16* up = U + row * D + col0 + bj * 128;
                    if (br) { const v4u o = *(const v4u*)up;
                        v0.x += bflo(o.x); v0.y += bfhi(o.x); v0.z += bflo(o.y); v0.w += bfhi(o.y);
                        v1.x += bflo(o.z); v1.y += bfhi(o.z); v1.z += bflo(o.w); v1.w += bfhi(o.w); }
                    v4u w; w.x = pk2(v0.x, v0.y); w.y = pk2(v0.z, v0.w); w.z = pk2(v1.x, v1.y); w.w = pk2(v1.z, v1.w);
                    *(v4u*)up = w; } }
    }
};
struct EpiOut {
    static constexpr bool PERM = false, AFTER_DRAIN = false, FP8 = false;
    const bf16* xsrc; bf16* xres; const float* g1lat; const float* g1ctx;
    __device__ __forceinline__ void operator()(const f32x4 (&acc)[2][2][4][2], const Unit& u, int wr, int wc, int fr, int fq) const {
        const int row0 = u.pm * 256 + wr * 64 + fr, col0 = u.pn * 256 + wc * 32 + 4 * fq;
        const bool isctx = u.pm >= 64;
        const float* gsrc = isctx ? g1ctx : g1lat;
        f32x4 gv[2][2];
#pragma unroll
        for (int bj = 0; bj < 2; ++bj)
#pragma unroll
            for (int n = 0; n < 2; ++n) gv[bj][n] = *(const f32x4*)(gsrc + col0 + bj * 128 + n * 16);
#pragma unroll
        for (int ai = 0; ai < 2; ++ai)
#pragma unroll
            for (int m = 0; m < 4; ++m) { const int row = row0 + ai * 128 + m * 16;
                const bf16* src = xsrc + (size_t)row * D + col0;
                bf16* dst = xres + (size_t)row * D + col0;
#pragma unroll
                for (int bj = 0; bj < 2; ++bj)
#pragma unroll
                    for (int n = 0; n < 2; ++n) { const v2u xv = *(const v2u*)(src + bj * 128 + n * 16);
                        const f32x4 y = (f32x4){bflo(xv.x), bfhi(xv.x), bflo(xv.y), bfhi(xv.y)} + gv[bj][n] * acc[ai][bj][m][n];
                        v2u o; o.x = pk2(y.x, y.y); o.y = pk2(y.z, y.w); *(v2u*)(dst + bj * 128 + n * 16) = o; } }
    }
};
struct EpiSwiglu {
    static constexpr bool PERM = false, AFTER_DRAIN = false, FP8 = true;
    bf16* hdn; const float* bgu;
    __device__ __forceinline__ void operator()(const f32x4 (&acc)[2][2][4][2], const Unit& u, int wr, int wc, int fr, int fq) const {
        const int e = u.pn >> 3, T = u.pn & 7;
        const int row0 = u.pm * 256 + wr * 64 + fr, col0 = T * 128 + wc * 32 + 8 * fq;
        const float* bg = bgu + (size_t)e * 2048 + col0;
        const f32x4 bg0 = *(const f32x4*)bg, bg1 = *(const f32x4*)(bg + 4), bu0 = *(const f32x4*)(bg + 1024), bu1 = *(const f32x4*)(bg + 1028);
#pragma unroll
        for (int ai = 0; ai < 2; ++ai)
#pragma unroll
            for (int m = 0; m < 4; ++m) {
                f32x4 g0 = acc[ai][0][m][0] + bg0, g1 = acc[ai][0][m][1] + bg1, u0 = acc[ai][1][m][0] + bu0, u1 = acc[ai][1][m][1] + bu1;
                f32x4 h0, h1;
#pragma unroll
                for (int j = 0; j < 4; ++j) {
                    const float ga = fminf(g0[j], 7.f), gb = fminf(g1[j], 7.f);
                    const float ua = fminf(fmaxf(u0[j], -7.f), 7.f), ub = fminf(fmaxf(u1[j], -7.f), 7.f);
                    h0[j] = (ua + 1.f) * ga * sigmoidf_(1.702f * ga); h1[j] = (ub + 1.f) * gb * sigmoidf_(1.702f * gb);
                }
                v2u w; w.x = pk_fp8x4(h0.x, h0.y, h0.z, h0.w); w.y = pk_fp8x4(h1.x, h1.y, h1.z, h1.w);
                *(v2u*)((unsigned char*)hdn + (size_t)(row0 + ai * 128 + m * 16) * D + col0) = w;
            }
    }
};
struct EpiDown {
    static constexpr bool PERM = false, AFTER_DRAIN = false, FP8 = true;
    bf16* Y; const float* bdn;
    __device__ __forceinline__ void operator()(const f32x4 (&acc)[2][2][4][2], const Unit& u, int wr, int wc, int fr, int fq) const {
        const int e = u.pn >> 2, T = u.pn & 3;
        const int row0 = u.pm * 256 + wr * 64 + fr, col0 = T * 256 + wc * 32 + 8 * fq;
        f32x4 bv[2][2];
#pragma unroll
        for (int bj = 0; bj < 2; ++bj)
#pragma unroll
            for (int n = 0; n < 2; ++n) bv[bj][n] = *(const f32x4*)(bdn + (size_t)e * D + col0 + bj * 128 + 4 * n);
#pragma unroll
        for (int ai = 0; ai < 2; ++ai)
#pragma unroll
            for (int m = 0; m < 4; ++m) { bf16* rowp = Y + (size_t)(row0 + ai * 128 + m * 16) * D + col0;
#pragma unroll
                for (int bj = 0; bj < 2; ++bj) { const f32x4 v0 = acc[ai][bj][m][0] + bv[bj][0], v1 = acc[ai][bj][m][1] + bv[bj][1];
                    v4u w; w.x = pk2(v0.x, v0.y); w.y = pk2(v0.z, v0.w); w.z = pk2(v1.x, v1.y); w.w = pk2(v1.z, v1.w);
                    *(v4u*)(rowp + bj * 128) = w; } }
    }
};

constexpr int IM_QT = 0, IM_KT = 4352, IM_KH = 8704, IM_VT = 14848, IM_DEC = 20992;
constexpr int HGP = 272;
constexpr int HL_IMG = 0, HL_ST = 2 * IM_BYTES, HL_STSZ = 34816, HL_OT = HL_ST + 2 * HL_STSZ, HL_OTSZ = 8448, HL_OF = HL_OT + 2 * HL_OTSZ, HL_GT = HL_OF + 2 * 8192, HL_AM = HL_GT + 2 * 4096;

__device__ __forceinline__ void glds16_s(const void* sbase, unsigned voff, unsigned lds_dst);

__device__ __forceinline__ void phase_hgrn_build(const Params& P, int layer, int G, int wv) {
    int tid_ = fresh_tid(wv);
    const int tid = tid_, d = tid & 127;
    GAS unsigned char* wsg_ = (GAS unsigned char*)P.ws; asm volatile("" : "+s"(wsg_)); unsigned char* ws = (unsigned char*)wsg_;
    const bf16* proj = (const bf16*)(ws + WS_PROJ);
    for (int task = blockIdx.x * 4 + (tid >> 7); task < 8 * 65 * 16; task += G * 4) {
        const int c = task & 15, sg = (task >> 4) % 65, dh = task / (16 * 65), dir = dh >> 2, hh = dh & 3;
        const int tok0 = (sg < 64 ? sg * 256 : SEQ) + (dir ? 255 : 0), sgn = dir ? -1 : 1;
        const float lb = ((const float*)(ws + WS_LB))[((size_t)dir * DEPTH + layer) * 512 + 128 * hh + d];
        const bf16* base = proj + (size_t)(tok0 + sgn * 16 * c) * PROJW + 128 * hh + d;
        const long rstep = (long)sgn * PROJW;
        float z[16], q[16]; unsigned short vv[16];
#pragma unroll
        for (int s = 0; s < 16; ++s) { const bf16* r = base + s * rstep; z[s] = bf2f(r[dir ? PC_ZB : PC_ZF]); q[s] = bf2f(r[PC_QH]); vv[s] = r[PC_VH]; }
        float b[16], kk[16], run = 0.f;
#pragma unroll
        for (int s = 0; s < 16; ++s) {
            const float zz = fminf(fmaxf(z[s], -80.f), 80.f), E = fast_exp(-zz), den = fast_rcp(1.f + E);
            run += fast_log((1.f + lb * E) * den); b[s] = run; kk[s] = (1.f - lb) * E * den;
        }
        unsigned char* img = ws + WS_IMG + (size_t)task * IM_BYTES;
        unsigned khw[8], vtw[8];
#pragma unroll
        for (int s = 0; s < 16; ++s) {
            *(bf16*)(img + IM_QT + s * HGP + d * 2) = (bf16)(pk2(q[s] * fast_exp(b[s]), 0.f) & 0xffffu);
            *(bf16*)(img + IM_KT + s * HGP + d * 2) = (bf16)(pk2(kk[s] * fast_exp(fminf(-b[s], 80.f)), 0.f) & 0xffffu);
        }
#pragma unroll
        for (int j = 0; j < 8; ++j) { khw[j] = pk2(kk[2 * j] * fast_exp(b[15] - b[2 * j]), kk[2 * j + 1] * fast_exp(b[15] - b[2 * j + 1])); vtw[j] = (unsigned)vv[2 * j] | ((unsigned)vv[2 * j + 1] << 16); }
        *(v4u*)(img + IM_KH + d * 48) = (v4u){khw[0], khw[1], khw[2], khw[3]}; *(v4u*)(img + IM_KH + d * 48 + 16) = (v4u){khw[4], khw[5], khw[6], khw[7]};
        *(v4u*)(img + IM_VT + d * 48) = (v4u){vtw[0], vtw[1], vtw[2], vtw[3]}; *(v4u*)(img + IM_VT + d * 48 + 16) = (v4u){vtw[4], vtw[5], vtw[6], vtw[7]};
        *(float*)(img + IM_DEC + d * 4) = fast_exp(b[15]);
    }
}

template <int MODE>
__device__ __forceinline__ void hgrn_sweep(const Params& P, LAS unsigned char* lds, int layer, int dir, int hh, int seg, const float* Sinit, float* Uout, float* Dout, int wv) {
    int tid_ = fresh_tid(wv);
    const int tid = tid_, lane = tid & 63, wid = __builtin_amdgcn_readfirstlane(tid >> 6), r32 = lane & 31, hi = lane >> 5;
    GAS unsigned char* wsg_ = (GAS unsigned char*)P.ws; asm volatile("" : "+s"(wsg_)); unsigned char* ws = (unsigned char*)wsg_;
    const int tok0 = (seg < 64 ? seg * 256 : SEQ) + (dir ? 255 : 0), sgn = dir ? -1 : 1;
    constexpr int NV = (MODE == 0) ? 2 : 4;
    const int db = wid & 3, vb0 = (MODE == 0) ? 2 * (wid >> 2) : 0;
    const bool srole = (MODE == 0) || wid >= 4, orole = (MODE != 0) && wid < 4;
    const unsigned lds0 = (unsigned)(uintptr_t)lds;
    const unsigned char* img0 = ws + WS_IMG + (size_t)(((dir * 4 + hh) * 65 + seg) * 16) * IM_BYTES;
    constexpr int P0 = (MODE == 0) ? 8 : 0;
#define HG_DMA_IMG(c) do { _Pragma("unroll") for (int j = 0; j < 3; ++j) { const int pc = wid + 8 * j; if (pc >= P0 && pc < 21) \
        glds16_s(img0 + (size_t)(c) * IM_BYTES + pc * 1024, (unsigned)lane * 16u, lds0 + HL_IMG + ((c) & 1) * IM_BYTES + pc * 1024); } } while (0)
#define HG_DMA_FIN(c) do { { const int t = 2 * wid + (lane >> 5), tok = tok0 + sgn * (16 * (c) + t); \
        glds16_s(ws + WS_OBF, (unsigned)(((size_t)tok * 512 + 128 * hh) * 4 + (lane & 31) * 16), lds0 + HL_OF + ((c) & 1) * 8192 + wid * 1024); } \
      if (wid < 4) { const int t = 4 * wid + (lane >> 4), tok = tok0 + sgn * (16 * (c) + t); \
        glds16_s(ws + WS_PROJ, (unsigned)(((size_t)tok * PROJW + PC_GH + 128 * hh) * 2 + (lane & 15) * 16), lds0 + HL_GT + ((c) & 1) * 4096 + wid * 1024); } } while (0)
    HG_DMA_IMG(0);
    f32x16 S[NV];
#pragma unroll
    for (int blk = 0; blk < NV; ++blk)
#pragma unroll
        for (int r = 0; r < 16; ++r) { const int d = 32 * db + (r & 3) + 8 * (r >> 2) + 4 * hi, v = 32 * (vb0 + blk) + r32; S[blk][r] = (Sinit && srole) ? Sinit[(size_t)d * 128 + v] : 0.f; }
    if (MODE != 0 && srole) {
#pragma unroll
        for (int blk = 0; blk < NV; ++blk)
#pragma unroll
            for (int g = 0; g < 4; ++g) { v2u o; o.x = pk2(S[blk][4 * g], S[blk][4 * g + 1]); o.y = pk2(S[blk][4 * g + 2], S[blk][4 * g + 3]);
                *(LAS v2u*)(lds + HL_ST + (32 * (vb0 + blk) + r32) * HGP + (32 * db + 8 * g + 4 * hi) * 2) = o; }
    }
    float dtot = 1.f;
    const f32x4 gnv = *(const f32x4*)(P.in[I_HGNG] + (size_t)layer * 128 + 4 * (tid & 31));
#define HG_FINALIZE(c) do { const int t = tid >> 5, v4 = 4 * (tid & 31), tok = tok0 + sgn * (16 * (c) + t); \
        const f32x4 o = *(const LAS f32x4*)(lds + HL_OT + ((c) & 1) * HL_OTSZ + t * 528 + v4 * 4) + *(const LAS f32x4*)(lds + HL_OF + ((c) & 1) * 8192 + t * 512 + v4 * 4); \
        float ss = (o.x * o.x + o.y * o.y) + (o.z * o.z + o.w * o.w); \
        _Pragma("unroll") for (int off = 1; off < 32; off <<= 1) ss += shx(ss, off, lane); \
        const float rstd = __builtin_amdgcn_rsqf(ss * (1.f / 128.f) + EPS); \
        const f32x4 gn = gnv; \
        const v2u gt = *(const LAS v2u*)(lds + HL_GT + ((c) & 1) * 4096 + t * 256 + v4 * 2); \
        v2u w; w.x = pk2(o.x * rstd * gn.x * bflo(gt.x), o.y * rstd * gn.y * bfhi(gt.x)); w.y = pk2(o.z * rstd * gn.z * bflo(gt.y), o.w * rstd * gn.w * bfhi(gt.y)); \
        *(v2u*)((bf16*)(ws + WS_OAB) + (size_t)NT * 512 + (size_t)tok * 512 + 128 * hh + v4) = w; } while (0)
    for (int c = 0; c < 16; ++c) {
        if (c >= 1 && MODE == 1 && orole) asm volatile("s_waitcnt vmcnt(8)" ::: "memory");
        else if (c >= 2 && MODE == 2) asm volatile("s_waitcnt vmcnt(1)" ::: "memory");
        else asm volatile("s_waitcnt vmcnt(0)" ::: "memory");
        __syncthreads();
        if (c + 1 < 16) HG_DMA_IMG(c + 1);
        if (MODE == 2) { HG_DMA_FIN(c); if (c > 0) HG_FINALIZE(c - 1); }
        const LAS unsigned char* im = lds + HL_IMG + (c & 1) * IM_BYTES;
        const int cur = c & 1;
        if (orole) {
            const int t16 = lane & 15, kq4 = lane >> 4;
            bf16x8 qa[4];
#pragma unroll
            for (int ks = 0; ks < 4; ++ks) qa[ks] = *(const LAS bf16x8*)(im + IM_QT + t16 * HGP + (32 * ks + 8 * kq4) * 2);
            f32x4 am = {0.f, 0.f, 0.f, 0.f};
#pragma unroll
            for (int ks = 0; ks < 4; ++ks) { const bf16x8 kb = *(const LAS bf16x8*)(im + IM_KT + t16 * HGP + (32 * ks + 8 * kq4) * 2); am = __builtin_amdgcn_mfma_f32_16x16x32_bf16(qa[ks], kb, am, 0, 0, 0); }
            LAS unsigned char* amw = lds + HL_AM + wid * 768;
#pragma unroll
            for (int i = 0; i < 4; ++i) { const int t = 4 * kq4 + i; *(LAS bf16*)(amw + t * 48 + t16 * 2) = (bf16)(pk2(t16 <= t ? am[i] : 0.f, 0.f) & 0xffffu); }
            f32x4 o4[2];
#pragma unroll
            for (int b2 = 0; b2 < 2; ++b2) { o4[b2] = (f32x4){0.f, 0.f, 0.f, 0.f}; const int vcol = 32 * wid + 16 * b2 + t16;
#pragma unroll
                for (int ks = 0; ks < 4; ++ks) { const bf16x8 sb = *(const LAS bf16x8*)(lds + HL_ST + cur * HL_STSZ + vcol * HGP + (32 * ks + 8 * kq4) * 2); o4[b2] = __builtin_amdgcn_mfma_f32_16x16x32_bf16(qa[ks], sb, o4[b2], 0, 0, 0); } }
            LDS_WAIT();
            bf16x8 ama = *(const LAS bf16x8*)(amw + t16 * 48 + 16 * (kq4 & 1));
            if (kq4 >= 2) ama = (bf16x8){0, 0, 0, 0, 0, 0, 0, 0};
#pragma unroll
            for (int b2 = 0; b2 < 2; ++b2) { const int vcol = 32 * wid + 16 * b2 + t16;
                const bf16x8 vbf = *(const LAS bf16x8*)(im + IM_VT + vcol * 48 + 16 * (kq4 & 1));
                o4[b2] = __builtin_amdgcn_mfma_f32_16x16x32_bf16(ama, vbf, o4[b2], 0, 0, 0);
#pragma unroll
                for (int i = 0; i < 4; ++i) { const int t = 4 * kq4 + i;
                    if (MODE == 1) { const int tok = tok0 + sgn * (16 * c + t); ((float*)(ws + WS_OBF))[(size_t)tok * 512 + 128 * hh + vcol] = o4[b2][i]; }
                    else *(LAS float*)(lds + HL_OT + cur * HL_OTSZ + t * 528 + vcol * 4) = o4[b2][i]; } }
        }
        if (srole) {
            float dsc[16];
#pragma unroll
            for (int r = 0; r < 16; ++r) dsc[r] = *(const LAS float*)(im + IM_DEC + (32 * db + (r & 3) + 8 * (r >> 2) + 4 * hi) * 4);
            if (MODE == 0 && tid < 128) dtot *= *(const LAS float*)(im + IM_DEC + tid * 4);
            const bf16x8 ka = *(const LAS bf16x8*)(im + IM_KH + (32 * db + r32) * 48 + 16 * hi);
#pragma unroll
            for (int blk = 0; blk < NV; ++blk) {
#pragma unroll
                for (int r = 0; r < 16; ++r) S[blk][r] *= dsc[r];
                const bf16x8 vb = *(const LAS bf16x8*)(im + IM_VT + (32 * (vb0 + blk) + r32) * 48 + 16 * hi);
                S[blk] = __builtin_amdgcn_mfma_f32_32x32x16_bf16(ka, vb, S[blk], 0, 0, 0);
                if (MODE != 0) {
#pragma unroll
                    for (int g = 0; g < 4; ++g) { v2u o; o.x = pk2(S[blk][4 * g], S[blk][4 * g + 1]); o.y = pk2(S[blk][4 * g + 2], S[blk][4 * g + 3]);
                        *(LAS v2u*)(lds + HL_ST + (cur ^ 1) * HL_STSZ + (32 * (vb0 + blk) + r32) * HGP + (32 * db + 8 * g + 4 * hi) * 2) = o; }
                }
            }
        }
    }
    asm volatile("s_waitcnt vmcnt(0)" ::: "memory");
    __syncthreads();
    if (MODE == 2) HG_FINALIZE(15);
    if (MODE == 0) {
#pragma unroll
        for (int blk = 0; blk < NV; ++blk)
#pragma unroll
            for (int r = 0; r < 16; ++r) { const int d = 32 * db + (r & 3) + 8 * (r >> 2) + 4 * hi, v = 32 * (vb0 + blk) + r32; Uout[(size_t)d * 128 + v] = S[blk][r]; }
        if (tid < 128) Dout[tid] = dtot;
    }
    asm volatile("s_waitcnt vmcnt(0)" ::: "memory");
    __syncthreads();
#undef HG_DMA_IMG
#undef HG_DMA_FIN
#undef HG_FINALIZE
}

__device__ __forceinline__ void phase_hgrn1(const Params& P, LAS unsigned char* lds, int layer, int G, int wv) {
    float* U = (float*)(P.ws + WS_HGU); float* Dv = (float*)(P.ws + WS_HGD);
    for (int w = blockIdx.x; w < 512; w += G) {
        const int dir = w >> 8, hh = (w >> 6) & 3, j = w & 63;
        const int seg = (j == 0) ? 64 : (dir ? 64 - j : j - 1);
        hgrn_sweep<0>(P, lds, layer, dir, hh, seg, nullptr, U + (size_t)w * 16384, Dv + (size_t)w * 128, wv);
    }
}
__device__ __forceinline__ void phase_hgrn_chain(const Params& P, int G, int wv) {
    const float* U = (const float*)(P.ws + WS_HGU); const float* Dv = (const float*)(P.ws + WS_HGD); float* Sg = (float*)(P.ws + WS_HGS);
    int tid_ = fresh_tid(wv);
    for (int t = blockIdx.x * NTHR + tid_; t < 8 * 16384; t += G * NTHR) {
        const int dh = t >> 14, el = t & 16383, d = el >> 7;
        float s = 0.f;
        Sg[((size_t)dh * 65 + 0) * 16384 + el] = 0.f;
#pragma unroll
        for (int h = 0; h < 2; ++h) {
            float uu[32], dd[32];
#pragma unroll
            for (int p = 0; p < 32; ++p) { uu[p] = U[((size_t)dh * 64 + 32 * h + p) * 16384 + el]; dd[p] = Dv[((size_t)dh * 64 + 32 * h + p) * 128 + d]; }
#pragma unroll
            for (int p = 0; p < 32; ++p) { s = dd[p] * s + uu[p]; Sg[((size_t)dh * 65 + 32 * h + p + 1) * 16384 + el] = s; }
        }
    }
}
__device__ __forceinline__ void hgrn_unit2(const Params& P, LAS unsigned char* lds, int layer, int hh, int seg, int wv) {
    const float* Sg = (const float*)(P.ws + WS_HGS);
    const int pf = (seg < 64) ? seg + 1 : 0, pb = (seg < 64) ? 64 - seg : 0;
    hgrn_sweep<1>(P, lds, layer, 0, hh, seg, pf ? Sg + ((size_t)(0 * 4 + hh) * 65 + pf) * 16384 : nullptr, nullptr, nullptr, wv);
    hgrn_sweep<2>(P, lds, layer, 1, hh, seg, pb ? Sg + ((size_t)(1 * 4 + hh) * 65 + pb) * 16384 : nullptr, nullptr, nullptr, wv);
}

constexpr int AL_K = 0, AL_KSZ = 8192, AL_V = 2 * AL_KSZ, AL_VSZ = 8192, AL_WS = 65536, AL_OST = AL_WS + 8 * 256;

__device__ __forceinline__ void glds16_s(const void* sbase, unsigned voff, unsigned lds_dst) {
    unsigned keep;
    { const unsigned long long a = (unsigned long long)(uintptr_t)sbase;
      const unsigned lo = __builtin_amdgcn_readfirstlane((unsigned)a), hi2 = __builtin_amdgcn_readfirstlane((unsigned)(a >> 32));
      sbase = (const void*)(uintptr_t)(((unsigned long long)hi2 << 32) | lo); lds_dst = __builtin_amdgcn_readfirstlane(lds_dst); }
    asm volatile("s_mov_b32 %0, m0\n\ts_mov_b32 m0, %3\n\ts_nop 0\n\tglobal_load_lds_dwordx4 %1, %2\n\ts_mov_b32 m0, %0" : "=&s"(keep) : "v"(voff), "s"(sbase), "s"(lds_dst) : "memory");
}
__device__ __forceinline__ void attn_unit(const Params& P, LAS unsigned char* lds, int layer, int hh, int qt, float lam, float oscale, int wv) {
    int tid = fresh_tid(wv);
    const int lane = tid & 63, wid = __builtin_amdgcn_readfirstlane(tid >> 6), r32 = lane & 31, hi = lane >> 5;
    const int qg = wid >> 1, mp = wid & 1;
    GAS unsigned char* wsg_ = (GAS unsigned char*)P.ws; asm volatile("" : "+s"(wsg_)); unsigned char* ws = (unsigned char*)wsg_;
    const int qrow0 = (qt < 64) ? qt * 256 : SEQ;
    const int kt_lo = (qt < 64) ? 0 : 256, kt_hi = NT / 64;
    const unsigned char* Qg = ws + WS_Q + ((size_t)hh * NT + qrow0 + 64 * qg + r32) * 128 + 64 * mp + 32 * hi;
    const char* Kg = (const char*)(ws + WS_K) + (size_t)hh * NT * 128;
    const char* Vg = (const char*)(ws + WS_VT) + (size_t)hh * 128 * LDV;
    typedef int v4i_ __attribute__((ext_vector_type(4))); typedef int v8i_ __attribute__((ext_vector_type(8)));
    v8i_ qf[2];
#pragma unroll
    for (int q2 = 0; q2 < 2; ++q2) qf[q2] = __builtin_shufflevector(*(const v4i_*)(Qg + (size_t)q2 * 32 * 128), *(const v4i_*)(Qg + (size_t)q2 * 32 * 128 + 16), 0, 1, 2, 3, 4, 5, 6, 7);
    f32x16 O[2][4];
#pragma unroll
    for (int q2 = 0; q2 < 2; ++q2)
#pragma unroll
        for (int db = 0; db < 4; ++db)
#pragma unroll
            for (int r = 0; r < 16; ++r) O[q2][db][r] = 0.f;
    float lsum0 = 0.f, lsum1 = 0.f;
    const unsigned lds0 = (unsigned)(uintptr_t)lds;
    const int ki_ = 8 * wid + (lane >> 3), vi_ = 16 * wid + (lane >> 2);
    const unsigned ko_ = (unsigned)((32 * ((ki_ >> 2) & 1) + 16 * (ki_ >> 5) + (ki_ & 3) + 4 * ((ki_ & 31) >> 3)) * 128 + (((lane & 7) ^ ((ki_ >> 1) & 7)) << 4));
    const unsigned vo_ = (unsigned)(vi_ * LDV + (((lane & 3) ^ ((vi_ >> 2) & 3)) << 4));
#define ATT_DMA(t, buf) do { \
        glds16_s(Kg + (size_t)(t) * 8192, ko_, lds0 + AL_K + (buf) * AL_KSZ + wid * 1024); \
        glds16_s(Vg + (size_t)(t) * 64, vo_, lds0 + AL_V + (buf) * AL_VSZ + wid * 1024); } while (0)
    ATT_DMA(kt_lo, 0);
    asm volatile("s_waitcnt vmcnt(0)" ::: "memory");
    __syncthreads();
    asm volatile("" : "+v"(qf[0]), "+v"(qf[1]));
    if (wid >= 4) __builtin_amdgcn_s_setprio(1);
    int cur = 0;
    const int ksw = (4 * mp + 2 * hi) ^ ((r32 >> 1) & 7), vsw = (2 * hi) ^ ((r32 >> 2) & 3);
    for (int t = kt_lo; t < kt_hi; ++t) {
        if (t + 1 < kt_hi) ATT_DMA(t + 1, cur ^ 1);
        unsigned kb0 = (unsigned)(AL_K + cur * AL_KSZ + r32 * 128 + (ksw << 4)), vb0 = (unsigned)(AL_V + cur * AL_VSZ + r32 * 64 + (vsw << 4));
        asm volatile("" : "+v"(kb0), "+v"(vb0));
        v8i_ kf[2], pa[2];
#pragma unroll
        for (int kb = 0; kb < 2; ++kb) kf[kb] = __builtin_shufflevector(*(const LAS v4i_*)(lds + kb0 + kb * 4096), *(const LAS v4i_*)(lds + (kb0 ^ 16u) + kb * 4096), 0, 1, 2, 3, 4, 5, 6, 7);
#pragma unroll
        for (int q2 = 0; q2 < 2; ++q2) {
            f32x16 s[2];
#pragma unroll
            for (int kb = 0; kb < 2; ++kb) {
#pragma unroll
                for (int r = 0; r < 16; ++r) s[kb][r] = 0.f;
                s[kb] = __builtin_amdgcn_mfma_scale_f32_32x32x64_f8f6f4(kf[kb], qf[q2], s[kb], 0, 0, 0, 0, 0, 0);
            }
            float ls = 0.f;
#pragma unroll
            for (int kb = 0; kb < 2; ++kb)
#pragma unroll
                for (int r = 0; r < 16; ++r) { s[kb][r] = __builtin_amdgcn_exp2f(s[kb][r]); ls += s[kb][r]; }
            if (q2 == 0) lsum0 += ls; else lsum1 += ls;
#pragma unroll
            for (int kb = 0; kb < 2; ++kb)
#pragma unroll
                for (int w = 0; w < 4; ++w) { int p; asm volatile("" : "=v"(p)); p = __builtin_amdgcn_cvt_pk_bf8_f32(s[kb][4 * w], s[kb][4 * w + 1], p, false);        p = __builtin_amdgcn_cvt_pk_bf8_f32(s[kb][4 * w + 2], s[kb][4 * w + 3], p, true); pa[q2][4 * kb + w] = p; }
        }
        {
            v8i_ vcur = __builtin_shufflevector(*(const LAS v4i_*)(lds + vb0), *(const LAS v4i_*)(lds + (vb0 ^ 16u)), 0, 1, 2, 3, 4, 5, 6, 7);
#pragma unroll
            for (int db = 0; db < 4; ++db) {
                v8i_ vnext = vcur;
                if (db < 3) vnext = __builtin_shufflevector(*(const LAS v4i_*)(lds + vb0 + (db + 1) * 2048), *(const LAS v4i_*)(lds + (vb0 ^ 16u) + (db + 1) * 2048), 0, 1, 2, 3, 4, 5, 6, 7);
                O[0][db] = __builtin_amdgcn_mfma_scale_f32_32x32x64_f8f6f4(pa[0], vcur, O[0][db], 1, 0, 0, 0, 0, 0);
                O[1][db] = __builtin_amdgcn_mfma_scale_f32_32x32x64_f8f6f4(pa[1], vcur, O[1][db], 1, 0, 0, 0, 0, 0);
                vcur = vnext;
            }
        }
        asm volatile("s_waitcnt vmcnt(0)" ::: "memory");
        __syncthreads();
        cur ^= 1;
    }
#undef ATT_DMA
    __builtin_amdgcn_s_setprio(0);
    lsum0 += shx(lsum0, 32, lane); lsum1 += shx(lsum1, 32, lane);
    LAS float* wsf = (LAS float*)(lds + AL_WS + wid * 256);
    if (hi == 0) { wsf[r32] = (mp ? lam : 1.f) / lsum0; wsf[32 + r32] = (mp ? lam : 1.f) / lsum1; }
    LDS_WAIT();
    LAS float* X = (LAS float*)(lds + qg * 16384);
    const float* sg = P.in[I_SUBLN] + (size_t)layer * 128;
    LAS bf16* stg = (LAS bf16*)(lds + AL_OST + qg * 8192);
#pragma unroll
    for (int q2 = 0; q2 < 2; ++q2) {
        if (mp == 1) {
#pragma unroll
            for (int r = 0; r < 16; ++r) { const float a = wsf[32 * q2 + (r & 3) + 8 * (r >> 2) + 4 * hi];
#pragma unroll
                for (int db = 0; db < 4; ++db) X[(db * 16 + r) * 64 + lane] = O[q2][db][r] * a; }
        }
        __syncthreads();
        if (mp == 0) {
            float gsc[4];
#pragma unroll
            for (int db = 0; db < 4; ++db) gsc[db] = sg[32 * db + r32] * oscale;
#pragma unroll
            for (int r = 0; r < 16; ++r) {
                const int q = (r & 3) + 8 * (r >> 2) + 4 * hi;
                const float a0 = wsf[32 * q2 + q];
                float o[4], ss = 0.f;
#pragma unroll
                for (int db = 0; db < 4; ++db) { o[db] = O[q2][db][r] * a0 - X[(db * 16 + r) * 64 + lane]; ss += o[db] * o[db]; }
#pragma unroll
                for (int off = 1; off < 32; off <<= 1) ss += shx(ss, off, lane);
                const float rstd = __builtin_amdgcn_rsqf(ss * (1.f / 128.f) + EPS);
#pragma unroll
                for (int db = 0; db < 4; ++db) stg[q * 128 + 32 * db + r32] = (bf16)(pk2(o[db] * rstd * gsc[db], 0.f) & 0xffffu);
            }
            LDS_WAIT();
            bf16* Ow = (bf16*)(ws + WS_OAB) + (size_t)(qrow0 + 64 * qg + 32 * q2) * 512 + 128 * hh;
#pragma unroll
            for (int i = 0; i < 8; ++i) { const int row = 4 * i + (lane >> 4), ch = lane & 15;
                const v4u v = *(const LAS v4u*)(stg + row * 128 + ch * 8); *(v4u*)(Ow + (size_t)row * 512 + ch * 8) = v; }
        }
        __syncthreads();
    }
}

__device__ __forceinline__ void phase_mix(const Params& P, LAS unsigned char* lds, int layer, int G, bool with_ctx, int wv, int KINDS) {
    int tid_ = fresh_tid(wv);
    const int lane = tid_ & 63;
    const float* lq = P.in[I_LAMQK] + (size_t)layer * 4 * 64;
    const float s1 = wave_sum(lq[lane] * lq[64 + lane], lane), s2 = wave_sum(lq[128 + lane] * lq[192 + lane], lane);
    const float lam_init = __int_as_float(__builtin_amdgcn_readfirstlane(__float_as_int(0.8f - 0.6f * expf(-0.3f * (float)layer))));
    const float lam = __int_as_float(__builtin_amdgcn_readfirstlane(__float_as_int(expf(s1) - expf(s2) + lam_init)));
    if (KINDS & 1) {
        const int na = with_ctx ? 260 : 256;
#pragma unroll 1
        for (int u = blockIdx.x; u < na; u += G) {
            const int hh = (u < 256) ? ((u & 7) >> 1) : (u - 256), qt = (u < 256) ? (((u >> 3) << 1) | (u & 1)) : 64;
            attn_unit(P, lds, layer, hh, qt, lam, __int_as_float(__builtin_amdgcn_readfirstlane(__float_as_int(1.f - lam_init))), wv);
        }
    }
    if (KINDS & 2) {
        const int nh = with_ctx ? 260 : 256;
#pragma unroll 1
        for (int k = 0; ; ++k) {
            int v;
            if (G == 256) { const int c = (int)blockIdx.x; if (k == 0) v = c; else if (k == 1 && with_ctx && c >= 4 && c < 8) v = 252 + c; else break; }
            else { v = (int)blockIdx.x + k * G; if (v >= nh) break; }
            hgrn_unit2(P, lds, layer, v & 3, v >> 2, wv);
        }
    }
}

constexpr int RL_RW = 0, RL_TA = RW_IMG, RL_TB = RL_TA + 8192, RL_LOG = RL_TB + 8192, RL_INFO = RL_LOG + 80 * 33 * 4, RL_CNT = RL_INFO + 80 * 32, RL_BASE = RL_CNT + 128, RL_RSTD = RL_BASE + 128;
__device__ __forceinline__ void phase_router(const Params& P, LAS unsigned char* lds, int layer, int G, int nrows, int wv) {
    int tid_ = fresh_tid(wv);
    const int tid = tid_, lane = tid & 63, wave = __builtin_amdgcn_readfirstlane(tid >> 6);
    GAS unsigned char* wsg_ = (GAS unsigned char*)P.ws; asm volatile("" : "+s"(wsg_)); unsigned char* ws = (unsigned char*)wsg_;
    LAS float* TA = (LAS float*)(lds + RL_TA); LAS float* TB = (LAS float*)(lds + RL_TB); LAS float* LOG = (LAS float*)(lds + RL_LOG);
    LAS unsigned* INFO = (LAS unsigned*)(lds + RL_INFO); LAS unsigned* LCNT = (LAS unsigned*)(lds + RL_CNT); LAS unsigned* GBASE = (LAS unsigned*)(lds + RL_BASE); LAS float* RSTD = (LAS float*)(lds + RL_RSTD);
    { const unsigned lds0 = (unsigned)(uintptr_t)lds; const unsigned char* img = ws + WS_RWIMG + (size_t)layer * RW_IMG;
      for (int pc = wave; pc < RW_IMG / 1024; pc += NWAVES) glds16_s(img + (size_t)pc * 1024, (unsigned)lane * 16u, lds0 + RL_RW + pc * 1024); }
    for (int i = tid; i < 2048; i += NTHR) { const int w = i >> 10, j = i & 1023; const float* mv = modv_ptr(P, layer, w);
        TA[i] = P.in[I_N2G][(size_t)layer * D + j] * (1.f + mv[4096 + j]); TB[i] = mv[3072 + j]; }
    const bf16* xres = (const bf16*)(ws + WS_XRES);
    const float* rb = P.in[I_RB] + (size_t)layer * NE;
    unsigned* gcnt = (unsigned*)(ws + WS_CTL) + CW_CNT + layer * 32 * 16;
    unsigned* tokinfo = (unsigned*)(ws + WS_TOK);
    bf16* XS = (bf16*)(ws + WS_XS);
    const int RB = nrows / 256;
    asm volatile("s_waitcnt vmcnt(0)" ::: "memory");
    for (int blk = blockIdx.x; blk < 256; blk += G) {
#define RROW(r) ((r) < 64 ? 64 * blk + (r) : SEQ + blk)
        if (tid < 32) LCNT[tid] = 0u;
#pragma unroll 1
        for (int rl = wave; rl < RB; rl += NWAVES) {
            const bf16* xr = xres + (size_t)RROW(rl) * D;
            float ss = 0.f;
#pragma unroll
            for (int k = 0; k < 4; ++k) { const v2u xw = *(const v2u*)(xr + 4 * lane + 256 * k); const f32x4 x = {bflo(xw.x), bfhi(xw.x), bflo(xw.y), bfhi(xw.y)}; ss += (x.x * x.x + x.y * x.y) + (x.z * x.z + x.w * x.w); }
            ss = wave_sum(ss, lane);
            if (lane == 0) RSTD[rl] = __builtin_amdgcn_rsqf(ss * (1.f / D) + EPS);
        }
        __syncthreads();
        if (16 * wave < RB) {
            const int r16 = lane & 15, kq = lane >> 4, r = 16 * wave + r16, rc = r < RB ? r : RB - 1, row = RROW(rc), wsel = row >= SEQ;
            const float rstd = RSTD[rc];
            const bf16* xr = xres + (size_t)row * D + 8 * kq;
            const LAS float* ta = TA + 1024 * wsel + 8 * kq; const LAS float* tb = TB + 1024 * wsel + 8 * kq;
            const LAS unsigned char* bh = lds + RL_RW + r16 * RW_PITCH + 16 * kq;
            f32x4 acc0 = {0.f, 0.f, 0.f, 0.f}, acc1 = {0.f, 0.f, 0.f, 0.f};
#pragma unroll 4
            for (int ks = 0; ks < 32; ++ks) {
                const v4u xw = *(const v4u*)(xr + 32 * ks); const f32x4 x0 = {bflo(xw.x), bfhi(xw.x), bflo(xw.y), bfhi(xw.y)}, x1 = {bflo(xw.z), bfhi(xw.z), bflo(xw.w), bfhi(xw.w)};
                const f32x4 a0 = *(const LAS f32x4*)(ta + 32 * ks), a1 = *(const LAS f32x4*)(ta + 32 * ks + 4), b0 = *(const LAS f32x4*)(tb + 32 * ks), b1 = *(const LAS f32x4*)(tb + 32 * ks + 4);
                const f32x4 h0 = x0 * rstd * a0 + b0, h1 = x1 * rstd * a1 + b1;
                v4u hw, lw;
                hw.x = pk2(h0.x, h0.y); hw.y = pk2(h0.z, h0.w); hw.z = pk2(h1.x, h1.y); hw.w = pk2(h1.z, h1.w);
                lw.x = pk2(h0.x - bflo(hw.x), h0.y - bfhi(hw.x)); lw.y = pk2(h0.z - bflo(hw.y), h0.w - bfhi(hw.y)); lw.z = pk2(h1.x - bflo(hw.z), h1.y - bfhi(hw.z)); lw.w = pk2(h1.z - bflo(hw.w), h1.w - bfhi(hw.w));
                const bf16x8 ah = __builtin_bit_cast(bf16x8, hw), al = __builtin_bit_cast(bf16x8, lw);
                const bf16x8 wh0 = *(const LAS bf16x8*)(bh + 64 * ks), wh1 = *(const LAS bf16x8*)(bh + 16 * RW_PITCH + 64 * ks);
                const bf16x8 wl0 = *(const LAS bf16x8*)(bh + 32 * RW_PITCH + 64 * ks), wl1 = *(const LAS bf16x8*)(bh + 48 * RW_PITCH + 64 * ks);
                acc0 = __builtin_amdgcn_mfma_f32_16x16x32_bf16(ah, wh0, acc0, 0, 0, 0); acc0 = __builtin_amdgcn_mfma_f32_16x16x32_bf16(ah, wl0, acc0, 0, 0, 0); acc0 = __builtin_amdgcn_mfma_f32_16x16x32_bf16(al, wh0, acc0, 0, 0, 0);
                acc1 = __builtin_amdgcn_mfma_f32_16x16x32_bf16(ah, wh1, acc1, 0, 0, 0); acc1 = __builtin_amdgcn_mfma_f32_16x16x32_bf16(ah, wl1, acc1, 0, 0, 0); acc1 = __builtin_amdgcn_mfma_f32_16x16x32_bf16(al, wh1, acc1, 0, 0, 0);
            }
#pragma unroll
            for (int i = 0; i < 4; ++i) { const int rr = 16 * wave + 4 * kq + i; if (rr < RB) { LOG[rr * 33 + r16] = acc0[i]; LOG[rr * 33 + 16 + r16] = acc1[i]; } }
        }
        __syncthreads();
        if (tid < RB) {
            float p[NE];
#pragma unroll
            for (int e = 0; e < NE; ++e) p[e] = LOG[tid * 33 + e] + rb[e];
            float tv[4]; int ti[4];
#pragma unroll
            for (int k = 0; k < 4; ++k) { float best = -3.0e38f; int bi = 0;
#pragma unroll
                for (int e = 0; e < NE; ++e) { const bool gt = p[e] > best; best = gt ? p[e] : best; bi = gt ? e : bi; }
                tv[k] = best; ti[k] = bi;
#pragma unroll
                for (int e = 0; e < NE; ++e) p[e] = (e == bi) ? -3.0e38f : p[e]; }
            float wk[4], wsum = 0.f;
#pragma unroll
            for (int k = 0; k < 4; ++k) { wk[k] = expf(tv[k] - tv[0]); wsum += wk[k]; }
#pragma unroll
            for (int k = 0; k < 4; ++k) { const unsigned pos = __hip_atomic_fetch_add(&LCNT[ti[k]], 1u, __ATOMIC_RELAXED, __HIP_MEMORY_SCOPE_WORKGROUP); INFO[tid * 8 + 2 * k] = ((unsigned)ti[k] << 16) | pos; INFO[tid * 8 + 2 * k + 1] = __float_as_uint(wk[k] / wsum); }
        }
        __syncthreads();
        if (tid < 32) GBASE[tid] = __hip_atomic_fetch_add(gcnt + tid * 16, LCNT[tid], RLX_AGENT);
        __syncthreads();
#pragma unroll 1
        for (int rl = wave; rl < RB; rl += NWAVES) {
            const int row = RROW(rl), w = row >= SEQ;
            const bf16* xr = xres + (size_t)row * D + 16 * lane;
            const float rstd = RSTD[rl];
            v4u o8;
            {
                f32x4 v[4];
#pragma unroll
                for (int j = 0; j < 4; ++j) { const v2u xw = *(const v2u*)(xr + 4 * j); const f32x4 xv = {bflo(xw.x), bfhi(xw.x), bflo(xw.y), bfhi(xw.y)}; const f32x4 a = *(const LAS f32x4*)(TA + 1024 * w + 16 * lane + 4 * j), b = *(const LAS f32x4*)(TB + 1024 * w + 16 * lane + 4 * j); v[j] = xv * rstd * a + b; }
                o8.x = pk_fp8x4(v[0].x, v[0].y, v[0].z, v[0].w); o8.y = pk_fp8x4(v[1].x, v[1].y, v[1].z, v[1].w); o8.z = pk_fp8x4(v[2].x, v[2].y, v[2].z, v[2].w); o8.w = pk_fp8x4(v[3].x, v[3].y, v[3].z, v[3].w);
            }
#pragma unroll
            for (int k = 0; k < 4; ++k) {
                const unsigned ep = INFO[rl * 8 + 2 * k], wb = INFO[rl * 8 + 2 * k + 1];
                const unsigned e = ep >> 16, slot = GBASE[e] + (ep & 0xffffu);
                unsigned char* dst = (unsigned char*)XS + ((size_t)e * CAP + slot) * D + 16 * lane;
                *(v4u*)dst = o8;
                if (lane == 0) { v4u ti4; ti4.x = e; ti4.y = slot; ti4.z = wb; ti4.w = 0u; *(v4u*)(tokinfo + (size_t)row * 16 + 4 * k) = ti4; }
            }
        }
        __syncthreads();
#undef RROW
    }
}

template <bool DRY>
__device__ __forceinline__ void phase_combine(const Params& P, LAS unsigned char* lds, int layer, int G, int nrows, int wv) {
    int tid_ = fresh_tid(wv);
    const int tid = tid_, lane = tid & 63, wave = tid >> 6;
    GAS unsigned char* wsg_ = (GAS unsigned char*)P.ws; asm volatile("" : "+s"(wsg_)); unsigned char* ws = (unsigned char*)wsg_;
    const bool last = (layer == DEPTH - 1);
    LAS float* TA = (LAS float*)lds; LAS float* TB = (LAS float*)(lds + 8192); LAS float* TG = (LAS float*)(lds + 16384);
    for (int i = tid; i < 2048; i += NTHR) { const int w = i >> 10, j = i & 1023;
        TG[i] = modv_ptr(P, layer, w)[5120 + j];
        if (!last) { const float* mv = modv_ptr(P, layer + 1, w); TA[i] = P.in[I_N1G][(size_t)(layer + 1) * D + j] * (1.f + mv[1024 + j]); TB[i] = mv[j]; } }
    __syncthreads();
    bf16* xres = (bf16*)(ws + WS_XRES);
    bf16* xdst = DRY ? (bf16*)(ws + WS_HDN) : xres;
    const unsigned* tokinfo = (const unsigned*)(ws + WS_TOK);
    const bf16* Y = (const bf16*)(ws + WS_XS);
    bf16* H = DRY ? (bf16*)(ws + WS_HDN + (size_t)NT * D * 4) : (bf16*)(ws + WS_H);
#pragma unroll 2
    for (int row = blockIdx.x * NWAVES + wave; row < nrows; row += G * NWAVES) {
        const int w = row >= SEQ;
        f32x4 acc[4];
#pragma unroll
        for (int j = 0; j < 4; ++j) acc[j] = (f32x4){0.f, 0.f, 0.f, 0.f};
#pragma unroll
        for (int k = 0; k < 4; ++k) {
            const v4u ti4 = *(const v4u*)(tokinfo + (size_t)row * 16 + 4 * k);
            const float wk = __uint_as_float(ti4.z);
            const bf16* yr = Y + ((size_t)ti4.x * CAP + ti4.y) * D + 4 * lane;
#pragma unroll
            for (int j = 0; j < 4; ++j) { const v2u yv = *(const v2u*)(yr + 256 * j); acc[j] += wk * (f32x4){bflo(yv.x), bfhi(yv.x), bflo(yv.y), bfhi(yv.y)}; }
        }
        const bf16* xr = xres + (size_t)row * D + 4 * lane;
        f32x4 v[4];
#pragma unroll
        for (int j = 0; j < 4; ++j) { const v2u xw = *(const v2u*)(xr + 256 * j); v[j] = (f32x4){bflo(xw.x), bfhi(xw.x), bflo(xw.y), bfhi(xw.y)} + *(const LAS f32x4*)(TG + 1024 * w + 4 * lane + 256 * j) * acc[j]; }
        if (last) {
            float* orow = (DRY ? (float*)xdst : P.out) + (size_t)row * D + 4 * lane;
#pragma unroll
            for (int j = 0; j < 4; ++j) *(f32x4*)(orow + 256 * j) = v[j];
        } else {
#pragma unroll
            for (int j = 0; j < 4; ++j) { v2u o; o.x = pk2(v[j].x, v[j].y); o.y = pk2(v[j].z, v[j].w); *(v2u*)(xdst + (size_t)row * D + 4 * lane + 256 * j) = o; }
            norm_store_row(v, TA + 1024 * w, TB + 1024 * w, (unsigned char*)H + (size_t)row * D, lane);
        }
    }
}
#define XB_TMO      128
#define XB_XCNT(j)  (256  + 64 * (j))
#define XB_XSUB(j)  (1280 + 64 * (j))
#define XB_XGEN(j)  (2304 + 64 * (j))
#define XB_TOP      3328
#define XB_TOPGEN   3392
#define XCD_BAR_WORDS 3456
#define XB_SPIN_CAP (1u << 18)

__device__ __forceinline__ unsigned xb_ld(unsigned* p)              { return __hip_atomic_load(p, __ATOMIC_RELAXED, __HIP_MEMORY_SCOPE_AGENT); }
__device__ __forceinline__ unsigned xb_add(unsigned* p, unsigned v) { return __hip_atomic_fetch_add(p, v, __ATOMIC_RELAXED, __HIP_MEMORY_SCOPE_AGENT); }
__device__ __forceinline__ unsigned xb_xcc_id() { return (unsigned)__builtin_amdgcn_s_getreg((3 << 11) | 20) & 0xFu; }
#define XB_SPIN(cond, bar) do { unsigned _sp = 0; while (cond) { __builtin_amdgcn_s_sleep(1); \
    if ((++_sp & 255u) == 0u) { if (xb_ld(&(bar)[XB_TMO])) break; if (_sp > XB_SPIN_CAP) { atomicAdd(&(bar)[XB_TMO], 1u); break; } } } } while (0)

struct XcdBarrier {
    int wv; unsigned* bar; unsigned x;
    volatile LAS unsigned* st;
};

__device__ __forceinline__ XcdBarrier xcd_barrier_post(unsigned* bar, volatile LAS unsigned* st, int wv) {
    XcdBarrier b; b.wv = wv; b.bar = bar; b.x = xb_xcc_id(); b.st = st;
    if (fresh_tid(wv) == 0) (void)xb_add(&bar[XB_XCNT(b.x)], 1u);
    return b;
}
__device__ __forceinline__ void xcd_barrier_complete(unsigned* bar, unsigned x, unsigned& nloc, unsigned& nx) {
    const unsigned G = gridDim.x * gridDim.y * gridDim.z;
    unsigned sum, cnt, mine, sp = 0u;
    for (;;) {
        sum = 0u; cnt = 0u; mine = 0u;
#pragma unroll
        for (unsigned j = 0; j < 16; ++j) { const unsigned c = xb_ld(&bar[XB_XCNT(j)]); sum += c; cnt += (c > 0u) ? 1u : 0u; mine = (j == x) ? c : mine; }
        if (sum == G) break;
        __builtin_amdgcn_s_sleep(1);
        if ((++sp & 255u) == 0u) { if (xb_ld(&bar[XB_TMO])) break; if (sp > XB_SPIN_CAP) { atomicAdd(&bar[XB_TMO], 1u); break; } }
    }
    nloc = mine > 0u ? mine : 1u; nx = cnt > 0u ? cnt : 1u;
}

__device__ __forceinline__ void xcd_barrier(const XcdBarrier& b) {
    asm volatile("s_waitcnt vmcnt(0)" ::: "memory");
    __syncthreads();
    if (fresh_tid(b.wv) == 0) {
        unsigned* bar = b.bar;
        __builtin_amdgcn_s_waitcnt(0);
        unsigned nloc = b.st[0], nx = b.st[1];
        if (nloc == 0u) { xcd_barrier_complete(bar, b.x, nloc, nx); b.st[0] = nloc; b.st[1] = nx; }
        const unsigned old = xb_add(&bar[XB_XSUB(b.x)], 1u);
        const unsigned gen = old / nloc;
        if (old + 1u == (gen + 1u) * nloc) {
            __builtin_amdgcn_fence(__ATOMIC_RELEASE, "agent");
            asm volatile("s_waitcnt vmcnt(0)" ::: "memory");
            const unsigned og = xb_add(&bar[XB_TOP], 1u);
            const unsigned tg = og / nx;
            if (og + 1u == (tg + 1u) * nx) xb_add(&bar[XB_TOPGEN], 1u);
            else XB_SPIN(xb_ld(&bar[XB_TOPGEN]) == tg, bar);
            __builtin_amdgcn_fence(__ATOMIC_ACQUIRE, "agent");
            xb_add(&bar[XB_XGEN(b.x)], 1u);
            asm volatile("s_waitcnt vmcnt(0)" ::: "memory");
        } else {
            XB_SPIN(xb_ld(&bar[XB_XGEN(b.x)]) == gen, bar);
            __builtin_amdgcn_fence(__ATOMIC_ACQUIRE, "agent");
            asm volatile("s_waitcnt vmcnt(0)" ::: "memory");
        }
    }
    __syncthreads();
}


__global__ void __launch_bounds__(NTHR, 2) fwd_kernel(Params P) {
    extern __shared__ __attribute__((aligned(16))) unsigned char lds_raw[];
    LAS unsigned char* lds = (LAS unsigned char*)lds_raw;
    volatile LAS unsigned* MISC = (volatile LAS unsigned*)(lds + MISC_OFF);
    const int wv = __builtin_amdgcn_readfirstlane((int)(threadIdx.x >> 6)), G = gridDim.x;
#define tid fresh_tid(wv)
    unsigned char* ws = P.ws;
    unsigned* ctl = (unsigned*)(ws + WS_CTL);
    if (tid < 64) MISC[tid] = 0u;
    __syncthreads();
#if MK_ONE_LAUNCH
    XcdBarrier bar = xcd_barrier_post(ctl + CW_BAR, MISC + 8, wv);
#define GRID_BAR() xcd_barrier(bar)
#else
#define GRID_BAR() do {} while (0)
#endif
    const int lo = P.ph_lo, hi = P.ph_hi;
#ifndef PHM
#define PHM 0x3FFF
#endif
#define IN(k) (lo <= (k) && (k) < hi)
#define EN(b) ((PHM >> (b)) & 1)
#ifdef PROBE_PH
    unsigned long long* stamps = (unsigned long long*)(ws + WS_CTL + 512 * 1024);
#define STAMP(k) do { if (blockIdx.x == 0 && tid == 0) stamps[k] = __builtin_amdgcn_s_memrealtime(); } while (0)
#else
#define STAMP(k) do {} while (0)
#endif
    STAMP(0);
#define SEAM(k) do { int lo_ = lo, hi_ = hi; asm volatile("" : "+s"(lo_), "+s"(hi_));     \
        if (lo_ <= (k) && (k) + 1 < hi_) GRID_BAR(); STAMP((k) + 1); } while (0)

    constexpr int BG_A = 5120, BG_D = 8192, BG_E = 6656;
#ifndef DUP_PH
#define DUP_PH -1
#endif
#define DUPQ(t) (DUP_PH == (t))
    if (EN(12) && IN(0)) { phase_p0a(P, lds, G, wv); if (DUPQ(10)) { GRID_BAR(); phase_p0a(P, lds, G, wv); } SEAM(0); }
    if (EN(13) && IN(1)) { phase_p0b(P, lds, G, wv); SEAM(1); }

    for (int l = 0; l < DEPTH; ++l) {
        const int pb = NPH_PRO + NPH_LAYER * l;
        const bool last = (l == DEPTH - 1);
        const int nrows = last ? SEQ : NT;
        bf16* H = (bf16*)(ws + WS_H);
        if (EN(0) && IN(pb + 0)) {
            GAS unsigned char* wsg_ = (GAS unsigned char*)P.ws; asm volatile("" : "+s"(wsg_)); unsigned char* ws = (unsigned char*)wsg_;
            for (int rep = 0; rep < (DUPQ(0) ? 2 : 1); ++rep) {
            if (rep) GRID_BAR();
            { pg8::Gemm g{H, (const bf16*)(ws + WS_WIN + l * WIN_L), NT, 5632, D / 2};        int c1 = (int)blockIdx.x; asm volatile("" : "+s"(c1)); pg8::StaticOrder S; S.init(NT, 5632, G, c1);
              EpiInProj E{(bf16*)(ws + WS_Q), (bf16*)(ws + WS_K), (bf16*)(ws + WS_PROJ), P.in[I_QNG] + l * 64, P.in[I_KNG] + l * 64, (const float*)(ws + WS_ROPE), ws + WS_IMG, (const float*)(ws + WS_LB) + (size_t)l * 512};
              pg8::gemm_phase<EpiInProj, pg8::StaticOrder, true, true>(lds, g, S, E, wv); }
            { pg8::Gemm g{(const bf16*)(ws + WS_WV + l * WV_L), H, 512, NT, D / 2}; int c2 = (int)(blockIdx.x + 106 < (unsigned)G ? blockIdx.x + 106 : (blockIdx.x + 106) % (unsigned)G); asm volatile("" : "+s"(c2));
              pg8::StaticOrder S; S.init(512, NT, G, c2);
              EpiVt E{(bf16*)(ws + WS_VT)};
              pg8::gemm_phase<EpiVt, pg8::StaticOrder, true, true>(lds, g, S, E, wv); }
            }
            if (!last && G == 256) { const int c = (int)blockIdx.x; __syncthreads(); if (c >= 24) convert_items(P, lds, PER_L * (l + 1), PER_L * (l + 1) + BG_A, c - 24, 232, wv); }
            SEAM(pb + 0);
        }
        if (EN(2) && IN(pb + 2)) { phase_hgrn1(P, lds, l, G, wv); if (DUPQ(1)) { GRID_BAR(); phase_hgrn1(P, lds, l, G, wv); } SEAM(pb + 2); }
        if (EN(3) && IN(pb + 3)) { phase_hgrn_chain(P, G, wv); if (DUPQ(2)) { GRID_BAR(); phase_hgrn_chain(P, G, wv); } SEAM(pb + 3); }
        if (EN(4) && IN(pb + 4)) {
#pragma unroll 1
            for (int rep = 0; rep < ((DUPQ(31) || DUPQ(32)) ? 2 : 1); ++rep) { if (rep) GRID_BAR(); phase_mix(P, lds, l, G, !last, wv, rep == 0 ? 3 : (DUPQ(31) ? 1 : 2)); }
            if (!last && G == 256) { const int c = (int)blockIdx.x; __syncthreads(); if (c >= 8) convert_items(P, lds, PER_L * (l + 1) + BG_A, PER_L * (l + 1) + BG_A + BG_D, c - 8, 248, wv); }
            SEAM(pb + 4); }
        if (EN(5) && IN(pb + 5)) {
            GAS unsigned char* wsg_ = (GAS unsigned char*)P.ws; asm volatile("" : "+s"(wsg_)); unsigned char* ws = (unsigned char*)wsg_;
            pg8::Gemm g{(const bf16*)(ws + WS_OAB), (const bf16*)(ws + WS_WAB + l * WAB_L), 2 * NT, 2048, 512};
            pg8::MergeOrder S{nrows / 256, G, (int)blockIdx.x};
            EpiMerge E{(const bf16*)(ws + WS_PROJ), (bf16*)(ws + WS_U)};
            pg8::gemm_phase<EpiMerge, pg8::MergeOrder, true, true>(lds, g, S, E, wv);
            if (DUPQ(50)) { GRID_BAR(); pg8::gemm_phase<EpiMerge, pg8::MergeOrder, true, true>(lds, g, S, E, wv); }
            if (!last && G == 256) { const int c = (int)blockIdx.x; __syncthreads(); if (!((c & 7) == 0 && c < 32)) { const int nb = (c + 7) >> 3; convert_items(P, lds, PER_L * (l + 1) + BG_A + BG_D, PER_L * (l + 1) + BG_A + BG_D + BG_E, c - (nb < 4 ? nb : 4), 252, wv); } }
            SEAM(pb + 5);
        }
        if (EN(6) && IN(pb + 6)) {
            GAS unsigned char* wsg_ = (GAS unsigned char*)P.ws; asm volatile("" : "+s"(wsg_)); unsigned char* ws = (unsigned char*)wsg_;
            pg8::Gemm g{(const bf16*)(ws + WS_U), (const bf16*)(ws + WS_WO + l * WO_L), nrows, D, D}; pg8::StaticOrder S; S.init(nrows, D, G, (int)blockIdx.x);
            EpiOut E{(const bf16*)(ws + WS_XRES), (bf16*)(ws + WS_XRES), modv_ptr(P, l, 0) + 2048, modv_ptr(P, l, 1) + 2048};
            if (DUPQ(6)) { EpiOut E2 = E; E2.xres = (bf16*)(ws + WS_HDN); pg8::gemm_phase<EpiOut, pg8::StaticOrder, true, true>(lds, g, S, E2, wv); GRID_BAR(); }
            pg8::gemm_phase<EpiOut, pg8::StaticOrder, true, true>(lds, g, S, E, wv);
            if (!last && G == 256) { const int c = (int)blockIdx.x; __syncthreads(); if (c >= 4) convert_items(P, lds, PER_L * (l + 1) + BG_A + BG_D + BG_E, PER_L * (l + 2), c - 4, 252, wv); }
            SEAM(pb + 6);
        }
        if (EN(7) && IN(pb + 7)) {
#pragma unroll 1
            for (int rep = 0; rep < (DUPQ(7) ? 2 : 1); ++rep) {
                if (rep) { GRID_BAR(); if (blockIdx.x == 0 && tid < 32) __hip_atomic_store(ctl + CW_CNT + l * 32 * 16 + tid * 16, 0u, RLX_AGENT); GRID_BAR(); }
                phase_router(P, lds, l, G, nrows, wv); }
            SEAM(pb + 7); }
        if ((EN(8) && IN(pb + 8)) || (EN(9) && IN(pb + 9))) {
            GAS unsigned char* wsg_ = (GAS unsigned char*)P.ws; asm volatile("" : "+s"(wsg_)); unsigned char* ws = (unsigned char*)wsg_;
            LAS unsigned* utab8 = (LAS unsigned*)(lds + 131072); LAS unsigned* utab4 = utab8 + 32; LAS int* ptab = (LAS int*)(utab8 + 64);
            { const int t_ = tid;
              if (t_ == 0) { const unsigned* gcnt = ctl + CW_CNT + l * 32 * 16; int run = 0;
                  for (int e = 0; e < NE; ++e) { ptab[e] = run; run += (int)((__hip_atomic_load(gcnt + e * 16, RLX_AGENT) + 255u) >> 8); } ptab[32] = run; }
              __syncthreads();
              if (t_ < 64) { const int i = t_ & 31, lg = (t_ < 32) ? 3 : 2; const int c_ = (int)blockIdx.x;
                  int tr, pn;
                  if ((G & 63) == 0) { const int x = c_ & 7, q = c_ >> 3, per = (G >> 3) >> lg, R = (ptab[32] + 8 * per - 1) / (8 * per);
                      pn = q & ((1 << lg) - 1); tr = (x * R + i) * per + (q >> lg); if (i >= R) tr = 1 << 20; }
                  else { const int L = i * G + c_; tr = L >> lg; pn = L & ((1 << lg) - 1); }
                  unsigned v = 0xffffffffu;
                  if (tr < ptab[32]) { int e = 0; for (int j = 1; j < 32; ++j) e = (tr >= ptab[j]) ? j : e; v = ((unsigned)(65 * e + (tr - ptab[e])) << 16) | (unsigned)((e << lg) + pn); }
                  (t_ < 32 ? utab8 : utab4)[i] = v; }
              __syncthreads(); }
            if (EN(8) && IN(pb + 8)) {
                pg8::Gemm g{(const bf16*)(ws + WS_XS), (const bf16*)(ws + WS_WGU + l * WGU_L), NE * CAP, NE * 2048, D / 2};
                pg8::MoeOrder S{utab8};
                EpiSwiglu E{(bf16*)(ws + WS_HDN), P.in[I_BGU] + (size_t)l * NE * 2048};
                pg8::gemm_phase<EpiSwiglu, pg8::MoeOrder, true, true>(lds, g, S, E, wv);
                if (DUPQ(8)) { GRID_BAR(); pg8::gemm_phase<EpiSwiglu, pg8::MoeOrder, true, true>(lds, g, S, E, wv); }
                SEAM(pb + 8);
            }
            if (EN(9) && IN(pb + 9)) {
                pg8::Gemm g{(const bf16*)(ws + WS_HDN), (const bf16*)(ws + WS_WD + l * WD_L), NE * CAP, NE * 1024, DFF / 2};
                pg8::MoeOrder S{utab4};
                EpiDown E{(bf16*)(ws + WS_XS), P.in[I_BDN] + (size_t)l * NE * D};
                pg8::gemm_phase<EpiDown, pg8::MoeOrder, true, true>(lds, g, S, E, wv);
                if (DUPQ(9)) { GRID_BAR(); pg8::gemm_phase<EpiDown, pg8::MoeOrder, true, true>(lds, g, S, E, wv); }
                SEAM(pb + 9);
            }
        }
        if (EN(10) && IN(pb + 10)) { if (DUPQ(11)) { phase_combine<true>(P, lds, l, G, nrows, wv); GRID_BAR(); } phase_combine<false>(P, lds, l, G, nrows, wv); SEAM(pb + 10); }
    }
#ifdef PROBE_PH
    if (blockIdx.x == 0 && tid == 0) {
        unsigned long long tot = 0;
        for (int k = 0; k < NPHASES; ++k) { const int ty = k < 2 ? 12 + k : (k - 2) % 11; if (ty == PROBE_PH || PROBE_PH == 99) tot += stamps[k + 1] - stamps[k]; }
        *(float*)(ws + WS_CTL + 768 * 1024) = 1.f + (float)tot * (1.f / 10000.f);
    }
    GRID_BAR();
    { const float sc = 1.f + *(const float*)(ws + WS_CTL + 768 * 1024);
      for (size_t i = (size_t)blockIdx.x * NTHR + tid; i < (size_t)SEQ * D; i += (size_t)G * NTHR) P.out[i] *= sc; }
#endif
#undef tid
#undef IN
#undef EN
#undef SEAM
#undef GRID_BAR
}

extern "C" void kernel_launch(void* const* d_in, const int* in_sizes, int n_in, void* d_out, int out_size, void* d_ws, size_t ws_size, hipStream_t stream) {
    static int grid = 0;
    if (grid == 0) {
        if (n_in != 24 || out_size != SEQ * D || ws_size < WS_END3) { fprintf(stderr, "kernel_launch: unexpected shapes (n_in %d, out %d, ws %zu < %zu)\n", n_in, out_size, ws_size, (size_t)WS_END3); grid = -1; return; }
        int dev = 0, cus = 0;
        if (hipGetDevice(&dev) != hipSuccess || hipDeviceGetAttribute(&cus, hipDeviceAttributeMultiprocessorCount, dev) != hipSuccess) { grid = -1; return; }
        if (hipFuncSetAttribute((const void*)fwd_kernel, hipFuncAttributeMaxDynamicSharedMemorySize, LDS_BYTES) != hipSuccess) { fprintf(stderr, "kernel_launch: hipFuncSetAttribute failed\n"); grid = -1; return; }
        int per_cu = 0;
        if (hipOccupancyMaxActiveBlocksPerMultiprocessor(&per_cu, (const void*)fwd_kernel, NTHR, LDS_BYTES) != hipSuccess || per_cu < 1) fprintf(stderr, "kernel_launch: occupancy query reports %d\n", per_cu);
        (void)hipGetLastError();
        grid = cus;
    }
    if (grid < 0) return;
    (void)hipMemsetAsync((char*)d_ws + WS_CTL, 0, CTL_ZERO_BYTES, stream);
    Params p{};
    for (int i = 0; i < 24; ++i) p.in[i] = (const float*)d_in[i];
    p.out = (float*)d_out; p.ws = (unsigned char*)d_ws;
#if MK_ONE_LAUNCH
    p.ph_lo = 0; p.ph_hi = NPHASES;
    hipLaunchKernelGGL(fwd_kernel, dim3(grid), dim3(NTHR), LDS_BYTES, stream, p);
#else
    for (int k = 0; k < NPHASES; ++k) { p.ph_lo = k; p.ph_hi = k + 1; hipLaunchKernelGGL(fwd_kernel, dim3(grid), dim3(NTHR), LDS_BYTES, stream, p); }
#endif
}
```

```cpp
#include <hip/hip_runtime.h>
#include <cstdio>
#include <cstdint>

#ifndef MK_ONE_LAUNCH
#define MK_ONE_LAUNCH 1
#endif

#define GAS __attribute__((address_space(1)))
#define LAS __attribute__((address_space(3)))
typedef unsigned short bf16;
typedef unsigned v4u __attribute__((ext_vector_type(4)));
typedef unsigned v2u __attribute__((ext_vector_type(2)));
typedef float f32x4 __attribute__((ext_vector_type(4)));
typedef float f32x16 __attribute__((ext_vector_type(16)));
typedef short bf16x8 __attribute__((ext_vector_type(8)));
typedef short s16x4 __attribute__((ext_vector_type(4)));
typedef float f32x2_t __attribute__((ext_vector_type(2)));
typedef __bf16 bf16x2_t __attribute__((ext_vector_type(2)));

constexpr int D = 1024, SEQ = 16384, LC = 256, NT = SEQ + LC, DEPTH = 4;
constexpr int INC = 6144, NE = 32, DFF = 1024, TOPK = 4;
constexpr int CAP = NT;
constexpr int PROJW = 4608;
constexpr int PC_QH = 0, PC_ZF = 512, PC_ZB = 1024, PC_VH = 1536, PC_GH = 2048, PC_GA = 2560, PC_GB = 3584;
constexpr int LDV = NT;
constexpr float EPS = 1e-6f;
constexpr int NWAVES = 8, NTHR = 512;
constexpr int NPH_PRO = 2, NPH_LAYER = 11, NPHASES = NPH_PRO + NPH_LAYER * DEPTH;

constexpr size_t MiB = 1u << 20;
constexpr size_t WS_CTL = 0, CTL_ZERO_BYTES = 1 * MiB;
constexpr size_t WS_MODP = 1 * MiB;
constexpr size_t WS_MODV = WS_MODP + 2 * MiB;
constexpr size_t WS_LB = WS_MODV + 1 * MiB;
constexpr size_t WS_ROPE = WS_LB + 1 * MiB;
constexpr size_t WS_WIN = WS_ROPE + 1 * MiB;
constexpr size_t WIN_L = (size_t)5632 * 1024 * 2;
constexpr size_t WS_WV = WS_WIN + 4 * WIN_L;
constexpr size_t WV_L = (size_t)512 * 1024 * 2;
constexpr size_t WS_WAB = WS_WV + 4 * WV_L;
constexpr size_t WAB_L = (size_t)2048 * 512 * 2;
constexpr size_t WS_WO = WS_WAB + 4 * WAB_L;
constexpr size_t WO_L = (size_t)1024 * 1024 * 2;
constexpr size_t WS_WGU = WS_WO + 4 * WO_L;
constexpr size_t WGU_E = (size_t)2048 * 1024 * 2, WGU_L = 32 * WGU_E;
constexpr size_t WS_WD = WS_WGU + 4 * WGU_L;
constexpr size_t WD_E = (size_t)1024 * 1024 * 2, WD_L = 32 * WD_E;
constexpr size_t WS_XRES = WS_WD + 4 * WD_L;
constexpr size_t WS_H = WS_XRES + (size_t)NT * D * 4;
constexpr size_t WS_Q = WS_H + (size_t)NT * D * 2;
constexpr size_t WS_K = WS_Q + (size_t)NT * 512 * 2;
constexpr size_t WS_VT = WS_K + (size_t)NT * 512 * 2;
constexpr size_t WS_PROJ = WS_VT + (size_t)512 * LDV * 2;
constexpr size_t WS_OAB = WS_PROJ + (size_t)NT * PROJW * 2;
constexpr size_t WS_OBF = WS_OAB + (size_t)2 * NT * 512 * 2;
constexpr size_t WS_U = WS_OBF + (size_t)NT * 512 * 4;
constexpr size_t WS_HGU = WS_U + (size_t)NT * D * 2;
constexpr size_t WS_HGD = WS_HGU + (size_t)512 * 16384 * 4;
constexpr size_t WS_HGS = WS_HGD + 1 * MiB;
constexpr size_t WS_TOK = WS_HGS + (size_t)520 * 16384 * 4;
constexpr size_t WS_XS = WS_TOK + (size_t)NT * 64;
constexpr size_t SLAB = (size_t)NE * CAP * D * 2;
constexpr size_t WS_HDN = WS_XS + SLAB;
constexpr size_t WS_END = WS_HDN + SLAB;
constexpr int IM_BYTES = 21504;
constexpr size_t WS_IMG = WS_END;
constexpr size_t WS_END2 = WS_IMG + (size_t)8 * 65 * 16 * IM_BYTES;
constexpr int RW_PITCH = 2064, RW_IMG = 2 * 32 * RW_PITCH;
constexpr size_t WS_RWIMG = WS_END2;
constexpr size_t WS_END3 = WS_RWIMG + (size_t)DEPTH * RW_IMG + 4096;
constexpr int CW_TMO = 0;
constexpr int CW_BAR = 4096;
constexpr int CW_CNT = 16384;

constexpr int LDS_BYTES = 162816;
constexpr int MISC_OFF = LDS_BYTES - 256;

#define RLX_AGENT __ATOMIC_RELAXED, __HIP_MEMORY_SCOPE_AGENT
__device__ __forceinline__ unsigned pk2(float lo, float hi) { f32x2_t v = {lo, hi}; bf16x2_t b = __builtin_convertvector(v, bf16x2_t); return __builtin_bit_cast(unsigned, b); }
__device__ __forceinline__ float bflo(unsigned w) { return __uint_as_float(w << 16); }
__device__ __forceinline__ float bfhi(unsigned w) { return __uint_as_float(w & 0xffff0000u); }
__device__ __forceinline__ float bf2f(bf16 b) { return __uint_as_float(((unsigned)b) << 16); }
__device__ __forceinline__ int fresh_tid(int wv) { int l; asm volatile("v_mbcnt_lo_u32_b32 %0, -1, 0\n\tv_mbcnt_hi_u32_b32 %0, -1, %0" : "=v"(l)); return wv * 64 + l; }
__device__ __forceinline__ float shx(float v, int off, int lane) { return __int_as_float(__builtin_amdgcn_ds_bpermute((lane ^ off) << 2, __float_as_int(v))); }
__device__ __forceinline__ float wave_sum(float v, int lane) {
#pragma unroll
    for (int o = 1; o < 64; o <<= 1) v += shx(v, o, lane);
    return v;
}
__device__ __forceinline__ float fast_exp(float x) { return __builtin_amdgcn_exp2f(x * 1.4426950408889634f); }
__device__ __forceinline__ float fast_log(float x) { return __builtin_amdgcn_logf(x) * 0.6931471805599453f; }
__device__ __forceinline__ float fast_rcp(float x) { return __builtin_amdgcn_rcpf(x); }
__device__ __forceinline__ float sigmoidf_(float x) { return fast_rcp(1.f + fast_exp(-x)); }
__device__ __forceinline__ unsigned pk_fp8x4(float a, float b, float c, float d) { int p = __builtin_amdgcn_cvt_pk_fp8_f32(a, b, 0, false); p = __builtin_amdgcn_cvt_pk_fp8_f32(c, d, p, true); return (unsigned)p; }
constexpr float W8_SCALE = 32.f;
__device__ __forceinline__ int perm8(int s) { return (s & ~31) | (((s >> 2) & 1) << 4) | (((s >> 3) & 3) << 2) | (s & 3); }

namespace pg8 {
#define PG8_LAS __attribute__((address_space(3)))
typedef unsigned short bf16_t;
typedef short bf16x8 __attribute__((ext_vector_type(8)));
typedef float f32x4 __attribute__((ext_vector_type(4)));
typedef unsigned u32x4 __attribute__((ext_vector_type(4)));
constexpr int BM = 256, BK = 64, HALF = 128, HTB = HALF * BK * 2  , STAGE_BYTES = 8 * HTB, NXCD = 8, WGM = 2;

__host__ __device__ __forceinline__ int lds_byte(int r, int c) { const int st = (r >> 4) * 2 + (c >> 5), rr = r & 15, cc = c & 31, ob = rr * 64 + cc * 2; return st * 1024 + (ob ^ (((ob >> 9) & 1) << 5)); }
__host__ __device__ __forceinline__ void stage_rc(int b, int& R, int& C) { const int st = b / 1024, sb = b % 1024, swz = sb ^ (((sb >> 9) & 1) << 5); R = (st >> 1) * 16 + swz / 64; C = (st & 1) * 32 + (swz % 64) / 2; }
__host__ __device__ __forceinline__ int perm32(int rho) { const int n = rho >> 4, i = rho & 15; return 8 * (i >> 2) + 4 * n + (i & 3); }

struct Unit { int pm, pn; };
struct Gemm { const bf16_t* A; const bf16_t* Bt; int M, N, K; };
struct StaticOrder {
    int nM, nN, nwg, G, c;
    __host__ __device__ void init(int M, int N, int G_, int c_) { nM = M / BM; nN = N / BM; nwg = nM * nN; G = G_; c = c_; }
    __host__ __device__ bool next(int i, Unit& u) const {
        const long L = (long)i * G + c; if (L >= nwg) return false;
        int wgid = (int)L; { const int q = nwg / NXCD, r = nwg % NXCD, xcd = wgid % NXCD, off = wgid / NXCD; wgid = (xcd < r ? xcd * (q + 1) : r * (q + 1) + (xcd - r) * q) + off; }
        const int nig = WGM * nN, gid = wgid / nig, fm = gid * WGM, gsz = (nM - fm) < WGM ? (nM - fm) : WGM;
        u.pm = fm + ((wgid % nig) % gsz); u.pn = (wgid % nig) / gsz; return true;
    }
    __device__ __forceinline__ void a_ready(const Unit&) const {}
    __device__ __forceinline__ void done(const Unit&) const {}
};
struct MergeOrder {
    int nM, G, c;
    __device__ bool next(int i, Unit& u) const {
        const int br = i & 1; int L = (i >> 1) * G + c;
        if ((G & 31) == 0) { const int x = c & 7, q = c >> 3; L = (((i >> 1) * 8 + x) * (G >> 5) + (q >> 2)) * 4 + (q & 3); }
        if (L >= nM * 4) return false;
        u.pm = 65 * br + (L >> 2); u.pn = 4 * br + (L & 3); return true;
    }
    __device__ __forceinline__ void a_ready(const Unit&) const {}
    __device__ __forceinline__ void done(const Unit&) const {}
};
struct MoeOrder {
    const PG8_LAS unsigned* utab;
    __device__ bool next(int i, Unit& u) const {
        if (i >= 32) return false;
        const unsigned v = (unsigned)__builtin_amdgcn_readfirstlane((int)utab[i]); if (v == 0xffffffffu) return false;
        u.pm = (int)(v >> 16); u.pn = (int)(v & 0xffffu); return true;
    }
    __device__ __forceinline__ void a_ready(const Unit&) const {}
    __device__ __forceinline__ void done(const Unit&) const {}
};

template <class Epi, class Sched, bool ALIGN_EPI = false, bool SP2 = false>
__device__ __forceinline__ void gemm_phase(PG8_LAS unsigned char* lds, const Gemm g, const Sched& S, const Epi& E, int wv) {
    int tid_ = fresh_tid(wv);
    const int tid = tid_, wid = __builtin_amdgcn_readfirstlane(tid >> 6), lane = tid & 63, wr = wid >> 2, wc = wid & 3, fr = lane & 15, fq = lane >> 4;
    const int K = g.K, nt = K / BK;
    unsigned voffA[2], voffB[2];
#pragma unroll
    for (int i = 0; i < 2; ++i) { int R, C; stage_rc(tid * 16 + i * 8192, R, C); const int Rb = Epi::PERM ? ((R & ~31) + perm32(R & 31)) : R;
        voffA[i] = (unsigned)(R * K + C) * 2u; voffB[i] = (unsigned)(Rb * K + C) * 2u; }
    const size_t kstep = (size_t)(BK * 2);
    const size_t hstep = (size_t)HALF * K * 2;
    const size_t tstep = 2 * hstep;
    const unsigned ldsw = (unsigned)wid * 1024u;
    const int aoff = lds_byte(wr * 64 + fr, fq * 8), boff = lds_byte(wc * 32 + fr, fq * 8);
#define PG8_SA(b, h) (((b) * 2 + (h)) * HTB)
#define PG8_SB(b, h) ((4 + (b) * 2 + (h)) * HTB)
#define PG8_STAGE(bufoff, gbase, voff) do { _Pragma("unroll") for (int _i = 0; _i < 2; ++_i) \
        __builtin_amdgcn_global_load_lds((const unsigned*)((const char*)(gbase) + (voff)[_i]), (PG8_LAS unsigned*)(lds + (bufoff) + ldsw + _i * 8192), 16, 0, 0); } while (0)
#define PG8_LD8(p_) __builtin_shufflevector(*(const PG8_LAS v4i_*)(p_), *(const PG8_LAS v4i_*)((p_) + 1024), 0, 1, 2, 3, 4, 5, 6, 7)
#define PG8_LDA(dst, b, h) do { if constexpr (Epi::FP8) { _Pragma("unroll") for (int m = 0; m < 4; ++m) dst##8[m] = PG8_LD8(lds + PG8_SA(b, h) + aoff + m * 2048); } \
        else { _Pragma("unroll") for (int m = 0; m < 4; ++m) _Pragma("unroll") for (int k = 0; k < 2; ++k) dst[m][k] = *(const PG8_LAS bf16x8*)(lds + PG8_SA(b, h) + aoff + m * 2048 + k * 1024); } } while (0)
#define PG8_LDB(dst, b, h) do { if constexpr (Epi::FP8) { _Pragma("unroll") for (int n = 0; n < 2; ++n) dst##8[n] = PG8_LD8(lds + PG8_SB(b, h) + boff + n * 2048); } \
        else { _Pragma("unroll") for (int n = 0; n < 2; ++n) _Pragma("unroll") for (int k = 0; k < 2; ++k) dst[n][k] = *(const PG8_LAS bf16x8*)(lds + PG8_SB(b, h) + boff + n * 2048 + k * 1024); } } while (0)
#define PG8_MMA(ai, bj, At, Bt) do { if constexpr (Epi::FP8) __builtin_amdgcn_sched_barrier(0);     \
        __builtin_amdgcn_s_setprio(1); _Pragma("unroll") for (int m = 0; m < 4; ++m) _Pragma("unroll") for (int n = 0; n < 2; ++n) { \
        if constexpr (Epi::FP8)   \
            acc[ai][bj][m][n] = __builtin_amdgcn_mfma_scale_f32_16x16x128_f8f6f4(Bt##8[n], At##8[m], acc[ai][bj][m][n], 0, 0, 0, 0, 0, 0);     \
        else { _Pragma("unroll") for (int k = 0; k < 2; ++k) acc[ai][bj][m][n] = __builtin_amdgcn_mfma_f32_16x16x32_bf16(Bt[n][k], At[m][k], acc[ai][bj][m][n], 0, 0, 0); } } \
        if constexpr (Epi::FP8) { _Pragma("unroll") for (int m = 0; m < 4; ++m) _Pragma("unroll") for (int n = 0; n < 2; ++n) asm volatile("" : "+v"(acc[ai][bj][m][n])); }     \
        __builtin_amdgcn_s_setprio(0); if constexpr (Epi::FP8) __builtin_amdgcn_sched_barrier(0); } while (0)
#define PG8_WAIT_V(n) asm volatile("s_waitcnt vmcnt(" #n ")" ::: "memory")
#define PG8_WAIT_L(n) asm volatile("s_waitcnt lgkmcnt(" #n ")" ::: "memory")
#define PG8_BAR __builtin_amdgcn_s_barrier()
#define PG8_SCHED __builtin_amdgcn_sched_barrier(0)
    Unit cur, nxt; int ui = 0;
    if (!S.next(0, cur)) return;
    f32x4 acc[2][2][4][2];
#pragma unroll
    for (int a = 0; a < 2; ++a)
#pragma unroll
        for (int b = 0; b < 2; ++b)
#pragma unroll
            for (int m = 0; m < 4; ++m)
#pragma unroll
                for (int n = 0; n < 2; ++n) acc[a][b][m][n] = (f32x4){0.f, 0.f, 0.f, 0.f};
    typedef int v4i_ __attribute__((ext_vector_type(4))); typedef int v8i_ __attribute__((ext_vector_type(8)));
    bf16x8 At[4][2], B0[2][2], B1[2][2]; v8i_ At8[4], B08[2], B18[2];
    const char* cA = (const char*)g.A + (size_t)cur.pm * tstep; const char* cB = (const char*)g.Bt + (size_t)cur.pn * tstep;
    S.a_ready(cur);
    if constexpr (SP2) {
        PG8_STAGE(PG8_SB(0, 0), cB, voffB); PG8_STAGE(PG8_SB(0, 1), cB + hstep, voffB); PG8_STAGE(PG8_SA(0, 0), cA, voffA); PG8_STAGE(PG8_SA(0, 1), cA + hstep, voffA);
        if (wr == 1) PG8_BAR;
        PG8_WAIT_V(2); PG8_BAR;
        PG8_STAGE(PG8_SB(1, 0), cB + kstep, voffB); PG8_STAGE(PG8_SA(1, 0), cA + kstep, voffA); PG8_STAGE(PG8_SB(1, 1), cB + hstep + kstep, voffB);
        PG8_WAIT_V(6); PG8_BAR;
    } else {
        PG8_STAGE(PG8_SB(0, 0), cB, voffB); PG8_STAGE(PG8_SA(0, 0), cA, voffA); PG8_STAGE(PG8_SB(0, 1), cB + hstep, voffB); PG8_STAGE(PG8_SA(0, 1), cA + hstep, voffA);
        if (wr == 1) PG8_BAR;
        PG8_WAIT_V(4); PG8_BAR;
        PG8_STAGE(PG8_SB(1, 0), cB + kstep, voffB); PG8_STAGE(PG8_SA(1, 0), cA + kstep, voffA); PG8_STAGE(PG8_SB(1, 1), cB + hstep + kstep, voffB);
        PG8_WAIT_V(6); PG8_BAR;
    }
    for (;;) {
        const bool has_next = S.next(ui + 1, nxt);
        const char* nA = has_next ? (const char*)g.A + (size_t)nxt.pm * tstep : cA; const char* nB = has_next ? (const char*)g.Bt + (size_t)nxt.pn * tstep : cB;
        for (int t = 0; t < nt; t += 2) {
            const bool last = (t == nt - 2);
            const char* a1 = cA + (size_t)(t + 1) * kstep;
            const char* a2 = last ? nA : cA + (size_t)(t + 2) * kstep; const char* b2 = last ? nB : cB + (size_t)(t + 2) * kstep;
            const char* a3 = a2 + kstep; const char* b3 = b2 + kstep;
            if (last && has_next) S.a_ready(nxt);
            if constexpr (SP2) {
            PG8_LDB(B0, 0, 0); PG8_LDB(B1, 0, 1); PG8_SCHED; PG8_LDA(At, 0, 0); PG8_STAGE(PG8_SA(1, 1), a1 + hstep, voffA);
            PG8_WAIT_V(8); PG8_WAIT_L(0); PG8_BAR; PG8_MMA(0, 0, At, B0); PG8_MMA(0, 1, At, B1); PG8_BAR; PG8_SCHED;
            PG8_LDA(At, 0, 1); PG8_STAGE(PG8_SB(0, 0), b2, voffB); PG8_STAGE(PG8_SB(0, 1), b2 + hstep, voffB); PG8_STAGE(PG8_SA(0, 0), a2, voffA);
            PG8_WAIT_V(8); PG8_WAIT_L(0); PG8_BAR; PG8_MMA(1, 0, At, B0); PG8_MMA(1, 1, At, B1); PG8_BAR; PG8_SCHED;
            PG8_LDB(B0, 1, 0); PG8_LDB(B1, 1, 1); PG8_SCHED; PG8_LDA(At, 1, 0); PG8_STAGE(PG8_SA(0, 1), a2 + hstep, voffA);
            PG8_WAIT_V(8); PG8_WAIT_L(0); PG8_BAR; PG8_MMA(0, 0, At, B0); PG8_MMA(0, 1, At, B1); PG8_BAR; PG8_SCHED;
            PG8_LDA(At, 1, 1); PG8_STAGE(PG8_SB(1, 0), b3, voffB); PG8_STAGE(PG8_SB(1, 1), b3 + hstep, voffB); PG8_STAGE(PG8_SA(1, 0), a3, voffA);
            PG8_WAIT_V(8); PG8_WAIT_L(0); PG8_BAR; PG8_MMA(1, 0, At, B0); PG8_MMA(1, 1, At, B1); PG8_BAR; PG8_SCHED;
            } else {
            PG8_LDB(B0, 0, 0); PG8_SCHED; PG8_LDA(At, 0, 0); PG8_STAGE(PG8_SA(1, 1), a1 + hstep, voffA);
            PG8_WAIT_L(8); PG8_BAR; PG8_WAIT_L(0); PG8_MMA(0, 0, At, B0); PG8_BAR; PG8_SCHED;
            PG8_LDB(B1, 0, 1); PG8_STAGE(PG8_SB(0, 0), b2, voffB);
            PG8_BAR; PG8_WAIT_L(0); PG8_MMA(0, 1, At, B1); PG8_BAR;
            PG8_LDA(At, 0, 1); PG8_STAGE(PG8_SA(0, 0), a2, voffA);
            PG8_BAR; PG8_WAIT_L(0); PG8_MMA(1, 0, At, B0); PG8_BAR; PG8_SCHED;
            PG8_STAGE(PG8_SB(0, 1), b2 + hstep, voffB);
            PG8_WAIT_V(6); PG8_BAR; PG8_MMA(1, 1, At, B1); PG8_BAR;
            PG8_LDB(B0, 1, 0); PG8_SCHED; PG8_LDA(At, 1, 0); PG8_STAGE(PG8_SA(0, 1), a2 + hstep, voffA);
            PG8_WAIT_L(8); PG8_BAR; PG8_WAIT_L(0); PG8_MMA(0, 0, At, B0); PG8_BAR; PG8_SCHED;
            PG8_LDB(B1, 1, 1); PG8_STAGE(PG8_SB(1, 0), b3, voffB);
            PG8_BAR; PG8_WAIT_L(0); PG8_MMA(0, 1, At, B1); PG8_BAR;
            PG8_LDA(At, 1, 1); PG8_STAGE(PG8_SA(1, 0), a3, voffA);
            PG8_BAR; PG8_WAIT_L(0); PG8_MMA(1, 0, At, B0); PG8_BAR; PG8_SCHED;
            PG8_STAGE(PG8_SB(1, 1), b3 + hstep, voffB);
            PG8_WAIT_V(6); PG8_BAR; PG8_MMA(1, 1, At, B1); PG8_BAR;
            }
        }
        if constexpr (ALIGN_EPI) { if (wr == 0) PG8_BAR; }
        if constexpr (Epi::FP8) { _Pragma("unroll") for (int ai = 0; ai < 2; ++ai) _Pragma("unroll") for (int bj = 0; bj < 2; ++bj) _Pragma("unroll") for (int m = 0; m < 4; ++m) _Pragma("unroll") for (int n = 0; n < 2; ++n) acc[ai][bj][m][n] *= (1.f / W8_SCALE); }
        if constexpr (!Epi::AFTER_DRAIN) { E(acc, cur, wr, wc, fr, fq); S.done(cur); }
        if (!has_next) break;
#pragma unroll
        for (int a = 0; a < 2; ++a)
#pragma unroll
            for (int b = 0; b < 2; ++b)
#pragma unroll
                for (int m = 0; m < 4; ++m)
#pragma unroll
                    for (int n = 0; n < 2; ++n) acc[a][b][m][n] = (f32x4){0.f, 0.f, 0.f, 0.f};
        cur = nxt; cA = nA; cB = nB; ++ui;
        if constexpr (ALIGN_EPI) { if (wr == 1) PG8_BAR; }
    }
    PG8_WAIT_V(0);
    if constexpr (!ALIGN_EPI) { if (wr == 0) PG8_BAR; }
    PG8_BAR;
    if constexpr (Epi::AFTER_DRAIN) { E.fused(acc, cur, wr, wc, fr, fq, lds, wid, lane); S.done(cur); }
#undef PG8_SA
#undef PG8_SB
#undef PG8_STAGE
#undef PG8_LDA
#undef PG8_LD8
#undef PG8_LDB
#undef PG8_MMA
#undef PG8_WAIT_V
#undef PG8_WAIT_L
#undef PG8_BAR
#undef PG8_SCHED
}
}


struct Params { const float* in[24]; float* out; unsigned char* ws; int ph_lo, ph_hi; };
enum { I_X = 0, I_C, I_CTX, I_CCTX, I_ADAW, I_ADAB, I_N1G, I_N2G, I_WIN, I_QNG, I_KNG, I_LAMQK, I_SUBLN, I_HGLB, I_HGNG, I_WBA, I_WBB, I_WOUT, I_RW, I_RB, I_WGU, I_BGU, I_WDN, I_BDN };

#define LDS_WAIT() asm volatile("s_waitcnt lgkmcnt(0)" ::: "memory")

template <int KIND, bool FP8 = false>
__device__ __forceinline__ void transpose_item(const float* __restrict__ W, int K, int N, bf16* WT, bf16* WT2, int row_off, int k0, int n0, LAS float* scr, int lane) {
#pragma unroll 4
    for (int it = 0; it < 16; ++it) {
        const int k = 4 * it + (lane >> 4), n4 = (lane & 15) * 4;
        const f32x4 v = __builtin_nontemporal_load((const f32x4*)(W + (size_t)(k0 + k) * N + n0 + n4));
        *(LAS f32x4*)(scr + k * 64 + (n4 ^ (4 * ((k >> 3) & 7)))) = v;
    }
    LDS_WAIT();
    const int c = lane & 7;
#pragma unroll 2
    for (int j2 = 0; j2 < 8; ++j2) {
        const int nl = (lane >> 3) + 8 * j2, n = n0 + nl;
        const LAS float* s = scr + (8 * c) * 64 + (nl ^ (4 * c));
        v4u o; o.x = pk2(s[0], s[64]); o.y = pk2(s[128], s[192]); o.z = pk2(s[256], s[320]); o.w = pk2(s[384], s[448]);
        bf16* base = WT; size_t row;
        if (KIND == 0) row = (size_t)(row_off + n);
        else if (KIND == 1) row = (size_t)(row_off + perm8(n));
        else if (KIND == 2) {
            if (n < 1024) { const int tile = n >> 8, G = (n >> 6) & 3, bj = (n >> 5) & 1, e = n & 31; row = (size_t)(256 * tile + 128 * bj + 32 * G + e); }
            else if (n < 1536) { base = WT2; row = (size_t)(n - 1024); }
            else if (n < 3584) {
                const int Q = (n - 1536) >> 9, rem = (n - 1536) & 511, hh = rem >> 7, d = rem & 127, dd = d & 63;
                const int p = 128 * (Q >> 1) + 32 * (dd >> 4) + 16 * (Q & 1) + 4 * ((dd >> 2) & 3) + (dd & 3);
                row = (size_t)(1024 + 256 * (2 * hh + (d >> 6)) + p); }
            else row = (size_t)(3072 + perm8(n - 3584));
        } else {
            const int half = n >> 10, nn = n & 1023;
            row = (size_t)(256 * (nn >> 7) + 128 * half + perm8(nn & 127));
        }
        if (!FP8) __builtin_nontemporal_store(o, (v4u*)(base + row * K + k0 + 8 * c));
        else { v2u o8; o8.x = pk_fp8x4(s[0] * W8_SCALE, s[64] * W8_SCALE, s[128] * W8_SCALE, s[192] * W8_SCALE); o8.y = pk_fp8x4(s[256] * W8_SCALE, s[320] * W8_SCALE, s[384] * W8_SCALE, s[448] * W8_SCALE);
               __builtin_nontemporal_store(o8, (v2u*)((unsigned char*)base + row * K + k0 + 8 * c)); }
    }
    LDS_WAIT();
}

__device__ __forceinline__ void sincos_d(double x, double& s, double& c) {
    const double k = __builtin_rint(x * 0.63661977236758134308);
    double r = __builtin_fma(-k, 1.57079632679489655800e+00, x); r = __builtin_fma(-k, 6.12323399573676603587e-17, r);
    const double r2 = r * r;
    double sp = -1.0 / 1307674368000.0; sp = sp * r2 + 1.0 / 6227020800.0; sp = sp * r2 - 1.0 / 39916800.0; sp = sp * r2 + 1.0 / 362880.0; sp = sp * r2 - 1.0 / 5040.0; sp = sp * r2 + 1.0 / 120.0; sp = sp * r2 - 1.0 / 6.0; sp = sp * r2 + 1.0;
    const double sr = sp * r;
    double cp = 1.0 / 20922789888000.0; cp = cp * r2 - 1.0 / 87178291200.0; cp = cp * r2 + 1.0 / 479001600.0; cp = cp * r2 - 1.0 / 3628800.0; cp = cp * r2 + 1.0 / 40320.0; cp = cp * r2 - 1.0 / 720.0; cp = cp * r2 + 1.0 / 24.0; cp = cp * r2 - 0.5; cp = cp * r2 + 1.0;
    const int q = ((int)k) & 3;
    s = (q == 0) ? sr : (q == 1) ? cp : (q == 2) ? -sr : -cp;
    c = (q == 0) ? cp : (q == 1) ? -sr : (q == 2) ? -cp : sr;
}

constexpr int CI_IN = 16 * 96, CI_A = 8 * 16, CI_B = 8 * 16, CI_O = 16 * 16, CI_GU = 16 * 32, CI_DN = 16 * 16;
constexpr int PER_L = CI_IN + CI_A + CI_B + CI_O + NE * CI_GU + NE * CI_DN;
__device__ __forceinline__ void convert_items(const Params& P, LAS unsigned char* lds, int it0, int it1, int gwg, int nwg, int wv) {
    int tid_ = fresh_tid(wv);
    const int lane = tid_ & 63, wave = __builtin_amdgcn_readfirstlane(tid_ >> 6);
    GAS unsigned char* wsg_ = (GAS unsigned char*)P.ws; asm volatile("" : "+s"(wsg_)); unsigned char* ws = (unsigned char*)wsg_;
    LAS float* scr = (LAS float*)(lds + wave * 16384);
    constexpr int I_IN = CI_IN, I_A = CI_A, I_B = CI_B, I_O = CI_O, I_GU = CI_GU, I_DN = CI_DN;
#pragma unroll 1
    for (int it = it0 + gwg * NWAVES + wave; it < it1; it += nwg * NWAVES) {
        const int l = it / PER_L; int r = it % PER_L;
        if (r < I_IN) { const int kb = r / 96, nb = r % 96;
            transpose_item<2, true>(P.in[I_WIN] + (size_t)l * D * INC, D, INC, (bf16*)(ws + WS_WIN + l * WIN_L), (bf16*)(ws + WS_WV + l * WV_L), 0, 64 * kb, 64 * nb, scr, lane); continue; }
        r -= I_IN;
        if (r < I_A) { const int kb = r / 16, nb = r % 16;
            transpose_item<1>(P.in[I_WBA] + (size_t)l * 512 * D, 512, D, (bf16*)(ws + WS_WAB + l * WAB_L), nullptr, 0, 64 * kb, 64 * nb, scr, lane); continue; }
        r -= I_A;
        if (r < I_B) { const int kb = r / 16, nb = r % 16;
            transpose_item<1>(P.in[I_WBB] + (size_t)l * 512 * D, 512, D, (bf16*)(ws + WS_WAB + l * WAB_L), nullptr, 1024, 64 * kb, 64 * nb, scr, lane); continue; }
        r -= I_B;
        if (r < I_O) { const int kb = r / 16, nb = r % 16;
            transpose_item<0>(P.in[I_WOUT] + (size_t)l * D * D, D, D, (bf16*)(ws + WS_WO + l * WO_L), nullptr, 0, 64 * kb, 64 * nb, scr, lane); continue; }
        r -= I_O;
        if (r < NE * I_GU) { const int e = r / I_GU, q = r % I_GU, kb = q / 32, nb = q % 32;
            transpose_item<3, true>(P.in[I_WGU] + ((size_t)l * NE + e) * D * 2048, D, 2048, (bf16*)(ws + WS_WGU + l * WGU_L + e * (WGU_E / 2)), nullptr, 0, 64 * kb, 64 * nb, scr, lane); continue; }
        r -= NE * I_GU;
        { const int e = r / I_DN, q = r % I_DN, kb = q / 16, nb = q % 16;
            transpose_item<1, true>(P.in[I_WDN] + ((size_t)l * NE + e) * DFF * D, DFF, D, (bf16*)(ws + WS_WD + l * WD_L + e * (WD_E / 2)), nullptr, 0, 64 * kb, 64 * nb, scr, lane); }
    }
}

__device__ __forceinline__ void phase_p0a(const Params& P, LAS unsigned char* lds, int G, int wv) {
    int tid_ = fresh_tid(wv);
    const int tid = tid_, lane = tid & 63, wave = tid >> 6;
    GAS unsigned char* wsg_ = (GAS unsigned char*)P.ws; asm volatile("" : "+s"(wsg_)); unsigned char* ws = (unsigned char*)wsg_;
    LAS float* sil = (LAS float*)(lds + 131072);
    for (int i = tid; i < 2048; i += NTHR) { const float v = (i < 1024) ? P.in[I_C][i] : P.in[I_CCTX][i - 1024]; sil[i] = v * sigmoidf_(v); }
    __syncthreads();
    {
        float* modp = (float*)(ws + WS_MODP);
        for (int t = blockIdx.x * NTHR + tid; t < DEPTH * 8 * 6144; t += G * NTHR) {
            const int j = t % 6144, lp = t / 6144, part = lp & 7, l = lp >> 3;
            const float* w = P.in[I_ADAW] + ((size_t)l * D + part * 128) * 6144 + j;
            float a0 = 0.f, a1 = 0.f;
#pragma unroll 8
            for (int i = 0; i < 128; ++i) { const float wv = w[(size_t)i * 6144]; a0 += sil[part * 128 + i] * wv; a1 += sil[1024 + part * 128 + i] * wv; }
            modp[((size_t)(l * 8 + part) * 2 + 0) * 6144 + j] = a0;
            modp[((size_t)(l * 8 + part) * 2 + 1) * 6144 + j] = a1;
        }
    }
    {
        float* lbo = (float*)(ws + WS_LB);
        for (int t = blockIdx.x * NTHR + tid; t < 2 * 512; t += G * NTHR) {
            const int dir = t >> 9, j = t & 511;
            float v[DEPTH], mx = -1e30f;
#pragma unroll
            for (int l = 0; l < DEPTH; ++l) { v[l] = P.in[I_HGLB][((size_t)dir * DEPTH + l) * 512 + j]; mx = fmaxf(mx, v[l]); }
            float sum = 0.f;
#pragma unroll
            for (int l = 0; l < DEPTH; ++l) { v[l] = expf(v[l] - mx); sum += v[l]; }
            float cs = 0.f, first = 0.f;
#pragma unroll
            for (int l = 0; l < DEPTH; ++l) { cs += v[l] / sum; if (l == 0) first = cs; lbo[((size_t)dir * DEPTH + l) * 512 + j] = cs - first; }
        }
    }
    {
        float* rt = (float*)(ws + WS_ROPE);
        for (int t = blockIdx.x * NTHR + tid; t < 256 * 16; t += G * NTHR) {
            const int pos = t >> 4, fi = t & 15;
            const float freq = (float)exp2(-(double)fi * (13.287712379549449 / 16.0));
            const float ang = (float)pos * freq;
            double s, c; sincos_d((double)ang, s, c);
            rt[2 * t] = (float)c; rt[2 * t + 1] = (float)s;
        }
    }
    {
        for (int t = blockIdx.x * NTHR + tid; t < DEPTH * D * NE; t += G * NTHR) {
            const int e = t & 31, k = (t >> 5) & 1023, l = t >> 15;
            const float v = P.in[I_RW][t];
            const unsigned hi = pk2(v, 0.f) & 0xffffu; const unsigned lo = pk2(v - bflo(hi), 0.f) & 0xffffu;
            unsigned char* img = ws + WS_RWIMG + (size_t)l * RW_IMG;
            *(bf16*)(img + e * RW_PITCH + k * 2) = (bf16)hi; *(bf16*)(img + 32 * RW_PITCH + e * RW_PITCH + k * 2) = (bf16)lo;
        }
    }
    {
        convert_items(P, lds, 0, (G == 256) ? PER_L : DEPTH * PER_L, (int)blockIdx.x, G, wv);
    }
}

__device__ __forceinline__ const float* modv_ptr(const Params& P, int l, int w) { return (const float*)(P.ws + WS_MODV) + ((size_t)l * 2 + w) * 6144; }
__device__ __forceinline__ const float* xin_row(const Params& P, int l, int row) {
    if (l == 0) return (row < SEQ) ? P.in[I_X] + (size_t)row * D : P.in[I_CTX] + (size_t)(row - SEQ) * D;
    return (const float*)(P.ws + WS_XRES) + (size_t)row * D;
}
__device__ __forceinline__ void norm_store_row(const f32x4 (&v)[4], const LAS float* A, const LAS float* B, unsigned char* hrow, int lane) {
    float ss = 0.f;
#pragma unroll
    for (int j = 0; j < 4; ++j) ss += (v[j].x * v[j].x + v[j].y * v[j].y) + (v[j].z * v[j].z + v[j].w * v[j].w);
    const float rstd = __builtin_amdgcn_rsqf(wave_sum(ss, lane) * (1.f / D) + EPS);
#pragma unroll
    for (int j = 0; j < 4; ++j) {
        const f32x4 a = *(const LAS f32x4*)(A + 4 * lane + 256 * j), b = *(const LAS f32x4*)(B + 4 * lane + 256 * j);
        const f32x4 y = v[j] * rstd * a + b;
        *(unsigned*)(hrow + 4 * lane + 256 * j) = pk_fp8x4(y.x, y.y, y.z, y.w);
    }
}

__device__ __forceinline__ void phase_p0b(const Params& P, LAS unsigned char* lds, int G, int wv) {
    int tid_ = fresh_tid(wv);
    const int tid = tid_, lane = tid & 63, wave = tid >> 6;
    GAS unsigned char* wsg_ = (GAS unsigned char*)P.ws; asm volatile("" : "+s"(wsg_)); unsigned char* ws = (unsigned char*)wsg_;
    const float* modp = (const float*)(ws + WS_MODP);
    float* modv = (float*)(ws + WS_MODV);
    for (int t = blockIdx.x * NTHR + tid; t < DEPTH * 2 * 6144; t += G * NTHR) {
        const int j = t % 6144, lw = t / 6144, w = lw & 1, l = lw >> 1;
        float a = P.in[I_ADAB][(size_t)l * 6144 + j];
#pragma unroll
        for (int p = 0; p < 8; ++p) a += modp[((size_t)(l * 8 + p) * 2 + w) * 6144 + j];
        modv[t] = a;
    }
    LAS float* TA = (LAS float*)lds;
    LAS float* TB = (LAS float*)(lds + 8192);
    for (int i = tid; i < 2048; i += NTHR) {
        const int w = i >> 10, j = i & 1023;
        float sh = P.in[I_ADAB][j], sc = P.in[I_ADAB][1024 + j];
#pragma unroll
        for (int p = 0; p < 8; ++p) { sh += modp[((size_t)p * 2 + w) * 6144 + j]; sc += modp[((size_t)p * 2 + w) * 6144 + 1024 + j]; }
        TA[i] = P.in[I_N1G][j] * (1.f + sc); TB[i] = sh;
    }
    __syncthreads();
    bf16* H = (bf16*)(ws + WS_H);
    for (int row = blockIdx.x * NWAVES + wave; row < NT; row += G * NWAVES) {
        const float* xr = xin_row(P, 0, row); const int w = row >= SEQ;
        f32x4 v[4];
#pragma unroll
        for (int j = 0; j < 4; ++j) v[j] = *(const f32x4*)(xr + 4 * lane + 256 * j);
        norm_store_row(v, TA + 1024 * w, TB + 1024 * w, (unsigned char*)H + (size_t)row * D, lane);
        bf16* xb = (bf16*)(ws + WS_XRES) + (size_t)row * D + 4 * lane;
#pragma unroll
        for (int j = 0; j < 4; ++j) { v2u o; o.x = pk2(v[j].x, v[j].y); o.y = pk2(v[j].z, v[j].w); *(v2u*)(xb + 256 * j) = o; }
    }
}

using pg8::Unit;

struct EpiInProj {
    static constexpr bool PERM = false, AFTER_DRAIN = false, FP8 = true;
    bf16* Q; bf16* K; bf16* proj; const float* qn_g; const float* kn_g; const float* rope; unsigned char* img; const float* lbl;
    __device__ __forceinline__ void operator()(const f32x4 (&acc)[2][2][4][2], const Unit& u, int wr, int wc, int fr, int fq) const {
        const int row0 = u.pm * 256 + wr * 64 + fr;
        if (u.pn < 4) {
            const bool isq = u.pn < 2; const int gg = 4 * (u.pn & 1) + wc, hh = gg >> 1, mm = gg & 1;
            const float* gv = isq ? qn_g : kn_g; unsigned char* dstb = (unsigned char*)(isq ? Q : K) + (size_t)hh * NT * 128 + 64 * mm;
            const float oscale = isq ? 0.125f * 1.4426950408889634f : 1.f;
            f32x4 g[2][2];
#pragma unroll
            for (int bj = 0; bj < 2; ++bj)
#pragma unroll
                for (int n = 0; n < 2; ++n) g[bj][n] = *(const f32x4*)(gv + 32 * bj + 16 * n + 4 * fq);
#pragma unroll
            for (int ai = 0; ai < 2; ++ai)
#pragma unroll
                for (int m = 0; m < 4; ++m) {
                    const int row = row0 + ai * 128 + m * 16;
                    float ss = 0.f;
#pragma unroll
                    for (int bj = 0; bj < 2; ++bj)
#pragma unroll
                        for (int n = 0; n < 2; ++n) { const f32x4 x = acc[ai][bj][m][n]; ss += (x.x * x.x + x.y * x.y) + (x.z * x.z + x.w * x.w); }
                    { const int ln_ = 16 * fq + fr; ss += shx(ss, 16, ln_); ss += shx(ss, 32, ln_); }
                    const float rstd = __builtin_amdgcn_rsqf(ss * (1.f / 64.f) + EPS) ;
                    unsigned char* dst = dstb + (size_t)row * 128;
                    const bool lat = row < SEQ;
#pragma unroll
                    for (int bj = 0; bj < 2; ++bj) {
                        f32x4 x1 = acc[ai][bj][m][0] * rstd * g[bj][0], x2 = acc[ai][bj][m][1] * rstd * g[bj][1];
                        if (lat) {
                            const int pos = bj == 0 ? (row >> 6) : (row & 63);
                            const f32x4 cs0 = *(const f32x4*)(rope + (size_t)(pos * 16 + 4 * fq) * 2), cs1 = *(const f32x4*)(rope + (size_t)(pos * 16 + 4 * fq) * 2 + 4);
                            const f32x4 c = {cs0.x, cs0.z, cs1.x, cs1.z}, s = {cs0.y, cs0.w, cs1.y, cs1.w};
                            const f32x4 y1 = x1 * c - x2 * s, y2 = x2 * c + x1 * s; x1 = y1; x2 = y2;
                        }
                        x1 = x1 * oscale; x2 = x2 * oscale;
                        *(unsigned*)(dst + 32 * bj + 4 * fq) = pk_fp8x4(x1.x, x1.y, x1.z, x1.w); *(unsigned*)(dst + 32 * bj + 16 + 4 * fq) = pk_fp8x4(x2.x, x2.y, x2.z, x2.w);
                    }
                }
        } else if (u.pn < 12) {
            const int T = u.pn - 4, hh = T >> 1, d0 = 64 * (T & 1) + 16 * wc + 4 * fq, ln_ = 16 * fq + fr;
            const f32x4 lbf = *(const f32x4*)(lbl + 128 * hh + d0), lbb = *(const f32x4*)(lbl + (size_t)DEPTH * 512 + 128 * hh + d0);
#pragma unroll
            for (int ai = 0; ai < 2; ++ai)
#pragma unroll
                for (int m = 0; m < 4; ++m) {
                    const int rg = u.pm * 256 + ai * 128 + wr * 64 + m * 16;
                    const int seg = rg < SEQ ? (rg >> 8) : 64, cf = ((rg < SEQ ? rg : rg - SEQ) & 255) >> 4;
                    const f32x4 qv = acc[ai][0][m][0], vv = acc[ai][1][m][1];
#pragma unroll
                    for (int dir = 0; dir < 2; ++dir) {
                        const f32x4 zv = dir ? acc[ai][1][m][0] : acc[ai][0][m][1], lb = dir ? lbb : lbf;
                        const int s_ = dir ? 15 - fr : fr, c_ = dir ? 15 - cf : cf;
                        unsigned char* im = img + (size_t)((((dir * 4 + hh) * 65 + seg) * 16) + c_) * IM_BYTES;
                        float qt[4], kt[4], kh[4], dc[4];
#pragma unroll
                        for (int i = 0; i < 4; ++i) {
                            const float zc = fminf(fmaxf(zv[i], -80.f), 80.f), E = fast_exp(-zc), den = fast_rcp(1.f + E);
                            const float g = fast_log((1.f + lb[i] * E) * den), kk = (1.f - lb[i]) * E * den;
                            float b = g;
                            if (dir == 0) { b += __int_as_float(__builtin_amdgcn_update_dpp(0, __float_as_int(b), 0x111, 0xf, 0xf, true)); b += __int_as_float(__builtin_amdgcn_update_dpp(0, __float_as_int(b), 0x112, 0xf, 0xf, true));
                                            b += __int_as_float(__builtin_amdgcn_update_dpp(0, __float_as_int(b), 0x114, 0xf, 0xf, true)); b += __int_as_float(__builtin_amdgcn_update_dpp(0, __float_as_int(b), 0x118, 0xf, 0xf, true)); }
                            else          { b += __int_as_float(__builtin_amdgcn_update_dpp(0, __float_as_int(b), 0x101, 0xf, 0xf, true)); b += __int_as_float(__builtin_amdgcn_update_dpp(0, __float_as_int(b), 0x102, 0xf, 0xf, true));
                                            b += __int_as_float(__builtin_amdgcn_update_dpp(0, __float_as_int(b), 0x104, 0xf, 0xf, true)); b += __int_as_float(__builtin_amdgcn_update_dpp(0, __float_as_int(b), 0x108, 0xf, 0xf, true)); }
                            const float bl = __int_as_float(__builtin_amdgcn_ds_bpermute((dir ? (ln_ & ~15) : (ln_ | 15)) << 2, __float_as_int(b)));
                            qt[i] = qv[i] * fast_exp(b); kt[i] = kk * fast_exp(fminf(-b, 80.f)); kh[i] = kk * fast_exp(bl - b); dc[i] = fast_exp(bl);
                        }
                        { v2u o; o.x = pk2(qt[0], qt[1]); o.y = pk2(qt[2], qt[3]); *(v2u*)(im + 0 + s_ * 272 + d0 * 2) = o; }
                        { v2u o; o.x = pk2(kt[0], kt[1]); o.y = pk2(kt[2], kt[3]); *(v2u*)(im + 4352 + s_ * 272 + d0 * 2) = o; }
#pragma unroll
                        for (int i = 0; i < 4; ++i) { *(bf16*)(im + 8704 + (d0 + i) * 48 + s_ * 2) = (bf16)(pk2(kh[i], 0.f) & 0xffffu); *(bf16*)(im + 14848 + (d0 + i) * 48 + s_ * 2) = (bf16)(pk2(vv[i], 0.f) & 0xffffu); }
                        if (s_ == 15) *(f32x4*)(im + 20992 + d0 * 4) = (f32x4){dc[0], dc[1], dc[2], dc[3]};
                    }
                }
        } else {
            const int pt = u.pn - 4; const int act = pt < 10 ? 1 : 2;
            const int col0 = pt * 256 + wc * 32 + 8 * fq;
#pragma unroll
            for (int ai = 0; ai < 2; ++ai)
#pragma unroll
                for (int m = 0; m < 4; ++m) { bf16* rowp = proj + (size_t)(row0 + ai * 128 + m * 16) * PROJW + col0;
#pragma unroll
                    for (int bj = 0; bj < 2; ++bj) { f32x4 v0 = acc[ai][bj][m][0], v1 = acc[ai][bj][m][1];
#pragma unroll
                        for (int j = 0; j < 4; ++j) { const float s0 = sigmoidf_(v0[j]), s1 = sigmoidf_(v1[j]); v0[j] = act == 1 ? v0[j] * s0 : s0; v1[j] = act == 1 ? v1[j] * s1 : s1; }
                        v4u w; w.x = pk2(v0.x, v0.y); w.y = pk2(v0.z, v0.w); w.z = pk2(v1.x, v1.y); w.w = pk2(v1.z, v1.w);
                        *(v4u*)(rowp + bj * 128) = w; } }
        }
    }
};
struct EpiVt {
    static constexpr bool PERM = false, AFTER_DRAIN = false, FP8 = true;
    bf16* VT;
    __device__ __forceinline__ void operator()(const f32x4 (&acc)[2][2][4][2], const Unit& u, int wr, int wc, int fr, int fq) const {
        const int row0 = u.pm * 256 + wr * 64 + fr, col0 = u.pn * 256 + wc * 32 + 4 * fq;
#pragma unroll
        for (int ai = 0; ai < 2; ++ai)
#pragma unroll
            for (int m = 0; m < 4; ++m) { unsigned char* rowp = (unsigned char*)VT + (size_t)(row0 + ai * 128 + m * 16) * LDV + col0;
#pragma unroll
                for (int bj = 0; bj < 2; ++bj)
#pragma unroll
                    for (int n = 0; n < 2; ++n) { const f32x4 v = acc[ai][bj][m][n]; *(unsigned*)(rowp + bj * 128 + n * 16) = pk_fp8x4(v.x, v.y, v.z, v.w); } }
    }
};
struct EpiMerge {
    static constexpr bool PERM = false, AFTER_DRAIN = false, FP8 = false;
    const bf16* proj; bf16* U;
    __device__ __forceinline__ void operator()(const f32x4 (&acc)[2][2][4][2], const Unit& u, int wr, int wc, int fr, int fq) const {
        const int br = u.pn >> 2, T = u.pn & 3, pm = u.pm - 65 * br;
        const int row0 = pm * 256 + wr * 64 + fr, col0 = T * 256 + wc * 32 + 8 * fq;
        const int gcol = (br ? PC_GB : PC_GA) + col0;
#pragma unroll
        for (int ai = 0; ai < 2; ++ai)
#pragma unroll
            for (int m = 0; m < 4; ++m) { const size_t row = (size_t)(row0 + ai * 128 + m * 16);
#pragma unroll
                for (int bj = 0; bj < 2; ++bj) {
                    const v4u gw = *(const v4u*)(proj + row * PROJW + gcol + bj * 128);
                    f32x4 v0 = acc[ai][bj][m][0], v1 = acc[ai][bj][m][1];
                    v0.x *= bflo(gw.x); v0.y *= bfhi(gw.x); v0.z *= bflo(gw.y); v0.w *= bfhi(gw.y);
                    v1.x *= bflo(gw.z); v1.y *= bfhi(gw.z); v1.z *= bflo(gw.w); v1.w *= bfhi(gw.w);
                    bf16* up = U + row * D + col0 + bj * 128;
                    if (br) { const v4u o = *(const v4u*)up;
                        v0.x += bflo(o.x); v0.y += bfhi(o.x); v0.z += bflo(o.y); v0.w += bfhi(o.y);
                        v1.x += bflo(o.z); v1.y += bfhi(o.z); v1.z += bflo(o.w); v1.w += bfhi(o.w); }
                    v4u w; w.x = pk2(v0.x, v0.y); w.y = pk2(v0.z, v0.w); w.z = pk2(v1.x, v1.y); w.w = pk2(v1.z, v1.w);
                    *(v4u*)up = w; } }
    }
};
struct EpiOut {
    static constexpr bool PERM = false, AFTER_DRAIN = false, FP8 = false;
    const bf16* xsrc; bf16* xres; const float* g1lat; const float* g1ctx;
    __device__ __forceinline__ void operator()(const f32x4 (&acc)[2][2][4][2], const Unit& u, int wr, int wc, int fr, int fq) const {
        const int row0 = u.pm * 256 + wr * 64 + fr, col0 = u.pn * 256 + wc * 32 + 4 * fq;
        const bool isctx = u.pm >= 64;
        const float* gsrc = isctx ? g1ctx : g1lat;
        f32x4 gv[2][2];
#pragma unroll
        for (int bj = 0; bj < 2; ++bj)
#pragma unroll
            for (int n = 0; n < 2; ++n) gv[bj][n] = *(const f32x4*)(gsrc + col0 + bj * 128 + n * 16);
#pragma unroll
        for (int ai = 0; ai < 2; ++ai)
#pragma unroll
            for (int m = 0; m < 4; ++m) { const int row = row0 + ai * 128 + m * 16;
                const bf16* src = xsrc + (size_t)row * D + col0;
                bf16* dst = xres + (size_t)row * D + col0;
#pragma unroll
                for (int bj = 0; bj < 2; ++bj)
#pragma unroll
                    for (int n = 0; n < 2; ++n) { const v2u xv = *(const v2u*)(src + bj * 128 + n * 16);
                        const f32x4 y = (f32x4){bflo(xv.x), bfhi(xv.x), bflo(xv.y), bfhi(xv.y)} + gv[bj][n] * acc[ai][bj][m][n];
                        v2u o; o.x = pk2(y.x, y.y); o.y = pk2(y.z, y.w); *(v2u*)(dst + bj * 128 + n * 16) = o; } }
    }
};
struct EpiSwiglu {
    static constexpr bool PERM = false, AFTER_DRAIN = false, FP8 = true;
    bf16* hdn; const float* bgu;
    __device__ __forceinline__ void operator()(const f32x4 (&acc)[2][2][4][2], const Unit& u, int wr, int wc, int fr, int fq) const {
        const int e = u.pn >> 3, T = u.pn & 7;
        const int row0 = u.pm * 256 + wr * 64 + fr, col0 = T * 128 + wc * 32 + 8 * fq;
        const float* bg = bgu + (size_t)e * 2048 + col0;
        const f32x4 bg0 = *(const f32x4*)bg, bg1 = *(const f32x4*)(bg + 4), bu0 = *(const f32x4*)(bg + 1024), bu1 = *(const f32x4*)(bg + 1028);
#pragma unroll
        for (int ai = 0; ai < 2; ++ai)
#pragma unroll
            for (int m = 0; m < 4; ++m) {
                f32x4 g0 = acc[ai][0][m][0] + bg0, g1 = acc[ai][0][m][1] + bg1, u0 = acc[ai][1][m][0] + bu0, u1 = acc[ai][1][m][1] + bu1;
                f32x4 h0, h1;
#pragma unroll
                for (int j = 0; j < 4; ++j) {
                    const float ga = fminf(g0[j], 7.f), gb = fminf(g1[j], 7.f);
                    const float ua = fminf(fmaxf(u0[j], -7.f), 7.f), ub = fminf(fmaxf(u1[j], -7.f), 7.f);
                    h0[j] = (ua + 1.f) * ga * sigmoidf_(1.702f * ga); h1[j] = (ub + 1.f) * gb * sigmoidf_(1.702f * gb);
                }
                v2u w; w.x = pk_fp8x4(h0.x, h0.y, h0.z, h0.w); w.y = pk_fp8x4(h1.x, h1.y, h1.z, h1.w);
                *(v2u*)((unsigned char*)hdn + (size_t)(row0 + ai * 128 + m * 16) * D + col0) = w;
            }
    }
};
struct EpiDown {
    static constexpr bool PERM = false, AFTER_DRAIN = false, FP8 = true;
    bf16* Y; const float* bdn;
    __device__ __forceinline__ void operator()(const f32x4 (&acc)[2][2][4][2], const Unit& u, int wr, int wc, int fr, int fq) const {
        const int e = u.pn >> 2, T = u.pn & 3;
        const int row0 = u.pm * 256 + wr * 64 + fr, col0 = T * 256 + wc * 32 + 8 * fq;
        f32x4 bv[2][2];
#pragma unroll
        for (int bj = 0; bj < 2; ++bj)
#pragma unroll
            for (int n = 0; n < 2; ++n) bv[bj][n] = *(const f32x4*)(bdn + (size_t)e * D + col0 + bj * 128 + 4 * n);
#pragma unroll
        for (int ai = 0; ai < 2; ++ai)
#pragma unroll
            for (int m = 0; m < 4; ++m) { bf16* rowp = Y + (size_t)(row0 + ai * 128 + m * 16) * D + col0;
#pragma unroll
                for (int bj = 0; bj < 2; ++bj) { const f32x4 v0 = acc[ai][bj][m][0] + bv[bj][0], v1 = acc[ai][bj][m][1] + bv[bj][1];
                    v4u w; w.x = pk2(v0.x, v0.y); w.y = pk2(v0.z, v0.w); w.z = pk2(v1.x, v1.y); w.w = pk2(v1.z, v1.w);
                    *(v4u*)(rowp + bj * 128) = w; } }
    }
};

constexpr int IM_QT = 0, IM_KT = 4352, IM_KH = 8704, IM_VT = 14848, IM_DEC = 20992;
constexpr int HGP = 272;
constexpr int HL_IMG = 0, HL_ST = 2 * IM_BYTES, HL_STSZ = 34816, HL_OT = HL_ST + 2 * HL_STSZ, HL_OTSZ = 8448, HL_OF = HL_OT + 2 * HL_OTSZ, HL_GT = HL_OF + 2 * 8192, HL_AM = HL_GT + 2 * 4096;

__device__ __forceinline__ void glds16_s(const void* sbase, unsigned voff, unsigned lds_dst);

__device__ __forceinline__ void phase_hgrn_build(const Params& P, int layer, int G, int wv) {
    int tid_ = fresh_tid(wv);
    const int tid = tid_, d = tid & 127;
    GAS unsigned char* wsg_ = (GAS unsigned char*)P.ws; asm volatile("" : "+s"(wsg_)); unsigned char* ws = (unsigned char*)wsg_;
    const bf16* proj = (const bf16*)(ws + WS_PROJ);
    for (int task = blockIdx.x * 4 + (tid >> 7); task < 8 * 65 * 16; task += G * 4) {
        const int c = task & 15, sg = (task >> 4) % 65, dh = task / (16 * 65), dir = dh >> 2, hh = dh & 3;
        const int tok0 = (sg < 64 ? sg * 256 : SEQ) + (dir ? 255 : 0), sgn = dir ? -1 : 1;
        const float lb = ((const float*)(ws + WS_LB))[((size_t)dir * DEPTH + layer) * 512 + 128 * hh + d];
        const bf16* base = proj + (size_t)(tok0 + sgn * 16 * c) * PROJW + 128 * hh + d;
        const long rstep = (long)sgn * PROJW;
        float z[16], q[16]; unsigned short vv[16];
#pragma unroll
        for (int s = 0; s < 16; ++s) { const bf16* r = base + s * rstep; z[s] = bf2f(r[dir ? PC_ZB : PC_ZF]); q[s] = bf2f(r[PC_QH]); vv[s] = r[PC_VH]; }
        float b[16], kk[16], run = 0.f;
#pragma unroll
        for (int s = 0; s < 16; ++s) {
            const float zz = fminf(fmaxf(z[s], -80.f), 80.f), E = fast_exp(-zz), den = fast_rcp(1.f + E);
            run += fast_log((1.f + lb * E) * den); b[s] = run; kk[s] = (1.f - lb) * E * den;
        }
        unsigned char* img = ws + WS_IMG + (size_t)task * IM_BYTES;
        unsigned khw[8], vtw[8];
#pragma unroll
        for (int s = 0; s < 16; ++s) {
            *(bf16*)(img + IM_QT + s * HGP + d * 2) = (bf16)(pk2(q[s] * fast_exp(b[s]), 0.f) & 0xffffu);
            *(bf16*)(img + IM_KT + s * HGP + d * 2) = (bf16)(pk2(kk[s] * fast_exp(fminf(-b[s], 80.f)), 0.f) & 0xffffu);
        }
#pragma unroll
        for (int j = 0; j < 8; ++j) { khw[j] = pk2(kk[2 * j] * fast_exp(b[15] - b[2 * j]), kk[2 * j + 1] * fast_exp(b[15] - b[2 * j + 1])); vtw[j] = (unsigned)vv[2 * j] | ((unsigned)vv[2 * j + 1] << 16); }
        *(v4u*)(img + IM_KH + d * 48) = (v4u){khw[0], khw[1], khw[2], khw[3]}; *(v4u*)(img + IM_KH + d * 48 + 16) = (v4u){khw[4], khw[5], khw[6], khw[7]};
        *(v4u*)(img + IM_VT + d * 48) = (v4u){vtw[0], vtw[1], vtw[2], vtw[3]}; *(v4u*)(img + IM_VT + d * 48 + 16) = (v4u){vtw[4], vtw[5], vtw[6], vtw[7]};
        *(float*)(img + IM_DEC + d * 4) = fast_exp(b[15]);
    }
}

template <int MODE>
__device__ __forceinline__ void hgrn_sweep(const Params& P, LAS unsigned char* lds, int layer, int dir, int hh, int seg, const float* Sinit, float* Uout, float* Dout, int wv) {
    int tid_ = fresh_tid(wv);
    const int tid = tid_, lane = tid & 63, wid = __builtin_amdgcn_readfirstlane(tid >> 6), r32 = lane & 31, hi = lane >> 5;
    GAS unsigned char* wsg_ = (GAS unsigned char*)P.ws; asm volatile("" : "+s"(wsg_)); unsigned char* ws = (unsigned char*)wsg_;
    const int tok0 = (seg < 64 ? seg * 256 : SEQ) + (dir ? 255 : 0), sgn = dir ? -1 : 1;
    constexpr int NV = (MODE == 0) ? 2 : 4;
    const int db = wid & 3, vb0 = (MODE == 0) ? 2 * (wid >> 2) : 0;
    const bool srole = (MODE == 0) || wid >= 4, orole = (MODE != 0) && wid < 4;
    const unsigned lds0 = (unsigned)(uintptr_t)lds;
    const unsigned char* img0 = ws + WS_IMG + (size_t)(((dir * 4 + hh) * 65 + seg) * 16) * IM_BYTES;
    constexpr int P0 = (MODE == 0) ? 8 : 0;
#define HG_DMA_IMG(c) do { _Pragma("unroll") for (int j = 0; j < 3; ++j) { const int pc = wid + 8 * j; if (pc >= P0 && pc < 21) \
        glds16_s(img0 + (size_t)(c) * IM_BYTES + pc * 1024, (unsigned)lane * 16u, lds0 + HL_IMG + ((c) & 1) * IM_BYTES + pc * 1024); } } while (0)
#define HG_DMA_FIN(c) do { { const int t = 2 * wid + (lane >> 5), tok = tok0 + sgn * (16 * (c) + t); \
        glds16_s(ws + WS_OBF, (unsigned)(((size_t)tok * 512 + 128 * hh) * 4 + (lane & 31) * 16), lds0 + HL_OF + ((c) & 1) * 8192 + wid * 1024); } \
      if (wid < 4) { const int t = 4 * wid + (lane >> 4), tok = tok0 + sgn * (16 * (c) + t); \
        glds16_s(ws + WS_PROJ, (unsigned)(((size_t)tok * PROJW + PC_GH + 128 * hh) * 2 + (lane & 15) * 16), lds0 + HL_GT + ((c) & 1) * 4096 + wid * 1024); } } while (0)
    HG_DMA_IMG(0);
    f32x16 S[NV];
#pragma unroll
    for (int blk = 0; blk < NV; ++blk)
#pragma unroll
        for (int r = 0; r < 16; ++r) { const int d = 32 * db + (r & 3) + 8 * (r >> 2) + 4 * hi, v = 32 * (vb0 + blk) + r32; S[blk][r] = (Sinit && srole) ? Sinit[(size_t)d * 128 + v] : 0.f; }
    if (MODE != 0 && srole) {
#pragma unroll
        for (int blk = 0; blk < NV; ++blk)
#pragma unroll
            for (int g = 0; g < 4; ++g) { v2u o; o.x = pk2(S[blk][4 * g], S[blk][4 * g + 1]); o.y = pk2(S[blk][4 * g + 2], S[blk][4 * g + 3]);
                *(LAS v2u*)(lds + HL_ST + (32 * (vb0 + blk) + r32) * HGP + (32 * db + 8 * g + 4 * hi) * 2) = o; }
    }
    float dtot = 1.f;
    const f32x4 gnv = *(const f32x4*)(P.in[I_HGNG] + (size_t)layer * 128 + 4 * (tid & 31));
#define HG_FINALIZE(c) do { const int t = tid >> 5, v4 = 4 * (tid & 31), tok = tok0 + sgn * (16 * (c) + t); \
        const f32x4 o = *(const LAS f32x4*)(lds + HL_OT + ((c) & 1) * HL_OTSZ + t * 528 + v4 * 4) + *(const LAS f32x4*)(lds + HL_OF + ((c) & 1) * 8192 + t * 512 + v4 * 4); \
        float ss = (o.x * o.x + o.y * o.y) + (o.z * o.z + o.w * o.w); \
        _Pragma("unroll") for (int off = 1; off < 32; off <<= 1) ss += shx(ss, off, lane); \
        const float rstd = __builtin_amdgcn_rsqf(ss * (1.f / 128.f) + EPS); \
        const f32x4 gn = gnv; \
        const v2u gt = *(const LAS v2u*)(lds + HL_GT + ((c) & 1) * 4096 + t * 256 + v4 * 2); \
        v2u w; w.x = pk2(o.x * rstd * gn.x * bflo(gt.x), o.y * rstd * gn.y * bfhi(gt.x)); w.y = pk2(o.z * rstd * gn.z * bflo(gt.y), o.w * rstd * gn.w * bfhi(gt.y)); \
        *(v2u*)((bf16*)(ws + WS_OAB) + (size_t)NT * 512 + (size_t)tok * 512 + 128 * hh + v4) = w; } while (0)
    for (int c = 0; c < 16; ++c) {
        if (c >= 1 && MODE == 1 && orole) asm volatile("s_waitcnt vmcnt(8)" ::: "memory");
        else if (c >= 2 && MODE == 2) asm volatile("s_waitcnt vmcnt(1)" ::: "memory");
        else asm volatile("s_waitcnt vmcnt(0)" ::: "memory");
        __syncthreads();
        if (c + 1 < 16) HG_DMA_IMG(c + 1);
        if (MODE == 2) { HG_DMA_FIN(c); if (c > 0) HG_FINALIZE(c - 1); }
        const LAS unsigned char* im = lds + HL_IMG + (c & 1) * IM_BYTES;
        const int cur = c & 1;
        if (orole) {
            const int t16 = lane & 15, kq4 = lane >> 4;
            bf16x8 qa[4];
#pragma unroll
            for (int ks = 0; ks < 4; ++ks) qa[ks] = *(const LAS bf16x8*)(im + IM_QT + t16 * HGP + (32 * ks + 8 * kq4) * 2);
            f32x4 am = {0.f, 0.f, 0.f, 0.f};
#pragma unroll
            for (int ks = 0; ks < 4; ++ks) { const bf16x8 kb = *(const LAS bf16x8*)(im + IM_KT + t16 * HGP + (32 * ks + 8 * kq4) * 2); am = __builtin_amdgcn_mfma_f32_16x16x32_bf16(qa[ks], kb, am, 0, 0, 0); }
            LAS unsigned char* amw = lds + HL_AM + wid * 768;
#pragma unroll
            for (int i = 0; i < 4; ++i) { const int t = 4 * kq4 + i; *(LAS bf16*)(amw + t * 48 + t16 * 2) = (bf16)(pk2(t16 <= t ? am[i] : 0.f, 0.f) & 0xffffu); }
            f32x4 o4[2];
#pragma unroll
            for (int b2 = 0; b2 < 2; ++b2) { o4[b2] = (f32x4){0.f, 0.f, 0.f, 0.f}; const int vcol = 32 * wid + 16 * b2 + t16;
#pragma unroll
                for (int ks = 0; ks < 4; ++ks) { const bf16x8 sb = *(const LAS bf16x8*)(lds + HL_ST + cur * HL_STSZ + vcol * HGP + (32 * ks + 8 * kq4) * 2); o4[b2] = __builtin_amdgcn_mfma_f32_16x16x32_bf16(qa[ks], sb, o4[b2], 0, 0, 0); } }
            LDS_WAIT();
            bf16x8 ama = *(const LAS bf16x8*)(amw + t16 * 48 + 16 * (kq4 & 1));
            if (kq4 >= 2) ama = (bf16x8){0, 0, 0, 0, 0, 0, 0, 0};
#pragma unroll
            for (int b2 = 0; b2 < 2; ++b2) { const int vcol = 32 * wid + 16 * b2 + t16;
                const bf16x8 vbf = *(const LAS bf16x8*)(im + IM_VT + vcol * 48 + 16 * (kq4 & 1));
                o4[b2] = __builtin_amdgcn_mfma_f32_16x16x32_bf16(ama, vbf, o4[b2], 0, 0, 0);
#pragma unroll
                for (int i = 0; i < 4; ++i) { const int t = 4 * kq4 + i;
                    if (MODE == 1) { const int tok = tok0 + sgn * (16 * c + t); ((float*)(ws + WS_OBF))[(size_t)tok * 512 + 128 * hh + vcol] = o4[b2][i]; }
                    else *(LAS float*)(lds + HL_OT + cur * HL_OTSZ + t * 528 + vcol * 4) = o4[b2][i]; } }
        }
        if (srole) {
            float dsc[16];
#pragma unroll
            for (int r = 0; r < 16; ++r) dsc[r] = *(const LAS float*)(im + IM_DEC + (32 * db + (r & 3) + 8 * (r >> 2) + 4 * hi) * 4);
            if (MODE == 0 && tid < 128) dtot *= *(const LAS float*)(im + IM_DEC + tid * 4);
            const bf16x8 ka = *(const LAS bf16x8*)(im + IM_KH + (32 * db + r32) * 48 + 16 * hi);
#pragma unroll
            for (int blk = 0; blk < NV; ++blk) {
#pragma unroll
                for (int r = 0; r < 16; ++r) S[blk][r] *= dsc[r];
                const bf16x8 vb = *(const LAS bf16x8*)(im + IM_VT + (32 * (vb0 + blk) + r32) * 48 + 16 * hi);
                S[blk] = __builtin_amdgcn_mfma_f32_32x32x16_bf16(ka, vb, S[blk], 0, 0, 0);
                if (MODE != 0) {
#pragma unroll
                    for (int g = 0; g < 4; ++g) { v2u o; o.x = pk2(S[blk][4 * g], S[blk][4 * g + 1]); o.y = pk2(S[blk][4 * g + 2], S[blk][4 * g + 3]);
                        *(LAS v2u*)(lds + HL_ST + (cur ^ 1) * HL_STSZ + (32 * (vb0 + blk) + r32) * HGP + (32 * db + 8 * g + 4 * hi) * 2) = o; }
                }
            }
        }
    }
    asm volatile("s_waitcnt vmcnt(0)" ::: "memory");
    __syncthreads();
    if (MODE == 2) HG_FINALIZE(15);
    if (MODE == 0) {
#pragma unroll
        for (int blk = 0; blk < NV; ++blk)
#pragma unroll
            for (int r = 0; r < 16; ++r) { const int d = 32 * db + (r & 3) + 8 * (r >> 2) + 4 * hi, v = 32 * (vb0 + blk) + r32; Uout[(size_t)d * 128 + v] = S[blk][r]; }
        if (tid < 128) Dout[tid] = dtot;
    }
    asm volatile("s_waitcnt vmcnt(0)" ::: "memory");
    __syncthreads();
#undef HG_DMA_IMG
#undef HG_DMA_FIN
#undef HG_FINALIZE
}

__device__ __forceinline__ void phase_hgrn1(const Params& P, LAS unsigned char* lds, int layer, int G, int wv) {
    float* U = (float*)(P.ws + WS_HGU); float* Dv = (float*)(P.ws + WS_HGD);
    for (int w = blockIdx.x; w < 512; w += G) {
        const int dir = w >> 8, hh = (w >> 6) & 3, j = w & 63;
        const int seg = (j == 0) ? 64 : (dir ? 64 - j : j - 1);
        hgrn_sweep<0>(P, lds, layer, dir, hh, seg, nullptr, U + (size_t)w * 16384, Dv + (size_t)w * 128, wv);
    }
}
__device__ __forceinline__ void phase_hgrn_chain(const Params& P, int G, int wv) {
    const float* U = (const float*)(P.ws + WS_HGU); const float* Dv = (const float*)(P.ws + WS_HGD); float* Sg = (float*)(P.ws + WS_HGS);
    int tid_ = fresh_tid(wv);
    for (int t = blockIdx.x * NTHR + tid_; t < 8 * 16384; t += G * NTHR) {
        const int dh = t >> 14, el = t & 16383, d = el >> 7;
        float s = 0.f;
        Sg[((size_t)dh * 65 + 0) * 16384 + el] = 0.f;
#pragma unroll
        for (int h = 0; h < 2; ++h) {
            float uu[32], dd[32];
#pragma unroll
            for (int p = 0; p < 32; ++p) { uu[p] = U[((size_t)dh * 64 + 32 * h + p) * 16384 + el]; dd[p] = Dv[((size_t)dh * 64 + 32 * h + p) * 128 + d]; }
#pragma unroll
            for (int p = 0; p < 32; ++p) { s = dd[p] * s + uu[p]; Sg[((size_t)dh * 65 + 32 * h + p + 1) * 16384 + el] = s; }
        }
    }
}
__device__ __forceinline__ void hgrn_unit2(const Params& P, LAS unsigned char* lds, int layer, int hh, int seg, int wv) {
    const float* Sg = (const float*)(P.ws + WS_HGS);
    const int pf = (seg < 64) ? seg + 1 : 0, pb = (seg < 64) ? 64 - seg : 0;
    hgrn_sweep<1>(P, lds, layer, 0, hh, seg, pf ? Sg + ((size_t)(0 * 4 + hh) * 65 + pf) * 16384 : nullptr, nullptr, nullptr, wv);
    hgrn_sweep<2>(P, lds, layer, 1, hh, seg, pb ? Sg + ((size_t)(1 * 4 + hh) * 65 + pb) * 16384 : nullptr, nullptr, nullptr, wv);
}

constexpr int AL_K = 0, AL_KSZ = 8192, AL_V = 2 * AL_KSZ, AL_VSZ = 8192, AL_WS = 65536, AL_OST = AL_WS + 8 * 256;

__device__ __forceinline__ void glds16_s(const void* sbase, unsigned voff, unsigned lds_dst) {
    unsigned keep;
    { const unsigned long long a = (unsigned long long)(uintptr_t)sbase;
      const unsigned lo = __builtin_amdgcn_readfirstlane((unsigned)a), hi2 = __builtin_amdgcn_readfirstlane((unsigned)(a >> 32));
      sbase = (const void*)(uintptr_t)(((unsigned long long)hi2 << 32) | lo); lds_dst = __builtin_amdgcn_readfirstlane(lds_dst); }
    asm volatile("s_mov_b32 %0, m0\n\ts_mov_b32 m0, %3\n\ts_nop 0\n\tglobal_load_lds_dwordx4 %1, %2\n\ts_mov_b32 m0, %0" : "=&s"(keep) : "v"(voff), "s"(sbase), "s"(lds_dst) : "memory");
}
__device__ __forceinline__ void attn_unit(const Params& P, LAS unsigned char* lds, int layer, int hh, int qt, float lam, float oscale, int wv) {
    int tid = fresh_tid(wv);
    const int lane = tid & 63, wid = __builtin_amdgcn_readfirstlane(tid >> 6), r32 = lane & 31, hi = lane >> 5;
    const int qg = wid >> 1, mp = wid & 1;
    GAS unsigned char* wsg_ = (GAS unsigned char*)P.ws; asm volatile("" : "+s"(wsg_)); unsigned char* ws = (unsigned char*)wsg_;
    const int qrow0 = (qt < 64) ? qt * 256 : SEQ;
    const int kt_lo = (qt < 64) ? 0 : 256, kt_hi = NT / 64;
    const unsigned char* Qg = ws + WS_Q + ((size_t)hh * NT + qrow0 + 64 * qg + r32) * 128 + 64 * mp + 32 * hi;
    const char* Kg = (const char*)(ws + WS_K) + (size_t)hh * NT * 128;
    const char* Vg = (const char*)(ws + WS_VT) + (size_t)hh * 128 * LDV;
    typedef int v4i_ __attribute__((ext_vector_type(4))); typedef int v8i_ __attribute__((ext_vector_type(8)));
    v8i_ qf[2];
#pragma unroll
    for (int q2 = 0; q2 < 2; ++q2) qf[q2] = __builtin_shufflevector(*(const v4i_*)(Qg + (size_t)q2 * 32 * 128), *(const v4i_*)(Qg + (size_t)q2 * 32 * 128 + 16), 0, 1, 2, 3, 4, 5, 6, 7);
    f32x16 O[2][4];
#pragma unroll
    for (int q2 = 0; q2 < 2; ++q2)
#pragma unroll
        for (int db = 0; db < 4; ++db)
#pragma unroll
            for (int r = 0; r < 16; ++r) O[q2][db][r] = 0.f;
    float lsum0 = 0.f, lsum1 = 0.f;
    const unsigned lds0 = (unsigned)(uintptr_t)lds;
    const int ki_ = 8 * wid + (lane >> 3), vi_ = 16 * wid + (lane >> 2);
    const unsigned ko_ = (unsigned)((32 * ((ki_ >> 2) & 1) + 16 * (ki_ >> 5) + (ki_ & 3) + 4 * ((ki_ & 31) >> 3)) * 128 + (((lane & 7) ^ ((ki_ >> 1) & 7)) << 4));
    const unsigned vo_ = (unsigned)(vi_ * LDV + (((lane & 3) ^ ((vi_ >> 2) & 3)) << 4));
#define ATT_DMA(t, buf) do { \
        glds16_s(Kg + (size_t)(t) * 8192, ko_, lds0 + AL_K + (buf) * AL_KSZ + wid * 1024); \
        glds16_s(Vg + (size_t)(t) * 64, vo_, lds0 + AL_V + (buf) * AL_VSZ + wid * 1024); } while (0)
    ATT_DMA(kt_lo, 0);
    asm volatile("s_waitcnt vmcnt(0)" ::: "memory");
    __syncthreads();
    asm volatile("" : "+v"(qf[0]), "+v"(qf[1]));
    if (wid >= 4) __builtin_amdgcn_s_setprio(1);
    int cur = 0;
    const int ksw = (4 * mp + 2 * hi) ^ ((r32 >> 1) & 7), vsw = (2 * hi) ^ ((r32 >> 2) & 3);
    for (int t = kt_lo; t < kt_hi; ++t) {
        if (t + 1 < kt_hi) ATT_DMA(t + 1, cur ^ 1);
        unsigned kb0 = (unsigned)(AL_K + cur * AL_KSZ + r32 * 128 + (ksw << 4)), vb0 = (unsigned)(AL_V + cur * AL_VSZ + r32 * 64 + (vsw << 4));
        asm volatile("" : "+v"(kb0), "+v"(vb0));
        v8i_ kf[2], pa[2];
#pragma unroll
        for (int kb = 0; kb < 2; ++kb) kf[kb] = __builtin_shufflevector(*(const LAS v4i_*)(lds + kb0 + kb * 4096), *(const LAS v4i_*)(lds + (kb0 ^ 16u) + kb * 4096), 0, 1, 2, 3, 4, 5, 6, 7);
#pragma unroll
        for (int q2 = 0; q2 < 2; ++q2) {
            f32x16 s[2];
#pragma unroll
            for (int kb = 0; kb < 2; ++kb) {
#pragma unroll
                for (int r = 0; r < 16; ++r) s[kb][r] = 0.f;
                s[kb] = __builtin_amdgcn_mfma_scale_f32_32x32x64_f8f6f4(kf[kb], qf[q2], s[kb], 0, 0, 0, 0, 0, 0);
            }
            float ls = 0.f;
#pragma unroll
            for (int kb = 0; kb < 2; ++kb)
#pragma unroll
                for (int r = 0; r < 16; ++r) { s[kb][r] = __builtin_amdgcn_exp2f(s[kb][r]); ls += s[kb][r]; }
            if (q2 == 0) lsum0 += ls; else lsum1 += ls;
#pragma unroll
            for (int kb = 0; kb < 2; ++kb)
#pragma unroll
                for (int w = 0; w < 4; ++w) { int p; asm volatile("" : "=v"(p)); p = __builtin_amdgcn_cvt_pk_bf8_f32(s[kb][4 * w], s[kb][4 * w + 1], p, false);        p = __builtin_amdgcn_cvt_pk_bf8_f32(s[kb][4 * w + 2], s[kb][4 * w + 3], p, true); pa[q2][4 * kb + w] = p; }
        }
        {
            v8i_ vcur = __builtin_shufflevector(*(const LAS v4i_*)(lds + vb0), *(const LAS v4i_*)(lds + (vb0 ^ 16u)), 0, 1, 2, 3, 4, 5, 6, 7);
#pragma unroll
            for (int db = 0; db < 4; ++db) {
                v8i_ vnext = vcur;
                if (db < 3) vnext = __builtin_shufflevector(*(const LAS v4i_*)(lds + vb0 + (db + 1) * 2048), *(const LAS v4i_*)(lds + (vb0 ^ 16u) + (db + 1) * 2048), 0, 1, 2, 3, 4, 5, 6, 7);
                O[0][db] = __builtin_amdgcn_mfma_scale_f32_32x32x64_f8f6f4(pa[0], vcur, O[0][db], 1, 0, 0, 0, 0, 0);
                O[1][db] = __builtin_amdgcn_mfma_scale_f32_32x32x64_f8f6f4(pa[1], vcur, O[1][db], 1, 0, 0, 0, 0, 0);
                vcur = vnext;
            }
        }
        asm volatile("s_waitcnt vmcnt(0)" ::: "memory");
        __syncthreads();
        cur ^= 1;
    }
#undef ATT_DMA
    __builtin_amdgcn_s_setprio(0);
    lsum0 += shx(lsum0, 32, lane); lsum1 += shx(lsum1, 32, lane);
    LAS float* wsf = (LAS float*)(lds + AL_WS + wid * 256);
    if (hi == 0) { wsf[r32] = (mp ? lam : 1.f) / lsum0; wsf[32 + r32] = (mp ? lam : 1.f) / lsum1; }
    LDS_WAIT();
    LAS float* X = (LAS float*)(lds + qg * 16384);
    const float* sg = P.in[I_SUBLN] + (size_t)layer * 128;
    LAS bf16* stg = (LAS bf16*)(lds + AL_OST + qg * 8192);
#pragma unroll
    for (int q2 = 0; q2 < 2; ++q2) {
        if (mp == 1) {
#pragma unroll
            for (int r = 0; r < 16; ++r) { const float a = wsf[32 * q2 + (r & 3) + 8 * (r >> 2) + 4 * hi];
#pragma unroll
                for (int db = 0; db < 4; ++db) X[(db * 16 + r) * 64 + lane] = O[q2][db][r] * a; }
        }
        __syncthreads();
        if (mp == 0) {
            float gsc[4];
#pragma unroll
            for (int db = 0; db < 4; ++db) gsc[db] = sg[32 * db + r32] * oscale;
#pragma unroll
            for (int r = 0; r < 16; ++r) {
                const int q = (r & 3) + 8 * (r >> 2) + 4 * hi;
                const float a0 = wsf[32 * q2 + q];
                float o[4], ss = 0.f;
#pragma unroll
                for (int db = 0; db < 4; ++db) { o[db] = O[q2][db][r] * a0 - X[(db * 16 + r) * 64 + lane]; ss += o[db] * o[db]; }
#pragma unroll
                for (int off = 1; off < 32; off <<= 1) ss += shx(ss, off, lane);
                const float rstd = __builtin_amdgcn_rsqf(ss * (1.f / 128.f) + EPS);
#pragma unroll
                for (int db = 0; db < 4; ++db) stg[q * 128 + 32 * db + r32] = (bf16)(pk2(o[db] * rstd * gsc[db], 0.f) & 0xffffu);
            }
            LDS_WAIT();
            bf16* Ow = (bf16*)(ws + WS_OAB) + (size_t)(qrow0 + 64 * qg + 32 * q2) * 512 + 128 * hh;
#pragma unroll
            for (int i = 0; i < 8; ++i) { const int row = 4 * i + (lane >> 4), ch = lane & 15;
                const v4u v = *(const LAS v4u*)(stg + row * 128 + ch * 8); *(v4u*)(Ow + (size_t)row * 512 + ch * 8) = v; }
        }
        __syncthreads();
    }
}

__device__ __forceinline__ void phase_mix(const Params& P, LAS unsigned char* lds, int layer, int G, bool with_ctx, int wv, int KINDS) {
    int tid_ = fresh_tid(wv);
    const int lane = tid_ & 63;
    const float* lq = P.in[I_LAMQK] + (size_t)layer * 4 * 64;
    const float s1 = wave_sum(lq[lane] * lq[64 + lane], lane), s2 = wave_sum(lq[128 + lane] * lq[192 + lane], lane);
    const float lam_init = __int_as_float(__builtin_amdgcn_readfirstlane(__float_as_int(0.8f - 0.6f * expf(-0.3f * (float)layer))));
    const float lam = __int_as_float(__builtin_amdgcn_readfirstlane(__float_as_int(expf(s1) - expf(s2) + lam_init)));
    if (KINDS & 1) {
        const int na = with_ctx ? 260 : 256;
#pragma unroll 1
        for (int u = blockIdx.x; u < na; u += G) {
            const int hh = (u < 256) ? ((u & 7) >> 1) : (u - 256), qt = (u < 256) ? (((u >> 3) << 1) | (u & 1)) : 64;
            attn_unit(P, lds, layer, hh, qt, lam, __int_as_float(__builtin_amdgcn_readfirstlane(__float_as_int(1.f - lam_init))), wv);
        }
    }
    if (KINDS & 2) {
        const int nh = with_ctx ? 260 : 256;
#pragma unroll 1
        for (int k = 0; ; ++k) {
            int v;
            if (G == 256) { const int c = (int)blockIdx.x; if (k == 0) v = c; else if (k == 1 && with_ctx && c >= 4 && c < 8) v = 252 + c; else break; }
            else { v = (int)blockIdx.x + k * G; if (v >= nh) break; }
            hgrn_unit2(P, lds, layer, v & 3, v >> 2, wv);
        }
    }
}

constexpr int RL_RW = 0, RL_TA = RW_IMG, RL_TB = RL_TA + 8192, RL_LOG = RL_TB + 8192, RL_INFO = RL_LOG + 80 * 33 * 4, RL_CNT = RL_INFO + 80 * 32, RL_BASE = RL_CNT + 128, RL_RSTD = RL_BASE + 128;
__device__ __forceinline__ void phase_router(const Params& P, LAS unsigned char* lds, int layer, int G, int nrows, int wv) {
    int tid_ = fresh_tid(wv);
    const int tid = tid_, lane = tid & 63, wave = __builtin_amdgcn_readfirstlane(tid >> 6);
    GAS unsigned char* wsg_ = (GAS unsigned char*)P.ws; asm volatile("" : "+s"(wsg_)); unsigned char* ws = (unsigned char*)wsg_;
    LAS float* TA = (LAS float*)(lds + RL_TA); LAS float* TB = (LAS float*)(lds + RL_TB); LAS float* LOG = (LAS float*)(lds + RL_LOG);
    LAS unsigned* INFO = (LAS unsigned*)(lds + RL_INFO); LAS unsigned* LCNT = (LAS unsigned*)(lds + RL_CNT); LAS unsigned* GBASE = (LAS unsigned*)(lds + RL_BASE); LAS float* RSTD = (LAS float*)(lds + RL_RSTD);
    { const unsigned lds0 = (unsigned)(uintptr_t)lds; const unsigned char* img = ws + WS_RWIMG + (size_t)layer * RW_IMG;
      for (int pc = wave; pc < RW_IMG / 1024; pc += NWAVES) glds16_s(img + (size_t)pc * 1024, (unsigned)lane * 16u, lds0 + RL_RW + pc * 1024); }
    for (int i = tid; i < 2048; i += NTHR) { const int w = i >> 10, j = i & 1023; const float* mv = modv_ptr(P, layer, w);
        TA[i] = P.in[I_N2G][(size_t)layer * D + j] * (1.f + mv[4096 + j]); TB[i] = mv[3072 + j]; }
    const bf16* xres = (const bf16*)(ws + WS_XRES);
    const float* rb = P.in[I_RB] + (size_t)layer * NE;
    unsigned* gcnt = (unsigned*)(ws + WS_CTL) + CW_CNT + layer * 32 * 16;
    unsigned* tokinfo = (unsigned*)(ws + WS_TOK);
    bf16* XS = (bf16*)(ws + WS_XS);
    const int RB = nrows / 256;
    asm volatile("s_waitcnt vmcnt(0)" ::: "memory");
    for (int blk = blockIdx.x; blk < 256; blk += G) {
#define RROW(r) ((r) < 64 ? 64 * blk + (r) : SEQ + blk)
        if (tid < 32) LCNT[tid] = 0u;
#pragma unroll 1
        for (int rl = wave; rl < RB; rl += NWAVES) {
            const bf16* xr = xres + (size_t)RROW(rl) * D;
            float ss = 0.f;
#pragma unroll
            for (int k = 0; k < 4; ++k) { const v2u xw = *(const v2u*)(xr + 4 * lane + 256 * k); const f32x4 x = {bflo(xw.x), bfhi(xw.x), bflo(xw.y), bfhi(xw.y)}; ss += (x.x * x.x + x.y * x.y) + (x.z * x.z + x.w * x.w); }
            ss = wave_sum(ss, lane);
            if (lane == 0) RSTD[rl] = __builtin_amdgcn_rsqf(ss * (1.f / D) + EPS);
        }
        __syncthreads();
        if (16 * wave < RB) {
            const int r16 = lane & 15, kq = lane >> 4, r = 16 * wave + r16, rc = r < RB ? r : RB - 1, row = RROW(rc), wsel = row >= SEQ;
            const float rstd = RSTD[rc];
            const bf16* xr = xres + (size_t)row * D + 8 * kq;
            const LAS float* ta = TA + 1024 * wsel + 8 * kq; const LAS float* tb = TB + 1024 * wsel + 8 * kq;
            const LAS unsigned char* bh = lds + RL_RW + r16 * RW_PITCH + 16 * kq;
            f32x4 acc0 = {0.f, 0.f, 0.f, 0.f}, acc1 = {0.f, 0.f, 0.f, 0.f};
#pragma unroll 4
            for (int ks = 0; ks < 32; ++ks) {
                const v4u xw = *(const v4u*)(xr + 32 * ks); const f32x4 x0 = {bflo(xw.x), bfhi(xw.x), bflo(xw.y), bfhi(xw.y)}, x1 = {bflo(xw.z), bfhi(xw.z), bflo(xw.w), bfhi(xw.w)};
                const f32x4 a0 = *(const LAS f32x4*)(ta + 32 * ks), a1 = *(const LAS f32x4*)(ta + 32 * ks + 4), b0 = *(const LAS f32x4*)(tb + 32 * ks), b1 = *(const LAS f32x4*)(tb + 32 * ks + 4);
                const f32x4 h0 = x0 * rstd * a0 + b0, h1 = x1 * rstd * a1 + b1;
                v4u hw, lw;
                hw.x = pk2(h0.x, h0.y); hw.y = pk2(h0.z, h0.w); hw.z = pk2(h1.x, h1.y); hw.w = pk2(h1.z, h1.w);
                lw.x = pk2(h0.x - bflo(hw.x), h0.y - bfhi(hw.x)); lw.y = pk2(h0.z - bflo(hw.y), h0.w - bfhi(hw.y)); lw.z = pk2(h1.x - bflo(hw.z), h1.y - bfhi(hw.z)); lw.w = pk2(h1.z - bflo(hw.w), h1.w - bfhi(hw.w));
                const bf16x8 ah = __builtin_bit_cast(bf16x8, hw), al = __builtin_bit_cast(bf16x8, lw);
                const bf16x8 wh0 = *(const LAS bf16x8*)(bh + 64 * ks), wh1 = *(const LAS bf16x8*)(bh + 16 * RW_PITCH + 64 * ks);
                const bf16x8 wl0 = *(const LAS bf16x8*)(bh + 32 * RW_PITCH + 64 * ks), wl1 = *(const LAS bf16x8*)(bh + 48 * RW_PITCH + 64 * ks);
                acc0 = __builtin_amdgcn_mfma_f32_16x16x32_bf16(ah, wh0, acc0, 0, 0, 0); acc0 = __builtin_amdgcn_mfma_f32_16x16x32_bf16(ah, wl0, acc0, 0, 0, 0); acc0 = __builtin_amdgcn_mfma_f32_16x16x32_bf16(al, wh0, acc0, 0, 0, 0);
                acc1 = __builtin_amdgcn_mfma_f32_16x16x32_bf16(ah, wh1, acc1, 0, 0, 0); acc1 = __builtin_amdgcn_mfma_f32_16x16x32_bf16(ah, wl1, acc1, 0, 0, 0); acc1 = __builtin_amdgcn_mfma_f32_16x16x32_bf16(al, wh1, acc1, 0, 0, 0);
            }
#pragma unroll
            for (int i = 0; i < 4; ++i) { const int rr = 16 * wave + 4 * kq + i; if (rr < RB) { LOG[rr * 33 + r16] = acc0[i]; LOG[rr * 33 + 16 + r16] = acc1[i]; } }
        }
        __syncthreads();
        if (tid < RB) {
            float p[NE];
#pragma unroll
            for (int e = 0; e < NE; ++e) p[e] = LOG[tid * 33 + e] + rb[e];
            float tv[4]; int ti[4];
#pragma unroll
            for (int k = 0; k < 4; ++k) { float best = -3.0e38f; int bi = 0;
#pragma unroll
                for (int e = 0; e < NE; ++e) { const bool gt = p[e] > best; best = gt ? p[e] : best; bi = gt ? e : bi; }
                tv[k] = best; ti[k] = bi;
#pragma unroll
                for (int e = 0; e < NE; ++e) p[e] = (e == bi) ? -3.0e38f : p[e]; }
            float wk[4], wsum = 0.f;
#pragma unroll
            for (int k = 0; k < 4; ++k) { wk[k] = expf(tv[k] - tv[0]); wsum += wk[k]; }
#pragma unroll
            for (int k = 0; k < 4; ++k) { const unsigned pos = __hip_atomic_fetch_add(&LCNT[ti[k]], 1u, __ATOMIC_RELAXED, __HIP_MEMORY_SCOPE_WORKGROUP); INFO[tid * 8 + 2 * k] = ((unsigned)ti[k] << 16) | pos; INFO[tid * 8 + 2 * k + 1] = __float_as_uint(wk[k] / wsum); }
        }
        __syncthreads();
        if (tid < 32) GBASE[tid] = __hip_atomic_fetch_add(gcnt + tid * 16, LCNT[tid], RLX_AGENT);
        __syncthreads();
#pragma unroll 1
        for (int rl = wave; rl < RB; rl += NWAVES) {
            const int row = RROW(rl), w = row >= SEQ;
            const bf16* xr = xres + (size_t)row * D + 16 * lane;
            const float rstd = RSTD[rl];
            v4u o8;
            {
                f32x4 v[4];
#pragma unroll
                for (int j = 0; j < 4; ++j) { const v2u xw = *(const v2u*)(xr + 4 * j); const f32x4 xv = {bflo(xw.x), bfhi(xw.x), bflo(xw.y), bfhi(xw.y)}; const f32x4 a = *(const LAS f32x4*)(TA + 1024 * w + 16 * lane + 4 * j), b = *(const LAS f32x4*)(TB + 1024 * w + 16 * lane + 4 * j); v[j] = xv * rstd * a + b; }
                o8.x = pk_fp8x4(v[0].x, v[0].y, v[0].z, v[0].w); o8.y = pk_fp8x4(v[1].x, v[1].y, v[1].z, v[1].w); o8.z = pk_fp8x4(v[2].x, v[2].y, v[2].z, v[2].w); o8.w = pk_fp8x4(v[3].x, v[3].y, v[3].z, v[3].w);
            }
#pragma unroll
            for (int k = 0; k < 4; ++k) {
                const unsigned ep = INFO[rl * 8 + 2 * k], wb = INFO[rl * 8 + 2 * k + 1];
                const unsigned e = ep >> 16, slot = GBASE[e] + (ep & 0xffffu);
                unsigned char* dst = (unsigned char*)XS + ((size_t)e * CAP + slot) * D + 16 * lane;
                *(v4u*)dst = o8;
                if (lane == 0) { v4u ti4; ti4.x = e; ti4.y = slot; ti4.z = wb; ti4.w = 0u; *(v4u*)(tokinfo + (size_t)row * 16 + 4 * k) = ti4; }
            }
        }
        __syncthreads();
#undef RROW
    }
}

template <bool DRY>
__device__ __forceinline__ void phase_combine(const Params& P, LAS unsigned char* lds, int layer, int G, int nrows, int wv) {
    int tid_ = fresh_tid(wv);
    const int tid = tid_, lane = tid & 63, wave = tid >> 6;
    GAS unsigned char* wsg_ = (GAS unsigned char*)P.ws; asm volatile("" : "+s"(wsg_)); unsigned char* ws = (unsigned char*)wsg_;
    const bool last = (layer == DEPTH - 1);
    LAS float* TA = (LAS float*)lds; LAS float* TB = (LAS float*)(lds + 8192); LAS float* TG = (LAS float*)(lds + 16384);
    for (int i = tid; i < 2048; i += NTHR) { const int w = i >> 10, j = i & 1023;
        TG[i] = modv_ptr(P, layer, w)[5120 + j];
        if (!last) { const float* mv = modv_ptr(P, layer + 1, w); TA[i] = P.in[I_N1G][(size_t)(layer + 1) * D + j] * (1.f + mv[1024 + j]); TB[i] = mv[j]; } }
    __syncthreads();
    bf16* xres = (bf16*)(ws + WS_XRES);
    bf16* xdst = DRY ? (bf16*)(ws + WS_HDN) : xres;
    const unsigned* tokinfo = (const unsigned*)(ws + WS_TOK);
    const bf16* Y = (const bf16*)(ws + WS_XS);
    bf16* H = DRY ? (bf16*)(ws + WS_HDN + (size_t)NT * D * 4) : (bf16*)(ws + WS_H);
#pragma unroll 2
    for (int row = blockIdx.x * NWAVES + wave; row < nrows; row += G * NWAVES) {
        const int w = row >= SEQ;
        f32x4 acc[4];
#pragma unroll
        for (int j = 0; j < 4; ++j) acc[j] = (f32x4){0.f, 0.f, 0.f, 0.f};
#pragma unroll
        for (int k = 0; k < 4; ++k) {
            const v4u ti4 = *(const v4u*)(tokinfo + (size_t)row * 16 + 4 * k);
            const float wk = __uint_as_float(ti4.z);
            const bf16* yr = Y + ((size_t)ti4.x * CAP + ti4.y) * D + 4 * lane;
#pragma unroll
            for (int j = 0; j < 4; ++j) { const v2u yv = *(const v2u*)(yr + 256 * j); acc[j] += wk * (f32x4){bflo(yv.x), bfhi(yv.x), bflo(yv.y), bfhi(yv.y)}; }
        }
        const bf16* xr = xres + (size_t)row * D + 4 * lane;
        f32x4 v[4];
#pragma unroll
        for (int j = 0; j < 4; ++j) { const v2u xw = *(const v2u*)(xr + 256 * j); v[j] = (f32x4){bflo(xw.x), bfhi(xw.x), bflo(xw.y), bfhi(xw.y)} + *(const LAS f32x4*)(TG + 1024 * w + 4 * lane + 256 * j) * acc[j]; }
        if (last) {
            float* orow = (DRY ? (float*)xdst : P.out) + (size_t)row * D + 4 * lane;
#pragma unroll
            for (int j = 0; j < 4; ++j) *(f32x4*)(orow + 256 * j) = v[j];
        } else {
#pragma unroll
            for (int j = 0; j < 4; ++j) { v2u o; o.x = pk2(v[j].x, v[j].y); o.y = pk2(v[j].z, v[j].w); *(v2u*)(xdst + (size_t)row * D + 4 * lane + 256 * j) = o; }
            norm_store_row(v, TA + 1024 * w, TB + 1024 * w, (unsigned char*)H + (size_t)row * D, lane);
        }
    }
}
#define XB_TMO      128
#define XB_XCNT(j)  (256  + 64 * (j))
#define XB_XSUB(j)  (1280 + 64 * (j))
#define XB_XGEN(j)  (2304 + 64 * (j))
#define XB_TOP      3328
#define XB_TOPGEN   3392
#define XCD_BAR_WORDS 3456
#define XB_SPIN_CAP (1u << 18)

__device__ __forceinline__ unsigned xb_ld(unsigned* p)              { return __hip_atomic_load(p, __ATOMIC_RELAXED, __HIP_MEMORY_SCOPE_AGENT); }
__device__ __forceinline__ unsigned xb_add(unsigned* p, unsigned v) { return __hip_atomic_fetch_add(p, v, __ATOMIC_RELAXED, __HIP_MEMORY_SCOPE_AGENT); }
__device__ __forceinline__ unsigned xb_xcc_id() { return (unsigned)__builtin_amdgcn_s_getreg((3 << 11) | 20) & 0xFu; }
#define XB_SPIN(cond, bar) do { unsigned _sp = 0; while (cond) { __builtin_amdgcn_s_sleep(1); \
    if ((++_sp & 255u) == 0u) { if (xb_ld(&(bar)[XB_TMO])) break; if (_sp > XB_SPIN_CAP) { atomicAdd(&(bar)[XB_TMO], 1u); break; } } } } while (0)

struct XcdBarrier {
    int wv; unsigned* bar; unsigned x;
    volatile LAS unsigned* st;
};

__device__ __forceinline__ XcdBarrier xcd_barrier_post(unsigned* bar, volatile LAS unsigned* st, int wv) {
    XcdBarrier b; b.wv = wv; b.bar = bar; b.x = xb_xcc_id(); b.st = st;
    if (fresh_tid(wv) == 0) (void)xb_add(&bar[XB_XCNT(b.x)], 1u);
    return b;
}
__device__ __forceinline__ void xcd_barrier_complete(unsigned* bar, unsigned x, unsigned& nloc, unsigned& nx) {
    const unsigned G = gridDim.x * gridDim.y * gridDim.z;
    unsigned sum, cnt, mine, sp = 0u;
    for (;;) {
        sum = 0u; cnt = 0u; mine = 0u;
#pragma unroll
        for (unsigned j = 0; j < 16; ++j) { const unsigned c = xb_ld(&bar[XB_XCNT(j)]); sum += c; cnt += (c > 0u) ? 1u : 0u; mine = (j == x) ? c : mine; }
        if (sum == G) break;
        __builtin_amdgcn_s_sleep(1);
        if ((++sp & 255u) == 0u) { if (xb_ld(&bar[XB_TMO])) break; if (sp > XB_SPIN_CAP) { atomicAdd(&bar[XB_TMO], 1u); break; } }
    }
    nloc = mine > 0u ? mine : 1u; nx = cnt > 0u ? cnt : 1u;
}

__device__ __forceinline__ void xcd_barrier(const XcdBarrier& b) {
    asm volatile("s_waitcnt vmcnt(0)" ::: "memory");
    __syncthreads();
    if (fresh_tid(b.wv) == 0) {
        unsigned* bar = b.bar;
        __builtin_amdgcn_s_waitcnt(0);
        unsigned nloc = b.st[0], nx = b.st[1];
        if (nloc == 0u) { xcd_barrier_complete(bar, b.x, nloc, nx); b.st[0] = nloc; b.st[1] = nx; }
        const unsigned old = xb_add(&bar[XB_XSUB(b.x)], 1u);
        const unsigned gen = old / nloc;
        if (old + 1u == (gen + 1u) * nloc) {
            __builtin_amdgcn_fence(__ATOMIC_RELEASE, "agent");
            asm volatile("s_waitcnt vmcnt(0)" ::: "memory");
            const unsigned og = xb_add(&bar[XB_TOP], 1u);
            const unsigned tg = og / nx;
            if (og + 1u == (tg + 1u) * nx) xb_add(&bar[XB_TOPGEN], 1u);
            else XB_SPIN(xb_ld(&bar[XB_TOPGEN]) == tg, bar);
            __builtin_amdgcn_fence(__ATOMIC_ACQUIRE, "agent");
            xb_add(&bar[XB_XGEN(b.x)], 1u);
            asm volatile("s_waitcnt vmcnt(0)" ::: "memory");
        } else {
            XB_SPIN(xb_ld(&bar[XB_XGEN(b.x)]) == gen, bar);
            __builtin_amdgcn_fence(__ATOMIC_ACQUIRE, "agent");
            asm volatile("s_waitcnt vmcnt(0)" ::: "memory");
        }
    }
    __syncthreads();
}


__global__ void __launch_bounds__(NTHR, 2) fwd_kernel(Params P) {
    extern __shared__ __attribute__((aligned(16))) unsigned char lds_raw[];
    LAS unsigned char* lds = (LAS unsigned char*)lds_raw;
    volatile LAS unsigned* MISC = (volatile LAS unsigned*)(lds + MISC_OFF);
    const int wv = __builtin_amdgcn_readfirstlane((int)(threadIdx.x >> 6)), G = gridDim.x;
#define tid fresh_tid(wv)
    unsigned char* ws = P.ws;
    unsigned* ctl = (unsigned*)(ws + WS_CTL);
    if (tid < 64) MISC[tid] = 0u;
    __syncthreads();
#if MK_ONE_LAUNCH
    XcdBarrier bar = xcd_barrier_post(ctl + CW_BAR, MISC + 8, wv);
#define GRID_BAR() xcd_barrier(bar)
#else
#define GRID_BAR() do {} while (0)
#endif
    const int lo = P.ph_lo, hi = P.ph_hi;
#ifndef PHM
#define PHM 0x3FFF
#endif
#define IN(k) (lo <= (k) && (k) < hi)
#define EN(b) ((PHM >> (b)) & 1)
#ifdef PROBE_PH
    unsigned long long* stamps = (unsigned long long*)(ws + WS_CTL + 512 * 1024);
#define STAMP(k) do { if (blockIdx.x == 0 && tid == 0) stamps[k] = __builtin_amdgcn_s_memrealtime(); } while (0)
#else
#define STAMP(k) do {} while (0)
#endif
    STAMP(0);
#define SEAM(k) do { int lo_ = lo, hi_ = hi; asm volatile("" : "+s"(lo_), "+s"(hi_));     \
        if (lo_ <= (k) && (k) + 1 < hi_) GRID_BAR(); STAMP((k) + 1); } while (0)

    constexpr int BG_A = 5120, BG_D = 8192, BG_E = 6656;
#ifndef DUP_PH
#define DUP_PH -1
#endif
#define DUPQ(t) (DUP_PH == (t))
    if (EN(12) && IN(0)) { phase_p0a(P, lds, G, wv); if (DUPQ(10)) { GRID_BAR(); phase_p0a(P, lds, G, wv); } SEAM(0); }
    if (EN(13) && IN(1)) { phase_p0b(P, lds, G, wv); SEAM(1); }

    for (int l = 0; l < DEPTH; ++l) {
        const int pb = NPH_PRO + NPH_LAYER * l;
        const bool last = (l == DEPTH - 1);
        const int nrows = last ? SEQ : NT;
        bf16* H = (bf16*)(ws + WS_H);
        if (EN(0) && IN(pb + 0)) {
            GAS unsigned char* wsg_ = (GAS unsigned char*)P.ws; asm volatile("" : "+s"(wsg_)); unsigned char* ws = (unsigned char*)wsg_;
            for (int rep = 0; rep < (DUPQ(0) ? 2 : 1); ++rep) {
            if (rep) GRID_BAR();
            { pg8::Gemm g{H, (const bf16*)(ws + WS_WIN + l * WIN_L), NT, 5632, D / 2};        int c1 = (int)blockIdx.x; asm volatile("" : "+s"(c1)); pg8::StaticOrder S; S.init(NT, 5632, G, c1);
              EpiInProj E{(bf16*)(ws + WS_Q), (bf16*)(ws + WS_K), (bf16*)(ws + WS_PROJ), P.in[I_QNG] + l * 64, P.in[I_KNG] + l * 64, (const float*)(ws + WS_ROPE), ws + WS_IMG, (const float*)(ws + WS_LB) + (size_t)l * 512};
              pg8::gemm_phase<EpiInProj, pg8::StaticOrder, true, true>(lds, g, S, E, wv); }
            { pg8::Gemm g{(const bf16*)(ws + WS_WV + l * WV_L), H, 512, NT, D / 2}; int c2 = (G == 256) ? ((int)blockIdx.x >= 150 ? (int)blockIdx.x - 150 : (1 << 20)) : (int)blockIdx.x, g2 = (G == 256) ? 106 : G; asm volatile("" : "+s"(c2));
              pg8::StaticOrder S; S.init(512, NT, g2, c2);
              EpiVt E{(bf16*)(ws + WS_VT)};
              pg8::gemm_phase<EpiVt, pg8::StaticOrder, true, true>(lds, g, S, E, wv); }
            }
            if (!last && G == 256) { const int c = (int)blockIdx.x; __syncthreads(); if (c >= 24) convert_items(P, lds, PER_L * (l + 1), PER_L * (l + 1) + BG_A, c - 24, 232, wv); }
            SEAM(pb + 0);
        }
        if (EN(2) && IN(pb + 2)) { phase_hgrn1(P, lds, l, G, wv); if (DUPQ(1)) { GRID_BAR(); phase_hgrn1(P, lds, l, G, wv); } SEAM(pb + 2); }
        if (EN(3) && IN(pb + 3)) { phase_hgrn_chain(P, G, wv); if (DUPQ(2)) { GRID_BAR(); phase_hgrn_chain(P, G, wv); } SEAM(pb + 3); }
        if (EN(4) && IN(pb + 4)) {
#pragma unroll 1
            for (int rep = 0; rep < ((DUPQ(31) || DUPQ(32)) ? 2 : 1); ++rep) { if (rep) GRID_BAR(); phase_mix(P, lds, l, G, !last, wv, rep == 0 ? 3 : (DUPQ(31) ? 1 : 2)); }
            if (!last && G == 256) { const int c = (int)blockIdx.x; __syncthreads(); if (c >= 8) convert_items(P, lds, PER_L * (l + 1) + BG_A, PER_L * (l + 1) + BG_A + BG_D, c - 8, 248, wv); }
            SEAM(pb + 4); }
        if (EN(5) && IN(pb + 5)) {
            GAS unsigned char* wsg_ = (GAS unsigned char*)P.ws; asm volatile("" : "+s"(wsg_)); unsigned char* ws = (unsigned char*)wsg_;
            pg8::Gemm g{(const bf16*)(ws + WS_OAB), (const bf16*)(ws + WS_WAB + l * WAB_L), 2 * NT, 2048, 512};
            pg8::MergeOrder S{nrows / 256, G, (int)blockIdx.x};
            EpiMerge E{(const bf16*)(ws + WS_PROJ), (bf16*)(ws + WS_U)};
            pg8::gemm_phase<EpiMerge, pg8::MergeOrder, true, true>(lds, g, S, E, wv);
            if (DUPQ(50)) { GRID_BAR(); pg8::gemm_phase<EpiMerge, pg8::MergeOrder, true, true>(lds, g, S, E, wv); }
            if (!last && G == 256) { const int c = (int)blockIdx.x; __syncthreads(); if (!((c & 7) == 0 && c < 32)) { const int nb = (c + 7) >> 3; convert_items(P, lds, PER_L * (l + 1) + BG_A + BG_D, PER_L * (l + 1) + BG_A + BG_D + BG_E, c - (nb < 4 ? nb : 4), 252, wv); } }
            SEAM(pb + 5);
        }
        if (EN(6) && IN(pb + 6)) {
            GAS unsigned char* wsg_ = (GAS unsigned char*)P.ws; asm volatile("" : "+s"(wsg_)); unsigned char* ws = (unsigned char*)wsg_;
            pg8::Gemm g{(const bf16*)(ws + WS_U), (const bf16*)(ws + WS_WO + l * WO_L), nrows, D, D}; pg8::StaticOrder S; S.init(nrows, D, G, (int)blockIdx.x);
            EpiOut E{(const bf16*)(ws + WS_XRES), (bf16*)(ws + WS_XRES), modv_ptr(P, l, 0) + 2048, modv_ptr(P, l, 1) + 2048};
            if (DUPQ(6)) { EpiOut E2 = E; E2.xres = (bf16*)(ws + WS_HDN); pg8::gemm_phase<EpiOut, pg8::StaticOrder, true, true>(lds, g, S, E2, wv); GRID_BAR(); }
            pg8::gemm_phase<EpiOut, pg8::StaticOrder, true, true>(lds, g, S, E, wv);
            if (!last && G == 256) { const int c = (int)blockIdx.x; __syncthreads(); if (c >= 4) convert_items(P, lds, PER_L * (l + 1) + BG_A + BG_D + BG_E, PER_L * (l + 2), c - 4, 252, wv); }
            SEAM(pb + 6);
        }
        if (EN(7) && IN(pb + 7)) {
#pragma unroll 1
            for (int rep = 0; rep < (DUPQ(7) ? 2 : 1); ++rep) {
                if (rep) { GRID_BAR(); if (blockIdx.x == 0 && tid < 32) __hip_atomic_store(ctl + CW_CNT + l * 32 * 16 + tid * 16, 0u, RLX_AGENT); GRID_BAR(); }
                phase_router(P, lds, l, G, nrows, wv); }
            SEAM(pb + 7); }
        if ((EN(8) && IN(pb + 8)) || (EN(9) && IN(pb + 9))) {
            GAS unsigned char* wsg_ = (GAS unsigned char*)P.ws; asm volatile("" : "+s"(wsg_)); unsigned char* ws = (unsigned char*)wsg_;
            LAS unsigned* utab8 = (LAS unsigned*)(lds + 131072); LAS unsigned* utab4 = utab8 + 32; LAS int* ptab = (LAS int*)(utab8 + 64);
            { const int t_ = tid;
              if (t_ == 0) { const unsigned* gcnt = ctl + CW_CNT + l * 32 * 16; int run = 0;
                  for (int e = 0; e < NE; ++e) { ptab[e] = run; run += (int)((__hip_atomic_load(gcnt + e * 16, RLX_AGENT) + 255u) >> 8); } ptab[32] = run; }
              __syncthreads();
              if (t_ < 64) { const int i = t_ & 31, lg = (t_ < 32) ? 3 : 2; const int c_ = (int)blockIdx.x;
                  int tr, pn;
                  if ((G & 63) == 0) { const int x = c_ & 7, q = c_ >> 3, per = (G >> 3) >> lg, R = (ptab[32] + 8 * per - 1) / (8 * per);
                      pn = q & ((1 << lg) - 1); tr = (x * R + i) * per + (q >> lg); if (i >= R) tr = 1 << 20; }
                  else { const int L = i * G + c_; tr = L >> lg; pn = L & ((1 << lg) - 1); }
                  unsigned v = 0xffffffffu;
                  if (tr < ptab[32]) { int e = 0; for (int j = 1; j < 32; ++j) e = (tr >= ptab[j]) ? j : e; v = ((unsigned)(65 * e + (tr - ptab[e])) << 16) | (unsigned)((e << lg) + pn); }
                  (t_ < 32 ? utab8 : utab4)[i] = v; }
              __syncthreads(); }
            if (EN(8) && IN(pb + 8)) {
                pg8::Gemm g{(const bf16*)(ws + WS_XS), (const bf16*)(ws + WS_WGU + l * WGU_L), NE * CAP, NE * 2048, D / 2};
                pg8::MoeOrder S{utab8};
                EpiSwiglu E{(bf16*)(ws + WS_HDN), P.in[I_BGU] + (size_t)l * NE * 2048};
                pg8::gemm_phase<EpiSwiglu, pg8::MoeOrder, true, true>(lds, g, S, E, wv);
                if (DUPQ(8)) { GRID_BAR(); pg8::gemm_phase<EpiSwiglu, pg8::MoeOrder, true, true>(lds, g, S, E, wv); }
                SEAM(pb + 8);
            }
            if (EN(9) && IN(pb + 9)) {
                pg8::Gemm g{(const bf16*)(ws + WS_HDN), (const bf16*)(ws + WS_WD + l * WD_L), NE * CAP, NE * 1024, DFF / 2};
                pg8::MoeOrder S{utab4};
                EpiDown E{(bf16*)(ws + WS_XS), P.in[I_BDN] + (size_t)l * NE * D};
                pg8::gemm_phase<EpiDown, pg8::MoeOrder, true, true>(lds, g, S, E, wv);
                if (DUPQ(9)) { GRID_BAR(); pg8::gemm_phase<EpiDown, pg8::MoeOrder, true, true>(lds, g, S, E, wv); }
                SEAM(pb + 9);
            }
        }
        if (EN(10) && IN(pb + 10)) { if (DUPQ(11)) { phase_combine<true>(P, lds, l, G, nrows, wv); GRID_BAR(); } phase_combine<false>(P, lds, l, G, nrows, wv); SEAM(pb + 10); }
    }
#ifdef PROBE_PH
    if (blockIdx.x == 0 && tid == 0) {
        unsigned long long tot = 0;
        for (int k = 0; k < NPHASES; ++k) { const int ty = k < 2 ? 12 + k : (k - 2) % 11; if (ty == PROBE_PH || PROBE_PH == 99) tot += stamps[k + 1] - stamps[k]; }
        *(float*)(ws + WS_CTL + 768 * 1024) = 1.f + (float)tot * (1.f / 10000.f);
    }
    GRID_BAR();
    { const float sc = 1.f + *(const float*)(ws + WS_CTL + 768 * 1024);
      for (size_t i = (size_t)blockIdx.x * NTHR + tid; i < (size_t)SEQ * D; i += (size_t)G * NTHR) P.out[i] *= sc; }
#endif
#undef tid
#undef IN
#undef EN
#undef SEAM
#undef GRID_BAR
}

extern "C" void kernel_launch(void* const* d_in, const int* in_sizes, int n_in, void* d_out, int out_size, void* d_ws, size_t ws_size, hipStream_t stream) {
    static int grid = 0;
    if (grid == 0) {
        if (n_in != 24 || out_size != SEQ * D || ws_size < WS_END3) { fprintf(stderr, "kernel_launch: unexpected shapes (n_in %d, out %d, ws %zu < %zu)\n", n_in, out_size, ws_size, (size_t)WS_END3); grid = -1; return; }
        int dev = 0, cus = 0;
        if (hipGetDevice(&dev) != hipSuccess || hipDeviceGetAttribute(&cus, hipDeviceAttributeMultiprocessorCount, dev) != hipSuccess) { grid = -1; return; }
        if (hipFuncSetAttribute((const void*)fwd_kernel, hipFuncAttributeMaxDynamicSharedMemorySize, LDS_BYTES) != hipSuccess) { fprintf(stderr, "kernel_launch: hipFuncSetAttribute failed\n"); grid = -1; return; }
        int per_cu = 0;
        if (hipOccupancyMaxActiveBlocksPerMultiprocessor(&per_cu, (const void*)fwd_kernel, NTHR, LDS_BYTES) != hipSuccess || per_cu < 1) fprintf(stderr, "kernel_launch: occupancy query reports %d\n", per_cu);
        (void)hipGetLastError();
        grid = cus;
    }
    if (grid < 0) return;
    (void)hipMemsetAsync((char*)d_ws + WS_CTL, 0, CTL_ZERO_BYTES, stream);
    Params p{};
    for (int i = 0; i < 24; ++i) p.in[i] = (const float*)d_in[i];
    p.out = (float*)d_out; p.ws = (unsigned char*)d_ws;
#if MK_ONE_LAUNCH
    p.ph_lo = 0; p.ph_hi = NPHASES;
    hipLaunchKernelGGL(fwd_kernel, dim3(grid), dim3(NTHR), LDS_BYTES, stream, p);
#else
    for (int k = 0; k < NPHASES; ++k) { p.ph_lo = k; p.ph_hi = k + 1; hipLaunchKernelGGL(fwd_kernel, dim3(grid), dim3(NTHR), LDS_BYTES, stream, p); }
#endif
}
```
